# Optimizing an MI355X kernel written in HIP

```python
import math
import jax
import jax.numpy as jnp
from jax import lax
import numpy as np


D_MODEL = 1024
BATCH = 16
SEQ = 2048
DEPTH = 1

MIX_WIDTH = D_MODEL
HEAD_DIM = 64
ATT_WIDTH = MIX_WIDTH // 2
ATT_HEADS = ATT_WIDTH // HEAD_DIM
IDX_HEADS = 4
IDX_DIM = HEAD_DIM
TOPK_MAX = 256
Q_BLOCK = 128
ROPE_THETA = 10000.0
INDEXER_SCALE = (IDX_HEADS ** -0.5) * (IDX_DIM ** -0.5)
SSD_WIDTH = MIX_WIDTH - ATT_WIDTH
SSD_HEAD_DIM = 64
SSD_HEADS = SSD_WIDTH // SSD_HEAD_DIM
SSD_GROUPS = 2
D_STATE = 64
CONV_WIDTH = 4
CONV_CH = SSD_WIDTH + 2 * SSD_GROUPS * D_STATE
CHUNK = 128
N_GROUPS_MOE = 4
EXPERTS_PER_GROUP = 4
N_EXPERTS = N_GROUPS_MOE * EXPERTS_PER_GROUP
TOP_K_IN_GROUP = 2
EXPERT_FF = 256
ALPHA = (2 * DEPTH) ** 0.25
BETA = (8 * DEPTH) ** -0.25
LN_EPS = 1e-5
IN_SPLIT_SIZES = (ATT_WIDTH, HEAD_DIM, HEAD_DIM, IDX_HEADS * IDX_DIM, IDX_DIM, IDX_HEADS, SSD_WIDTH, CONV_CH, SSD_HEADS)
IN_WIDTH = sum(IN_SPLIT_SIZES)
IN_SPLIT_POINTS = tuple(int(v) for v in np.cumsum(IN_SPLIT_SIZES)[:-1])

kernel_name = 'hybrid_dsa_ssd_hmoe_deepnorm'


def layer_norm(x, g, b):
    xf = x.astype(jnp.float32)
    mu = jnp.mean(xf, -1, keepdims=True)
    var = jnp.mean(jnp.square(xf - mu), -1, keepdims=True)
    return ((xf - mu) * lax.rsqrt(var + LN_EPS)).astype(x.dtype) * g + b


def rope_tables(seq_len):
    inv = ROPE_THETA ** (-jnp.arange(0, HEAD_DIM, 2, dtype=jnp.float32) / HEAD_DIM)
    ang = jnp.arange(seq_len, dtype=jnp.float32)[:, None] * inv[None, :]
    return jnp.cos(ang), jnp.sin(ang)


def apply_rope(x, cos, sin):
    half = x.shape[-1] // 2
    x1, x2 = x[..., :half], x[..., half:]
    cos = cos.astype(x.dtype)
    sin = sin.astype(x.dtype)
    return jnp.concatenate([x1 * cos - x2 * sin, x1 * sin + x2 * cos], -1)


def dsa_attention(q, k, v, iq, ik, iw, topk):
    bsz, s, h, dh = q.shape
    n_blocks = s // Q_BLOCK
    key_pos = jnp.arange(s)

    def block(i):
        t0 = i * Q_BLOCK
        qb = lax.dynamic_slice_in_dim(q, t0, Q_BLOCK, 1)
        iqb = lax.dynamic_slice_in_dim(iq, t0, Q_BLOCK, 1)
        iwb = lax.dynamic_slice_in_dim(iw, t0, Q_BLOCK, 1)
        qpos = t0 + jnp.arange(Q_BLOCK)
        causal = key_pos[None, :] <= qpos[:, None]
        sc = jax.nn.relu(jnp.einsum('bthd,bsd->bths', iqb, ik))
        sc = jnp.einsum('bths,bth->bts', sc, iwb).astype(jnp.float32)
        sc = jnp.where(causal[None], sc, -jnp.inf)
        _, sel = lax.top_k(sc, topk)
        valid = sel <= qpos[None, :, None]
        k_sel = jax.vmap(lambda a, idx: a[idx])(k, sel)
        v_sel = jax.vmap(lambda a, idx: a[idx])(v, sel)
        logits = jnp.einsum('bthd,btkd->bthk', qb, k_sel).astype(jnp.float32) * (dh ** -0.5)
        logits = jnp.where(valid[:, :, None, :], logits, -jnp.inf)
        p = jax.nn.softmax(logits, -1).astype(v.dtype)
        return jnp.einsum('bthk,btkd->bthd', p, v_sel)

    out = lax.map(block, jnp.arange(n_blocks))
    return jnp.moveaxis(out, 0, 1).reshape(bsz, s, h * dh)


def causal_depthwise_conv(u, w, b):
    out = lax.conv_general_dilated(
        u, w[:, None, :].astype(u.dtype), window_strides=(1,),
        padding=[(CONV_WIDTH - 1, 0)], dimension_numbers=('NWC', 'WIO', 'NWC'),
        feature_group_count=u.shape[-1])
    return out + b


def segsum(a):
    t = a.shape[-1]
    ar = jnp.broadcast_to(a[..., :, None], a.shape + (t,))
    strict = jnp.tril(jnp.ones((t, t), dtype=bool), -1)
    cs = jnp.cumsum(jnp.where(strict, ar, 0.0), axis=-2)
    return jnp.where(jnp.tril(jnp.ones((t, t), dtype=bool)), cs, -jnp.inf)


def ssd_chunked(xdt, adt, bm, cm):
    b, s, h, p = xdt.shape
    n = bm.shape[-1]
    c = s // CHUNK
    X = xdt.reshape(b, c, CHUNK, h, p)
    Bc = bm.reshape(b, c, CHUNK, h, n)
    Cc = cm.reshape(b, c, CHUNK, h, n)
    A = adt.reshape(b, c, CHUNK, h).transpose(0, 3, 1, 2)
    a_cum = jnp.cumsum(A, -1)
    Lmat = jnp.exp(segsum(A))
    y_diag = jnp.einsum('bclhn,bcshn,bhcls,bcshp->bclhp', Cc, Bc, Lmat, X)
    decay_states = jnp.exp(a_cum[..., -1:] - a_cum)
    chunk_states = jnp.einsum('bclhn,bhcl,bclhp->bchpn', Bc, decay_states, X)
    chunk_decay = jnp.exp(a_cum[..., -1])

    def step(carry, inp):
        st, dec = inp
        return carry * dec[..., None, None] + st, carry

    init = jnp.zeros((b, h, p, n), X.dtype)
    _, prev = lax.scan(step, init, (jnp.moveaxis(chunk_states, 1, 0), jnp.moveaxis(chunk_decay, 2, 0)))
    prev = jnp.moveaxis(prev, 0, 1)
    y_off = jnp.einsum('bclhn,bchpn,bhcl->bclhp', Cc, prev, jnp.exp(a_cum))
    return (y_diag + y_off).reshape(b, s, h, p)


def ssd_mixer(z, xbc, dt_raw, conv_w, conv_b, dt_bias, a_log, d_skip, norm_w):
    bsz, s, _ = xbc.shape
    f32 = jnp.float32
    xbc = jax.nn.silu(causal_depthwise_conv(xbc, conv_w, conv_b))
    gn = SSD_GROUPS * D_STATE
    xs = xbc[..., :SSD_WIDTH].reshape(bsz, s, SSD_HEADS, SSD_HEAD_DIM).astype(f32)
    bm = xbc[..., SSD_WIDTH:SSD_WIDTH + gn].reshape(bsz, s, SSD_GROUPS, D_STATE)
    cm = xbc[..., SSD_WIDTH + gn:].reshape(bsz, s, SSD_GROUPS, D_STATE)
    rep = SSD_HEADS // SSD_GROUPS
    bm = jnp.repeat(bm, rep, axis=2).astype(f32)
    cm = jnp.repeat(cm, rep, axis=2).astype(f32)
    dt = jax.nn.softplus(dt_raw.astype(f32) + dt_bias.astype(f32))
    a = -jnp.exp(a_log.astype(f32))
    y = ssd_chunked(xs * dt[..., None], dt * a, bm, cm)
    y = y + d_skip.astype(f32)[:, None] * xs
    y = y.reshape(bsz, s, SSD_WIDTH) * jax.nn.silu(z.astype(f32))
    y = y * lax.rsqrt(jnp.mean(jnp.square(y), -1, keepdims=True) + LN_EPS)
    return y.astype(z.dtype) * norm_w


def hier_moe(h, w_rg, b_rg, w_re, b_re, w_gate, w_up, w_down):
    bsz, s, _ = h.shape
    f32 = jnp.float32
    p_group = jax.nn.softmax((h @ w_rg + b_rg).astype(f32), -1)
    g_idx = jnp.argmax(p_group, -1)
    g_prob = jnp.max(p_group, -1)
    e_logits = (h @ w_re + b_re).astype(f32).reshape(bsz, s, N_GROUPS_MOE, EXPERTS_PER_GROUP)
    e_in_group = jnp.take_along_axis(e_logits, g_idx[..., None, None], axis=2)[..., 0, :]
    top_logits, top_idx = lax.top_k(e_in_group, TOP_K_IN_GROUP)
    top_w = jax.nn.softmax(top_logits, -1) * g_prob[..., None]
    expert_id = g_idx[..., None] * EXPERTS_PER_GROUP + top_idx
    gates = jnp.sum(jax.nn.one_hot(expert_id, N_EXPERTS, dtype=f32) * top_w[..., None], axis=-2).astype(h.dtype)
    y = jnp.zeros_like(h)
    for e in range(N_EXPERTS):
        hid = jax.nn.silu(h @ w_gate[e]) * (h @ w_up[e])
        y = y + gates[..., e:e + 1] * (hid @ w_down[e])
    return y


def setup_inputs(seed: int = 0) -> dict:
    key = jax.random.key(seed)
    ks = jax.random.split(key, 21)
    f32 = jnp.float32

    def nrm(k, shape, scale):
        return jax.random.normal(k, shape, f32) * scale

    x = nrm(ks[0], (BATCH, SEQ, D_MODEL), 1.0)
    w_in = nrm(ks[1], (DEPTH, D_MODEL, IN_WIDTH), D_MODEL ** -0.5)
    conv_w = nrm(ks[2], (DEPTH, CONV_WIDTH, CONV_CH), CONV_WIDTH ** -0.5)
    conv_b = nrm(ks[3], (DEPTH, CONV_CH), 0.02)
    dt0 = jnp.exp(jax.random.uniform(ks[4], (DEPTH, SSD_HEADS), f32, math.log(1e-3), math.log(1e-1)))
    dt_bias = dt0 + jnp.log(-jnp.expm1(-dt0))
    a_log = jnp.log(jax.random.uniform(ks[5], (DEPTH, SSD_HEADS), f32, 1.0, 16.0))
    d_skip = 1.0 + nrm(ks[6], (DEPTH, SSD_HEADS), 0.1)
    ssd_norm_w = 1.0 + nrm(ks[7], (DEPTH, SSD_WIDTH), 0.05)
    w_out = nrm(ks[8], (DEPTH, MIX_WIDTH, D_MODEL), (MIX_WIDTH ** -0.5) * BETA)
    ln1_g = 1.0 + nrm(ks[9], (DEPTH, D_MODEL), 0.05)
    ln1_b = nrm(ks[10], (DEPTH, D_MODEL), 0.02)
    w_route_group = nrm(ks[11], (DEPTH, D_MODEL, N_GROUPS_MOE), D_MODEL ** -0.5)
    b_route_group = nrm(ks[12], (DEPTH, N_GROUPS_MOE), 0.01)
    w_route_expert = nrm(ks[13], (DEPTH, D_MODEL, N_EXPERTS), D_MODEL ** -0.5)
    b_route_expert = nrm(ks[14], (DEPTH, N_EXPERTS), 0.01)
    w_gate = nrm(ks[15], (DEPTH, N_EXPERTS, D_MODEL, EXPERT_FF), D_MODEL ** -0.5)
    w_up = nrm(ks[16], (DEPTH, N_EXPERTS, D_MODEL, EXPERT_FF), D_MODEL ** -0.5)
    w_down = nrm(ks[17], (DEPTH, N_EXPERTS, EXPERT_FF, D_MODEL), (EXPERT_FF ** -0.5) * BETA)
    ln2_g = 1.0 + nrm(ks[18], (DEPTH, D_MODEL), 0.05)
    ln2_b = nrm(ks[19], (DEPTH, D_MODEL), 0.02)
    return {'x': x, 'w_in': w_in, 'conv_w': conv_w, 'conv_b': conv_b, 'dt_bias': dt_bias,
            'a_log': a_log, 'd_skip': d_skip, 'ssd_norm_w': ssd_norm_w, 'w_out': w_out,
            'ln1_g': ln1_g, 'ln1_b': ln1_b, 'w_route_group': w_route_group,
            'b_route_group': b_route_group, 'w_route_expert': w_route_expert,
            'b_route_expert': b_route_expert, 'w_gate': w_gate, 'w_up': w_up,
            'w_down': w_down, 'ln2_g': ln2_g, 'ln2_b': ln2_b}


def reference(x, w_in, conv_w, conv_b, dt_bias, a_log, d_skip, ssd_norm_w, w_out, ln1_g, ln1_b,
              w_route_group, b_route_group, w_route_expert, b_route_expert, w_gate, w_up,
              w_down, ln2_g, ln2_b):
    bsz, s, _ = x.shape
    topk = min(TOPK_MAX, s // 4)
    cos, sin = rope_tables(s)
    cos_h, sin_h = cos[:, None, :], sin[:, None, :]
    for l in range(DEPTH):
        proj = jnp.einsum('bsd,de->bse', x, w_in[l])
        q, k, v, iq, ik, iw, z, xbc, dt_raw = jnp.split(proj, IN_SPLIT_POINTS, axis=-1)
        q = apply_rope(q.reshape(bsz, s, ATT_HEADS, HEAD_DIM), cos_h, sin_h)
        k = apply_rope(k, cos, sin)
        iq = apply_rope(iq.reshape(bsz, s, IDX_HEADS, IDX_DIM), cos_h, sin_h)
        ik = apply_rope(ik, cos, sin)
        att = dsa_attention(q, k, v, iq, ik, iw * INDEXER_SCALE, topk)
        ssd = ssd_mixer(z, xbc, dt_raw, conv_w[l], conv_b[l], dt_bias[l], a_log[l],
                        d_skip[l], ssd_norm_w[l])
        mixed = jnp.einsum('bse,ed->bsd', jnp.concatenate([att, ssd], -1), w_out[l])
        x = layer_norm(ALPHA * x + mixed, ln1_g[l], ln1_b[l])
        ffn = hier_moe(x, w_route_group[l], b_route_group[l], w_route_expert[l],
                       b_route_expert[l], w_gate[l], w_up[l], w_down[l])
        x = layer_norm(ALPHA * x + ffn, ln2_g[l], ln2_b[l])
    return x
```

```cpp
#include <hip/hip_runtime.h>
#include <hip/hip_cooperative_groups.h>
#include <cstdio>
#include <cstdint>
namespace cg = cooperative_groups;

constexpr int BATCH = 16, SEQ = 2048, DM = 1024, M = BATCH * SEQ;
constexpr int INW = 2252;
constexpr int C_Q = 0, C_K = 512, C_V = 576, C_IQ = 640, C_IK = 896, C_IW = 960, C_Z = 964, C_XBC = 1476, C_DT = 2244;
constexpr int NEXP = 16, EFF = 256;
constexpr float LN_EPS = 1e-5f;
constexpr float ALPHA = 1.189207115002721f;
constexpr float INDEXER_SCALE = 0.0625f;
constexpr float QSCALE = 0.125f * 1.4426950408889634f;
constexpr int TOPK = 256;
constexpr int NT = 512;
constexpr int LDS_BYTES = 147456;

constexpr size_t MiB = 1u << 20;
constexpr size_t WS_CTL = 0, CTL_BYTES = 1 * MiB;
constexpr size_t WS_ROPE = 1 * MiB;
constexpr size_t WS_TOKW = 2 * MiB;
constexpr size_t WS_LISTS = 3 * MiB;
constexpr size_t WS_Q = 48 * MiB;
constexpr size_t WS_K = 80 * MiB, WS_V = 84 * MiB, WS_IK = 88 * MiB;
constexpr size_t WS_IW = 92 * MiB;
constexpr size_t WS_DT = 93 * MiB;
constexpr size_t WS_IQ = 96 * MiB;
constexpr size_t WS_Z = 112 * MiB;
constexpr size_t WS_XBC = 144 * MiB;
constexpr size_t WS_AS = 192 * MiB;
constexpr size_t WS_X1 = 256 * MiB;
constexpr size_t WS_X1B = 384 * MiB;
constexpr size_t WS_Y0 = 48 * MiB, WS_Y1 = 112 * MiB;
constexpr size_t WS_P32 = 224 * MiB;
constexpr size_t WS_XC = 256 * MiB;
constexpr size_t WS_YG = 352 * MiB;
constexpr size_t WS_END = 512 * MiB;
constexpr int CW_CNT = 64;

typedef unsigned short bf16;
typedef float f32x4 __attribute__((ext_vector_type(4)));
typedef unsigned u32x4 __attribute__((ext_vector_type(4)));
typedef unsigned u32x2 __attribute__((ext_vector_type(2)));

__device__ __forceinline__ float bf2f(bf16 v) { return __uint_as_float((unsigned)v << 16); }
__device__ __forceinline__ bf16 f2bf(float f) { unsigned u = __float_as_uint(f); return (bf16)((u + 0x7fffu + ((u >> 16) & 1u)) >> 16); }
__device__ __forceinline__ float silu(float v) { return v / (1.f + __expf(-v)); }
__device__ __forceinline__ float wave_sum(float v) {
#pragma unroll
    for (int o = 1; o < 64; o <<= 1) v += __shfl_xor(v, o);
    return v;
}
__device__ __forceinline__ float wave_max(float v) {
#pragma unroll
    for (int o = 1; o < 64; o <<= 1) v = fmaxf(v, __shfl_xor(v, o));
    return v;
}
__device__ __forceinline__ unsigned sortkey(float f) { unsigned u = __float_as_uint(f); return (u & 0x80000000u) ? ~u : (u | 0x80000000u); }

struct Params {
    const float* x; const float* w_in; const float* conv_w; const float* conv_b; const float* dt_bias; const float* a_log; const float* d_skip;
    const float* ssd_norm_w; const float* w_out; const float* ln1_g; const float* ln1_b; const float* w_rg; const float* b_rg; const float* w_re; const float* b_re;
    const float* w_gate; const float* w_up; const float* w_down; const float* ln2_g; const float* ln2_b;
    float* out; unsigned char* ws;
};

template <class AL, class EP>
__device__ __forceinline__ void naive_gemm(float* lds, int Mr, int N, int K, const float* B, int ldb, AL aload, EP epi) {
    constexpr int TM = 128, TN = 64, TK = 32, AS = TM + 4, BS = TN + 4;
    float* As = lds;
    float* Bs = lds + TK * AS;
    const int tid = threadIdx.x, ty = tid >> 4, tx = tid & 15;
    const int tm = Mr / TM, tn = (N + TN - 1) / TN;
    for (int tile = blockIdx.x; tile < tm * tn; tile += gridDim.x) {
        const int row0 = (tile / tn) * TM, col0 = (tile % tn) * TN;
        float acc[4][4];
#pragma unroll
        for (int i = 0; i < 4; ++i)
#pragma unroll
            for (int j = 0; j < 4; ++j) acc[i][j] = 0.f;
        for (int k0 = 0; k0 < K; k0 += TK) {
#pragma unroll
            for (int i = 0; i < 8; ++i) { const int e = tid + NT * i, r = e >> 5, kk = e & 31; As[kk * AS + r] = aload(row0 + r, k0 + kk); }
#pragma unroll
            for (int i = 0; i < 4; ++i) { const int e = tid + NT * i, kk = e >> 6, c = e & 63; Bs[kk * BS + c] = (col0 + c < N) ? B[(size_t)(k0 + kk) * ldb + col0 + c] : 0.f; }
            __syncthreads();
#pragma unroll 8
            for (int kk = 0; kk < TK; ++kk) {
                const f32x4 a = *(const f32x4*)(As + kk * AS + ty * 4), b = *(const f32x4*)(Bs + kk * BS + tx * 4);
#pragma unroll
                for (int i = 0; i < 4; ++i)
#pragma unroll
                    for (int j = 0; j < 4; ++j) acc[i][j] = fmaf(a[i], b[j], acc[i][j]);
            }
            __syncthreads();
        }
#pragma unroll
        for (int i = 0; i < 4; ++i)
#pragma unroll
            for (int j = 0; j < 4; ++j) { const int c = col0 + tx * 4 + j; if (c < N) epi(row0 + ty * 4 + i, c, acc[i][j]); }
    }
}

__device__ __forceinline__ unsigned wave_select(const unsigned (&keys)[32], int kk, int lane) {
    unsigned T = 0u;
    for (int bit = 31; bit >= 0; --bit) {
        const unsigned cand = T | (1u << bit);
        int c = 0;
#pragma unroll
        for (int i = 0; i < 32; ++i) c += (keys[i] >= cand) ? 1 : 0;
#pragma unroll
        for (int o = 1; o < 64; o <<= 1) c += __shfl_xor(c, o);
        if (c >= kk) T = cand;
    }
    unsigned mgt = 0u, meq = 0u;
#pragma unroll
    for (int i = 0; i < 32; ++i) { mgt |= (keys[i] > T) ? (1u << i) : 0u; meq |= (keys[i] == T) ? (1u << i) : 0u; }
    int ngt = __popc(mgt), neq = __popc(meq);
    int tgt = ngt, teq = neq;
#pragma unroll
    for (int o = 1; o < 64; o <<= 1) { tgt += __shfl_xor(tgt, o); teq += __shfl_xor(teq, o); }
    const int need = kk - tgt;
    if (teq == need) return mgt | meq;
    int pre = neq;
#pragma unroll
    for (int o = 1; o < 64; o <<= 1) { const int v = __shfl_up(pre, o); if (lane >= o) pre += v; }
    pre -= neq;
    unsigned sel = mgt; int taken = pre;
#pragma unroll
    for (int i = 0; i < 32; ++i) { if ((meq >> i) & 1u) { if (taken < need) sel |= (1u << i); ++taken; } }
    return sel;
}

__global__ void __launch_bounds__(NT, 2) hybrid_fwd(Params p) {
    extern __shared__ __attribute__((aligned(16))) unsigned char lds[];
    cg::grid_group grid = cg::this_grid();
    const int tid = threadIdx.x, lane = tid & 63, wave = tid >> 6;
    const int G = gridDim.x, bid = blockIdx.x;
    const int gw = bid * 8 + wave, NGW = G * 8;
    unsigned char* ws = p.ws;
    unsigned* ctl = (unsigned*)(ws + WS_CTL);
    float2* rope = (float2*)(ws + WS_ROPE);
    float* tokw = (float*)(ws + WS_TOKW);
    int* lists = (int*)(ws + WS_LISTS);
    bf16* Qb = (bf16*)(ws + WS_Q); bf16* Kb = (bf16*)(ws + WS_K); bf16* Vb = (bf16*)(ws + WS_V); bf16* IKb = (bf16*)(ws + WS_IK);
    float* IW = (float*)(ws + WS_IW); float* DT = (float*)(ws + WS_DT);
    bf16* IQb = (bf16*)(ws + WS_IQ); bf16* Zb = (bf16*)(ws + WS_Z); bf16* XBC = (bf16*)(ws + WS_XBC);
    bf16* ASb = (bf16*)(ws + WS_AS); float* X1 = (float*)(ws + WS_X1); bf16* X1b = (bf16*)(ws + WS_X1B);
    bf16* Y0 = (bf16*)(ws + WS_Y0); bf16* Y1 = (bf16*)(ws + WS_Y1);
    float* P32 = (float*)(ws + WS_P32); float* XC = (float*)(ws + WS_XC); float* YG = (float*)(ws + WS_YG);

    for (int e = bid * NT + tid; e < SEQ * 32; e += G * NT) {
        const int t = e >> 5, i = e & 31;
        const float inv = powf(10000.0f, -(float)(2 * i) / 64.0f);
        const float ang = (float)t * inv;
        float s, c; sincosf(ang, &s, &c);
        rope[e] = make_float2(c, s);
    }
    {
        const float* x = p.x;
        naive_gemm((float*)lds, M, INW, DM, p.w_in, INW,
                   [&](int r, int k) { return x[(size_t)r * DM + k]; },
                   [&](int r, int c, float v) { P32[(size_t)r * INW + c] = v; });
    }
    grid.sync();
    for (int row = bid; row < M; row += G) {
        const float* pr = P32 + (size_t)row * INW;
        const int t = row & (SEQ - 1);
        if (tid < 448) {
            const int hd = tid >> 5, i = tid & 31;
            int base; bf16* dst; float sc = 1.f;
            if (hd < 8) { base = C_Q + hd * 64; dst = Qb + (size_t)row * 512 + hd * 64; sc = QSCALE; }
            else if (hd == 8) { base = C_K; dst = Kb + (size_t)row * 64; }
            else if (hd < 13) { base = C_IQ + (hd - 9) * 64; dst = IQb + (size_t)row * 256 + (hd - 9) * 64; }
            else { base = C_IK; dst = IKb + (size_t)row * 64; }
            const float x1 = pr[base + i], x2 = pr[base + i + 32];
            const float2 cs = rope[t * 32 + i];
            dst[i] = f2bf((x1 * cs.x - x2 * cs.y) * sc);
            dst[i + 32] = f2bf((x1 * cs.y + x2 * cs.x) * sc);
        } else {
            const int u = tid - 448;
            Vb[(size_t)row * 64 + u] = f2bf(pr[C_V + u]);
            if (u < 4) IW[(size_t)row * 4 + u] = pr[C_IW + u] * INDEXER_SCALE;
            if (u < 8) DT[(size_t)row * 8 + u] = pr[C_DT + u];
        }
        for (int c = tid; c < 512; c += NT) Zb[(size_t)row * 512 + c] = f2bf(pr[C_Z + c]);
        for (int c = tid; c < 768; c += NT) XBC[(size_t)row * 768 + c] = f2bf(pr[C_XBC + c]);
    }
    grid.sync();
    for (int e = bid * NT + tid; e < M * 768; e += G * NT) {
        const int row = e / 768, c = e - row * 768, t = row & (SEQ - 1);
        float a = p.conv_b[c];
#pragma unroll
        for (int j = 0; j < 4; ++j) { const int tt = t - 3 + j; if (tt >= 0) a = fmaf(p.conv_w[j * 768 + c], bf2f(XBC[(size_t)(row - 3 + j) * 768 + c]), a); }
        XC[e] = silu(a);
    }
    grid.sync();
    {
        float* xs = (float*)lds;
        float* Bs = xs + 4096;
        float* Cs = Bs + 4096;
        float* ys = Cs + 4096;
        float* dts = ys + 4096;
        for (int item = bid; item < BATCH * 8; item += G) {
            const int b = item >> 3, h = item & 7, g = h >> 2;
            const float A = -__expf(p.a_log[h]), dtb = p.dt_bias[h], Dh = p.d_skip[h];
            const int pp = tid >> 3, ng = tid & 7;
            float H[8];
#pragma unroll
            for (int j = 0; j < 8; ++j) H[j] = 0.f;
            for (int t0 = 0; t0 < SEQ; t0 += 64) {
                const size_t rbase = (size_t)b * SEQ + t0;
                for (int e = tid; e < 4096; e += NT) { const int tt = e >> 6, c = e & 63; const float* xr = XC + (rbase + tt) * 768;
                    xs[e] = xr[h * 64 + c]; Bs[e] = xr[512 + g * 64 + c]; Cs[e] = xr[640 + g * 64 + c]; }
                if (tid < 64) { const float v = DT[(rbase + tid) * 8 + h] + dtb; dts[tid] = (v > 20.f) ? v : log1pf(__expf(v)); }
                __syncthreads();
                for (int tt = 0; tt < 64; ++tt) {
                    const float dt = dts[tt], dA = __expf(dt * A), xdt = xs[tt * 64 + pp] * dt;
                    float part = 0.f;
#pragma unroll
                    for (int j = 0; j < 8; ++j) { H[j] = fmaf(H[j], dA, xdt * Bs[tt * 64 + ng * 8 + j]); part = fmaf(Cs[tt * 64 + ng * 8 + j], H[j], part); }
                    part += __shfl_xor(part, 1); part += __shfl_xor(part, 2); part += __shfl_xor(part, 4);
                    if (ng == 0) ys[tt * 64 + pp] = part;
                }
                __syncthreads();
                for (int e = tid; e < 4096; e += NT) { const int tt = e >> 6, c = e & 63;
                    const float z = bf2f(Zb[(rbase + tt) * 512 + h * 64 + c]);
                    const float y = (ys[e] + Dh * xs[e]) * silu(z);
                    YG[(rbase + tt) * 512 + h * 64 + c] = y; }
                __syncthreads();
            }
        }
    }
    {
        float* iqs = (float*)lds;
        float* qs = iqs + 256;
        unsigned* keys = (unsigned*)(qs + 512);
        int* sel = (int*)(keys + 2048);
        float* pbuf = (float*)(sel + 256);
        float* misc = pbuf + 2048;
        for (int qi = bid; qi < M; qi += G) {
            const int b = qi >> 11, t = qi & (SEQ - 1);
            const size_t rb = (size_t)b * SEQ;
            if (tid < 256) iqs[tid] = bf2f(IQb[(size_t)qi * 256 + tid]);
            qs[tid] = bf2f(Qb[(size_t)qi * 512 + tid]);
            if (tid < 4) misc[tid] = IW[(size_t)qi * 4 + tid];
            __syncthreads();
            const float w0 = misc[0], w1 = misc[1], w2 = misc[2], w3 = misc[3];
            for (int s = tid; s < SEQ; s += NT) {
                unsigned key = 0u;
                if (s <= t) {
                    const bf16* kr = IKb + (rb + s) * 64;
                    float d0 = 0.f, d1 = 0.f, d2 = 0.f, d3 = 0.f;
                    for (int d = 0; d < 64; ++d) { const float kv = bf2f(kr[d]); d0 = fmaf(iqs[d], kv, d0); d1 = fmaf(iqs[64 + d], kv, d1); d2 = fmaf(iqs[128 + d], kv, d2); d3 = fmaf(iqs[192 + d], kv, d3); }
                    float sc = w0 * fmaxf(d0, 0.f); sc = fmaf(w1, fmaxf(d1, 0.f), sc); sc = fmaf(w2, fmaxf(d2, 0.f), sc); sc = fmaf(w3, fmaxf(d3, 0.f), sc);
                    key = sortkey(sc);
                }
                keys[s] = key;
            }
            __syncthreads();
            const int kk = (t + 1 < TOPK) ? (t + 1) : TOPK;
            if (wave == 0) {
                unsigned kr[32];
#pragma unroll
                for (int i = 0; i < 32; ++i) kr[i] = keys[lane * 32 + i];
                const unsigned m = wave_select(kr, kk, lane);
                int cnt = __popc(m), pre = cnt;
#pragma unroll
                for (int o = 1; o < 64; o <<= 1) { const int v = __shfl_up(pre, o); if (lane >= o) pre += v; }
                pre -= cnt;
                for (int i = 0; i < 32; ++i) if ((m >> i) & 1u) { sel[pre++] = lane * 32 + i; }
            }
            __syncthreads();
            {
                const int h = wave;
                float lg[4]; float mx = -INFINITY;
#pragma unroll
                for (int j4 = 0; j4 < 4; ++j4) {
                    const int j = lane + 64 * j4; lg[j4] = -INFINITY;
                    if (j < kk) { const bf16* kr = Kb + (rb + sel[j]) * 64; float d = 0.f;
                        for (int dd = 0; dd < 64; ++dd) d = fmaf(qs[h * 64 + dd], bf2f(kr[dd]), d);
                        lg[j4] = d; }
                    mx = fmaxf(mx, lg[j4]);
                }
                mx = wave_max(mx);
                float sum = 0.f;
#pragma unroll
                for (int j4 = 0; j4 < 4; ++j4) { const int j = lane + 64 * j4; const float pv = (j < kk) ? exp2f(lg[j4] - mx) : 0.f; sum += pv; pbuf[h * 256 + j] = pv; }
                sum = wave_sum(sum);
                float o = 0.f;
                for (int j = 0; j < kk; ++j) o = fmaf(pbuf[h * 256 + j], bf2f(Vb[(rb + sel[j]) * 64 + lane]), o);
                ASb[(size_t)qi * 1024 + h * 64 + lane] = f2bf(o / sum);
            }
            __syncthreads();
        }
    }
    grid.sync();
    for (int row = gw; row < M; row += NGW) {
        const float* yr = YG + (size_t)row * 512;
        float v[8]; float ss = 0.f;
#pragma unroll
        for (int j = 0; j < 8; ++j) { v[j] = yr[lane + 64 * j]; ss = fmaf(v[j], v[j], ss); }
        ss = wave_sum(ss);
        const float r = rsqrtf(ss * (1.f / 512.f) + LN_EPS);
#pragma unroll
        for (int j = 0; j < 8; ++j) ASb[(size_t)row * 1024 + 512 + lane + 64 * j] = f2bf(v[j] * r * p.ssd_norm_w[lane + 64 * j]);
    }
    grid.sync();
    {
        const float* x = p.x;
        naive_gemm((float*)lds, M, DM, DM, p.w_out, DM,
                   [&](int r, int k) { return bf2f(ASb[(size_t)r * DM + k]); },
                   [&](int r, int c, float v) { X1[(size_t)r * DM + c] = fmaf(ALPHA, x[(size_t)r * DM + c], v); });
    }
    grid.sync();
    for (int row = gw; row < M; row += NGW) {
        float* xr = X1 + (size_t)row * DM;
        f32x4 v[4]; float s = 0.f;
#pragma unroll
        for (int j = 0; j < 4; ++j) { v[j] = *(const f32x4*)(xr + lane * 4 + 256 * j); s += (v[j][0] + v[j][1]) + (v[j][2] + v[j][3]); }
        const float mean = wave_sum(s) * (1.f / DM); float s2 = 0.f;
#pragma unroll
        for (int j = 0; j < 4; ++j) { v[j] = v[j] - mean; s2 += (v[j][0] * v[j][0] + v[j][1] * v[j][1]) + (v[j][2] * v[j][2] + v[j][3] * v[j][3]); }
        const float rstd = rsqrtf(wave_sum(s2) * (1.f / DM) + LN_EPS);
        float lg[20];
#pragma unroll
        for (int i = 0; i < 20; ++i) lg[i] = 0.f;
#pragma unroll
        for (int j = 0; j < 4; ++j) {
            const int c0 = lane * 4 + 256 * j;
            const f32x4 gg = *(const f32x4*)(p.ln1_g + c0), bb = *(const f32x4*)(p.ln1_b + c0);
            v[j] = v[j] * rstd * gg + bb;
            *(f32x4*)(xr + c0) = v[j];
            u32x2 w; w.x = (unsigned)f2bf(v[j][0]) | ((unsigned)f2bf(v[j][1]) << 16); w.y = (unsigned)f2bf(v[j][2]) | ((unsigned)f2bf(v[j][3]) << 16);
            *(u32x2*)(X1b + (size_t)row * DM + c0) = w;
#pragma unroll
            for (int e = 0; e < 4; ++e) {
                const float xv = v[j][e];
                const f32x4 wg = *(const f32x4*)(p.w_rg + (size_t)(c0 + e) * 4);
#pragma unroll
                for (int i = 0; i < 4; ++i) lg[i] = fmaf(xv, wg[i], lg[i]);
#pragma unroll
                for (int q = 0; q < 4; ++q) { const f32x4 we = *(const f32x4*)(p.w_re + (size_t)(c0 + e) * 16 + q * 4);
#pragma unroll
                    for (int i = 0; i < 4; ++i) lg[4 + q * 4 + i] = fmaf(xv, we[i], lg[4 + q * 4 + i]); }
            }
        }
#pragma unroll
        for (int i = 0; i < 20; ++i) lg[i] = wave_sum(lg[i]);
        if (lane == 0) {
            float gl[4]; int gi = 0; float gm = -INFINITY;
#pragma unroll
            for (int i = 0; i < 4; ++i) { gl[i] = lg[i] + p.b_rg[i]; if (gl[i] > gm) { gm = gl[i]; gi = i; } }
            float gs = 0.f;
#pragma unroll
            for (int i = 0; i < 4; ++i) gs += __expf(gl[i] - gm);
            const float gprob = 1.f / gs;
            float el[4];
#pragma unroll
            for (int i = 0; i < 4; ++i) { float v0 = 0.f;
#pragma unroll
                for (int g2 = 0; g2 < 4; ++g2) if (g2 == gi) v0 = lg[4 + g2 * 4 + i] + p.b_re[g2 * 4 + i];
                el[i] = v0; }
            int i0 = 0; float m0 = el[0];
#pragma unroll
            for (int i = 1; i < 4; ++i) if (el[i] > m0) { m0 = el[i]; i0 = i; }
            int i1 = -1; float m1 = -INFINITY;
#pragma unroll
            for (int i = 0; i < 4; ++i) if (i != i0 && el[i] > m1) { m1 = el[i]; i1 = i; }
            const float e1 = __expf(m1 - m0), inv = 1.f / (1.f + e1);
            const float w0 = inv * gprob, w1 = e1 * inv * gprob;
            const int ex0 = gi * 4 + i0, ex1 = gi * 4 + i1;
            const unsigned s0 = atomicAdd(&ctl[CW_CNT + ex0], 1u), s1 = atomicAdd(&ctl[CW_CNT + ex1], 1u);
            lists[(size_t)ex0 * M + s0] = row * 2; lists[(size_t)ex1 * M + s1] = row * 2 + 1;
            tokw[row * 2] = w0; tokw[row * 2 + 1] = w1;
        }
    }
    grid.sync();
    {
        bf16* xs = (bf16*)lds;
        float* hid = (float*)(lds + 65536);
        int* ent = (int*)(lds + 65536 + 32768);
        float* ew = (float*)(ent + 32);
        int tiles_pre[NEXP + 1]; tiles_pre[0] = 0;
#pragma unroll
        for (int e = 0; e < NEXP; ++e) tiles_pre[e + 1] = tiles_pre[e] + (int)((__hip_atomic_load(&ctl[CW_CNT + e], __ATOMIC_RELAXED, __HIP_MEMORY_SCOPE_AGENT) + 31u) >> 5);
        const int total = tiles_pre[NEXP];
        for (int item = bid; item < total; item += G) {
            int e = 0;
#pragma unroll
            for (int i = 1; i < NEXP; ++i) if (item >= tiles_pre[i]) e = i;
            int tbase = 0, cnt_e = 0;
#pragma unroll
            for (int i = 0; i < NEXP; ++i) if (i == e) { tbase = tiles_pre[i]; cnt_e = (int)__hip_atomic_load(&ctl[CW_CNT + i], __ATOMIC_RELAXED, __HIP_MEMORY_SCOPE_AGENT); }
            const int off = (item - tbase) * 32, n = min(32, cnt_e - off);
            if (tid < 32) { const int en = (tid < n) ? lists[(size_t)e * M + off + tid] : -1; ent[tid] = en; ew[tid] = (en >= 0) ? tokw[en] : 0.f; }
            __syncthreads();
            for (int i = 0; i < 32; ++i) { const int en = ent[i];
                for (int c = tid; c < 512; c += NT) { const unsigned v = (en >= 0) ? ((const unsigned*)(X1b + (size_t)(en >> 1) * DM))[c] : 0u; ((unsigned*)xs)[i * 512 + c] = v; } }
            __syncthreads();
            {
                const int j = tid & 255, hf = tid >> 8;
                const float* wg = p.w_gate + (size_t)e * DM * EFF + j; const float* wu = p.w_up + (size_t)e * DM * EFF + j;
                float ag[16], au[16];
#pragma unroll
                for (int i = 0; i < 16; ++i) { ag[i] = 0.f; au[i] = 0.f; }
                for (int k = 0; k < DM; ++k) {
                    const float g = wg[(size_t)k * EFF], u = wu[(size_t)k * EFF];
#pragma unroll
                    for (int i = 0; i < 16; ++i) { const float xv = bf2f(xs[(hf * 16 + i) * DM + k]); ag[i] = fmaf(xv, g, ag[i]); au[i] = fmaf(xv, u, au[i]); }
                }
#pragma unroll
                for (int i = 0; i < 16; ++i) hid[(hf * 16 + i) * EFF + j] = silu(ag[i]) * au[i];
            }
            __syncthreads();
            for (int cc = 0; cc < 2; ++cc) {
                const int c = tid + NT * cc;
                const float* wd = p.w_down + (size_t)e * EFF * DM + c;
                float acc[32];
#pragma unroll
                for (int i = 0; i < 32; ++i) acc[i] = 0.f;
                for (int k = 0; k < EFF; ++k) { const float w = wd[(size_t)k * DM];
#pragma unroll
                    for (int i = 0; i < 32; ++i) acc[i] = fmaf(hid[i * EFF + k], w, acc[i]); }
#pragma unroll
                for (int i = 0; i < 32; ++i) { const int en = ent[i]; if (en >= 0) { bf16* Y = (en & 1) ? Y1 : Y0; Y[(size_t)(en >> 1) * DM + c] = f2bf(acc[i] * ew[i]); } }
            }
            __syncthreads();
        }
    }
    grid.sync();
    for (int row = gw; row < M; row += NGW) {
        const float* xr = X1 + (size_t)row * DM;
        f32x4 v[4]; float s = 0.f;
#pragma unroll
        for (int j = 0; j < 4; ++j) { const int c0 = lane * 4 + 256 * j; v[j] = *(const f32x4*)(xr + c0) * ALPHA;
            const u32x2 a = *(const u32x2*)(Y0 + (size_t)row * DM + c0), b = *(const u32x2*)(Y1 + (size_t)row * DM + c0);
            v[j][0] += __uint_as_float(a.x << 16) + __uint_as_float(b.x << 16); v[j][1] += __uint_as_float(a.x & 0xffff0000u) + __uint_as_float(b.x & 0xffff0000u);
            v[j][2] += __uint_as_float(a.y << 16) + __uint_as_float(b.y << 16); v[j][3] += __uint_as_float(a.y & 0xffff0000u) + __uint_as_float(b.y & 0xffff0000u);
            s += (v[j][0] + v[j][1]) + (v[j][2] + v[j][3]); }
        const float mean = wave_sum(s) * (1.f / DM); float s2 = 0.f;
#pragma unroll
        for (int j = 0; j < 4; ++j) { v[j] = v[j] - mean; s2 += (v[j][0] * v[j][0] + v[j][1] * v[j][1]) + (v[j][2] * v[j][2] + v[j][3] * v[j][3]); }
        const float rstd = rsqrtf(wave_sum(s2) * (1.f / DM) + LN_EPS);
#pragma unroll
        for (int j = 0; j < 4; ++j) { const int c0 = lane * 4 + 256 * j;
            const f32x4 gg = *(const f32x4*)(p.ln2_g + c0), bb = *(const f32x4*)(p.ln2_b + c0);
            *(f32x4*)(p.out + (size_t)row * DM + c0) = v[j] * rstd * gg + bb; }
    }
}

extern "C" void kernel_launch(void* const* d_in, const int* in_sizes, int n_in, void* d_out, int out_size, void* d_ws, size_t ws_size, hipStream_t stream) {
    static int grid = 0;
    if (grid == 0) {
        if (n_in != 20 || in_sizes[0] != M * DM || out_size != M * DM || ws_size < WS_END) { fprintf(stderr, "kernel_launch: unexpected shapes (n_in %d, in0 %d, out %d, ws %zu)\n", n_in, n_in > 0 ? in_sizes[0] : -1, out_size, ws_size); grid = -1; return; }
        int dev = 0, cus = 0, per_cu = 0;
        (void)hipGetDevice(&dev);
        (void)hipDeviceGetAttribute(&cus, hipDeviceAttributeMultiprocessorCount, dev);
        (void)hipFuncSetAttribute((const void*)hybrid_fwd, hipFuncAttributeMaxDynamicSharedMemorySize, LDS_BYTES);
        (void)hipOccupancyMaxActiveBlocksPerMultiprocessor(&per_cu, (const void*)hybrid_fwd, NT, LDS_BYTES);
        if (per_cu < 1) { fprintf(stderr, "kernel_launch: occupancy query says %d blocks/CU\n", per_cu); grid = -1; return; }
        grid = cus;
    }
    if (grid < 0) return;
    (void)hipMemsetAsync((char*)d_ws + WS_CTL, 0, CTL_BYTES, stream);
    Params p{};
    const float** f = (const float**)&p;
    for (int i = 0; i < 20; ++i) f[i] = (const float*)d_in[i];
    p.out = (float*)d_out; p.ws = (unsigned char*)d_ws;
    void* args[] = {&p};
    hipError_t e = hipLaunchCooperativeKernel((const void*)hybrid_fwd, dim3(grid), dim3(NT), args, LDS_BYTES, stream);
    if (e != hipSuccess) fprintf(stderr, "cooperative launch failed: %s (grid %d)\n", hipGetErrorString(e), grid);
}
```

```cpp
#include <hip/hip_runtime.h>
#include <hip/hip_cooperative_groups.h>
#include <cstdio>
#include <cstdint>
namespace cg = cooperative_groups;

constexpr int BATCH = 16, SEQ = 2048, DM = 1024, M = BATCH * SEQ;
constexpr int INW = 2252;
constexpr int C_Q = 0, C_K = 512, C_V = 576, C_IQ = 640, C_IK = 896, C_IW = 960, C_Z = 964, C_XBC = 1476, C_DT = 2244;
constexpr int NEXP = 16, EFF = 256;
constexpr float LN_EPS = 1e-5f;
constexpr float ALPHA = 1.189207115002721f;
constexpr float INDEXER_SCALE = 0.0625f;
constexpr float QSCALE = 0.125f * 1.4426950408889634f;
constexpr int TOPK = 256;
constexpr int NT = 512;
constexpr int LDS_BYTES = 147456;

constexpr size_t MiB = 1u << 20;
constexpr size_t WS_CTL = 0, CTL_BYTES = 1 * MiB;
constexpr size_t WS_ROPE = 1 * MiB;
constexpr size_t WS_TOKW = 2 * MiB;
constexpr size_t WS_LISTS = 3 * MiB;
constexpr size_t WS_WIN_T = 8 * MiB;
constexpr size_t WS_WOUT_T = 16 * MiB;
constexpr size_t WS_WGU_T = 18 * MiB;
constexpr size_t WS_WD_T = 34 * MiB;
constexpr size_t WS_ENT = 5 * MiB;
constexpr size_t WS_XS = 48 * MiB;
constexpr size_t WS_HID = 192 * MiB;
constexpr int MAXTILES = 272, MAXROWS = MAXTILES * 256;
constexpr size_t WS_XB = 256 * MiB;
constexpr int NPAD = 2304;
constexpr size_t WS_Q = 48 * MiB;
constexpr size_t WS_K = 80 * MiB, WS_V = 84 * MiB, WS_IK = 88 * MiB;
constexpr size_t WS_IW = 92 * MiB;
constexpr size_t WS_DT = 93 * MiB;
constexpr size_t WS_IQ = 96 * MiB;
constexpr size_t WS_Z = 112 * MiB;
constexpr size_t WS_XBC = 144 * MiB;
constexpr size_t WS_AS = 192 * MiB;
constexpr size_t WS_X1 = 256 * MiB;
constexpr size_t WS_X1B = 384 * MiB;
constexpr size_t WS_Y0 = 48 * MiB, WS_Y1 = 112 * MiB;
constexpr size_t WS_P32 = 224 * MiB;
constexpr size_t WS_XC = 256 * MiB;
constexpr size_t WS_YG = 352 * MiB;
constexpr size_t WS_END = 512 * MiB;
constexpr int CW_CNT = 64;

typedef unsigned short bf16;
typedef float f32x4 __attribute__((ext_vector_type(4)));
typedef unsigned u32x4 __attribute__((ext_vector_type(4)));
typedef unsigned u32x2 __attribute__((ext_vector_type(2)));

__device__ __forceinline__ float bf2f(bf16 v) { return __uint_as_float((unsigned)v << 16); }
__device__ __forceinline__ bf16 f2bf(float f) { unsigned u = __float_as_uint(f); return (bf16)((u + 0x7fffu + ((u >> 16) & 1u)) >> 16); }
__device__ __forceinline__ float silu(float v) { return v / (1.f + __expf(-v)); }
__device__ __forceinline__ float wave_sum(float v) {
#pragma unroll
    for (int o = 1; o < 64; o <<= 1) v += __shfl_xor(v, o);
    return v;
}
__device__ __forceinline__ float wave_max(float v) {
#pragma unroll
    for (int o = 1; o < 64; o <<= 1) v = fmaxf(v, __shfl_xor(v, o));
    return v;
}
__device__ __forceinline__ int launder_i(int v) { asm volatile("" : "+v"(v)); return v; }
__device__ __forceinline__ unsigned sortkey(float f) { unsigned u = __float_as_uint(f); return (u & 0x80000000u) ? ~u : (u | 0x80000000u); }

namespace pg8 {
#define PG8_LAS __attribute__((address_space(3)))
typedef unsigned short bf16_t;
typedef short bf16x8 __attribute__((ext_vector_type(8)));
typedef float f32x4 __attribute__((ext_vector_type(4)));
typedef unsigned u32x4 __attribute__((ext_vector_type(4)));
constexpr int BM = 256, BK = 64, HALF = 128, HTB = HALF * BK * 2  , STAGE_BYTES = 8 * HTB, NXCD = 8, WGM = 8;

__host__ __device__ __forceinline__ int lds_byte(int r, int c) { const int st = (r >> 4) * 2 + (c >> 5), rr = r & 15, cc = c & 31, ob = rr * 64 + cc * 2; return st * 1024 + (ob ^ (((ob >> 9) & 1) << 5)); }
__host__ __device__ __forceinline__ void stage_rc(int b, int& R, int& C) { const int st = b / 1024, sb = b % 1024, swz = sb ^ (((sb >> 9) & 1) << 5); R = (st >> 1) * 16 + swz / 64; C = (st & 1) * 32 + (swz % 64) / 2; }
__host__ __device__ __forceinline__ int perm32(int rho) { const int n = rho >> 4, i = rho & 15; return 8 * (i >> 2) + 4 * n + (i & 3); }

struct Unit { int pm, pn; };
struct Gemm { const bf16_t* A; const bf16_t* Bt; int M, N, K; };

struct StaticOrder {
    int nM, nN, nwg, G, c;
    __host__ __device__ void init(int M, int N, int G_, int c_) { nM = M / BM; nN = N / BM; nwg = nM * nN; G = G_; c = c_; }
    __host__ __device__ bool next(int i, Unit& u) const {
        const long L = (long)i * G + c; if (L >= nwg) return false;
        int wgid = (int)L; { const int q = nwg / NXCD, r = nwg % NXCD, xcd = wgid % NXCD, off = wgid / NXCD; wgid = (xcd < r ? xcd * (q + 1) : r * (q + 1) + (xcd - r) * q) + off; }
        const int nig = WGM * nN, gid = wgid / nig, fm = gid * WGM, gsz = (nM - fm) < WGM ? (nM - fm) : WGM;
        u.pm = fm + ((wgid % nig) % gsz); u.pn = (wgid % nig) / gsz; return true;
    }
    __device__ __forceinline__ void a_ready(const Unit&) const {}
    __device__ __forceinline__ void done(const Unit&) const {}
};

__device__ __forceinline__ unsigned cvt_pk_bf16(float lo, float hi) { unsigned r; asm volatile("v_cvt_pk_bf16_f32 %0, %1, %2" : "=v"(r) : "v"(lo), "v"(hi)); return r; }
template <class Epi, class Sched, bool ALIGN_EPI = false, bool SP2 = false>
__device__ __forceinline__ void gemm_phase(PG8_LAS unsigned char* lds, const Gemm g, const Sched& S, const Epi& E) {
    int tid_l = threadIdx.x; asm volatile("" : "+v"(tid_l));
    const int tid = tid_l, wid = __builtin_amdgcn_readfirstlane(tid >> 6), lane = tid & 63, wr = wid >> 2, wc = wid & 3, fr = lane & 15, fq = lane >> 4;
    const int K = g.K, nt = K / BK;
    unsigned voffA[2], voffB[2];
#pragma unroll
    for (int i = 0; i < 2; ++i) { int R, C; stage_rc(tid * 16 + i * 8192, R, C); const int Rb = Epi::PERM ? ((R & ~31) + perm32(R & 31)) : R;
        voffA[i] = (unsigned)(R * K + C) * 2u; voffB[i] = (unsigned)(Rb * K + C) * 2u; }
    const size_t kstep = (size_t)(BK * 2);
    const size_t hstep = (size_t)HALF * K * 2;
    const size_t tstep = 2 * hstep;
    const unsigned ldsw = (unsigned)wid * 1024u;
    const int aoff = lds_byte(wr * 64 + fr, fq * 8), boff = lds_byte(wc * 32 + fr, fq * 8);
#define PG8_SA(b, h) (((b) * 2 + (h)) * HTB)
#define PG8_SB(b, h) ((4 + (b) * 2 + (h)) * HTB)
#define PG8_STAGE(bufoff, gbase, voff) do { _Pragma("unroll") for (int _i = 0; _i < 2; ++_i) \
        __builtin_amdgcn_global_load_lds((const unsigned*)((const char*)(gbase) + (voff)[_i]), (PG8_LAS unsigned*)(lds + (bufoff) + ldsw + _i * 8192), 16, 0, 0); } while (0)
#define PG8_LDA(dst, b, h) do { _Pragma("unroll") for (int m = 0; m < 4; ++m) _Pragma("unroll") for (int k = 0; k < 2; ++k) dst[m][k] = *(const PG8_LAS bf16x8*)(lds + PG8_SA(b, h) + aoff + m * 2048 + k * 1024); } while (0)
#define PG8_LDB(dst, b, h) do { _Pragma("unroll") for (int n = 0; n < 2; ++n) _Pragma("unroll") for (int k = 0; k < 2; ++k) dst[n][k] = *(const PG8_LAS bf16x8*)(lds + PG8_SB(b, h) + boff + n * 2048 + k * 1024); } while (0)
#define PG8_MMA(ai, bj, At, Bt) do { __builtin_amdgcn_s_setprio(1); _Pragma("unroll") for (int m = 0; m < 4; ++m) _Pragma("unroll") for (int n = 0; n < 2; ++n) _Pragma("unroll") for (int k = 0; k < 2; ++k) \
        acc[ai][bj][m][n] = __builtin_amdgcn_mfma_f32_16x16x32_bf16(Bt[n][k], At[m][k], acc[ai][bj][m][n], 0, 0, 0); __builtin_amdgcn_s_setprio(0); } while (0)
#define PG8_WAIT_V(n) asm volatile("s_waitcnt vmcnt(" #n ")" ::: "memory")
#define PG8_WAIT_L(n) asm volatile("s_waitcnt lgkmcnt(" #n ")" ::: "memory")
#define PG8_BAR __builtin_amdgcn_s_barrier()
#define PG8_SCHED __builtin_amdgcn_sched_barrier(0)
    Unit cur, nxt; int ui = 0;
    if (!S.next(0, cur)) return;
    f32x4 acc[2][2][4][2];
#pragma unroll
    for (int a = 0; a < 2; ++a)
#pragma unroll
        for (int b = 0; b < 2; ++b)
#pragma unroll
            for (int m = 0; m < 4; ++m)
#pragma unroll
                for (int n = 0; n < 2; ++n) acc[a][b][m][n] = (f32x4){0.f, 0.f, 0.f, 0.f};
    bf16x8 At[4][2], B0[2][2], B1[2][2];
    const char* cA = (const char*)g.A + (size_t)cur.pm * tstep; const char* cB = (const char*)g.Bt + (size_t)cur.pn * tstep;
    S.a_ready(cur);
    if constexpr (SP2) {
        PG8_STAGE(PG8_SB(0, 0), cB, voffB); PG8_STAGE(PG8_SB(0, 1), cB + hstep, voffB); PG8_STAGE(PG8_SA(0, 0), cA, voffA); PG8_STAGE(PG8_SA(0, 1), cA + hstep, voffA);
        if (wr == 1) PG8_BAR;
        PG8_WAIT_V(2); PG8_BAR;
        PG8_STAGE(PG8_SB(1, 0), cB + kstep, voffB); PG8_STAGE(PG8_SA(1, 0), cA + kstep, voffA); PG8_STAGE(PG8_SB(1, 1), cB + hstep + kstep, voffB);
        PG8_WAIT_V(6); PG8_BAR;
    } else {
        PG8_STAGE(PG8_SB(0, 0), cB, voffB); PG8_STAGE(PG8_SA(0, 0), cA, voffA); PG8_STAGE(PG8_SB(0, 1), cB + hstep, voffB); PG8_STAGE(PG8_SA(0, 1), cA + hstep, voffA);
        if (wr == 1) PG8_BAR;
        PG8_WAIT_V(4); PG8_BAR;
        PG8_STAGE(PG8_SB(1, 0), cB + kstep, voffB); PG8_STAGE(PG8_SA(1, 0), cA + kstep, voffA); PG8_STAGE(PG8_SB(1, 1), cB + hstep + kstep, voffB);
        PG8_WAIT_V(6); PG8_BAR;
    }
    for (;;) {
        const bool has_next = S.next(ui + 1, nxt);
        const char* nA = has_next ? (const char*)g.A + (size_t)nxt.pm * tstep : cA; const char* nB = has_next ? (const char*)g.Bt + (size_t)nxt.pn * tstep : cB;
        for (int t = 0; t < nt; t += 2) {
            const bool last = (t == nt - 2);
            const char* a1 = cA + (size_t)(t + 1) * kstep;
            const char* a2 = last ? nA : cA + (size_t)(t + 2) * kstep; const char* b2 = last ? nB : cB + (size_t)(t + 2) * kstep;
            const char* a3 = a2 + kstep; const char* b3 = b2 + kstep;
            if (last && has_next) S.a_ready(nxt);
            if constexpr (SP2) {
            PG8_LDB(B0, 0, 0); PG8_LDB(B1, 0, 1); PG8_SCHED; PG8_LDA(At, 0, 0); PG8_STAGE(PG8_SA(1, 1), a1 + hstep, voffA);
            PG8_WAIT_V(8); PG8_WAIT_L(0); PG8_BAR; PG8_MMA(0, 0, At, B0); PG8_MMA(0, 1, At, B1); PG8_BAR; PG8_SCHED;
            PG8_LDA(At, 0, 1); PG8_STAGE(PG8_SB(0, 0), b2, voffB); PG8_STAGE(PG8_SB(0, 1), b2 + hstep, voffB); PG8_STAGE(PG8_SA(0, 0), a2, voffA);
            PG8_WAIT_V(8); PG8_WAIT_L(0); PG8_BAR; PG8_MMA(1, 0, At, B0); PG8_MMA(1, 1, At, B1); PG8_BAR; PG8_SCHED;
            PG8_LDB(B0, 1, 0); PG8_LDB(B1, 1, 1); PG8_SCHED; PG8_LDA(At, 1, 0); PG8_STAGE(PG8_SA(0, 1), a2 + hstep, voffA);
            PG8_WAIT_V(8); PG8_WAIT_L(0); PG8_BAR; PG8_MMA(0, 0, At, B0); PG8_MMA(0, 1, At, B1); PG8_BAR; PG8_SCHED;
            PG8_LDA(At, 1, 1); PG8_STAGE(PG8_SB(1, 0), b3, voffB); PG8_STAGE(PG8_SB(1, 1), b3 + hstep, voffB); PG8_STAGE(PG8_SA(1, 0), a3, voffA);
            PG8_WAIT_V(8); PG8_WAIT_L(0); PG8_BAR; PG8_MMA(1, 0, At, B0); PG8_MMA(1, 1, At, B1); PG8_BAR; PG8_SCHED;
            } else {
            PG8_LDB(B0, 0, 0); PG8_SCHED; PG8_LDA(At, 0, 0); PG8_STAGE(PG8_SA(1, 1), a1 + hstep, voffA);
            PG8_WAIT_L(8); PG8_BAR; PG8_WAIT_L(0); PG8_MMA(0, 0, At, B0); PG8_BAR; PG8_SCHED;
            PG8_LDB(B1, 0, 1); PG8_STAGE(PG8_SB(0, 0), b2, voffB);
            PG8_BAR; PG8_WAIT_L(0); PG8_MMA(0, 1, At, B1); PG8_BAR;
            PG8_LDA(At, 0, 1); PG8_STAGE(PG8_SA(0, 0), a2, voffA);
            PG8_BAR; PG8_WAIT_L(0); PG8_MMA(1, 0, At, B0); PG8_BAR; PG8_SCHED;
            PG8_STAGE(PG8_SB(0, 1), b2 + hstep, voffB);
            PG8_WAIT_V(6); PG8_BAR; PG8_MMA(1, 1, At, B1); PG8_BAR;
            PG8_LDB(B0, 1, 0); PG8_SCHED; PG8_LDA(At, 1, 0); PG8_STAGE(PG8_SA(0, 1), a2 + hstep, voffA);
            PG8_WAIT_L(8); PG8_BAR; PG8_WAIT_L(0); PG8_MMA(0, 0, At, B0); PG8_BAR; PG8_SCHED;
            PG8_LDB(B1, 1, 1); PG8_STAGE(PG8_SB(1, 0), b3, voffB);
            PG8_BAR; PG8_WAIT_L(0); PG8_MMA(0, 1, At, B1); PG8_BAR;
            PG8_LDA(At, 1, 1); PG8_STAGE(PG8_SA(1, 0), a3, voffA);
            PG8_BAR; PG8_WAIT_L(0); PG8_MMA(1, 0, At, B0); PG8_BAR; PG8_SCHED;
            PG8_STAGE(PG8_SB(1, 1), b3 + hstep, voffB);
            PG8_WAIT_V(6); PG8_BAR; PG8_MMA(1, 1, At, B1); PG8_BAR;
            }
        }
        if constexpr (ALIGN_EPI) { if (wr == 0) PG8_BAR; }
        if constexpr (!Epi::AFTER_DRAIN) { E(acc, cur, wr, wc, fr, fq); S.done(cur); }
        if (!has_next) break;
#pragma unroll
        for (int a = 0; a < 2; ++a)
#pragma unroll
            for (int b = 0; b < 2; ++b)
#pragma unroll
                for (int m = 0; m < 4; ++m)
#pragma unroll
                    for (int n = 0; n < 2; ++n) acc[a][b][m][n] = (f32x4){0.f, 0.f, 0.f, 0.f};
        cur = nxt; cA = nA; cB = nB; ++ui;
        if constexpr (ALIGN_EPI) { if (wr == 1) PG8_BAR; }
    }
    PG8_WAIT_V(0);
    if constexpr (!ALIGN_EPI) { if (wr == 0) PG8_BAR; }
    PG8_BAR;
    if constexpr (Epi::AFTER_DRAIN) { E.fused(acc, cur, wr, wc, fr, fq, lds, wid, lane); S.done(cur); }
#undef PG8_SA
#undef PG8_SB
#undef PG8_STAGE
#undef PG8_LDA
#undef PG8_LDB
#undef PG8_MMA
#undef PG8_WAIT_V
#undef PG8_WAIT_L
#undef PG8_BAR
#undef PG8_SCHED
}
}

#define LAS __attribute__((address_space(3)))
__host__ __device__ __forceinline__ int rope_pos(int j) { return 2 * (j & 31) + (j >> 5); }
__host__ __device__ __forceinline__ int win_dest_row(int c) {
    if (c < C_K) return (c & ~63) + rope_pos(c & 63);
    if (c < C_V) return 512 + rope_pos(c - C_K);
    if (c < C_IQ) return 512 + 64 + (c - C_V);
    if (c < C_IK) return 768 + ((c - C_IQ) & ~63) + rope_pos((c - C_IQ) & 63);
    if (c < C_IW) return 512 + 128 + rope_pos(c - C_IK);
    if (c < C_Z) return 512 + 192 + (c - C_IW);
    if (c < C_XBC) return 1024 + (c - C_Z);
    if (c < C_DT) return 1536 + (c - C_XBC);
    return 512 + 200 + (c - C_DT);
}
struct EpiInProj {
    static constexpr bool PERM = true, AFTER_DRAIN = false;
    bf16 *Q, *K, *V, *IK, *IQ, *Z, *XBC; float *IW, *DT; const float2* rope;
    __device__ __forceinline__ u32x4 pack8(const f32x4 a, const f32x4 b) const { u32x4 w; w.x = pg8::cvt_pk_bf16(a[0], a[1]); w.y = pg8::cvt_pk_bf16(a[2], a[3]); w.z = pg8::cvt_pk_bf16(b[0], b[1]); w.w = pg8::cvt_pk_bf16(b[2], b[3]); return w; }
    __device__ __forceinline__ u32x4 rope8(const f32x4 v0, const f32x4 v1, const f32x4 r0, const f32x4 r1, float sc) const {
        f32x4 a, b;
        a[0] = (v0[0] * r0[0] - v0[1] * r0[1]) * sc; a[1] = (v0[0] * r0[1] + v0[1] * r0[0]) * sc;
        a[2] = (v0[2] * r0[2] - v0[3] * r0[3]) * sc; a[3] = (v0[2] * r0[3] + v0[3] * r0[2]) * sc;
        b[0] = (v1[0] * r1[0] - v1[1] * r1[1]) * sc; b[1] = (v1[0] * r1[1] + v1[1] * r1[0]) * sc;
        b[2] = (v1[2] * r1[2] - v1[3] * r1[3]) * sc; b[3] = (v1[2] * r1[3] + v1[3] * r1[2]) * sc;
        return pack8(a, b);
    }
    __device__ __forceinline__ void operator()(const pg8::f32x4 (&acc)[2][2][4][2], const pg8::Unit& u, int wr, int wc, int fr, int fq) const {
        const int pn = u.pn, row0 = u.pm * 256 + wr * 64 + fr, cw = 32 * wc + 8 * fq;
        if (pn <= 1 || pn == 3) {
            bf16* dst = (pn == 3) ? IQ : Q; const int ld = (pn == 3) ? 256 : 512; const float sc = (pn == 3) ? 1.f : QSCALE; const int hb = (pn == 3) ? 0 : pn * 4;
#pragma unroll
            for (int ai = 0; ai < 2; ++ai)
#pragma unroll
                for (int m = 0; m < 4; ++m) { const int row = row0 + ai * 128 + m * 16, t = row & (SEQ - 1);
                    const f32x4* rp = (const f32x4*)(rope + t * 32 + 16 * (wc & 1) + 4 * fq); const f32x4 r0 = rp[0], r1 = rp[1];
#pragma unroll
                    for (int bj = 0; bj < 2; ++bj) { const int head = hb + 2 * bj + (wc >> 1);
                        *(u32x4*)(dst + (size_t)row * ld + head * 64 + 32 * (wc & 1) + 8 * fq) = rope8(acc[ai][bj][m][0], acc[ai][bj][m][1], r0, r1, sc); } }
        } else if (pn == 2) {
#pragma unroll
            for (int ai = 0; ai < 2; ++ai)
#pragma unroll
                for (int m = 0; m < 4; ++m) { const int row = row0 + ai * 128 + m * 16, t = row & (SEQ - 1);
                    if (wc < 2) { const f32x4* rp = (const f32x4*)(rope + t * 32 + 16 * wc + 4 * fq); const f32x4 r0 = rp[0], r1 = rp[1];
                        *(u32x4*)(K + (size_t)row * 64 + cw) = rope8(acc[ai][0][m][0], acc[ai][0][m][1], r0, r1, 1.f);
                        *(u32x4*)(IK + (size_t)row * 64 + cw) = rope8(acc[ai][1][m][0], acc[ai][1][m][1], r0, r1, 1.f);
                    } else {
                        *(u32x4*)(V + (size_t)row * 64 + (cw - 64)) = pack8(acc[ai][0][m][0], acc[ai][0][m][1]);
                        if (wc == 2 && fq == 0) *(f32x4*)(IW + (size_t)row * 4) = acc[ai][1][m][0] * INDEXER_SCALE;
                        if (wc == 2 && fq == 1) { *(f32x4*)(DT + (size_t)row * 8) = acc[ai][1][m][0]; *(f32x4*)(DT + (size_t)row * 8 + 4) = acc[ai][1][m][1]; }
                    } }
        } else {
            bf16* dst = (pn < 6) ? Z : XBC; const int ld = (pn < 6) ? 512 : 768; const int cb = (pn < 6) ? (pn - 4) * 256 : (pn - 6) * 256;
#pragma unroll
            for (int ai = 0; ai < 2; ++ai)
#pragma unroll
                for (int m = 0; m < 4; ++m) { const int row = row0 + ai * 128 + m * 16;
#pragma unroll
                    for (int bj = 0; bj < 2; ++bj) *(u32x4*)(dst + (size_t)row * ld + cb + 128 * bj + cw) = pack8(acc[ai][bj][m][0], acc[ai][bj][m][1]); }
        }
    }
};
struct EpiH1 {
    static constexpr bool PERM = false, AFTER_DRAIN = false;
    const float* x; float* out;
    __device__ __forceinline__ void operator()(const pg8::f32x4 (&acc)[2][2][4][2], const pg8::Unit& u, int wr, int wc, int fr, int fq) const {
        const int row0 = u.pm * 256 + wr * 64 + fr, col0 = u.pn * 256 + wc * 32 + 4 * fq;
#pragma unroll
        for (int ai = 0; ai < 2; ++ai)
#pragma unroll
            for (int m = 0; m < 4; ++m) { const size_t off = (size_t)(row0 + ai * 128 + m * 16) * DM + col0;
#pragma unroll
                for (int bj = 0; bj < 2; ++bj)
#pragma unroll
                    for (int n = 0; n < 2; ++n) { const f32x4 xv = *(const f32x4*)(x + off + bj * 128 + n * 16); *(f32x4*)(out + off + bj * 128 + n * 16) = xv * ALPHA + acc[ai][bj][m][n]; } }
    }
};
template <class DR>
__device__ __forceinline__ void transpose_item(const float* W, int K, int N, bf16* WT, LAS float* scr, int item, int lane, DR drow) {
    const int nblk = (N + 31) / 32, kb = item / nblk, nb = item % nblk, k0 = 64 * kb, n0 = 32 * nb;
#pragma unroll 8
    for (int i = 0; i < 32; ++i) { const int kk = 2 * i + (lane >> 5), col = n0 + (lane & 31); scr[kk * 33 + (lane & 31)] = (col < N) ? W[(size_t)(k0 + kk) * N + col] : 0.f; }
    asm volatile("s_waitcnt lgkmcnt(0)" ::: "memory");
    const int c = lane & 7;
#pragma unroll
    for (int j = 0; j < 4; ++j) { const int n = (lane >> 3) + 8 * j, col = n0 + n; const LAS float* s = scr + (8 * c) * 33 + n;
        u32x4 o; o.x = pg8::cvt_pk_bf16(s[0 * 33], s[1 * 33]); o.y = pg8::cvt_pk_bf16(s[2 * 33], s[3 * 33]); o.z = pg8::cvt_pk_bf16(s[4 * 33], s[5 * 33]); o.w = pg8::cvt_pk_bf16(s[6 * 33], s[7 * 33]);
        if (col < N) *(u32x4*)(WT + (size_t)drow(col) * K + k0 + 8 * c) = o; }
    asm volatile("s_waitcnt lgkmcnt(0)" ::: "memory");
}
namespace attn_body {
using bf16=unsigned short;
using bf16x8=__attribute__((ext_vector_type(8)))short;
using s16x4=__attribute__((ext_vector_type(4)))short;
using f32x16=__attribute__((ext_vector_type(16)))float;
using u32x4=__attribute__((ext_vector_type(4)))unsigned;
constexpr int SEQ=2048,D=64,QP=512,KP=64,OP=1024;
constexpr int NW=8,QBLK=32,KVBLK=64;
__device__ __forceinline__ int crow(int r,int hi){return (r&3)+8*(r>>2)+4*hi;}
#define SBAR() __builtin_amdgcn_sched_barrier(0)
__device__ __forceinline__ void amask(f32x16&p0,f32x16&p1,unsigned mlo,unsigned mhi,int hi){
  const unsigned NEGB=0xff800000u; const unsigned a=mlo>>(4*hi), b=mhi>>(4*hi);
  #pragma unroll
  for(int r=0;r<16;++r){ const int pos=(r&3)+8*(r>>2);
    const unsigned s0=(unsigned)__builtin_amdgcn_sbfe((int)a,pos,1), s1=(unsigned)__builtin_amdgcn_sbfe((int)b,pos,1);
    const float v0=p0[r], v1=p1[r];
    p0[r]=__uint_as_float((s0&__float_as_uint(v0))|(~s0&NEGB));
    p1[r]=__uint_as_float((s1&__float_as_uint(v1))|(~s1&NEGB)); }
}

constexpr int NSLOT=3, SLOTB=8192;
constexpr int LDS_K=0, LDS_V=NSLOT*SLOTB, LDS_WS=2*NSLOT*SLOTB, LDS_OST=LDS_WS+NW*64*4, LDS_BYTES=LDS_OST+NW*4096;
constexpr float C2=0.125f*1.4426950408889634f;
__device__ __forceinline__ void glds16(const void*gsrc,unsigned lds_dst){unsigned keep;
  asm volatile("s_mov_b32 %0, m0\n\ts_mov_b32 m0, %2\n\ts_nop 0\n\tglobal_load_lds_dwordx4 %1, off\n\ts_mov_b32 m0, %0":"=&s"(keep):"v"(gsrc),"s"(lds_dst):"memory");}
__device__ __forceinline__ float max3f(float a,float b,float c){float r;asm("v_max3_f32 %0, %1, %2, %3":"=v"(r):"v"(a),"v"(b),"v"(c));return r;}
__device__ __forceinline__ float max2f(float a,float b){float r;asm("v_max_f32_e32 %0, %1, %2":"=v"(r):"v"(a),"v"(b));return r;}
__device__ __forceinline__ float fadd_s(float a,float b){float r;asm("v_add_f32_e32 %0, %1, %2":"=v"(r):"v"(a),"v"(b));return r;}
__device__ __forceinline__ float fsub_s(float a,float b){float r;asm("v_sub_f32_e32 %0, %1, %2":"=v"(r):"v"(a),"v"(b));return r;}
typedef float f32x2_t __attribute__((ext_vector_type(2))); typedef __bf16 bf16x2_t __attribute__((ext_vector_type(2)));
__device__ __forceinline__ unsigned cvtpk_s(float lo,float hi){f32x2_t v={lo,hi};bf16x2_t b=__builtin_convertvector(v,bf16x2_t);return __builtin_bit_cast(unsigned,b);}
#define WAIT_BAR(N) asm volatile("s_waitcnt vmcnt(" #N ") lgkmcnt(0)\n\ts_barrier":::"memory")

__device__ __forceinline__ void qkt(f32x16&p0,f32x16&p1,const char*Kslot,const bf16x8*qr,const f32x16&negm,int r32,int hi){
  const char*kb=Kslot+hi*1024+r32*16;
  #pragma unroll
  for(int d0=0;d0<4;++d0){
    const bf16x8 b0=*reinterpret_cast<const bf16x8*>(kb+d0*2048);
    const bf16x8 b1=*reinterpret_cast<const bf16x8*>(kb+d0*2048+512);
    if(d0==0){p0=__builtin_amdgcn_mfma_f32_32x32x16_bf16(b0,qr[0],negm,0,0,0);p1=__builtin_amdgcn_mfma_f32_32x32x16_bf16(b1,qr[0],negm,0,0,0);}
    else{p0=__builtin_amdgcn_mfma_f32_32x32x16_bf16(b0,qr[d0],p0,0,0,0);p1=__builtin_amdgcn_mfma_f32_32x32x16_bf16(b1,qr[d0],p1,0,0,0);}}
}
typedef __attribute__((address_space(3))) const char* lds_cptr;
typedef short v4i16_t __attribute__((ext_vector_type(4)));
__device__ __forceinline__ void kload8(bf16x8*kf,lds_cptr kp){
  kf[0]=*(const __attribute__((address_space(3))) bf16x8*)(kp);      kf[1]=*(const __attribute__((address_space(3))) bf16x8*)(kp+512);
  kf[2]=*(const __attribute__((address_space(3))) bf16x8*)(kp+2048); kf[3]=*(const __attribute__((address_space(3))) bf16x8*)(kp+2560);
  kf[4]=*(const __attribute__((address_space(3))) bf16x8*)(kp+4096); kf[5]=*(const __attribute__((address_space(3))) bf16x8*)(kp+4608);
  kf[6]=*(const __attribute__((address_space(3))) bf16x8*)(kp+6144); kf[7]=*(const __attribute__((address_space(3))) bf16x8*)(kp+6656);
}
__device__ __forceinline__ void kload2(bf16x8*kf,lds_cptr kp,int j){ kf[2*j]=*(const __attribute__((address_space(3))) bf16x8*)(kp+j*2048); kf[2*j+1]=*(const __attribute__((address_space(3))) bf16x8*)(kp+j*2048+512); }
__device__ __forceinline__ s16x4 vtr(lds_cptr p){ return __builtin_bit_cast(s16x4,__builtin_amdgcn_ds_read_tr16_b64_v4i16((__attribute__((address_space(3))) v4i16_t*)p)); }
__device__ __forceinline__ float rowmax(const f32x16&p0,const f32x16&p1){
  float a=max3f(p0[0],p0[1],p1[0]),b=max3f(p0[2],p0[3],p1[1]);a=max3f(a,p1[2],p1[3]);
  #pragma unroll
  for(int r=4;r<16;r+=4){a=max3f(a,p0[r],p0[r+1]);b=max3f(b,p0[r+2],p0[r+3]);a=max3f(a,p1[r],p1[r+1]);b=max3f(b,p1[r+2],p1[r+3]);}
  const float m=max2f(a,b);
  auto rr=__builtin_amdgcn_permlane32_swap(__float_as_uint(m),__float_as_uint(m),false,false);
  return max2f(__uint_as_float(rr[0]),__uint_as_float(rr[1]));
}
__device__ __forceinline__ void pv(f32x16*o,int vb,bf16x8 pa0,bf16x8 pa1,bf16x8 pa2,bf16x8 pa3){
  #pragma unroll
  for(int d0=0;d0<2;++d0){s16x4 lo[4],hi[4];
    #pragma unroll
    for(int ks=0;ks<4;++ks){
      asm volatile("ds_read_b64_tr_b16 %0,%1 offset:%c2":"=&v"(lo[ks]):"v"(vb),"i"(d0*4096+ks*1024):"memory");
      asm volatile("ds_read_b64_tr_b16 %0,%1 offset:%c2":"=&v"(hi[ks]):"v"(vb),"i"(d0*4096+ks*1024+512):"memory");}
    asm volatile("s_waitcnt lgkmcnt(0)":::"memory");SBAR();
    #define PK(k) (bf16x8){lo[k][0],lo[k][1],lo[k][2],lo[k][3],hi[k][0],hi[k][1],hi[k][2],hi[k][3]}
    o[d0]=__builtin_amdgcn_mfma_f32_32x32x16_bf16(pa0,PK(0),o[d0],0,0,0);
    o[d0]=__builtin_amdgcn_mfma_f32_32x32x16_bf16(pa1,PK(1),o[d0],0,0,0);
    o[d0]=__builtin_amdgcn_mfma_f32_32x32x16_bf16(pa2,PK(2),o[d0],0,0,0);
    o[d0]=__builtin_amdgcn_mfma_f32_32x32x16_bf16(pa3,PK(3),o[d0],0,0,0);
    #undef PK
  }
}

#ifndef ATTN_STORE16
#define ATTN_STORE16(p,v) (*(u32x4*)(p)=(v))
#endif
template<int THRL> __device__ __forceinline__ void attn_unit(int b,int qb,const bf16*Q,const bf16*__restrict__ K,const bf16*__restrict__ V,bf16*O,char*shm,const char*maskb){
  int tid_l=threadIdx.x; asm volatile("":"+v"(tid_l)); const int tid=tid_l,lane=tid&63,r32=lane&31,hi=lane>>5; const int wid=__builtin_amdgcn_readfirstlane(tid>>6);
  const long rowbase=(long)b*SEQ; const int q0=qb*QBLK;
  const bf16*Qw=Q+(rowbase+q0)*QP+wid*D;
  const bf16*Kh=K+rowbase*KP,*Vh=V+rowbase*KP;
  const unsigned lds0=(unsigned)(uintptr_t)shm;
  float*wsf=(float*)(shm+LDS_WS)+wid*64;
  const bf16*ksrc=Kh+(long)lane*KP+wid*8;
  const bf16*vsrc=Vh+(long)(16*(wid&3)+(lane>>2))*KP+(wid>>2)*32+(lane&3)*8;
  const unsigned kdst=lds0+LDS_K+wid*1024, vdst=lds0+LDS_V+wid*1024;
  #define DMA_K(t,slot) glds16(ksrc+(long)(t)*KVBLK*KP,(unsigned)__builtin_amdgcn_readfirstlane(kdst+(slot)))
  #define DMA_V(t,slot) glds16(vsrc+(long)(t)*KVBLK*KP,(unsigned)__builtin_amdgcn_readfirstlane(vdst+(slot)))
  const int vb0=(int)(lds0+LDS_V)+((lane>>4)&1)*32+(lane&3)*8+(4*hi+((lane&15)>>2))*64;
  const char*Kbase=shm+LDS_K; bf16x8 kf[8];
  const lds_cptr shm3=(lds_cptr)shm; const lds_cptr kp0=shm3+LDS_K+hi*1024+r32*16; const lds_cptr vp0=shm3+LDS_V+((lane>>4)&1)*32+(lane&3)*8+(4*hi+((lane&15)>>2))*64;
  const int NTr=(q0+QBLK+KVBLK-1)/KVBLK; const int NT=(NTr<4)?4:((NTr+1)&~1);
  const __attribute__((address_space(3))) unsigned*mrow=(const __attribute__((address_space(3))) unsigned*)((__attribute__((address_space(3))) const char*)maskb)+r32*66;
  DMA_K(0,0);DMA_V(0,0);DMA_K(1,SLOTB);
  bf16x8 qr[4];
  #pragma unroll
  for(int d0=0;d0<4;++d0)qr[d0]=*reinterpret_cast<const bf16x8*>(&Qw[(long)r32*QP+d0*16+hi*8]);
  float zz_=0.f; asm volatile("":"+v"(zz_)); float mhat=zz_,l_reg=zz_;f32x16 o[2];
  #pragma unroll
  for(int r=0;r<16;++r){o[0][r]=zz_;o[1][r]=zz_;}
  f32x16 negm;
  #pragma unroll
  for(int r=0;r<16;++r)negm[r]=zz_;
  asm volatile("":"+v"(negm));
  #define CMASK(P0,P1,t) do{ const unsigned ml_=mrow[2*(t)], mh_=mrow[2*(t)+1]; amask(P0,P1,ml_,mh_,hi); }while(0)
  bool resc=false;
  #define START(P0,P1) do{ const float rm=rowmax(P0,P1); resc=false; \
    { const float dl=(rm>-INFINITY)?rm:0.f; mhat=fadd_s(mhat,dl); \
      _Pragma("unroll") for(int r=0;r<16;++r){P0[r]=fsub_s(P0[r],dl);P1[r]=fsub_s(P1[r],dl);} \
      _Pragma("unroll") for(int r=0;r<16;++r)negm[r]=-mhat; asm volatile("":"+v"(negm)); } \
    _Pragma("unroll") for(int r=0;r<16;++r)P0[r]=__builtin_amdgcn_exp2f(P0[r]); }while(0)
  #define RESC() do{ if(resc){ asm volatile("s_waitcnt lgkmcnt(0)":::"memory"); \
      _Pragma("unroll") for(int d_=0;d_<2;++d_) _Pragma("unroll") for(int r=0;r<16;++r)o[d_][r]*=wsf[crow(r,hi)]; } }while(0)
  f32x16 pA0,pA1,pB0,pB1;
  int sl_prev=0,sl_cur=0,sl_next=SLOTB;
  #define ROT() do{sl_prev=sl_cur;sl_cur=sl_next;sl_next=(sl_next==(NSLOT-1)*SLOTB)?0:sl_next+SLOTB;}while(0)
  DMA_K(2,2*SLOTB);
  WAIT_BAR(3);
  qkt(pA0,pA1,Kbase,qr,negm,r32,hi);asm volatile("s_nop 15\n\ts_nop 7":"+v"(pA0),"+v"(pA1));CMASK(pA0,pA1,0);
  START(pA0,pA1);
  _Pragma("unroll") for(int r=0;r<16;++r)pA1[r]=__builtin_amdgcn_exp2f(pA1[r]);
  WAIT_BAR(0);
  DMA_K(3,0);DMA_V(1,SLOTB);
  ROT();
  kload8(kf,kp0+sl_cur);
  WAIT_BAR(2);
  s16x4 vlo[8],vhi[8]; u32x4 pw0,pw1,pw2,pw3;
  #define PKW(P,B) cvtpk_s(P[B],P[B+1])
  #define PAF(k) __builtin_bit_cast(bf16x8,pw##k)
  #define VFR(i) (bf16x8){vlo[i][0],vlo[i][1],vlo[i][2],vlo[i][3],vhi[i][0],vhi[i][1],vhi[i][2],vhi[i][3]}
  #define PIN(x) asm volatile("":"+v"(x))
  #define MX3(a,b,c) __builtin_fmaxf(__builtin_fmaxf((a),(b)),(c))
  #define GAPA(MF,A0,A1,A2,A3,W0,W1,PW) do{ MF; sacc+=A0; sacc+=A1; sacc+=A2; sacc+=A3; PIN(sacc); W0; W1; PIN(PW); SBAR(); }while(0)
  #define EX(v) __builtin_amdgcn_exp2f(v)
  #define GAPB(MF,X,B) do{ MF; X[B]=EX(X[B]); X[B+1]=EX(X[B+1]); X[B+2]=EX(X[B+2]); X[B+3]=EX(X[B+3]); PIN(X); SBAR(); }while(0)
  #define VRD(i) do{ vlo[i]=vtr(vp_+(((i)>>2)*4096+((i)&3)*1024)); vhi[i]=vtr(vp_+(((i)>>2)*4096+((i)&3)*1024+512)); }while(0)
  #define KRD(G,j) do{ if(G){ kload2(kf,kp0+sl_next,j); SBAR(); } }while(0)
  #define STEP(C0,C1,P0,P1,t,GK,GV,GL) do{ SBAR(); \
    const lds_cptr vp_=vp0+sl_prev; \
    VRD(0); SBAR(); float sacc=(P0[0]+P0[1]); \
    GAPA(C0=__builtin_amdgcn_mfma_f32_32x32x16_bf16(kf[0],qr[0],negm,0,0,0), P0[2],P0[3],P0[4],P0[5],     pw0[0]=PKW(P0,0), pw0[1]=PKW(P0,2), pw0); \
    VRD(4); SBAR(); GAPA(C1=__builtin_amdgcn_mfma_f32_32x32x16_bf16(kf[1],qr[0],negm,0,0,0), P0[6],P0[7],P0[8],P0[9],     pw0[2]=PKW(P0,4), pw0[3]=PKW(P0,6), pw0); \
    VRD(1); SBAR(); GAPA(C0=__builtin_amdgcn_mfma_f32_32x32x16_bf16(kf[2],qr[1],C0,0,0,0),   P0[10],P0[11],P0[12],P0[13], pw1[0]=PKW(P0,8), pw1[1]=PKW(P0,10), pw1); \
    VRD(5); SBAR(); GAPA(C1=__builtin_amdgcn_mfma_f32_32x32x16_bf16(kf[3],qr[1],C1,0,0,0),   P0[14],P0[15],P1[0],P1[1],   pw1[2]=PKW(P0,12),pw1[3]=PKW(P0,14), pw1); \
    VRD(2); SBAR(); GAPA(C0=__builtin_amdgcn_mfma_f32_32x32x16_bf16(kf[4],qr[2],C0,0,0,0),   P1[2],P1[3],P1[4],P1[5],     pw2[0]=PKW(P1,0), pw2[1]=PKW(P1,2), pw2); \
    VRD(6); SBAR(); GAPA(C1=__builtin_amdgcn_mfma_f32_32x32x16_bf16(kf[5],qr[2],C1,0,0,0),   P1[6],P1[7],P1[8],P1[9],     pw2[2]=PKW(P1,4), pw2[3]=PKW(P1,6), pw2); \
    VRD(3); SBAR(); GAPA(C0=__builtin_amdgcn_mfma_f32_32x32x16_bf16(kf[6],qr[3],C0,0,0,0),   P1[10],P1[11],P1[12],P1[13], pw3[0]=PKW(P1,8), pw3[1]=PKW(P1,10), pw3); \
    VRD(7); SBAR(); GAPA(C1=__builtin_amdgcn_mfma_f32_32x32x16_bf16(kf[7],qr[3],C1,0,0,0),   P1[14],P1[15],0.f,0.f,       pw3[2]=PKW(P1,12),pw3[3]=PKW(P1,14), pw3); \
    l_reg+=sacc; \
    if(GK){DMA_K((t)+3,sl_cur);} if(GV){DMA_V((t)+1,sl_next);} \
    CMASK(C0,C1,t); \
    { float a=MX3(C0[0],C0[1],C1[0]),b=MX3(C0[2],C0[3],C1[1]); a=MX3(a,C1[2],C1[3]); \
      _Pragma("unroll") for(int r=4;r<16;r+=4){a=MX3(a,C0[r],C0[r+1]);b=MX3(b,C0[r+2],C0[r+3]);a=MX3(a,C1[r],C1[r+1]);b=MX3(b,C1[r+2],C1[r+3]);} \
      float rm=__builtin_fmaxf(a,b); { auto rr=__builtin_amdgcn_permlane32_swap(__float_as_uint(rm),__float_as_uint(rm),false,false); rm=__builtin_fmaxf(__uint_as_float(rr[0]),__uint_as_float(rr[1])); } \
      resc=false; \
      if(__builtin_expect(__any(rm>(float)THRL),0)){ const float dl=__builtin_fmaxf(rm,0.f); mhat+=dl; \
        _Pragma("unroll") for(int r=0;r<16;++r){C0[r]-=dl;C1[r]-=dl;} \
        _Pragma("unroll") for(int r=0;r<16;++r)negm[r]=-mhat; asm volatile("":"+v"(negm)); \
        const float f=__builtin_amdgcn_exp2f(-dl); l_reg*=f; if(hi==0)wsf[r32]=f; resc=true; } } \
    SBAR(); \
    GAPB(o[0]=__builtin_amdgcn_mfma_f32_32x32x16_bf16(PAF(0),VFR(0),o[0],0,0,0), C0,0); \
    GAPB(o[1]=__builtin_amdgcn_mfma_f32_32x32x16_bf16(PAF(0),VFR(4),o[1],0,0,0), C0,4); \
    KRD(GL,0); GAPB(o[0]=__builtin_amdgcn_mfma_f32_32x32x16_bf16(PAF(1),VFR(1),o[0],0,0,0), C0,8); \
    KRD(GL,1); GAPB(o[1]=__builtin_amdgcn_mfma_f32_32x32x16_bf16(PAF(1),VFR(5),o[1],0,0,0), C0,12); \
    KRD(GL,2); GAPB(o[0]=__builtin_amdgcn_mfma_f32_32x32x16_bf16(PAF(2),VFR(2),o[0],0,0,0), C1,0); \
    KRD(GL,3); GAPB(o[1]=__builtin_amdgcn_mfma_f32_32x32x16_bf16(PAF(2),VFR(6),o[1],0,0,0), C1,4); \
    GAPB(o[0]=__builtin_amdgcn_mfma_f32_32x32x16_bf16(PAF(3),VFR(3),o[0],0,0,0), C1,8); \
    GAPB(o[1]=__builtin_amdgcn_mfma_f32_32x32x16_bf16(PAF(3),VFR(7),o[1],0,0,0), C1,12); \
    }while(0)
  int t=1;
  for(;t+5<NT;t+=2){
    STEP(pB0,pB1,pA0,pA1,t,true,true,true);     WAIT_BAR(2); RESC(); ROT();
    STEP(pA0,pA1,pB0,pB1,t+1,true,true,true);   WAIT_BAR(2); RESC(); ROT();
  }
  #define ENDW(tt) do{ if((tt)+3<NT){WAIT_BAR(2);} else if((tt)+2<NT){WAIT_BAR(1);} else {WAIT_BAR(0);} }while(0)
  for(;t+1<NT;t+=2){
    STEP(pB0,pB1,pA0,pA1,t,(t+3<NT),(t+1<NT),(t+1<NT));       ENDW(t);   RESC(); ROT();
    STEP(pA0,pA1,pB0,pB1,t+1,(t+4<NT),(t+2<NT),(t+2<NT));     ENDW(t+1); RESC(); ROT();
  }
  STEP(pB0,pB1,pA0,pA1,NT-1,false,false,false); RESC();
  { float sacc=pB0[0]+pB0[1]; _Pragma("unroll") for(int r=2;r<16;++r)sacc+=pB0[r]; _Pragma("unroll") for(int r=0;r<16;++r)sacc+=pB1[r]; l_reg+=sacc;
    pw0=(u32x4){PKW(pB0,0),PKW(pB0,2),PKW(pB0,4),PKW(pB0,6)};pw1=(u32x4){PKW(pB0,8),PKW(pB0,10),PKW(pB0,12),PKW(pB0,14)};pw2=(u32x4){PKW(pB1,0),PKW(pB1,2),PKW(pB1,4),PKW(pB1,6)};pw3=(u32x4){PKW(pB1,8),PKW(pB1,10),PKW(pB1,12),PKW(pB1,14)};
    SBAR(); pv(o,vb0+sl_cur,PAF(0),PAF(1),PAF(2),PAF(3)); }
  #undef PKW
  #undef PAF
  #undef VFR
  #undef PIN
  #undef MX3
  #undef GAPA
  #undef GAPB
  #undef EX
  #undef VRD
  #undef KRD
  #undef STEP
  #undef ENDW
  {auto rr=__builtin_amdgcn_permlane32_swap(__float_as_uint(l_reg),__float_as_uint(l_reg),false,false);l_reg=__uint_as_float(rr[0])+__uint_as_float(rr[1]);}
  if(hi==0)wsf[32+r32]=l_reg;asm volatile("s_waitcnt lgkmcnt(0)":::"memory");
  float rli[16];
  #pragma unroll
  for(int r=0;r<16;++r)rli[r]=__builtin_amdgcn_rcpf(wsf[32+crow(r,hi)]);
  bf16*Ow=O+(rowbase+q0)*OP+wid*D;
  { bf16*stg=(bf16*)(shm+LDS_OST)+wid*2048;
    #pragma unroll
    for(int r=0;r<16;++r){const int orow=crow(r,hi);
      #pragma unroll
      for(int d0=0;d0<2;++d0)stg[orow*64+d0*32+r32]=(bf16)(cvtpk_s(o[d0][r]*rli[r],0.f)&0xffffu);}
    asm volatile("s_waitcnt lgkmcnt(0)":::"memory");
    #pragma unroll
    for(int i=0;i<4;++i){const int row=i*8+(lane>>3),ch=lane&7; const u32x4 v=*(const u32x4*)(stg+row*64+ch*8); ATTN_STORE16(Ow+(long)row*OP+ch*8,v);} }
  asm volatile("s_waitcnt lgkmcnt(0)\n\ts_barrier":::"memory");
  #undef DMA_K
  #undef DMA_V
  #undef CMASK
  #undef START
  #undef RESC
  #undef ROT
}
constexpr int ATTN_LDS_BYTES=LDS_BYTES;
#undef SBAR
#undef WAIT_BAR
}

constexpr int DSA_MASK_OFF = 131072, DSA_MASK_STRIDE = 66;
typedef short bf16x8_t __attribute__((ext_vector_type(8)));
__device__ __forceinline__ unsigned long long select_topk(const unsigned (&k)[32], int kk, int nreg, int lane) {
    unsigned T = 0u; bool exact = false;
    for (int bit = 31; bit >= 0; --bit) {
        const unsigned cand = T | (1u << bit);
        int c = 0;
#pragma unroll
        for (int g4 = 0; g4 < 8; ++g4) if (4 * g4 < nreg) {
#pragma unroll
            for (int j = 0; j < 4; ++j) c += __popcll(__ballot(k[4 * g4 + j] >= cand)); }
        if (c == kk) { T = cand; exact = true; break; }
        if (c > kk) T = cand;
    }
    unsigned long long mine = 0ull;
    if (exact) {
#pragma unroll
        for (int i = 0; i < 32; ++i) { const unsigned long long m = __ballot(k[i] >= T); if (lane == i) mine = m; }
    } else {
        int ngt = 0;
#pragma unroll
        for (int i = 0; i < 32; ++i) ngt += __popcll(__ballot(k[i] > T));
        int need = kk - ngt;
#pragma unroll
        for (int i = 0; i < 32; ++i) {
            const unsigned long long eqb = __ballot(k[i] == T);
            const int rank = __builtin_amdgcn_mbcnt_hi((unsigned)(eqb >> 32), __builtin_amdgcn_mbcnt_lo((unsigned)eqb, 0u));
            const bool sel = (k[i] > T) || ((k[i] == T) && (rank < need));
            const unsigned long long m = __ballot(sel);
            need -= __popcll(eqb); if (need < 0) need = 0;
            if (lane == i) mine = m;
        }
    }
    return mine;
}
__device__ __forceinline__ void dsa_select(int b, int qb, const bf16* IQb, const bf16* IKb, const float* IW, unsigned char* lds, int lane, int wave) {
    lane = launder_i(lane);
    unsigned* keys = (unsigned*)lds; unsigned* maskw = (unsigned*)(lds + DSA_MASK_OFF);
    const size_t rb = (size_t)b * SEQ; const int q0 = qb * 32; const int ntk16 = 4 * ((qb >> 1) + 1);
    const int l15 = lane & 15, l4 = lane >> 4;
    for (int rnd = 0; rnd < 2; ++rnd) {
        const int qb0 = q0 + 16 * rnd;
        bf16x8_t a[4][2]; f32x4 wq[4];
#pragma unroll
        for (int mt = 0; mt < 4; ++mt) {
            const bf16* ar = IQb + (rb + qb0 + 4 * mt + (l15 >> 2)) * 256 + (l15 & 3) * 64 + 8 * l4;
            a[mt][0] = *(const bf16x8_t*)ar; a[mt][1] = *(const bf16x8_t*)(ar + 32);
            wq[mt] = *(const f32x4*)(IW + (rb + qb0 + 4 * mt + l4) * 4);
        }
        for (int nt = wave; nt < ntk16; nt += 8) {
            const int s = 16 * nt + l15;
            const bf16* br = IKb + (rb + s) * 64 + 8 * l4;
            const bf16x8_t b0 = *(const bf16x8_t*)br, b1 = *(const bf16x8_t*)(br + 32);
#pragma unroll
            for (int mt = 0; mt < 4; ++mt) {
                f32x4 c = (f32x4){0.f, 0.f, 0.f, 0.f};
                c = __builtin_amdgcn_mfma_f32_16x16x32_bf16(a[mt][0], b0, c, 0, 0, 0);
                c = __builtin_amdgcn_mfma_f32_16x16x32_bf16(a[mt][1], b1, c, 0, 0, 0);
                float sc = wq[mt][0] * fmaxf(c[0], 0.f); sc = fmaf(wq[mt][1], fmaxf(c[1], 0.f), sc); sc = fmaf(wq[mt][2], fmaxf(c[2], 0.f), sc); sc = fmaf(wq[mt][3], fmaxf(c[3], 0.f), sc);
                const int ql = 4 * mt + l4, t = qb0 + ql;
                keys[ql * 2048 + s] = (s <= t) ? sortkey(sc) : 0u;
            }
        }
        __syncthreads();
#pragma unroll 1
        for (int j = 0; j < 2; ++j) {
            const int ql = 2 * wave + j, t = qb0 + ql, kk = (t + 1 < TOPK) ? (t + 1) : TOPK, nreg = (t >> 6) + 1;
            unsigned k[32];
#pragma unroll
            for (int i = 0; i < 32; ++i) k[i] = (i < nreg) ? keys[ql * 2048 + 64 * i + lane] : 0u;
            const unsigned long long mine = select_topk(k, kk, nreg, lane);
            if (lane < 32) *(unsigned long long*)(maskw + (16 * rnd + ql) * DSA_MASK_STRIDE + 2 * lane) = mine;
        }
        __syncthreads();
    }
}

struct MoeOrder {
    int n; const LAS int* ul;
    __device__ __forceinline__ bool next(int i, pg8::Unit& u) const { if (i >= n) return false; u.pm = ul[2 * i]; u.pn = ul[2 * i + 1]; return true; }
    __device__ __forceinline__ void a_ready(const pg8::Unit&) const {}
    __device__ __forceinline__ void done(const pg8::Unit&) const {}
};
struct EpiSwiGLU {
    static constexpr bool PERM = true, AFTER_DRAIN = false;
    bf16* Hid;
    __device__ __forceinline__ void operator()(const pg8::f32x4 (&acc)[2][2][4][2], const pg8::Unit& u, int wr, int wc, int fr, int fq) const {
        const int row0 = u.pm * 256 + wr * 64 + fr, pl = u.pn & 1, hc = 128 * pl + 16 * wc + 4 * fq;
#pragma unroll
        for (int ai = 0; ai < 2; ++ai)
#pragma unroll
            for (int m = 0; m < 4; ++m) { const int row = row0 + ai * 128 + m * 16;
#pragma unroll
                for (int bj = 0; bj < 2; ++bj) { const f32x4 g = acc[ai][bj][m][0], uu = acc[ai][bj][m][1]; f32x4 h;
#pragma unroll
                    for (int e = 0; e < 4; ++e) h[e] = g[e] / (1.f + __expf(-g[e])) * uu[e];
                    u32x2 w; w.x = pg8::cvt_pk_bf16(h[0], h[1]); w.y = pg8::cvt_pk_bf16(h[2], h[3]);
                    *(u32x2*)(Hid + (size_t)row * EFF + hc + 64 * bj) = w; } }
    }
};
struct EpiDown {
    static constexpr bool PERM = true, AFTER_DRAIN = false;
    const int* DSTI; const float* WGT; bf16* Y;
    __device__ __forceinline__ void operator()(const pg8::f32x4 (&acc)[2][2][4][2], const pg8::Unit& u, int wr, int wc, int fr, int fq) const {
        const int row0 = u.pm * 256 + wr * 64 + fr, col0 = (u.pn & 3) * 256 + 32 * wc + 8 * fq;
#pragma unroll
        for (int ai = 0; ai < 2; ++ai)
#pragma unroll
            for (int m = 0; m < 4; ++m) { const int row = row0 + ai * 128 + m * 16; const unsigned di = (unsigned)DSTI[row]; const float w = WGT[row];
                bf16* Yr = Y + (size_t)di * DM + col0;
#pragma unroll
                for (int bj = 0; bj < 2; ++bj) { const f32x4 a = acc[ai][bj][m][0] * w, b = acc[ai][bj][m][1] * w;
                    u32x4 o; o.x = pg8::cvt_pk_bf16(a[0], a[1]); o.y = pg8::cvt_pk_bf16(a[2], a[3]); o.z = pg8::cvt_pk_bf16(b[0], b[1]); o.w = pg8::cvt_pk_bf16(b[2], b[3]);
                    *(u32x4*)(Yr + 128 * bj) = o; }
                asm volatile("" ::: "memory"); }
    }
};

struct Params {
    const float* x; const float* w_in; const float* conv_w; const float* conv_b; const float* dt_bias; const float* a_log; const float* d_skip;
    const float* ssd_norm_w; const float* w_out; const float* ln1_g; const float* ln1_b; const float* w_rg; const float* b_rg; const float* w_re; const float* b_re;
    const float* w_gate; const float* w_up; const float* w_down; const float* ln2_g; const float* ln2_b;
    float* out; unsigned char* ws;
};

template <class AL, class EP>
__device__ __forceinline__ void naive_gemm(float* lds, int Mr, int N, int K, const float* B, int ldb, AL aload, EP epi) {
    constexpr int TM = 128, TN = 64, TK = 32, AS = TM + 4, BS = TN + 4;
    float* As = lds;
    float* Bs = lds + TK * AS;
    const int tid = threadIdx.x, ty = tid >> 4, tx = tid & 15;
    const int tm = Mr / TM, tn = (N + TN - 1) / TN;
    for (int tile = blockIdx.x; tile < tm * tn; tile += gridDim.x) {
        const int row0 = (tile / tn) * TM, col0 = (tile % tn) * TN;
        float acc[4][4];
#pragma unroll
        for (int i = 0; i < 4; ++i)
#pragma unroll
            for (int j = 0; j < 4; ++j) acc[i][j] = 0.f;
        for (int k0 = 0; k0 < K; k0 += TK) {
#pragma unroll
            for (int i = 0; i < 8; ++i) { const int e = tid + NT * i, r = e >> 5, kk = e & 31; As[kk * AS + r] = aload(row0 + r, k0 + kk); }
#pragma unroll
            for (int i = 0; i < 4; ++i) { const int e = tid + NT * i, kk = e >> 6, c = e & 63; Bs[kk * BS + c] = (col0 + c < N) ? B[(size_t)(k0 + kk) * ldb + col0 + c] : 0.f; }
            __syncthreads();
#pragma unroll 8
            for (int kk = 0; kk < TK; ++kk) {
                const f32x4 a = *(const f32x4*)(As + kk * AS + ty * 4), b = *(const f32x4*)(Bs + kk * BS + tx * 4);
#pragma unroll
                for (int i = 0; i < 4; ++i)
#pragma unroll
                    for (int j = 0; j < 4; ++j) acc[i][j] = fmaf(a[i], b[j], acc[i][j]);
            }
            __syncthreads();
        }
#pragma unroll
        for (int i = 0; i < 4; ++i)
#pragma unroll
            for (int j = 0; j < 4; ++j) { const int c = col0 + tx * 4 + j; if (c < N) epi(row0 + ty * 4 + i, c, acc[i][j]); }
    }
}

__device__ __forceinline__ unsigned wave_select(const unsigned (&keys)[32], int kk, int lane) {
    unsigned T = 0u;
    for (int bit = 31; bit >= 0; --bit) {
        const unsigned cand = T | (1u << bit);
        int c = 0;
#pragma unroll
        for (int i = 0; i < 32; ++i) c += (keys[i] >= cand) ? 1 : 0;
#pragma unroll
        for (int o = 1; o < 64; o <<= 1) c += __shfl_xor(c, o);
        if (c >= kk) T = cand;
    }
    unsigned mgt = 0u, meq = 0u;
#pragma unroll
    for (int i = 0; i < 32; ++i) { mgt |= (keys[i] > T) ? (1u << i) : 0u; meq |= (keys[i] == T) ? (1u << i) : 0u; }
    int ngt = __popc(mgt), neq = __popc(meq);
    int tgt = ngt, teq = neq;
#pragma unroll
    for (int o = 1; o < 64; o <<= 1) { tgt += __shfl_xor(tgt, o); teq += __shfl_xor(teq, o); }
    const int need = kk - tgt;
    if (teq == need) return mgt | meq;
    int pre = neq;
#pragma unroll
    for (int o = 1; o < 64; o <<= 1) { const int v = __shfl_up(pre, o); if (lane >= o) pre += v; }
    pre -= neq;
    unsigned sel = mgt; int taken = pre;
#pragma unroll
    for (int i = 0; i < 32; ++i) { if ((meq >> i) & 1u) { if (taken < need) sel |= (1u << i); ++taken; } }
    return sel;
}

typedef const __attribute__((address_space(4))) Params* KPtr;
__device__ __forceinline__ KPtr launder_k(KPtr k) { asm volatile("" : "+s"(k)); return k; }
#define PHASE_VARS const KPtr P = launder_k(KP0); const int tid = launder_i(tid0), lane = tid & 63, wave = tid >> 6, gw = bid * 8 + wave; unsigned char* ws = P->ws; unsigned* ctl = (unsigned*)(ws + WS_CTL); float2* rope = (float2*)(ws + WS_ROPE); float* tokw = (float*)(ws + WS_TOKW); int* lists = (int*)(ws + WS_LISTS); bf16* Qb = (bf16*)(ws + WS_Q); bf16* Kb = (bf16*)(ws + WS_K); bf16* Vb = (bf16*)(ws + WS_V); bf16* IKb = (bf16*)(ws + WS_IK); float* IW = (float*)(ws + WS_IW); float* DT = (float*)(ws + WS_DT); bf16* IQb = (bf16*)(ws + WS_IQ); bf16* Zb = (bf16*)(ws + WS_Z); bf16* XBC = (bf16*)(ws + WS_XBC); bf16* ASb = (bf16*)(ws + WS_AS); float* X1 = (float*)(ws + WS_X1); bf16* X1b = (bf16*)(ws + WS_X1B); bf16* Y0 = (bf16*)(ws + WS_Y0); bf16* Y1 = (bf16*)(ws + WS_Y1); float* XC = (float*)(ws + WS_XC); float* YG = (float*)(ws + WS_YG); bf16* WguT = (bf16*)(ws + WS_WGU_T); bf16* WdT = (bf16*)(ws + WS_WD_T); int* ENT = (int*)(ws + WS_ENT); float* WGT = (float*)(ws + WS_ENT + 512 * 1024); bf16* Xs = (bf16*)(ws + WS_XS); bf16* Hid = (bf16*)(ws + WS_HID); bf16* XB = (bf16*)(ws + WS_XB); bf16* WinT = (bf16*)(ws + WS_WIN_T); bf16* WoutT = (bf16*)(ws + WS_WOUT_T);
__global__ void __launch_bounds__(NT, 2) hybrid_fwd(Params p) {
    extern __shared__ __attribute__((aligned(16))) unsigned char lds[];
    cg::grid_group grid = cg::this_grid();
    const int tid0 = threadIdx.x;
    const int G = gridDim.x, bid = blockIdx.x, NGW = G * 8;
    const KPtr KP0 = (KPtr)__builtin_amdgcn_kernarg_segment_ptr();
    {   PHASE_VARS
    for (int e = bid * NT + tid; e < SEQ * 32; e += G * NT) {
        const int t = e >> 5, i = e & 31;
        const float inv = powf(10000.0f, -(float)(2 * i) / 64.0f);
        const float ang = (float)t * inv;
        float s, c; sincosf(ang, &s, &c);
        rope[e] = make_float2(c, s);
    }
    for (int e = bid * NT + tid; e < 52 * 128; e += G * NT) {
        const int r = e >> 7, c = e & 127; const int row = (r < 4) ? (512 + 196 + r) : (512 + 208 + (r - 4));
        *(u32x4*)(WinT + (size_t)row * DM + c * 8) = (u32x4){0u, 0u, 0u, 0u};
    }
    {
        LAS float* scr = (LAS float*)((LAS unsigned char*)lds + wave * 16384);
        constexpr int I_IN = (DM / 64) * ((INW + 31) / 32), I_OUT = (DM / 64) * (DM / 32), I_GU = NEXP * 2 * 128, I_D = NEXP * 128;
        for (int it = launder_i(gw); it < I_IN + I_OUT + I_GU + I_D; it += NGW) {
            int r = it;
            if (r < I_IN) { transpose_item(P->w_in, DM, INW, WinT, scr, r, lane, [](int c) { return win_dest_row(c); }); continue; } r -= I_IN;
            if (r < I_OUT) { transpose_item(P->w_out, DM, DM, WoutT, scr, r, lane, [](int c) { return c; }); continue; } r -= I_OUT;
            if (r < I_GU) { const int e = r >> 8, up = (r >> 7) & 1, sub = r & 127; const float* W = (up ? P->w_up : P->w_gate) + (size_t)e * DM * EFF;
                transpose_item(W, DM, EFF, WguT + (size_t)e * 512 * DM, scr, sub, lane, [up](int c) { return 8 * (c >> 2) + 4 * up + (c & 3); }); continue; } r -= I_GU;
            { const int e = r >> 7, sub = r & 127; transpose_item(P->w_down + (size_t)e * EFF * DM, EFF, DM, WdT + (size_t)e * DM * EFF, scr, sub, lane, [](int c) { return c; }); }
        }
    }
    for (size_t e = (size_t)bid * NT + tid; e < (size_t)M * DM / 8; e += (size_t)G * NT) {
        const f32x4 a = *(const f32x4*)(P->x + e * 8), b = *(const f32x4*)(P->x + e * 8 + 4);
        u32x4 w; w.x = pg8::cvt_pk_bf16(a[0], a[1]); w.y = pg8::cvt_pk_bf16(a[2], a[3]); w.z = pg8::cvt_pk_bf16(b[0], b[1]); w.w = pg8::cvt_pk_bf16(b[2], b[3]);
        *(u32x4*)(XB + e * 8) = w;
    }
    }
    grid.sync();
    {   PHASE_VARS
    {
        pg8::Gemm g{XB, WinT, M, NPAD, DM}; pg8::StaticOrder S; S.init(M, NPAD, G, bid);
        EpiInProj E{Qb, Kb, Vb, IKb, IQb, Zb, XBC, IW, DT, rope};
        pg8::gemm_phase<EpiInProj, pg8::StaticOrder, true, true>((PG8_LAS unsigned char*)lds, g, S, E);
    }
    }
    grid.sync();
    {   PHASE_VARS
    for (int e = bid * NT + tid; e < M * 768; e += G * NT) {
        const int row = e / 768, c = e - row * 768, t = row & (SEQ - 1);
        float a = P->conv_b[c];
#pragma unroll
        for (int j = 0; j < 4; ++j) { const int tt = t - 3 + j; if (tt >= 0) a = fmaf(P->conv_w[j * 768 + c], bf2f(XBC[(size_t)(row - 3 + j) * 768 + c]), a); }
        XC[e] = silu(a);
    }
    }
    grid.sync();
    {   PHASE_VARS
    {
        float* xs = (float*)lds;
        float* Bs = xs + 4096;
        float* Cs = Bs + 4096;
        float* ys = Cs + 4096;
        float* dts = ys + 4096;
        for (int item = bid; item < BATCH * 8; item += G) {
            const int b = item >> 3, h = item & 7, g = h >> 2;
            const float A = -__expf(P->a_log[h]), dtb = P->dt_bias[h], Dh = P->d_skip[h];
            const int pp = tid >> 3, ng = tid & 7;
            float H[8];
#pragma unroll
            for (int j = 0; j < 8; ++j) H[j] = 0.f;
            for (int t0 = 0; t0 < SEQ; t0 += 64) {
                const size_t rbase = (size_t)b * SEQ + t0;
                for (int e = tid; e < 4096; e += NT) { const int tt = e >> 6, c = e & 63; const float* xr = XC + (rbase + tt) * 768;
                    xs[e] = xr[h * 64 + c]; Bs[e] = xr[512 + g * 64 + c]; Cs[e] = xr[640 + g * 64 + c]; }
                if (tid < 64) { const float v = DT[(rbase + tid) * 8 + h] + dtb; dts[tid] = (v > 20.f) ? v : log1pf(__expf(v)); }
                __syncthreads();
                for (int tt = 0; tt < 64; ++tt) {
                    const float dt = dts[tt], dA = __expf(dt * A), xdt = xs[tt * 64 + pp] * dt;
                    float part = 0.f;
#pragma unroll
                    for (int j = 0; j < 8; ++j) { H[j] = fmaf(H[j], dA, xdt * Bs[tt * 64 + ng * 8 + j]); part = fmaf(Cs[tt * 64 + ng * 8 + j], H[j], part); }
                    part += __shfl_xor(part, 1); part += __shfl_xor(part, 2); part += __shfl_xor(part, 4);
                    if (ng == 0) ys[tt * 64 + pp] = part;
                }
                __syncthreads();
                for (int e = tid; e < 4096; e += NT) { const int tt = e >> 6, c = e & 63;
                    const float z = bf2f(Zb[(rbase + tt) * 512 + h * 64 + c]);
                    const float y = (ys[e] + Dh * xs[e]) * silu(z);
                    YG[(rbase + tt) * 512 + h * 64 + c] = y; }
                __syncthreads();
            }
        }
    }
    {
        const int vcu = (G % 8 == 0) ? (bid % 8) * (G / 8) + bid / 8 : bid;
        for (int pi = vcu; pi < BATCH * 32; pi += G) {
            const int b = pi >> 5, s = pi & 31;
#pragma unroll 1
            for (int hb = 0; hb < 2; ++hb) {
                const int qb = hb ? (63 - s) : s;
                dsa_select(b, qb, IQb, IKb, IW, lds, lane, __builtin_amdgcn_readfirstlane(wave));
                attn_body::attn_unit<8>(b, qb, Qb, Kb, Vb, ASb, (char*)lds, (const char*)lds + DSA_MASK_OFF);
            }
        }
    }
    }
    grid.sync();
    {   PHASE_VARS
    for (int row = launder_i(gw); row < M; row += NGW) {
        const float* yr = YG + (size_t)row * 512;
        float v[8]; float ss = 0.f;
#pragma unroll
        for (int j = 0; j < 8; ++j) { v[j] = yr[lane + 64 * j]; ss = fmaf(v[j], v[j], ss); }
        ss = wave_sum(ss);
        const float r = rsqrtf(ss * (1.f / 512.f) + LN_EPS);
#pragma unroll
        for (int j = 0; j < 8; ++j) ASb[(size_t)row * 1024 + 512 + lane + 64 * j] = f2bf(v[j] * r * P->ssd_norm_w[lane + 64 * j]);
    }
    }
    grid.sync();
    {   PHASE_VARS
    {
        pg8::Gemm g{ASb, WoutT, M, DM, DM}; pg8::StaticOrder S; S.init(M, DM, G, bid);
        EpiH1 E{P->x, X1};
        pg8::gemm_phase<EpiH1, pg8::StaticOrder, true, true>((PG8_LAS unsigned char*)lds, g, S, E);
    }
    }
    grid.sync();
    {   PHASE_VARS
    for (int row = launder_i(gw); row < M; row += NGW) {
        float* xr = X1 + (size_t)row * DM;
        f32x4 v[4]; float s = 0.f;
#pragma unroll
        for (int j = 0; j < 4; ++j) { v[j] = *(const f32x4*)(xr + lane * 4 + 256 * j); s += (v[j][0] + v[j][1]) + (v[j][2] + v[j][3]); }
        const float mean = wave_sum(s) * (1.f / DM); float s2 = 0.f;
#pragma unroll
        for (int j = 0; j < 4; ++j) { v[j] = v[j] - mean; s2 += (v[j][0] * v[j][0] + v[j][1] * v[j][1]) + (v[j][2] * v[j][2] + v[j][3] * v[j][3]); }
        const float rstd = rsqrtf(wave_sum(s2) * (1.f / DM) + LN_EPS);
        float lg[20];
#pragma unroll
        for (int i = 0; i < 20; ++i) lg[i] = 0.f;
#pragma unroll
        for (int j = 0; j < 4; ++j) {
            const int c0 = lane * 4 + 256 * j;
            const f32x4 gg = *(const f32x4*)(P->ln1_g + c0), bb = *(const f32x4*)(P->ln1_b + c0);
            v[j] = v[j] * rstd * gg + bb;
            *(f32x4*)(xr + c0) = v[j];
            u32x2 w; w.x = (unsigned)f2bf(v[j][0]) | ((unsigned)f2bf(v[j][1]) << 16); w.y = (unsigned)f2bf(v[j][2]) | ((unsigned)f2bf(v[j][3]) << 16);
            *(u32x2*)(X1b + (size_t)row * DM + c0) = w;
#pragma unroll
            for (int e = 0; e < 4; ++e) {
                const float xv = v[j][e];
                const f32x4 wg = *(const f32x4*)(P->w_rg + (size_t)(c0 + e) * 4);
#pragma unroll
                for (int i = 0; i < 4; ++i) lg[i] = fmaf(xv, wg[i], lg[i]);
#pragma unroll
                for (int q = 0; q < 4; ++q) { const f32x4 we = *(const f32x4*)(P->w_re + (size_t)(c0 + e) * 16 + q * 4);
#pragma unroll
                    for (int i = 0; i < 4; ++i) lg[4 + q * 4 + i] = fmaf(xv, we[i], lg[4 + q * 4 + i]); }
            }
        }
#pragma unroll
        for (int i = 0; i < 20; ++i) lg[i] = wave_sum(lg[i]);
        if (lane == 0) {
            float gl[4]; int gi = 0; float gm = -INFINITY;
#pragma unroll
            for (int i = 0; i < 4; ++i) { gl[i] = lg[i] + P->b_rg[i]; if (gl[i] > gm) { gm = gl[i]; gi = i; } }
            float gs = 0.f;
#pragma unroll
            for (int i = 0; i < 4; ++i) gs += __expf(gl[i] - gm);
            const float gprob = 1.f / gs;
            float el[4];
#pragma unroll
            for (int i = 0; i < 4; ++i) { float v0 = 0.f;
#pragma unroll
                for (int g2 = 0; g2 < 4; ++g2) if (g2 == gi) v0 = lg[4 + g2 * 4 + i] + P->b_re[g2 * 4 + i];
                el[i] = v0; }
            int i0 = 0; float m0 = el[0];
#pragma unroll
            for (int i = 1; i < 4; ++i) if (el[i] > m0) { m0 = el[i]; i0 = i; }
            int i1 = -1; float m1 = -INFINITY;
#pragma unroll
            for (int i = 0; i < 4; ++i) if (i != i0 && el[i] > m1) { m1 = el[i]; i1 = i; }
            const float e1 = __expf(m1 - m0), inv = 1.f / (1.f + e1);
            const float w0 = inv * gprob, w1 = e1 * inv * gprob;
            const int ex0 = gi * 4 + i0, ex1 = gi * 4 + i1;
            const unsigned s0 = atomicAdd(&ctl[CW_CNT + ex0], 1u), s1 = atomicAdd(&ctl[CW_CNT + ex1], 1u);
            lists[(size_t)ex0 * M + s0] = row * 2; lists[(size_t)ex1 * M + s1] = row * 2 + 1;
            tokw[row * 2] = w0; tokw[row * 2 + 1] = w1;
        }
    }
    }
    grid.sync();
    {   PHASE_VARS
    int* tb = (int*)(lds + 135168);
    if (tid == 0) { int a = 0; for (int e = 0; e < NEXP; ++e) { tb[e] = a; a += (int)((__hip_atomic_load(&ctl[CW_CNT + e], __ATOMIC_RELAXED, __HIP_MEMORY_SCOPE_AGENT) + 255u) >> 8); } tb[NEXP] = a; }
    __syncthreads();
    const int ntiles = tb[NEXP];
    for (int sr = launder_i(gw); sr < ntiles * 256; sr += NGW) {
        const int rt = sr >> 8; int e = 0;
#pragma unroll
        for (int j = 1; j < NEXP; ++j) if (rt >= tb[j]) e = j;
        const int slot = sr - tb[e] * 256; const int cnt_e = (int)__hip_atomic_load(&ctl[CW_CNT + e], __ATOMIC_RELAXED, __HIP_MEMORY_SCOPE_AGENT);
        const int en = (slot < cnt_e) ? lists[(size_t)e * M + slot] : -1;
        if (lane == 0) { ENT[sr] = (en >= 0) ? ((en & 1) * M + (en >> 1)) : 2 * M; WGT[sr] = (en >= 0) ? tokw[en] : 0.f; }
        u32x4 a = (u32x4){0u, 0u, 0u, 0u}, b = a;
        if (en >= 0) { const u32x4* s = (const u32x4*)(X1b + (size_t)(en >> 1) * DM); a = s[lane]; b = s[lane + 64]; }
        u32x4* d = (u32x4*)(Xs + (size_t)sr * DM); d[lane] = a; d[lane + 64] = b;
    }
    }
    grid.sync();
    {   PHASE_VARS
    const LAS int* tb = (const LAS int*)((LAS unsigned char*)lds + 135168); const int ntiles = tb[NEXP];
    {
        LAS int* ul = (LAS int*)((LAS unsigned char*)lds + 135168 + 128); int n = 0;
        if (tid == 0) { for (int L = bid; L < ntiles * 2; L += G) { const int rt = L >> 1; int e = 0; for (int j = 1; j < NEXP; ++j) if (rt >= tb[j]) e = j; ul[2 * n] = rt; ul[2 * n + 1] = e * 2 + (L & 1); ++n; } ul[62] = n; }
        __syncthreads(); n = ul[62];
        pg8::Gemm g{Xs, WguT, MAXROWS, 512, DM}; MoeOrder S{n, ul};
        EpiSwiGLU E{Hid};
        pg8::gemm_phase<EpiSwiGLU, MoeOrder, true, true>((PG8_LAS unsigned char*)lds, g, S, E);
    }
    }
    grid.sync();
    {   PHASE_VARS
    const LAS int* tb = (const LAS int*)((LAS unsigned char*)lds + 135168); const int ntiles = tb[NEXP];
    {
        LAS int* ul = (LAS int*)((LAS unsigned char*)lds + 135168 + 128); int n = 0;
        __syncthreads();
        if (tid == 0) { for (int L = bid; L < ntiles * 4; L += G) { const int rt = L >> 2; int e = 0; for (int j = 1; j < NEXP; ++j) if (rt >= tb[j]) e = j; ul[2 * n] = rt; ul[2 * n + 1] = e * 4 + (L & 3); ++n; } ul[62] = n; }
        __syncthreads(); n = ul[62];
        pg8::Gemm g{Hid, WdT, MAXROWS, DM, EFF}; MoeOrder S{n, ul};
        EpiDown E{ENT, WGT, Y0};
        pg8::gemm_phase<EpiDown, MoeOrder, true, true>((PG8_LAS unsigned char*)lds, g, S, E);
    }
    }
    grid.sync();
    {   PHASE_VARS
    for (int row = launder_i(gw); row < M; row += NGW) {
        const float* xr = X1 + (size_t)row * DM;
        f32x4 v[4]; float s = 0.f;
#pragma unroll
        for (int j = 0; j < 4; ++j) { const int c0 = lane * 4 + 256 * j; v[j] = *(const f32x4*)(xr + c0) * ALPHA;
            const u32x2 a = *(const u32x2*)(Y0 + (size_t)row * DM + c0), b = *(const u32x2*)(Y1 + (size_t)row * DM + c0);
            v[j][0] += __uint_as_float(a.x << 16) + __uint_as_float(b.x << 16); v[j][1] += __uint_as_float(a.x & 0xffff0000u) + __uint_as_float(b.x & 0xffff0000u);
            v[j][2] += __uint_as_float(a.y << 16) + __uint_as_float(b.y << 16); v[j][3] += __uint_as_float(a.y & 0xffff0000u) + __uint_as_float(b.y & 0xffff0000u);
            s += (v[j][0] + v[j][1]) + (v[j][2] + v[j][3]); }
        const float mean = wave_sum(s) * (1.f / DM); float s2 = 0.f;
#pragma unroll
        for (int j = 0; j < 4; ++j) { v[j] = v[j] - mean; s2 += (v[j][0] * v[j][0] + v[j][1] * v[j][1]) + (v[j][2] * v[j][2] + v[j][3] * v[j][3]); }
        const float rstd = rsqrtf(wave_sum(s2) * (1.f / DM) + LN_EPS);
#pragma unroll
        for (int j = 0; j < 4; ++j) { const int c0 = lane * 4 + 256 * j;
            const f32x4 gg = *(const f32x4*)(P->ln2_g + c0), bb = *(const f32x4*)(P->ln2_b + c0);
            *(f32x4*)(P->out + (size_t)row * DM + c0) = v[j] * rstd * gg + bb; }
    }
    }
}

extern "C" void kernel_launch(void* const* d_in, const int* in_sizes, int n_in, void* d_out, int out_size, void* d_ws, size_t ws_size, hipStream_t stream) {
    static int grid = 0;
    if (grid == 0) {
        if (n_in != 20 || in_sizes[0] != M * DM || out_size != M * DM || ws_size < WS_END) { fprintf(stderr, "kernel_launch: unexpected shapes (n_in %d, in0 %d, out %d, ws %zu)\n", n_in, n_in > 0 ? in_sizes[0] : -1, out_size, ws_size); grid = -1; return; }
        int dev = 0, cus = 0, per_cu = 0;
        (void)hipGetDevice(&dev);
        (void)hipDeviceGetAttribute(&cus, hipDeviceAttributeMultiprocessorCount, dev);
        (void)hipFuncSetAttribute((const void*)hybrid_fwd, hipFuncAttributeMaxDynamicSharedMemorySize, LDS_BYTES);
        (void)hipOccupancyMaxActiveBlocksPerMultiprocessor(&per_cu, (const void*)hybrid_fwd, NT, LDS_BYTES);
        if (per_cu < 1) { fprintf(stderr, "kernel_launch: occupancy query says %d blocks/CU\n", per_cu); grid = -1; return; }
        grid = cus;
    }
    if (grid < 0) return;
    (void)hipMemsetAsync((char*)d_ws + WS_CTL, 0, CTL_BYTES, stream);
    Params p{};
    const float** f = (const float**)&p;
    for (int i = 0; i < 20; ++i) f[i] = (const float*)d_in[i];
    p.out = (float*)d_out; p.ws = (unsigned char*)d_ws;
    void* args[] = {&p};
    hipError_t e = hipLaunchCooperativeKernel((const void*)hybrid_fwd, dim3(grid), dim3(NT), args, LDS_BYTES, stream);
    if (e != hipSuccess) fprintf(stderr, "cooperative launch failed: %s (grid %d)\n", hipGetErrorString(e), grid);
}
```

```cpp
#include <hip/hip_runtime.h>
#include <hip/hip_cooperative_groups.h>
#include <cstdio>
#include <cstdint>
namespace cg = cooperative_groups;

constexpr int BATCH = 16, SEQ = 2048, DM = 1024, M = BATCH * SEQ;
constexpr int INW = 2252;
constexpr int C_Q = 0, C_K = 512, C_V = 576, C_IQ = 640, C_IK = 896, C_IW = 960, C_Z = 964, C_XBC = 1476, C_DT = 2244;
constexpr int NEXP = 16, EFF = 256;
constexpr float LN_EPS = 1e-5f;
constexpr float ALPHA = 1.189207115002721f;
constexpr float INDEXER_SCALE = 0.0625f;
constexpr float QSCALE = 0.125f * 1.4426950408889634f;
constexpr int TOPK = 256;
constexpr int NT = 512;
constexpr int LDS_BYTES = 147456;

constexpr size_t MiB = 1u << 20;
constexpr size_t WS_CTL = 0, CTL_BYTES = 1 * MiB;
constexpr size_t WS_ROPE = 1 * MiB;
constexpr size_t WS_TOKW = 2 * MiB;
constexpr size_t WS_LISTS = 3 * MiB;
constexpr size_t WS_WIN_T = 8 * MiB;
constexpr size_t WS_WOUT_T = 16 * MiB;
constexpr size_t WS_WGU_T = 18 * MiB;
constexpr size_t WS_WD_T = 34 * MiB;
constexpr size_t WS_RCONST = 7 * MiB;
constexpr size_t WS_ENT = 5 * MiB;
constexpr size_t WS_XS = 48 * MiB;
constexpr size_t WS_HID = 192 * MiB;
constexpr int MAXTILES = 272, MAXROWS = MAXTILES * 256;
constexpr size_t WS_XB = 256 * MiB;
constexpr int NPAD = 2304;
constexpr size_t WS_Q = 48 * MiB;
constexpr size_t WS_K = 80 * MiB, WS_V = 84 * MiB, WS_IK = 88 * MiB;
constexpr size_t WS_IW = 92 * MiB;
constexpr size_t WS_DT = 93 * MiB;
constexpr size_t WS_IQ = 96 * MiB;
constexpr size_t WS_Z = 112 * MiB;
constexpr size_t WS_XBC = 144 * MiB;
constexpr size_t WS_AS = 192 * MiB;
constexpr size_t WS_X1 = 256 * MiB;
constexpr size_t WS_X1B = 384 * MiB;
constexpr size_t WS_Y0 = 48 * MiB, WS_Y1 = 112 * MiB;
constexpr size_t WS_P32 = 224 * MiB;
constexpr size_t WS_XC = 256 * MiB;
constexpr size_t WS_YG = 352 * MiB;
constexpr size_t WS_END = 512 * MiB;
constexpr int CW_CNT = 8192;
constexpr int CW_BAR = 4096;
constexpr int CW_DSAQ = 128;

typedef unsigned short bf16;
typedef float f32x4 __attribute__((ext_vector_type(4)));
typedef unsigned u32x4 __attribute__((ext_vector_type(4)));
typedef unsigned u32x2 __attribute__((ext_vector_type(2)));

struct Params {
    const float* x; const float* w_in; const float* conv_w; const float* conv_b; const float* dt_bias; const float* a_log; const float* d_skip;
    const float* ssd_norm_w; const float* w_out; const float* ln1_g; const float* ln1_b; const float* w_rg; const float* b_rg; const float* w_re; const float* b_re;
    const float* w_gate; const float* w_up; const float* w_down; const float* ln2_g; const float* ln2_b;
    float* out; unsigned char* ws;
};

__device__ __forceinline__ int launder_i(int v);
typedef const __attribute__((address_space(4))) Params* KPtr;
__device__ __forceinline__ KPtr launder_k(KPtr k) { asm volatile("" : "+s"(k)); return k; }
__device__ __forceinline__ float bf2f(bf16 v) { return __uint_as_float((unsigned)v << 16); }
__device__ __forceinline__ bf16 f2bf(float f) { unsigned u = __float_as_uint(f); return (bf16)((u + 0x7fffu + ((u >> 16) & 1u)) >> 16); }
__device__ __forceinline__ float silu(float v) { return v / (1.f + __expf(-v)); }
__device__ __forceinline__ float wave_sum(float v) {
#pragma unroll
    for (int o = 1; o < 64; o <<= 1) v += __shfl_xor(v, o);
    return v;
}
__device__ __forceinline__ float wave_max(float v) {
#pragma unroll
    for (int o = 1; o < 64; o <<= 1) v = fmaxf(v, __shfl_xor(v, o));
    return v;
}
__device__ __forceinline__ int launder_i(int v) { asm volatile("" : "+v"(v)); return v; }
__device__ __forceinline__ unsigned sortkey(float f) { unsigned u = __float_as_uint(f); return (u & 0x80000000u) ? ~u : (u | 0x80000000u); }

namespace pg8 {
#define PG8_LAS __attribute__((address_space(3)))
typedef unsigned short bf16_t;
typedef short bf16x8 __attribute__((ext_vector_type(8)));
typedef float f32x4 __attribute__((ext_vector_type(4)));
typedef unsigned u32x4 __attribute__((ext_vector_type(4)));
constexpr int BM = 256, BK = 64, HALF = 128, HTB = HALF * BK * 2  , STAGE_BYTES = 8 * HTB, NXCD = 8, WGM = 8;

__host__ __device__ __forceinline__ int lds_byte(int r, int c) { const int st = (r >> 4) * 2 + (c >> 5), rr = r & 15, cc = c & 31, ob = rr * 64 + cc * 2; return st * 1024 + (ob ^ (((ob >> 9) & 1) << 5)); }
__host__ __device__ __forceinline__ void stage_rc(int b, int& R, int& C) { const int st = b / 1024, sb = b % 1024, swz = sb ^ (((sb >> 9) & 1) << 5); R = (st >> 1) * 16 + swz / 64; C = (st & 1) * 32 + (swz % 64) / 2; }
__host__ __device__ __forceinline__ int perm32(int rho) { const int n = rho >> 4, i = rho & 15; return 8 * (i >> 2) + 4 * n + (i & 3); }

struct Unit { int pm, pn; };
struct Gemm { const bf16_t* A; const bf16_t* Bt; int M, N, K; };

struct StaticOrder {
    int nM, nN, nwg, G, c;
    __host__ __device__ void init(int M, int N, int G_, int c_) { nM = M / BM; nN = N / BM; nwg = nM * nN; G = G_; c = c_; }
    __host__ __device__ bool next(int i, Unit& u) const {
        const long L = (long)i * G + c; if (L >= nwg) return false;
        int wgid = (int)L; { const int q = nwg / NXCD, r = nwg % NXCD, xcd = wgid % NXCD, off = wgid / NXCD; wgid = (xcd < r ? xcd * (q + 1) : r * (q + 1) + (xcd - r) * q) + off; }
        const int nig = WGM * nN, gid = wgid / nig, fm = gid * WGM, gsz = (nM - fm) < WGM ? (nM - fm) : WGM;
        u.pm = fm + ((wgid % nig) % gsz); u.pn = (wgid % nig) / gsz; return true;
    }
    __device__ __forceinline__ void a_ready(const Unit&) const {}
    __device__ __forceinline__ void done(const Unit&) const {}
};

__device__ __forceinline__ unsigned cvt_pk_bf16(float lo, float hi) { unsigned r; asm volatile("v_cvt_pk_bf16_f32 %0, %1, %2" : "=v"(r) : "v"(lo), "v"(hi)); return r; }
template <class Epi, class Sched, bool ALIGN_EPI = false, bool SP2 = false>
__device__ __forceinline__ void gemm_phase(PG8_LAS unsigned char* lds, const Gemm g, const Sched& S, const Epi& E) {
    int tid_l = threadIdx.x; asm volatile("" : "+v"(tid_l));
    const int tid = tid_l, wid = __builtin_amdgcn_readfirstlane(tid >> 6), lane = tid & 63, wr = wid >> 2, wc = wid & 3, fr = lane & 15, fq = lane >> 4;
    const int K = g.K, nt = K / BK;
    unsigned voffA[2], voffB[2];
#pragma unroll
    for (int i = 0; i < 2; ++i) { int R, C; stage_rc(tid * 16 + i * 8192, R, C); const int Rb = Epi::PERM ? ((R & ~31) + perm32(R & 31)) : R;
        voffA[i] = (unsigned)(R * K + C) * 2u; voffB[i] = (unsigned)(Rb * K + C) * 2u; }
    const size_t kstep = (size_t)(BK * 2);
    const size_t hstep = (size_t)HALF * K * 2;
    const size_t tstep = 2 * hstep;
    const unsigned ldsw = (unsigned)wid * 1024u;
    const int aoff = lds_byte(wr * 64 + fr, fq * 8), boff = lds_byte(wc * 32 + fr, fq * 8);
#define PG8_SA(b, h) (((b) * 2 + (h)) * HTB)
#define PG8_SB(b, h) ((4 + (b) * 2 + (h)) * HTB)
#define PG8_STAGE(bufoff, gbase, voff) do { _Pragma("unroll") for (int _i = 0; _i < 2; ++_i) \
        __builtin_amdgcn_global_load_lds((const unsigned*)((const char*)(gbase) + (voff)[_i]), (PG8_LAS unsigned*)(lds + (bufoff) + ldsw + _i * 8192), 16, 0, 0); } while (0)
#define PG8_LDA(dst, b, h) do { _Pragma("unroll") for (int m = 0; m < 4; ++m) _Pragma("unroll") for (int k = 0; k < 2; ++k) dst[m][k] = *(const PG8_LAS bf16x8*)(lds + PG8_SA(b, h) + aoff + m * 2048 + k * 1024); } while (0)
#define PG8_LDB(dst, b, h) do { _Pragma("unroll") for (int n = 0; n < 2; ++n) _Pragma("unroll") for (int k = 0; k < 2; ++k) dst[n][k] = *(const PG8_LAS bf16x8*)(lds + PG8_SB(b, h) + boff + n * 2048 + k * 1024); } while (0)
#define PG8_MMA(ai, bj, At, Bt) do { __builtin_amdgcn_s_setprio(1); _Pragma("unroll") for (int m = 0; m < 4; ++m) _Pragma("unroll") for (int n = 0; n < 2; ++n) _Pragma("unroll") for (int k = 0; k < 2; ++k) \
        acc[ai][bj][m][n] = __builtin_amdgcn_mfma_f32_16x16x32_bf16(Bt[n][k], At[m][k], acc[ai][bj][m][n], 0, 0, 0); __builtin_amdgcn_s_setprio(0); } while (0)
#define PG8_WAIT_V(n) asm volatile("s_waitcnt vmcnt(" #n ")" ::: "memory")
#define PG8_WAIT_L(n) asm volatile("s_waitcnt lgkmcnt(" #n ")" ::: "memory")
#define PG8_BAR __builtin_amdgcn_s_barrier()
#define PG8_SCHED __builtin_amdgcn_sched_barrier(0)
    Unit cur, nxt; int ui = 0;
    if (!S.next(0, cur)) return;
    f32x4 acc[2][2][4][2];
#pragma unroll
    for (int a = 0; a < 2; ++a)
#pragma unroll
        for (int b = 0; b < 2; ++b)
#pragma unroll
            for (int m = 0; m < 4; ++m)
#pragma unroll
                for (int n = 0; n < 2; ++n) acc[a][b][m][n] = (f32x4){0.f, 0.f, 0.f, 0.f};
    bf16x8 At[4][2], B0[2][2], B1[2][2];
    const char* cA = (const char*)g.A + (size_t)cur.pm * tstep; const char* cB = (const char*)g.Bt + (size_t)cur.pn * tstep;
    S.a_ready(cur);
    if constexpr (SP2) {
        PG8_STAGE(PG8_SB(0, 0), cB, voffB); PG8_STAGE(PG8_SB(0, 1), cB + hstep, voffB); PG8_STAGE(PG8_SA(0, 0), cA, voffA); PG8_STAGE(PG8_SA(0, 1), cA + hstep, voffA);
        if (wr == 1) PG8_BAR;
        PG8_WAIT_V(2); PG8_BAR;
        PG8_STAGE(PG8_SB(1, 0), cB + kstep, voffB); PG8_STAGE(PG8_SA(1, 0), cA + kstep, voffA); PG8_STAGE(PG8_SB(1, 1), cB + hstep + kstep, voffB);
        PG8_WAIT_V(6); PG8_BAR;
    } else {
        PG8_STAGE(PG8_SB(0, 0), cB, voffB); PG8_STAGE(PG8_SA(0, 0), cA, voffA); PG8_STAGE(PG8_SB(0, 1), cB + hstep, voffB); PG8_STAGE(PG8_SA(0, 1), cA + hstep, voffA);
        if (wr == 1) PG8_BAR;
        PG8_WAIT_V(4); PG8_BAR;
        PG8_STAGE(PG8_SB(1, 0), cB + kstep, voffB); PG8_STAGE(PG8_SA(1, 0), cA + kstep, voffA); PG8_STAGE(PG8_SB(1, 1), cB + hstep + kstep, voffB);
        PG8_WAIT_V(6); PG8_BAR;
    }
    for (;;) {
        const bool has_next = S.next(ui + 1, nxt);
        const char* nA = has_next ? (const char*)g.A + (size_t)nxt.pm * tstep : cA; const char* nB = has_next ? (const char*)g.Bt + (size_t)nxt.pn * tstep : cB;
        for (int t = 0; t < nt; t += 2) {
            const bool last = (t == nt - 2);
            const char* a1 = cA + (size_t)(t + 1) * kstep;
            const char* a2 = last ? nA : cA + (size_t)(t + 2) * kstep; const char* b2 = last ? nB : cB + (size_t)(t + 2) * kstep;
            const char* a3 = a2 + kstep; const char* b3 = b2 + kstep;
            if (last && has_next) S.a_ready(nxt);
            if constexpr (SP2) {
            PG8_LDB(B0, 0, 0); PG8_LDB(B1, 0, 1); PG8_SCHED; PG8_LDA(At, 0, 0); PG8_STAGE(PG8_SA(1, 1), a1 + hstep, voffA);
            PG8_WAIT_V(8); PG8_WAIT_L(0); PG8_BAR; PG8_MMA(0, 0, At, B0); PG8_MMA(0, 1, At, B1); PG8_BAR; PG8_SCHED;
            PG8_LDA(At, 0, 1); PG8_STAGE(PG8_SB(0, 0), b2, voffB); PG8_STAGE(PG8_SB(0, 1), b2 + hstep, voffB); PG8_STAGE(PG8_SA(0, 0), a2, voffA);
            PG8_WAIT_V(8); PG8_WAIT_L(0); PG8_BAR; PG8_MMA(1, 0, At, B0); PG8_MMA(1, 1, At, B1); PG8_BAR; PG8_SCHED;
            PG8_LDB(B0, 1, 0); PG8_LDB(B1, 1, 1); PG8_SCHED; PG8_LDA(At, 1, 0); PG8_STAGE(PG8_SA(0, 1), a2 + hstep, voffA);
            PG8_WAIT_V(8); PG8_WAIT_L(0); PG8_BAR; PG8_MMA(0, 0, At, B0); PG8_MMA(0, 1, At, B1); PG8_BAR; PG8_SCHED;
            PG8_LDA(At, 1, 1); PG8_STAGE(PG8_SB(1, 0), b3, voffB); PG8_STAGE(PG8_SB(1, 1), b3 + hstep, voffB); PG8_STAGE(PG8_SA(1, 0), a3, voffA);
            PG8_WAIT_V(8); PG8_WAIT_L(0); PG8_BAR; PG8_MMA(1, 0, At, B0); PG8_MMA(1, 1, At, B1); PG8_BAR; PG8_SCHED;
            } else {
            PG8_LDB(B0, 0, 0); PG8_SCHED; PG8_LDA(At, 0, 0); PG8_STAGE(PG8_SA(1, 1), a1 + hstep, voffA);
            PG8_WAIT_L(8); PG8_BAR; PG8_WAIT_L(0); PG8_MMA(0, 0, At, B0); PG8_BAR; PG8_SCHED;
            PG8_LDB(B1, 0, 1); PG8_STAGE(PG8_SB(0, 0), b2, voffB);
            PG8_BAR; PG8_WAIT_L(0); PG8_MMA(0, 1, At, B1); PG8_BAR;
            PG8_LDA(At, 0, 1); PG8_STAGE(PG8_SA(0, 0), a2, voffA);
            PG8_BAR; PG8_WAIT_L(0); PG8_MMA(1, 0, At, B0); PG8_BAR; PG8_SCHED;
            PG8_STAGE(PG8_SB(0, 1), b2 + hstep, voffB);
            PG8_WAIT_V(6); PG8_BAR; PG8_MMA(1, 1, At, B1); PG8_BAR;
            PG8_LDB(B0, 1, 0); PG8_SCHED; PG8_LDA(At, 1, 0); PG8_STAGE(PG8_SA(0, 1), a2 + hstep, voffA);
            PG8_WAIT_L(8); PG8_BAR; PG8_WAIT_L(0); PG8_MMA(0, 0, At, B0); PG8_BAR; PG8_SCHED;
            PG8_LDB(B1, 1, 1); PG8_STAGE(PG8_SB(1, 0), b3, voffB);
            PG8_BAR; PG8_WAIT_L(0); PG8_MMA(0, 1, At, B1); PG8_BAR;
            PG8_LDA(At, 1, 1); PG8_STAGE(PG8_SA(1, 0), a3, voffA);
            PG8_BAR; PG8_WAIT_L(0); PG8_MMA(1, 0, At, B0); PG8_BAR; PG8_SCHED;
            PG8_STAGE(PG8_SB(1, 1), b3 + hstep, voffB);
            PG8_WAIT_V(6); PG8_BAR; PG8_MMA(1, 1, At, B1); PG8_BAR;
            }
        }
        if constexpr (ALIGN_EPI) { if (wr == 0) PG8_BAR; }
        if constexpr (!Epi::AFTER_DRAIN) { E(acc, cur, wr, wc, fr, fq); S.done(cur); }
        if (!has_next) break;
#pragma unroll
        for (int a = 0; a < 2; ++a)
#pragma unroll
            for (int b = 0; b < 2; ++b)
#pragma unroll
                for (int m = 0; m < 4; ++m)
#pragma unroll
                    for (int n = 0; n < 2; ++n) acc[a][b][m][n] = (f32x4){0.f, 0.f, 0.f, 0.f};
        cur = nxt; cA = nA; cB = nB; ++ui;
        if constexpr (ALIGN_EPI) { if (wr == 1) PG8_BAR; }
    }
    PG8_WAIT_V(0);
    if constexpr (!ALIGN_EPI) { if (wr == 0) PG8_BAR; }
    PG8_BAR;
    if constexpr (Epi::AFTER_DRAIN) { E.fused(acc, cur, wr, wc, fr, fq, lds, wid, lane); S.done(cur); }
#undef PG8_SA
#undef PG8_SB
#undef PG8_STAGE
#undef PG8_LDA
#undef PG8_LDB
#undef PG8_MMA
#undef PG8_WAIT_V
#undef PG8_WAIT_L
#undef PG8_BAR
#undef PG8_SCHED
}
}

#define LAS __attribute__((address_space(3)))
__host__ __device__ __forceinline__ int rope_pos(int j) { return 2 * (j & 31) + (j >> 5); }
__host__ __device__ __forceinline__ int win_dest_row(int c) {
    if (c < C_K) return (c & ~63) + rope_pos(c & 63);
    if (c < C_V) return 512 + rope_pos(c - C_K);
    if (c < C_IQ) return 512 + 64 + (c - C_V);
    if (c < C_IK) return 768 + ((c - C_IQ) & ~63) + rope_pos((c - C_IQ) & 63);
    if (c < C_IW) return 512 + 128 + rope_pos(c - C_IK);
    if (c < C_Z) return 512 + 192 + (c - C_IW);
    if (c < C_XBC) return 1024 + (c - C_Z);
    if (c < C_DT) return 1536 + (c - C_XBC);
    return 512 + 200 + (c - C_DT);
}
struct EpiInProj {
    static constexpr bool PERM = true, AFTER_DRAIN = false;
    bf16 *Q, *K, *V, *IK, *IQ, *Z, *XBC; float *IW, *DT; const float2* rope;
    __device__ __forceinline__ u32x4 pack8(const f32x4 a, const f32x4 b) const { u32x4 w; w.x = pg8::cvt_pk_bf16(a[0], a[1]); w.y = pg8::cvt_pk_bf16(a[2], a[3]); w.z = pg8::cvt_pk_bf16(b[0], b[1]); w.w = pg8::cvt_pk_bf16(b[2], b[3]); return w; }
    __device__ __forceinline__ u32x4 rope8(const f32x4 v0, const f32x4 v1, const f32x4 r0, const f32x4 r1, float sc) const {
        f32x4 a, b;
        a[0] = (v0[0] * r0[0] - v0[1] * r0[1]) * sc; a[1] = (v0[0] * r0[1] + v0[1] * r0[0]) * sc;
        a[2] = (v0[2] * r0[2] - v0[3] * r0[3]) * sc; a[3] = (v0[2] * r0[3] + v0[3] * r0[2]) * sc;
        b[0] = (v1[0] * r1[0] - v1[1] * r1[1]) * sc; b[1] = (v1[0] * r1[1] + v1[1] * r1[0]) * sc;
        b[2] = (v1[2] * r1[2] - v1[3] * r1[3]) * sc; b[3] = (v1[2] * r1[3] + v1[3] * r1[2]) * sc;
        return pack8(a, b);
    }
    __device__ __forceinline__ void operator()(const pg8::f32x4 (&acc)[2][2][4][2], const pg8::Unit& u, int wr, int wc, int fr, int fq) const {
        const int pn = u.pn, row0 = u.pm * 256 + wr * 64 + fr, cw = 32 * wc + 8 * fq;
        if (pn <= 1 || pn == 3) {
            bf16* dst = (pn == 3) ? IQ : Q; const int ld = (pn == 3) ? 256 : 512; const float sc = (pn == 3) ? 1.f : QSCALE; const int hb = (pn == 3) ? 0 : pn * 4;
#pragma unroll
            for (int ai = 0; ai < 2; ++ai)
#pragma unroll
                for (int m = 0; m < 4; ++m) { const int row = row0 + ai * 128 + m * 16, t = row & (SEQ - 1);
                    const f32x4* rp = (const f32x4*)(rope + t * 32 + 16 * (wc & 1) + 4 * fq); const f32x4 r0 = rp[0], r1 = rp[1];
#pragma unroll
                    for (int bj = 0; bj < 2; ++bj) { const int head = hb + 2 * bj + (wc >> 1);
                        *(u32x4*)(dst + (size_t)row * ld + head * 64 + 32 * (wc & 1) + 8 * fq) = rope8(acc[ai][bj][m][0], acc[ai][bj][m][1], r0, r1, sc); } }
        } else if (pn == 2) {
#pragma unroll
            for (int ai = 0; ai < 2; ++ai)
#pragma unroll
                for (int m = 0; m < 4; ++m) { const int row = row0 + ai * 128 + m * 16, t = row & (SEQ - 1);
                    if (wc < 2) { const f32x4* rp = (const f32x4*)(rope + t * 32 + 16 * wc + 4 * fq); const f32x4 r0 = rp[0], r1 = rp[1];
                        *(u32x4*)(K + (size_t)row * 64 + cw) = rope8(acc[ai][0][m][0], acc[ai][0][m][1], r0, r1, 1.f);
                        *(u32x4*)(IK + (size_t)row * 64 + cw) = rope8(acc[ai][1][m][0], acc[ai][1][m][1], r0, r1, 1.f);
                    } else {
                        *(u32x4*)(V + (size_t)row * 64 + (cw - 64)) = pack8(acc[ai][0][m][0], acc[ai][0][m][1]);
                        if (wc == 2 && fq == 0) *(f32x4*)(IW + (size_t)row * 4) = acc[ai][1][m][0] * INDEXER_SCALE;
                        if (wc == 2 && fq == 1) { *(f32x4*)(DT + (size_t)row * 8) = acc[ai][1][m][0]; *(f32x4*)(DT + (size_t)row * 8 + 4) = acc[ai][1][m][1]; }
                    } }
        } else {
            bf16* dst = (pn < 6) ? Z : XBC; const int ld = (pn < 6) ? 512 : 768; const int cb = (pn < 6) ? (pn - 4) * 256 : (pn - 6) * 256;
#pragma unroll
            for (int ai = 0; ai < 2; ++ai)
#pragma unroll
                for (int m = 0; m < 4; ++m) { const int row = row0 + ai * 128 + m * 16;
#pragma unroll
                    for (int bj = 0; bj < 2; ++bj) *(u32x4*)(dst + (size_t)row * ld + cb + 128 * bj + cw) = pack8(acc[ai][bj][m][0], acc[ai][bj][m][1]); }
        }
    }
};
struct EpiH1 {
    static constexpr bool PERM = false, AFTER_DRAIN = false;
    const float* x; float* out;
    __device__ __forceinline__ void operator()(const pg8::f32x4 (&acc)[2][2][4][2], const pg8::Unit& u, int wr, int wc, int fr, int fq) const {
        const int row0 = u.pm * 256 + wr * 64 + fr, col0 = u.pn * 256 + wc * 32 + 4 * fq;
#pragma unroll
        for (int ai = 0; ai < 2; ++ai)
#pragma unroll
            for (int m = 0; m < 4; ++m) { const size_t off = (size_t)(row0 + ai * 128 + m * 16) * DM + col0;
#pragma unroll
                for (int bj = 0; bj < 2; ++bj)
#pragma unroll
                    for (int n = 0; n < 2; ++n) { const f32x4 xv = *(const f32x4*)(x + off + bj * 128 + n * 16); *(f32x4*)(out + off + bj * 128 + n * 16) = xv * ALPHA + acc[ai][bj][m][n]; } }
    }
};
template <class DR>
__device__ __forceinline__ void transpose_item(const float* W, int K, int N, bf16* WT, LAS float* scr, int item, int lane, DR drow) {
    const int nblk = (N + 31) / 32, kb = item / nblk, nb = item % nblk, k0 = 64 * kb, n0 = 32 * nb;
#pragma unroll 8
    for (int i = 0; i < 32; ++i) { const int kk = 2 * i + (lane >> 5), col = n0 + (lane & 31); scr[kk * 33 + (lane & 31)] = (col < N) ? W[(size_t)(k0 + kk) * N + col] : 0.f; }
    asm volatile("s_waitcnt lgkmcnt(0)" ::: "memory");
    const int c = lane & 7;
#pragma unroll
    for (int j = 0; j < 4; ++j) { const int n = (lane >> 3) + 8 * j, col = n0 + n; const LAS float* s = scr + (8 * c) * 33 + n;
        u32x4 o; o.x = pg8::cvt_pk_bf16(s[0 * 33], s[1 * 33]); o.y = pg8::cvt_pk_bf16(s[2 * 33], s[3 * 33]); o.z = pg8::cvt_pk_bf16(s[4 * 33], s[5 * 33]); o.w = pg8::cvt_pk_bf16(s[6 * 33], s[7 * 33]);
        if (col < N) *(u32x4*)(WT + (size_t)drow(col) * K + k0 + 8 * c) = o; }
    asm volatile("s_waitcnt lgkmcnt(0)" ::: "memory");
}
namespace attn_body {
using bf16=unsigned short;
using bf16x8=__attribute__((ext_vector_type(8)))short;
using s16x4=__attribute__((ext_vector_type(4)))short;
using f32x16=__attribute__((ext_vector_type(16)))float;
using u32x4=__attribute__((ext_vector_type(4)))unsigned;
constexpr int SEQ=2048,D=64,QP=512,KP=64,OP=1024;
constexpr int NW=8,QBLK=32,KVBLK=64;
__device__ __forceinline__ int crow(int r,int hi){return (r&3)+8*(r>>2)+4*hi;}
#define SBAR() __builtin_amdgcn_sched_barrier(0)
__device__ __forceinline__ void amask(f32x16&p0,f32x16&p1,unsigned mlo,unsigned mhi,int hi){
  const unsigned NEGB=0xff800000u; const unsigned a=mlo>>(4*hi), b=mhi>>(4*hi);
  #pragma unroll
  for(int r=0;r<16;++r){ const int pos=(r&3)+8*(r>>2);
    const unsigned s0=(unsigned)__builtin_amdgcn_sbfe((int)a,pos,1), s1=(unsigned)__builtin_amdgcn_sbfe((int)b,pos,1);
    const float v0=p0[r], v1=p1[r];
    p0[r]=__uint_as_float((s0&__float_as_uint(v0))|(~s0&NEGB));
    p1[r]=__uint_as_float((s1&__float_as_uint(v1))|(~s1&NEGB)); }
}

constexpr int NSLOT=3, SLOTB=8192;
constexpr int LDS_K=0, LDS_V=NSLOT*SLOTB, LDS_WS=2*NSLOT*SLOTB, LDS_OST=LDS_WS+NW*64*4, LDS_BYTES=LDS_OST+NW*4096;
constexpr float C2=0.125f*1.4426950408889634f;
__device__ __forceinline__ void glds16(const void*gsrc,unsigned lds_dst){unsigned keep;
  asm volatile("s_mov_b32 %0, m0\n\ts_mov_b32 m0, %2\n\ts_nop 0\n\tglobal_load_lds_dwordx4 %1, off\n\ts_mov_b32 m0, %0":"=&s"(keep):"v"(gsrc),"s"(lds_dst):"memory");}
__device__ __forceinline__ float max3f(float a,float b,float c){float r;asm("v_max3_f32 %0, %1, %2, %3":"=v"(r):"v"(a),"v"(b),"v"(c));return r;}
__device__ __forceinline__ float max2f(float a,float b){float r;asm("v_max_f32_e32 %0, %1, %2":"=v"(r):"v"(a),"v"(b));return r;}
__device__ __forceinline__ float fadd_s(float a,float b){float r;asm("v_add_f32_e32 %0, %1, %2":"=v"(r):"v"(a),"v"(b));return r;}
__device__ __forceinline__ float fsub_s(float a,float b){float r;asm("v_sub_f32_e32 %0, %1, %2":"=v"(r):"v"(a),"v"(b));return r;}
typedef float f32x2_t __attribute__((ext_vector_type(2))); typedef __bf16 bf16x2_t __attribute__((ext_vector_type(2)));
__device__ __forceinline__ unsigned cvtpk_s(float lo,float hi){f32x2_t v={lo,hi};bf16x2_t b=__builtin_convertvector(v,bf16x2_t);return __builtin_bit_cast(unsigned,b);}
#define WAIT_BAR(N) asm volatile("s_waitcnt vmcnt(" #N ") lgkmcnt(0)\n\ts_barrier":::"memory")

__device__ __forceinline__ void qkt(f32x16&p0,f32x16&p1,const char*Kslot,const bf16x8*qr,const f32x16&negm,int r32,int hi){
  const char*kb=Kslot+hi*1024+r32*16;
  #pragma unroll
  for(int d0=0;d0<4;++d0){
    const bf16x8 b0=*reinterpret_cast<const bf16x8*>(kb+d0*2048);
    const bf16x8 b1=*reinterpret_cast<const bf16x8*>(kb+d0*2048+512);
    if(d0==0){p0=__builtin_amdgcn_mfma_f32_32x32x16_bf16(b0,qr[0],negm,0,0,0);p1=__builtin_amdgcn_mfma_f32_32x32x16_bf16(b1,qr[0],negm,0,0,0);}
    else{p0=__builtin_amdgcn_mfma_f32_32x32x16_bf16(b0,qr[d0],p0,0,0,0);p1=__builtin_amdgcn_mfma_f32_32x32x16_bf16(b1,qr[d0],p1,0,0,0);}}
}
typedef __attribute__((address_space(3))) const char* lds_cptr;
typedef short v4i16_t __attribute__((ext_vector_type(4)));
__device__ __forceinline__ void kload8(bf16x8*kf,lds_cptr kp){
  kf[0]=*(const __attribute__((address_space(3))) bf16x8*)(kp);      kf[1]=*(const __attribute__((address_space(3))) bf16x8*)(kp+512);
  kf[2]=*(const __attribute__((address_space(3))) bf16x8*)(kp+2048); kf[3]=*(const __attribute__((address_space(3))) bf16x8*)(kp+2560);
  kf[4]=*(const __attribute__((address_space(3))) bf16x8*)(kp+4096); kf[5]=*(const __attribute__((address_space(3))) bf16x8*)(kp+4608);
  kf[6]=*(const __attribute__((address_space(3))) bf16x8*)(kp+6144); kf[7]=*(const __attribute__((address_space(3))) bf16x8*)(kp+6656);
}
__device__ __forceinline__ void kload2(bf16x8*kf,lds_cptr kp,int j){ kf[2*j]=*(const __attribute__((address_space(3))) bf16x8*)(kp+j*2048); kf[2*j+1]=*(const __attribute__((address_space(3))) bf16x8*)(kp+j*2048+512); }
__device__ __forceinline__ s16x4 vtr(lds_cptr p){ return __builtin_bit_cast(s16x4,__builtin_amdgcn_ds_read_tr16_b64_v4i16((__attribute__((address_space(3))) v4i16_t*)p)); }
__device__ __forceinline__ float rowmax(const f32x16&p0,const f32x16&p1){
  float a=max3f(p0[0],p0[1],p1[0]),b=max3f(p0[2],p0[3],p1[1]);a=max3f(a,p1[2],p1[3]);
  #pragma unroll
  for(int r=4;r<16;r+=4){a=max3f(a,p0[r],p0[r+1]);b=max3f(b,p0[r+2],p0[r+3]);a=max3f(a,p1[r],p1[r+1]);b=max3f(b,p1[r+2],p1[r+3]);}
  const float m=max2f(a,b);
  auto rr=__builtin_amdgcn_permlane32_swap(__float_as_uint(m),__float_as_uint(m),false,false);
  return max2f(__uint_as_float(rr[0]),__uint_as_float(rr[1]));
}
__device__ __forceinline__ void pv(f32x16*o,int vb,bf16x8 pa0,bf16x8 pa1,bf16x8 pa2,bf16x8 pa3){
  #pragma unroll
  for(int d0=0;d0<2;++d0){s16x4 lo[4],hi[4];
    #pragma unroll
    for(int ks=0;ks<4;++ks){
      asm volatile("ds_read_b64_tr_b16 %0,%1 offset:%c2":"=&v"(lo[ks]):"v"(vb),"i"(d0*4096+ks*1024):"memory");
      asm volatile("ds_read_b64_tr_b16 %0,%1 offset:%c2":"=&v"(hi[ks]):"v"(vb),"i"(d0*4096+ks*1024+512):"memory");}
    asm volatile("s_waitcnt lgkmcnt(0)":::"memory");SBAR();
    #define PK(k) (bf16x8){lo[k][0],lo[k][1],lo[k][2],lo[k][3],hi[k][0],hi[k][1],hi[k][2],hi[k][3]}
    o[d0]=__builtin_amdgcn_mfma_f32_32x32x16_bf16(pa0,PK(0),o[d0],0,0,0);
    o[d0]=__builtin_amdgcn_mfma_f32_32x32x16_bf16(pa1,PK(1),o[d0],0,0,0);
    o[d0]=__builtin_amdgcn_mfma_f32_32x32x16_bf16(pa2,PK(2),o[d0],0,0,0);
    o[d0]=__builtin_amdgcn_mfma_f32_32x32x16_bf16(pa3,PK(3),o[d0],0,0,0);
    #undef PK
  }
}

#ifndef ATTN_STORE16
#define ATTN_STORE16(p,v) (*(u32x4*)(p)=(v))
#endif
template<int THRL> __device__ __forceinline__ void attn_unit(int b,int qb,const bf16*Q,const bf16*__restrict__ K,const bf16*__restrict__ V,bf16*O,char*shm,const char*maskb){
  int tid_l=threadIdx.x; asm volatile("":"+v"(tid_l)); const int tid=tid_l,lane=tid&63,r32=lane&31,hi=lane>>5; const int wid=__builtin_amdgcn_readfirstlane(tid>>6);
  const long rowbase=(long)b*SEQ; const int q0=qb*QBLK;
  const bf16*Qw=Q+(rowbase+q0)*QP+wid*D;
  const bf16*Kh=K+rowbase*KP,*Vh=V+rowbase*KP;
  const unsigned lds0=(unsigned)(uintptr_t)shm;
  float*wsf=(float*)(shm+LDS_WS)+wid*64;
  const bf16*ksrc=Kh+(long)lane*KP+wid*8;
  const bf16*vsrc=Vh+(long)(16*(wid&3)+(lane>>2))*KP+(wid>>2)*32+(lane&3)*8;
  const unsigned kdst=lds0+LDS_K+wid*1024, vdst=lds0+LDS_V+wid*1024;
  #define DMA_K(t,slot) glds16(ksrc+(long)(t)*KVBLK*KP,(unsigned)__builtin_amdgcn_readfirstlane(kdst+(slot)))
  #define DMA_V(t,slot) glds16(vsrc+(long)(t)*KVBLK*KP,(unsigned)__builtin_amdgcn_readfirstlane(vdst+(slot)))
  const int vb0=(int)(lds0+LDS_V)+((lane>>4)&1)*32+(lane&3)*8+(4*hi+((lane&15)>>2))*64;
  const char*Kbase=shm+LDS_K; bf16x8 kf[8];
  const lds_cptr shm3=(lds_cptr)shm; const lds_cptr kp0=shm3+LDS_K+hi*1024+r32*16; const lds_cptr vp0=shm3+LDS_V+((lane>>4)&1)*32+(lane&3)*8+(4*hi+((lane&15)>>2))*64;
  const int NTr=(q0+QBLK+KVBLK-1)/KVBLK; const int NT=(NTr<4)?4:((NTr+1)&~1);
  const __attribute__((address_space(3))) unsigned*mrow=(const __attribute__((address_space(3))) unsigned*)((__attribute__((address_space(3))) const char*)maskb)+r32*66;
  DMA_K(0,0);DMA_V(0,0);DMA_K(1,SLOTB);
  bf16x8 qr[4];
  #pragma unroll
  for(int d0=0;d0<4;++d0)qr[d0]=*reinterpret_cast<const bf16x8*>(&Qw[(long)r32*QP+d0*16+hi*8]);
  float zz_=0.f; asm volatile("":"+v"(zz_)); float mhat=zz_,l_reg=zz_;f32x16 o[2];
  #pragma unroll
  for(int r=0;r<16;++r){o[0][r]=zz_;o[1][r]=zz_;}
  f32x16 negm;
  #pragma unroll
  for(int r=0;r<16;++r)negm[r]=zz_;
  asm volatile("":"+v"(negm));
  #define CMASK(P0,P1,t) do{ const unsigned ml_=mrow[2*(t)], mh_=mrow[2*(t)+1]; amask(P0,P1,ml_,mh_,hi); }while(0)
  bool resc=false;
  #define START(P0,P1) do{ const float rm=rowmax(P0,P1); resc=false; \
    { const float dl=(rm>-INFINITY)?rm:0.f; mhat=fadd_s(mhat,dl); \
      _Pragma("unroll") for(int r=0;r<16;++r){P0[r]=fsub_s(P0[r],dl);P1[r]=fsub_s(P1[r],dl);} \
      _Pragma("unroll") for(int r=0;r<16;++r)negm[r]=-mhat; asm volatile("":"+v"(negm)); } \
    _Pragma("unroll") for(int r=0;r<16;++r)P0[r]=__builtin_amdgcn_exp2f(P0[r]); }while(0)
  #define RESC() do{ if(resc){ asm volatile("s_waitcnt lgkmcnt(0)":::"memory"); \
      _Pragma("unroll") for(int d_=0;d_<2;++d_) _Pragma("unroll") for(int r=0;r<16;++r)o[d_][r]*=wsf[crow(r,hi)]; } }while(0)
  f32x16 pA0,pA1,pB0,pB1;
  int sl_prev=0,sl_cur=0,sl_next=SLOTB;
  #define ROT() do{sl_prev=sl_cur;sl_cur=sl_next;sl_next=(sl_next==(NSLOT-1)*SLOTB)?0:sl_next+SLOTB;}while(0)
  DMA_K(2,2*SLOTB);
  WAIT_BAR(3);
  qkt(pA0,pA1,Kbase,qr,negm,r32,hi);asm volatile("s_nop 15\n\ts_nop 7":"+v"(pA0),"+v"(pA1));CMASK(pA0,pA1,0);
  START(pA0,pA1);
  _Pragma("unroll") for(int r=0;r<16;++r)pA1[r]=__builtin_amdgcn_exp2f(pA1[r]);
  WAIT_BAR(0);
  DMA_K(3,0);DMA_V(1,SLOTB);
  ROT();
  kload8(kf,kp0+sl_cur);
  WAIT_BAR(2);
  s16x4 vlo[8],vhi[8]; u32x4 pw0,pw1,pw2,pw3;
  #define PKW(P,B) cvtpk_s(P[B],P[B+1])
  #define PAF(k) __builtin_bit_cast(bf16x8,pw##k)
  #define VFR(i) (bf16x8){vlo[i][0],vlo[i][1],vlo[i][2],vlo[i][3],vhi[i][0],vhi[i][1],vhi[i][2],vhi[i][3]}
  #define PIN(x) asm volatile("":"+v"(x))
  #define MX3(a,b,c) __builtin_fmaxf(__builtin_fmaxf((a),(b)),(c))
  #define GAPA(MF,A0,A1,A2,A3,W0,W1,PW) do{ MF; sacc+=A0; sacc+=A1; sacc+=A2; sacc+=A3; PIN(sacc); W0; W1; PIN(PW); SBAR(); }while(0)
  #define EX(v) __builtin_amdgcn_exp2f(v)
  #define GAPB(MF,X,B) do{ MF; X[B]=EX(X[B]); X[B+1]=EX(X[B+1]); X[B+2]=EX(X[B+2]); X[B+3]=EX(X[B+3]); PIN(X); SBAR(); }while(0)
  #define VRD(i) do{ vlo[i]=vtr(vp_+(((i)>>2)*4096+((i)&3)*1024)); vhi[i]=vtr(vp_+(((i)>>2)*4096+((i)&3)*1024+512)); }while(0)
  #define KRD(G,j) do{ if(G){ kload2(kf,kp0+sl_next,j); SBAR(); } }while(0)
  #define STEP(C0,C1,P0,P1,t,GK,GV,GL) do{ SBAR(); \
    const lds_cptr vp_=vp0+sl_prev; \
    VRD(0); SBAR(); float sacc=(P0[0]+P0[1]); \
    GAPA(C0=__builtin_amdgcn_mfma_f32_32x32x16_bf16(kf[0],qr[0],negm,0,0,0), P0[2],P0[3],P0[4],P0[5],     pw0[0]=PKW(P0,0), pw0[1]=PKW(P0,2), pw0); \
    VRD(4); SBAR(); GAPA(C1=__builtin_amdgcn_mfma_f32_32x32x16_bf16(kf[1],qr[0],negm,0,0,0), P0[6],P0[7],P0[8],P0[9],     pw0[2]=PKW(P0,4), pw0[3]=PKW(P0,6), pw0); \
    VRD(1); SBAR(); GAPA(C0=__builtin_amdgcn_mfma_f32_32x32x16_bf16(kf[2],qr[1],C0,0,0,0),   P0[10],P0[11],P0[12],P0[13], pw1[0]=PKW(P0,8), pw1[1]=PKW(P0,10), pw1); \
    VRD(5); SBAR(); GAPA(C1=__builtin_amdgcn_mfma_f32_32x32x16_bf16(kf[3],qr[1],C1,0,0,0),   P0[14],P0[15],P1[0],P1[1],   pw1[2]=PKW(P0,12),pw1[3]=PKW(P0,14), pw1); \
    VRD(2); SBAR(); GAPA(C0=__builtin_amdgcn_mfma_f32_32x32x16_bf16(kf[4],qr[2],C0,0,0,0),   P1[2],P1[3],P1[4],P1[5],     pw2[0]=PKW(P1,0), pw2[1]=PKW(P1,2), pw2); \
    VRD(6); SBAR(); GAPA(C1=__builtin_amdgcn_mfma_f32_32x32x16_bf16(kf[5],qr[2],C1,0,0,0),   P1[6],P1[7],P1[8],P1[9],     pw2[2]=PKW(P1,4), pw2[3]=PKW(P1,6), pw2); \
    VRD(3); SBAR(); GAPA(C0=__builtin_amdgcn_mfma_f32_32x32x16_bf16(kf[6],qr[3],C0,0,0,0),   P1[10],P1[11],P1[12],P1[13], pw3[0]=PKW(P1,8), pw3[1]=PKW(P1,10), pw3); \
    VRD(7); SBAR(); GAPA(C1=__builtin_amdgcn_mfma_f32_32x32x16_bf16(kf[7],qr[3],C1,0,0,0),   P1[14],P1[15],0.f,0.f,       pw3[2]=PKW(P1,12),pw3[3]=PKW(P1,14), pw3); \
    l_reg+=sacc; \
    if(GK){DMA_K((t)+3,sl_cur);} if(GV){DMA_V((t)+1,sl_next);} \
    CMASK(C0,C1,t); \
    { float a=MX3(C0[0],C0[1],C1[0]),b=MX3(C0[2],C0[3],C1[1]); a=MX3(a,C1[2],C1[3]); \
      _Pragma("unroll") for(int r=4;r<16;r+=4){a=MX3(a,C0[r],C0[r+1]);b=MX3(b,C0[r+2],C0[r+3]);a=MX3(a,C1[r],C1[r+1]);b=MX3(b,C1[r+2],C1[r+3]);} \
      float rm=__builtin_fmaxf(a,b); { auto rr=__builtin_amdgcn_permlane32_swap(__float_as_uint(rm),__float_as_uint(rm),false,false); rm=__builtin_fmaxf(__uint_as_float(rr[0]),__uint_as_float(rr[1])); } \
      resc=false; \
      if(__builtin_expect(__any(rm>(float)THRL),0)){ const float dl=__builtin_fmaxf(rm,0.f); mhat+=dl; \
        _Pragma("unroll") for(int r=0;r<16;++r){C0[r]-=dl;C1[r]-=dl;} \
        _Pragma("unroll") for(int r=0;r<16;++r)negm[r]=-mhat; asm volatile("":"+v"(negm)); \
        const float f=__builtin_amdgcn_exp2f(-dl); l_reg*=f; if(hi==0)wsf[r32]=f; resc=true; } } \
    SBAR(); \
    GAPB(o[0]=__builtin_amdgcn_mfma_f32_32x32x16_bf16(PAF(0),VFR(0),o[0],0,0,0), C0,0); \
    GAPB(o[1]=__builtin_amdgcn_mfma_f32_32x32x16_bf16(PAF(0),VFR(4),o[1],0,0,0), C0,4); \
    KRD(GL,0); GAPB(o[0]=__builtin_amdgcn_mfma_f32_32x32x16_bf16(PAF(1),VFR(1),o[0],0,0,0), C0,8); \
    KRD(GL,1); GAPB(o[1]=__builtin_amdgcn_mfma_f32_32x32x16_bf16(PAF(1),VFR(5),o[1],0,0,0), C0,12); \
    KRD(GL,2); GAPB(o[0]=__builtin_amdgcn_mfma_f32_32x32x16_bf16(PAF(2),VFR(2),o[0],0,0,0), C1,0); \
    KRD(GL,3); GAPB(o[1]=__builtin_amdgcn_mfma_f32_32x32x16_bf16(PAF(2),VFR(6),o[1],0,0,0), C1,4); \
    GAPB(o[0]=__builtin_amdgcn_mfma_f32_32x32x16_bf16(PAF(3),VFR(3),o[0],0,0,0), C1,8); \
    GAPB(o[1]=__builtin_amdgcn_mfma_f32_32x32x16_bf16(PAF(3),VFR(7),o[1],0,0,0), C1,12); \
    }while(0)
  int t=1;
  for(;t+5<NT;t+=2){
    STEP(pB0,pB1,pA0,pA1,t,true,true,true);     WAIT_BAR(2); RESC(); ROT();
    STEP(pA0,pA1,pB0,pB1,t+1,true,true,true);   WAIT_BAR(2); RESC(); ROT();
  }
  #define ENDW(tt) do{ if((tt)+3<NT){WAIT_BAR(2);} else if((tt)+2<NT){WAIT_BAR(1);} else {WAIT_BAR(0);} }while(0)
  for(;t+1<NT;t+=2){
    STEP(pB0,pB1,pA0,pA1,t,(t+3<NT),(t+1<NT),(t+1<NT));       ENDW(t);   RESC(); ROT();
    STEP(pA0,pA1,pB0,pB1,t+1,(t+4<NT),(t+2<NT),(t+2<NT));     ENDW(t+1); RESC(); ROT();
  }
  STEP(pB0,pB1,pA0,pA1,NT-1,false,false,false); RESC();
  { float sacc=pB0[0]+pB0[1]; _Pragma("unroll") for(int r=2;r<16;++r)sacc+=pB0[r]; _Pragma("unroll") for(int r=0;r<16;++r)sacc+=pB1[r]; l_reg+=sacc;
    pw0=(u32x4){PKW(pB0,0),PKW(pB0,2),PKW(pB0,4),PKW(pB0,6)};pw1=(u32x4){PKW(pB0,8),PKW(pB0,10),PKW(pB0,12),PKW(pB0,14)};pw2=(u32x4){PKW(pB1,0),PKW(pB1,2),PKW(pB1,4),PKW(pB1,6)};pw3=(u32x4){PKW(pB1,8),PKW(pB1,10),PKW(pB1,12),PKW(pB1,14)};
    SBAR(); pv(o,vb0+sl_cur,PAF(0),PAF(1),PAF(2),PAF(3)); }
  #undef PKW
  #undef PAF
  #undef VFR
  #undef PIN
  #undef MX3
  #undef GAPA
  #undef GAPB
  #undef EX
  #undef VRD
  #undef KRD
  #undef STEP
  #undef ENDW
  {auto rr=__builtin_amdgcn_permlane32_swap(__float_as_uint(l_reg),__float_as_uint(l_reg),false,false);l_reg=__uint_as_float(rr[0])+__uint_as_float(rr[1]);}
  if(hi==0)wsf[32+r32]=l_reg;asm volatile("s_waitcnt lgkmcnt(0)":::"memory");
  float rli[16];
  #pragma unroll
  for(int r=0;r<16;++r)rli[r]=__builtin_amdgcn_rcpf(wsf[32+crow(r,hi)]);
  bf16*Ow=O+(rowbase+q0)*OP+wid*D;
  { bf16*stg=(bf16*)(shm+LDS_OST)+wid*2048;
    #pragma unroll
    for(int r=0;r<16;++r){const int orow=crow(r,hi);
      #pragma unroll
      for(int d0=0;d0<2;++d0)stg[orow*64+d0*32+r32]=(bf16)(cvtpk_s(o[d0][r]*rli[r],0.f)&0xffffu);}
    asm volatile("s_waitcnt lgkmcnt(0)":::"memory");
    #pragma unroll
    for(int i=0;i<4;++i){const int row=i*8+(lane>>3),ch=lane&7; const u32x4 v=*(const u32x4*)(stg+row*64+ch*8); ATTN_STORE16(Ow+(long)row*OP+ch*8,v);} }
  asm volatile("s_waitcnt lgkmcnt(0)\n\ts_barrier":::"memory");
  #undef DMA_K
  #undef DMA_V
  #undef CMASK
  #undef START
  #undef RESC
  #undef ROT
}
constexpr int ATTN_LDS_BYTES=LDS_BYTES;
#undef SBAR
#undef WAIT_BAR
}

constexpr int DSA_MASK_OFF = 131072, DSA_MASK_STRIDE = 66;
typedef short bf16x8_t __attribute__((ext_vector_type(8)));
__device__ __forceinline__ unsigned long long select_topk(const unsigned (&k)[32], int kk, int nreg, int lane) {
    unsigned T = 0u; bool exact = false;
    for (int bit = 31; bit >= 0; --bit) {
        const unsigned cand = T | (1u << bit);
        int c = 0;
#pragma unroll
        for (int g4 = 0; g4 < 8; ++g4) if (4 * g4 < nreg) {
#pragma unroll
            for (int j = 0; j < 4; ++j) c += __popcll(__ballot(k[4 * g4 + j] >= cand)); }
        if (c == kk) { T = cand; exact = true; break; }
        if (c > kk) T = cand;
    }
    unsigned long long mine = 0ull;
    if (exact) {
#pragma unroll
        for (int i = 0; i < 32; ++i) { const unsigned long long m = __ballot(k[i] >= T); if (lane == i) mine = m; }
    } else {
        int ngt = 0;
#pragma unroll
        for (int i = 0; i < 32; ++i) ngt += __popcll(__ballot(k[i] > T));
        int need = kk - ngt;
#pragma unroll
        for (int i = 0; i < 32; ++i) {
            const unsigned long long eqb = __ballot(k[i] == T);
            const int rank = __builtin_amdgcn_mbcnt_hi((unsigned)(eqb >> 32), __builtin_amdgcn_mbcnt_lo((unsigned)eqb, 0u));
            const bool sel = (k[i] > T) || ((k[i] == T) && (rank < need));
            const unsigned long long m = __ballot(sel);
            need -= __popcll(eqb); if (need < 0) need = 0;
            if (lane == i) mine = m;
        }
    }
    return mine;
}
__device__ __forceinline__ void dsa_select(int b, int qb, const bf16* IQb, const bf16* IKb, const float* IW, unsigned char* lds, int lane, int wave) {
    lane = launder_i(lane);
    unsigned* keys = (unsigned*)lds; unsigned* maskw = (unsigned*)(lds + DSA_MASK_OFF);
    const size_t rb = (size_t)b * SEQ; const int q0 = qb * 32; const int ntk16 = 4 * ((qb >> 1) + 1);
    const int l15 = lane & 15, l4 = lane >> 4;
    for (int rnd = 0; rnd < 2; ++rnd) {
        const int qb0 = q0 + 16 * rnd;
        bf16x8_t a[4][2]; f32x4 wq[4];
#pragma unroll
        for (int mt = 0; mt < 4; ++mt) {
            const bf16* ar = IQb + (rb + qb0 + 4 * mt + (l15 >> 2)) * 256 + (l15 & 3) * 64 + 8 * l4;
            a[mt][0] = *(const bf16x8_t*)ar; a[mt][1] = *(const bf16x8_t*)(ar + 32);
            wq[mt] = *(const f32x4*)(IW + (rb + qb0 + 4 * mt + l4) * 4);
        }
        for (int nt = wave; nt < ntk16; nt += 8) {
            const int s = 16 * nt + l15;
            const bf16* br = IKb + (rb + s) * 64 + 8 * l4;
            const bf16x8_t b0 = *(const bf16x8_t*)br, b1 = *(const bf16x8_t*)(br + 32);
#pragma unroll
            for (int mt = 0; mt < 4; ++mt) {
                f32x4 c = (f32x4){0.f, 0.f, 0.f, 0.f};
                c = __builtin_amdgcn_mfma_f32_16x16x32_bf16(a[mt][0], b0, c, 0, 0, 0);
                c = __builtin_amdgcn_mfma_f32_16x16x32_bf16(a[mt][1], b1, c, 0, 0, 0);
                float sc = wq[mt][0] * fmaxf(c[0], 0.f); sc = fmaf(wq[mt][1], fmaxf(c[1], 0.f), sc); sc = fmaf(wq[mt][2], fmaxf(c[2], 0.f), sc); sc = fmaf(wq[mt][3], fmaxf(c[3], 0.f), sc);
                const int ql = 4 * mt + l4, t = qb0 + ql;
                keys[ql * 2048 + s] = (s <= t) ? sortkey(sc) : 0u;
            }
        }
        __syncthreads();
#pragma unroll 1
        for (int j = 0; j < 2; ++j) {
            const int ql = 2 * wave + j, t = qb0 + ql, kk = (t + 1 < TOPK) ? (t + 1) : TOPK, nreg = (t >> 6) + 1;
            unsigned k[32];
#pragma unroll
            for (int i = 0; i < 32; ++i) k[i] = (i < nreg) ? keys[ql * 2048 + 64 * i + lane] : 0u;
            const unsigned long long mine = select_topk(k, kk, nreg, lane);
            if (lane < 32) *(unsigned long long*)(maskw + (16 * rnd + ql) * DSA_MASK_STRIDE + 2 * lane) = mine;
        }
        __syncthreads();
    }
}

constexpr int LD64 = 72, LD128 = 136;
constexpr int SSD_CM = 0, SSD_BM = 18432, SSD_XS = 36864, SSD_XDT = 55296, SSD_BDT = 72704, SSD_MT = 90112, SSD_HB = 124928, SSD_DTS = 134144, SSD_ACUM = 134656, SSD_CW = 135168;
__device__ __forceinline__ bf16x8_t ldfrag(const bf16* base, int row, int ld, int k0) { return *(const bf16x8_t*)(base + row * ld + k0); }
__device__ __forceinline__ void ssd_item(int b, int h, KPtr P, const bf16* XBC, const float* DT, const bf16* Zb, float* YG, unsigned char* lds, int tid) {
    tid = launder_i(tid);
    const int lane = tid & 63, w = __builtin_amdgcn_readfirstlane(tid >> 6), l15 = lane & 15, l4 = lane >> 4, g = h >> 2;
    bf16* Cm = (bf16*)(lds + SSD_CM); bf16* Bm = (bf16*)(lds + SSD_BM); bf16* xs = (bf16*)(lds + SSD_XS); bf16* XdtT = (bf16*)(lds + SSD_XDT);
    bf16* BdT = (bf16*)(lds + SSD_BDT); bf16* Mt = (bf16*)(lds + SSD_MT); bf16* Hb = (bf16*)(lds + SSD_HB);
    float* dts = (float*)(lds + SSD_DTS); float* acum = (float*)(lds + SSD_ACUM);
    const float A = -__expf(P->a_log[h]), dtb = P->dt_bias[h], Dh = P->d_skip[h];
    f32x4 Hacc[2]; Hacc[0] = (f32x4){0.f, 0.f, 0.f, 0.f}; Hacc[1] = Hacc[0];
    for (int e = tid; e < 64 * LD64 / 2; e += NT) ((unsigned*)Hb)[e] = 0u;
    float* cwl = (float*)(lds + SSD_CW);
    for (int e = tid; e < 960; e += NT) { const int T = (e < 768) ? (e >> 8) : ((e - 768) >> 6), ch = e & 63, cb = (T == 0) ? h * 64 : (T == 1 ? 512 + g * 64 : 640 + g * 64);
        cwl[e] = (e < 768) ? P->conv_w[((e >> 6) & 3) * 768 + cb + ch] : P->conv_b[cb + ch]; }
    const int pt = w >> 1, ntb = 2 * (w & 1);
    for (int c = 0; c < SEQ / 128; ++c) {
        const size_t rbase = (size_t)b * SEQ + c * 128;
        if (tid < 128) { const float v = DT[(rbase + tid) * 8 + h] + dtb; dts[tid] = (v > 20.f) ? v : log1pf(__expf(v)); }
        __syncthreads();
        if (w == 0) {
            const float a0 = dts[2 * lane] * A, a1 = dts[2 * lane + 1] * A; const float s = a0 + a1; float inc = s;
#pragma unroll
            for (int o = 1; o < 64; o <<= 1) { const float v = __shfl_up(inc, o); if (lane >= o) inc += v; }
            const float ex = inc - s; acum[2 * lane] = ex + a0; acum[2 * lane + 1] = ex + s;
        }
        __syncthreads();
        const float alast = acum[127];
        {
            const int l = tid >> 2, c0 = (tid & 3) * 16;
            const bf16* xr = XBC + (rbase + l) * 768;
            const float dtl = dts[l], dec = __expf(alast - acum[l]);
            const int tmin = 3 - (c * 128 + l);
#pragma unroll
            for (int T = 0; T < 3; ++T) {
                const int cb = (T == 0) ? h * 64 : (T == 1 ? 512 + g * 64 : 640 + g * 64);
                u32x4 u[4][2];
#pragma unroll
                for (int j = 0; j < 4; ++j) { if (j >= tmin) { u[j][0] = *(const u32x4*)(xr + (j - 3) * 768 + cb + c0); u[j][1] = *(const u32x4*)(xr + (j - 3) * 768 + cb + c0 + 8); }
                                              else { u[j][0] = (u32x4){0u, 0u, 0u, 0u}; u[j][1] = u[j][0]; } }
                float v[16];
#pragma unroll
                for (int i = 0; i < 16; ++i) v[i] = cwl[768 + T * 64 + c0 + i];
#pragma unroll
                for (int j = 0; j < 4; ++j)
#pragma unroll
                    for (int i = 0; i < 16; ++i) { const unsigned wd = u[j][i >> 3][(i >> 1) & 3]; const float xv = (i & 1) ? __uint_as_float(wd & 0xffff0000u) : __uint_as_float(wd << 16);
                        v[i] = fmaf(cwl[(T * 4 + j) * 64 + c0 + i], xv, v[i]); }
#pragma unroll
                for (int i = 0; i < 16; ++i) v[i] = silu(v[i]);
                bf16* dstm = (T == 0) ? xs : (T == 1 ? Bm : Cm);
                u32x4 o0, o1; o0.x = pg8::cvt_pk_bf16(v[0], v[1]); o0.y = pg8::cvt_pk_bf16(v[2], v[3]); o0.z = pg8::cvt_pk_bf16(v[4], v[5]); o0.w = pg8::cvt_pk_bf16(v[6], v[7]);
                o1.x = pg8::cvt_pk_bf16(v[8], v[9]); o1.y = pg8::cvt_pk_bf16(v[10], v[11]); o1.z = pg8::cvt_pk_bf16(v[12], v[13]); o1.w = pg8::cvt_pk_bf16(v[14], v[15]);
                *(u32x4*)(dstm + l * LD64 + c0) = o0; *(u32x4*)(dstm + l * LD64 + c0 + 8) = o1;
                if (T == 0) {
#pragma unroll
                    for (int i = 0; i < 16; ++i) XdtT[(c0 + i) * LD128 + l] = f2bf(v[i] * dtl); }
                if (T == 1) {
#pragma unroll
                    for (int i = 0; i < 16; ++i) BdT[(c0 + i) * LD128 + l] = f2bf(v[i] * dec); }
            }
        }
        __syncthreads();
        const int lrow = 16 * w + l15; const float al = acum[lrow];
        {
            const bf16x8_t c0f = ldfrag(Cm, lrow, LD64, 8 * l4), c1f = ldfrag(Cm, lrow, LD64, 32 + 8 * l4);
            for (int j = 0; j <= w; ++j) {
                f32x4 acc = (f32x4){0.f, 0.f, 0.f, 0.f};
                acc = __builtin_amdgcn_mfma_f32_16x16x32_bf16(ldfrag(Bm, 16 * j + l15, LD64, 8 * l4), c0f, acc, 0, 0, 0);
                acc = __builtin_amdgcn_mfma_f32_16x16x32_bf16(ldfrag(Bm, 16 * j + l15, LD64, 32 + 8 * l4), c1f, acc, 0, 0, 0);
                const int s0 = 16 * j + 4 * l4; float m[4];
#pragma unroll
                for (int r = 0; r < 4; ++r) { const int s = s0 + r; m[r] = (s <= lrow) ? acc[r] * __expf(al - acum[s]) : 0.f; }
                u32x2 o; o.x = pg8::cvt_pk_bf16(m[0], m[1]); o.y = pg8::cvt_pk_bf16(m[2], m[3]);
                *(u32x2*)(Mt + lrow * LD128 + s0) = o;
            }
            if ((w & 1) == 0) *(u32x2*)(Mt + lrow * LD128 + 16 * (w + 1) + 4 * l4) = (u32x2){0u, 0u};
        }
        {
            const bf16x8_t c0f = ldfrag(Cm, lrow, LD64, 8 * l4), c1f = ldfrag(Cm, lrow, LD64, 32 + 8 * l4);
            const float ea = __expf(al); const int nks = (w >> 1) + 1;
            bf16x8_t mf[4];
#pragma unroll
            for (int ks = 0; ks < 4; ++ks) mf[ks] = (ks < nks) ? ldfrag(Mt, lrow, LD128, 32 * ks + 8 * l4) : (bf16x8_t){0, 0, 0, 0, 0, 0, 0, 0};
#pragma unroll
            for (int jt = 0; jt < 4; ++jt) {
                f32x4 acc = (f32x4){0.f, 0.f, 0.f, 0.f};
                acc = __builtin_amdgcn_mfma_f32_16x16x32_bf16(ldfrag(Hb, 16 * jt + l15, LD64, 8 * l4), c0f, acc, 0, 0, 0);
                acc = __builtin_amdgcn_mfma_f32_16x16x32_bf16(ldfrag(Hb, 16 * jt + l15, LD64, 32 + 8 * l4), c1f, acc, 0, 0, 0);
                acc = acc * ea;
#pragma unroll
                for (int ks = 0; ks < 4; ++ks) if (ks < nks) acc = __builtin_amdgcn_mfma_f32_16x16x32_bf16(ldfrag(XdtT, 16 * jt + l15, LD128, 32 * ks + 8 * l4), mf[ks], acc, 0, 0, 0);
                const int p0 = 16 * jt + 4 * l4;
                const u32x2 xb = *(const u32x2*)(xs + lrow * LD64 + p0);
                const u32x2 zb = *(const u32x2*)(Zb + (rbase + lrow) * 512 + h * 64 + p0);
                const float x0 = __uint_as_float(xb.x << 16), x1 = __uint_as_float(xb.x & 0xffff0000u), x2 = __uint_as_float(xb.y << 16), x3 = __uint_as_float(xb.y & 0xffff0000u);
                const float z0 = __uint_as_float(zb.x << 16), z1 = __uint_as_float(zb.x & 0xffff0000u), z2 = __uint_as_float(zb.y << 16), z3 = __uint_as_float(zb.y & 0xffff0000u);
                f32x4 y; y[0] = (acc[0] + Dh * x0) * silu(z0); y[1] = (acc[1] + Dh * x1) * silu(z1); y[2] = (acc[2] + Dh * x2) * silu(z2); y[3] = (acc[3] + Dh * x3) * silu(z3);
                *(f32x4*)(YG + (rbase + lrow) * 512 + h * 64 + p0) = y;
            }
        }
        __syncthreads();
        {
            const float el = __expf(alast);
            bf16x8_t xf[4];
#pragma unroll
            for (int ks = 0; ks < 4; ++ks) xf[ks] = ldfrag(XdtT, 16 * pt + l15, LD128, 32 * ks + 8 * l4);
#pragma unroll
            for (int i = 0; i < 2; ++i) {
                f32x4 acc = Hacc[i] * el;
#pragma unroll
                for (int ks = 0; ks < 4; ++ks) acc = __builtin_amdgcn_mfma_f32_16x16x32_bf16(xf[ks], ldfrag(BdT, 16 * (ntb + i) + l15, LD128, 32 * ks + 8 * l4), acc, 0, 0, 0);
                Hacc[i] = acc;
#pragma unroll
                for (int r = 0; r < 4; ++r) Hb[(16 * pt + 4 * l4 + r) * LD64 + 16 * (ntb + i) + l15] = f2bf(acc[r]);
            }
        }
    }
    __syncthreads();
}

struct MoeOrder {
    int n; const LAS int* ul;
    __device__ __forceinline__ bool next(int i, pg8::Unit& u) const { if (i >= n) return false; u.pm = ul[2 * i]; u.pn = ul[2 * i + 1]; return true; }
    __device__ __forceinline__ void a_ready(const pg8::Unit&) const {}
    __device__ __forceinline__ void done(const pg8::Unit&) const {}
};
struct EpiSwiGLU {
    static constexpr bool PERM = true, AFTER_DRAIN = false;
    bf16* Hid;
    __device__ __forceinline__ void operator()(const pg8::f32x4 (&acc)[2][2][4][2], const pg8::Unit& u, int wr, int wc, int fr, int fq) const {
        const int row0 = u.pm * 256 + wr * 64 + fr, pl = u.pn & 1, hc = 128 * pl + 16 * wc + 4 * fq;
#pragma unroll
        for (int ai = 0; ai < 2; ++ai)
#pragma unroll
            for (int m = 0; m < 4; ++m) { const int row = row0 + ai * 128 + m * 16;
#pragma unroll
                for (int bj = 0; bj < 2; ++bj) { const f32x4 g = acc[ai][bj][m][0], uu = acc[ai][bj][m][1]; f32x4 h;
#pragma unroll
                    for (int e = 0; e < 4; ++e) h[e] = g[e] / (1.f + __expf(-g[e])) * uu[e];
                    u32x2 w; w.x = pg8::cvt_pk_bf16(h[0], h[1]); w.y = pg8::cvt_pk_bf16(h[2], h[3]);
                    *(u32x2*)(Hid + (size_t)row * EFF + hc + 64 * bj) = w; } }
    }
};
struct EpiDown {
    static constexpr bool PERM = true, AFTER_DRAIN = false;
    const int* DSTI; const float* WGT; bf16* Y;
    __device__ __forceinline__ void operator()(const pg8::f32x4 (&acc)[2][2][4][2], const pg8::Unit& u, int wr, int wc, int fr, int fq) const {
        const int row0 = u.pm * 256 + wr * 64 + fr, col0 = (u.pn & 3) * 256 + 32 * wc + 8 * fq;
#pragma unroll
        for (int ai = 0; ai < 2; ++ai)
#pragma unroll
            for (int m = 0; m < 4; ++m) { const int row = row0 + ai * 128 + m * 16; const unsigned di = (unsigned)DSTI[row]; const float w = WGT[row];
                bf16* Yr = Y + (size_t)di * DM + col0;
#pragma unroll
                for (int bj = 0; bj < 2; ++bj) { const f32x4 a = acc[ai][bj][m][0] * w, b = acc[ai][bj][m][1] * w;
                    u32x4 o; o.x = pg8::cvt_pk_bf16(a[0], a[1]); o.y = pg8::cvt_pk_bf16(a[2], a[3]); o.z = pg8::cvt_pk_bf16(b[0], b[1]); o.w = pg8::cvt_pk_bf16(b[2], b[3]);
                    *(u32x4*)(Yr + 128 * bj) = o; }
                asm volatile("" ::: "memory"); }
    }
};


template <class AL, class EP>
__device__ __forceinline__ void naive_gemm(float* lds, int Mr, int N, int K, const float* B, int ldb, AL aload, EP epi) {
    constexpr int TM = 128, TN = 64, TK = 32, AS = TM + 4, BS = TN + 4;
    float* As = lds;
    float* Bs = lds + TK * AS;
    const int tid = threadIdx.x, ty = tid >> 4, tx = tid & 15;
    const int tm = Mr / TM, tn = (N + TN - 1) / TN;
    for (int tile = blockIdx.x; tile < tm * tn; tile += gridDim.x) {
        const int row0 = (tile / tn) * TM, col0 = (tile % tn) * TN;
        float acc[4][4];
#pragma unroll
        for (int i = 0; i < 4; ++i)
#pragma unroll
            for (int j = 0; j < 4; ++j) acc[i][j] = 0.f;
        for (int k0 = 0; k0 < K; k0 += TK) {
#pragma unroll
            for (int i = 0; i < 8; ++i) { const int e = tid + NT * i, r = e >> 5, kk = e & 31; As[kk * AS + r] = aload(row0 + r, k0 + kk); }
#pragma unroll
            for (int i = 0; i < 4; ++i) { const int e = tid + NT * i, kk = e >> 6, c = e & 63; Bs[kk * BS + c] = (col0 + c < N) ? B[(size_t)(k0 + kk) * ldb + col0 + c] : 0.f; }
            __syncthreads();
#pragma unroll 8
            for (int kk = 0; kk < TK; ++kk) {
                const f32x4 a = *(const f32x4*)(As + kk * AS + ty * 4), b = *(const f32x4*)(Bs + kk * BS + tx * 4);
#pragma unroll
                for (int i = 0; i < 4; ++i)
#pragma unroll
                    for (int j = 0; j < 4; ++j) acc[i][j] = fmaf(a[i], b[j], acc[i][j]);
            }
            __syncthreads();
        }
#pragma unroll
        for (int i = 0; i < 4; ++i)
#pragma unroll
            for (int j = 0; j < 4; ++j) { const int c = col0 + tx * 4 + j; if (c < N) epi(row0 + ty * 4 + i, c, acc[i][j]); }
    }
}

__device__ __forceinline__ unsigned wave_select(const unsigned (&keys)[32], int kk, int lane) {
    unsigned T = 0u;
    for (int bit = 31; bit >= 0; --bit) {
        const unsigned cand = T | (1u << bit);
        int c = 0;
#pragma unroll
        for (int i = 0; i < 32; ++i) c += (keys[i] >= cand) ? 1 : 0;
#pragma unroll
        for (int o = 1; o < 64; o <<= 1) c += __shfl_xor(c, o);
        if (c >= kk) T = cand;
    }
    unsigned mgt = 0u, meq = 0u;
#pragma unroll
    for (int i = 0; i < 32; ++i) { mgt |= (keys[i] > T) ? (1u << i) : 0u; meq |= (keys[i] == T) ? (1u << i) : 0u; }
    int ngt = __popc(mgt), neq = __popc(meq);
    int tgt = ngt, teq = neq;
#pragma unroll
    for (int o = 1; o < 64; o <<= 1) { tgt += __shfl_xor(tgt, o); teq += __shfl_xor(teq, o); }
    const int need = kk - tgt;
    if (teq == need) return mgt | meq;
    int pre = neq;
#pragma unroll
    for (int o = 1; o < 64; o <<= 1) { const int v = __shfl_up(pre, o); if (lane >= o) pre += v; }
    pre -= neq;
    unsigned sel = mgt; int taken = pre;
#pragma unroll
    for (int i = 0; i < 32; ++i) { if ((meq >> i) & 1u) { if (taken < need) sel |= (1u << i); ++taken; } }
    return sel;
}

#define XB_TMO      128
#define XB_XCNT(j)  (256  + 64 * (j))
#define XB_XSUB(j)  (1280 + 64 * (j))
#define XB_XGEN(j)  (2304 + 64 * (j))
#define XB_TOP      3328
#define XB_TOPGEN   3392
#define XCD_BAR_WORDS 3456
#define XB_SPIN_CAP (1u << 18)

__device__ __forceinline__ unsigned xb_ld(unsigned* p)              { return __hip_atomic_load(p, __ATOMIC_RELAXED, __HIP_MEMORY_SCOPE_AGENT); }
__device__ __forceinline__ unsigned xb_add(unsigned* p, unsigned v) { return __hip_atomic_fetch_add(p, v, __ATOMIC_RELAXED, __HIP_MEMORY_SCOPE_AGENT); }
__device__ __forceinline__ unsigned xb_xcc_id() { return (unsigned)__builtin_amdgcn_s_getreg((3 << 11) | 20) & 0xFu; }
#define XB_SPIN(cond, bar) do { unsigned _sp = 0; while (cond) { __builtin_amdgcn_s_sleep(1); \
    if ((++_sp & 255u) == 0u) { if (xb_ld(&(bar)[XB_TMO])) break; if (_sp > XB_SPIN_CAP) { atomicAdd(&(bar)[XB_TMO], 1u); break; } } } } while (0)

struct XcdBarrier {
    unsigned* bar; unsigned x;
    volatile LAS unsigned* st;
};

__device__ __forceinline__ XcdBarrier xcd_barrier_post(unsigned* bar, volatile LAS unsigned* st) {
    XcdBarrier b; b.bar = bar; b.x = xb_xcc_id(); b.st = st;
    if (threadIdx.x == 0) (void)xb_add(&bar[XB_XCNT(b.x)], 1u);
    return b;
}
__device__ __forceinline__ void xcd_barrier_complete(unsigned* bar, unsigned x, unsigned& nloc, unsigned& nx) {
    const unsigned G = gridDim.x * gridDim.y * gridDim.z;
    unsigned sum, cnt, mine, sp = 0u;
    for (;;) {
        sum = 0u; cnt = 0u; mine = 0u;
#pragma unroll
        for (unsigned j = 0; j < 16; ++j) { const unsigned c = xb_ld(&bar[XB_XCNT(j)]); sum += c; cnt += (c > 0u) ? 1u : 0u; mine = (j == x) ? c : mine; }
        if (sum == G) break;
        __builtin_amdgcn_s_sleep(1);
        if ((++sp & 255u) == 0u) { if (xb_ld(&bar[XB_TMO])) break; if (sp > XB_SPIN_CAP) { atomicAdd(&bar[XB_TMO], 1u); break; } }
    }
    nloc = mine > 0u ? mine : 1u; nx = cnt > 0u ? cnt : 1u;
}

__device__ __forceinline__ void xcd_barrier(const XcdBarrier& b) {
    asm volatile("s_waitcnt vmcnt(0)" ::: "memory");
    __syncthreads();
    if (threadIdx.x == 0) {
        unsigned* bar = b.bar;
        __builtin_amdgcn_s_waitcnt(0);
        unsigned nloc = b.st[0], nx = b.st[1];
        if (nloc == 0u) { xcd_barrier_complete(bar, b.x, nloc, nx); b.st[0] = nloc; b.st[1] = nx; }
        const unsigned old = xb_add(&bar[XB_XSUB(b.x)], 1u);
        const unsigned gen = old / nloc;
        if (old + 1u == (gen + 1u) * nloc) {
            __builtin_amdgcn_fence(__ATOMIC_RELEASE, "agent");
            asm volatile("s_waitcnt vmcnt(0)" ::: "memory");
            const unsigned og = xb_add(&bar[XB_TOP], 1u);
            const unsigned tg = og / nx;
            if (og + 1u == (tg + 1u) * nx) xb_add(&bar[XB_TOPGEN], 1u);
            else XB_SPIN(xb_ld(&bar[XB_TOPGEN]) == tg, bar);
            __builtin_amdgcn_fence(__ATOMIC_ACQUIRE, "agent");
            xb_add(&bar[XB_XGEN(b.x)], 1u);
            asm volatile("s_waitcnt vmcnt(0)" ::: "memory");
        } else {
            XB_SPIN(xb_ld(&bar[XB_XGEN(b.x)]) == gen, bar);
            __builtin_amdgcn_fence(__ATOMIC_ACQUIRE, "agent");
            asm volatile("s_waitcnt vmcnt(0)" ::: "memory");
        }
    }
    __syncthreads();
}


#define PHASE_VARS const KPtr P = launder_k(KP0); const int tid = launder_i(tid0), lane = tid & 63, wave = tid >> 6, gw = bid * 8 + wave; unsigned char* ws = P->ws; unsigned* ctl = (unsigned*)(ws + WS_CTL); float2* rope = (float2*)(ws + WS_ROPE); float* tokw = (float*)(ws + WS_TOKW); int* lists = (int*)(ws + WS_LISTS); bf16* Qb = (bf16*)(ws + WS_Q); bf16* Kb = (bf16*)(ws + WS_K); bf16* Vb = (bf16*)(ws + WS_V); bf16* IKb = (bf16*)(ws + WS_IK); float* IW = (float*)(ws + WS_IW); float* DT = (float*)(ws + WS_DT); bf16* IQb = (bf16*)(ws + WS_IQ); bf16* Zb = (bf16*)(ws + WS_Z); bf16* XBC = (bf16*)(ws + WS_XBC); bf16* ASb = (bf16*)(ws + WS_AS); float* X1 = (float*)(ws + WS_X1); bf16* X1b = (bf16*)(ws + WS_X1B); bf16* Y0 = (bf16*)(ws + WS_Y0); bf16* Y1 = (bf16*)(ws + WS_Y1); float* XC = (float*)(ws + WS_XC); float* YG = (float*)(ws + WS_YG); bf16* WguT = (bf16*)(ws + WS_WGU_T); bf16* WdT = (bf16*)(ws + WS_WD_T); int* ENT = (int*)(ws + WS_ENT); float* WGT = (float*)(ws + WS_ENT + 512 * 1024); bf16* Xs = (bf16*)(ws + WS_XS); bf16* Hid = (bf16*)(ws + WS_HID); bf16* XB = (bf16*)(ws + WS_XB); bf16* WinT = (bf16*)(ws + WS_WIN_T); bf16* WoutT = (bf16*)(ws + WS_WOUT_T);
#ifndef PROBE_MASK
#define PROBE_MASK 0
#endif
#define STAMP(k) do { if (PROBE_MASK && bid == 0 && tid0 == 0) { const unsigned long long now_ = __builtin_amdgcn_s_memrealtime(); if ((PROBE_MASK >> (k)) & 1) pst[1] += now_ - pst[0]; pst[0] = now_; } } while (0)
__global__ void __launch_bounds__(NT, 2) hybrid_fwd(Params p) {
    extern __shared__ __attribute__((aligned(16))) unsigned char lds[];
    cg::grid_group grid = cg::this_grid();
    const int tid0 = threadIdx.x;
    const int G = gridDim.x, bid = blockIdx.x, NGW = G * 8;
    const KPtr KP0 = (KPtr)__builtin_amdgcn_kernarg_segment_ptr();
    volatile LAS unsigned* xst = (volatile LAS unsigned*)((LAS unsigned char*)lds + LDS_BYTES - 32);
    if (tid0 < 4) xst[tid0] = 0u;
    __syncthreads();
    const XcdBarrier xbar = xcd_barrier_post((unsigned*)(KP0->ws + WS_CTL) + CW_BAR, xst);
    if (KP0->ws == nullptr) grid.sync();
#define GRID_SYNC() xcd_barrier(xbar)
    volatile LAS unsigned long long* pst = (volatile LAS unsigned long long*)((LAS unsigned char*)lds + LDS_BYTES - 96);
    if (PROBE_MASK && bid == 0 && tid0 == 0) { pst[0] = __builtin_amdgcn_s_memrealtime(); pst[1] = 0ull; }
    {   PHASE_VARS
    for (int e = bid * NT + tid; e < SEQ * 32; e += G * NT) {
        const int t = e >> 5, i = e & 31;
        const float inv = powf(10000.0f, -(float)(2 * i) / 64.0f);
        const float ang = (float)t * inv;
        float s, c; sincosf(ang, &s, &c);
        rope[e] = make_float2(c, s);
    }
    for (int e = bid * NT + tid; e < 52 * 128; e += G * NT) {
        const int r = e >> 7, c = e & 127; const int row = (r < 4) ? (512 + 196 + r) : (512 + 208 + (r - 4));
        *(u32x4*)(WinT + (size_t)row * DM + c * 8) = (u32x4){0u, 0u, 0u, 0u};
    }
    {
        LAS float* scr = (LAS float*)((LAS unsigned char*)lds + wave * 16384);
        constexpr int I_IN = (DM / 64) * ((INW + 31) / 32), I_OUT = (DM / 64) * (DM / 32), I_GU = NEXP * 2 * 128, I_D = NEXP * 128;
        for (int it = launder_i(gw); it < I_IN + I_OUT + I_GU + I_D; it += NGW) {
            int r = it;
            if (r < I_IN) { transpose_item(P->w_in, DM, INW, WinT, scr, r, lane, [](int c) { return win_dest_row(c); }); continue; } r -= I_IN;
            if (r < I_OUT) { transpose_item(P->w_out, DM, DM, WoutT, scr, r, lane, [](int c) { return c; }); continue; } r -= I_OUT;
            if (r < I_GU) { const int e = r >> 8, up = (r >> 7) & 1, sub = r & 127; const float* W = (up ? P->w_up : P->w_gate) + (size_t)e * DM * EFF;
                transpose_item(W, DM, EFF, WguT + (size_t)e * 512 * DM, scr, sub, lane, [up](int c) { return 8 * (c >> 2) + 4 * up + (c & 3); }); continue; } r -= I_GU;
            { const int e = r >> 7, sub = r & 127; transpose_item(P->w_down + (size_t)e * EFF * DM, EFF, DM, WdT + (size_t)e * DM * EFF, scr, sub, lane, [](int c) { return c; }); }
        }
    }
    if (bid == G - 1) {
        float* rc = (float*)(ws + WS_RCONST);
        for (int j = wave; j < 20; j += 8) { float gs = 0.f, bs = 0.f;
            for (int k = lane; k < DM; k += 64) { const float wv = (j < 4) ? P->w_rg[k * 4 + j] : P->w_re[k * 16 + (j - 4)]; gs = fmaf(P->ln1_g[k], wv, gs); bs = fmaf(P->ln1_b[k], wv, bs); }
            gs = wave_sum(gs); bs = wave_sum(bs);
            if (lane == 0) { rc[j] = gs; rc[20 + j] = bs + ((j < 4) ? P->b_rg[j] : P->b_re[j - 4]); } }
    }
    for (size_t e = (size_t)bid * NT + tid; e < (size_t)M * DM / 8; e += (size_t)G * NT) {
        const f32x4 a = *(const f32x4*)(P->x + e * 8), b = *(const f32x4*)(P->x + e * 8 + 4);
        u32x4 w; w.x = pg8::cvt_pk_bf16(a[0], a[1]); w.y = pg8::cvt_pk_bf16(a[2], a[3]); w.z = pg8::cvt_pk_bf16(b[0], b[1]); w.w = pg8::cvt_pk_bf16(b[2], b[3]);
        *(u32x4*)(XB + e * 8) = w;
    }
    }
    GRID_SYNC(); STAMP(0);
    {   PHASE_VARS
    {
        pg8::Gemm g{XB, WinT, M, NPAD, DM}; pg8::StaticOrder S; S.init(M, NPAD, G, bid);
        EpiInProj E{Qb, Kb, Vb, IKb, IQb, Zb, XBC, IW, DT, rope};
        pg8::gemm_phase<EpiInProj, pg8::StaticOrder, true, true>((PG8_LAS unsigned char*)lds, g, S, E);
    }
    }
    GRID_SYNC(); STAMP(1);
    {   PHASE_VARS
    for (int item = bid; item < BATCH * 8; item += G) ssd_item(item >> 3, item & 7, P, XBC, DT, Zb, YG, lds, tid);
    {
        volatile int* qslot = (volatile int*)(lds + LDS_BYTES - 64);
        const unsigned xcc = (unsigned)__builtin_amdgcn_s_getreg((3 << 11) | 20) & 7u;
        for (;;) {
            __syncthreads();
            if (tid == 0) { int pi = -1;
                for (unsigned a = 0; a < 8 && pi < 0; ++a) { const unsigned q = (xcc + a) & 7u; const unsigned idx = atomicAdd(&ctl[CW_DSAQ + 16 * q], 1u); if (idx < 64u) pi = (int)(q * 64u + idx); }
                *qslot = pi; }
            __syncthreads();
            const int pi = *qslot; if (pi < 0) break;
            const int q = pi >> 6, idx = pi & 63, b = q + 8 * (idx >> 5), s = idx & 31;
#pragma unroll 1
            for (int hb = 0; hb < 2; ++hb) {
                const int qb = hb ? (63 - s) : s;
                dsa_select(b, qb, IQb, IKb, IW, lds, lane, __builtin_amdgcn_readfirstlane(wave));
                attn_body::attn_unit<8>(b, qb, Qb, Kb, Vb, ASb, (char*)lds, (const char*)lds + DSA_MASK_OFF);
            }
        }
    }
    }
    GRID_SYNC(); STAMP(2);
    {   PHASE_VARS
    for (int row = launder_i(gw); row < M; row += NGW) {
        const float* yr = YG + (size_t)row * 512;
        float v[8]; float ss = 0.f;
#pragma unroll
        for (int j = 0; j < 8; ++j) { v[j] = yr[lane + 64 * j]; ss = fmaf(v[j], v[j], ss); }
        ss = wave_sum(ss);
        const float r = rsqrtf(ss * (1.f / 512.f) + LN_EPS);
#pragma unroll
        for (int j = 0; j < 8; ++j) ASb[(size_t)row * 1024 + 512 + lane + 64 * j] = f2bf(v[j] * r * P->ssd_norm_w[lane + 64 * j]);
    }
    }
    GRID_SYNC(); STAMP(3);
    {   PHASE_VARS
    {
        pg8::Gemm g{ASb, WoutT, M, DM, DM}; pg8::StaticOrder S; S.init(M, DM, G, bid);
        EpiH1 E{P->x, X1};
        pg8::gemm_phase<EpiH1, pg8::StaticOrder, true, true>((PG8_LAS unsigned char*)lds, g, S, E);
    }
    }
    GRID_SYNC(); STAMP(4);
    {   PHASE_VARS
    {
        float* Wg = (float*)lds;
        int* lcnt = (int*)(lds + 81920); int* lbase = lcnt + 16; int* rec = lbase + 16;
        float* recw = (float*)(rec + 4 * 128);
        float* rlg = recw + 2 * 128;
        float* rstat = rlg + 20 * 128;
        for (int e = tid; e < DM * 20; e += NT) { const int k = e / 20, j = e - k * 20; Wg[e] = P->ln1_g[k] * ((j < 4) ? P->w_rg[k * 4 + j] : P->w_re[k * 16 + (j - 4)]); }
        if (tid < 16) lcnt[tid] = 0;
        __syncthreads();
        const int rows_per_wave = M / NGW;
        const int l15 = lane & 15, ph = lane >> 4;
        {
            const float* hr = X1 + (size_t)(gw + NGW * l15) * DM + 4 * ph;
            const float* wb0 = Wg + (4 * ph) * 20 + l15; const float* wb1 = Wg + (4 * ph) * 20 + 16 + (l15 < 4 ? l15 : 3);
            f32x4 c0 = (f32x4){0.f, 0.f, 0.f, 0.f}, c1 = c0; float s = 0.f, ss = 0.f;
#pragma unroll 1
            for (int i0 = 0; i0 < 64; i0 += 8) {
                f32x4 a[8];
#pragma unroll
                for (int u = 0; u < 8; ++u) a[u] = *(const f32x4*)(hr + 16 * (i0 + u));
#pragma unroll
                for (int u = 0; u < 8; ++u) {
                    s += (a[u][0] + a[u][1]) + (a[u][2] + a[u][3]); ss += (a[u][0] * a[u][0] + a[u][1] * a[u][1]) + (a[u][2] * a[u][2] + a[u][3] * a[u][3]);
#pragma unroll
                    for (int e = 0; e < 4; ++e) { const int ko = (16 * (i0 + u) + e) * 20;
                        c0 = __builtin_amdgcn_mfma_f32_16x16x4f32(a[u][e], wb0[ko], c0, 0, 0, 0);
                        c1 = __builtin_amdgcn_mfma_f32_16x16x4f32(a[u][e], wb1[ko], c1, 0, 0, 0); }
                }
            }
            { const int ln2 = launder_i(lane); const int i16 = (ln2 ^ 16) << 2, i32 = (ln2 ^ 32) << 2;
              s += __builtin_bit_cast(float, __builtin_amdgcn_ds_bpermute(i16, __builtin_bit_cast(int, s))); s += __builtin_bit_cast(float, __builtin_amdgcn_ds_bpermute(i32, __builtin_bit_cast(int, s)));
              ss += __builtin_bit_cast(float, __builtin_amdgcn_ds_bpermute(i16, __builtin_bit_cast(int, ss))); ss += __builtin_bit_cast(float, __builtin_amdgcn_ds_bpermute(i32, __builtin_bit_cast(int, ss))); }
            const float mean = s * (1.f / DM), var = ss * (1.f / DM) - mean * mean;
            if (ph == 0) { rstat[(wave * 16 + l15) * 2] = mean; rstat[(wave * 16 + l15) * 2 + 1] = rsqrtf(var + LN_EPS); }
#pragma unroll
            for (int r = 0; r < 4; ++r) { const int rl = wave * 16 + 4 * ph + r; rlg[rl * 20 + l15] = c0[r]; if (l15 < 4) rlg[rl * 20 + 16 + l15] = c1[r]; }
        }
        __syncthreads();
        for (int it = 0; it < rows_per_wave; ++it) {
            const int row = gw + NGW * it; const float mean = rstat[(wave * 16 + it) * 2], rstd = rstat[(wave * 16 + it) * 2 + 1];
            const float* xr = X1 + (size_t)row * DM;
#pragma unroll
            for (int j = 0; j < 4; ++j) { const int c0 = lane * 4 + 256 * j; const f32x4 v = *(const f32x4*)(xr + c0), gg = *(const f32x4*)(P->ln1_g + c0), bb = *(const f32x4*)(P->ln1_b + c0);
                const f32x4 o = (v - mean) * rstd * gg + bb; u32x2 w; w.x = pg8::cvt_pk_bf16(o[0], o[1]); w.y = pg8::cvt_pk_bf16(o[2], o[3]);
                *(u32x2*)(X1b + (size_t)row * DM + c0) = w; }
        }
        const float* rc = (const float*)(ws + WS_RCONST);
        for (int rl = tid; rl < 8 * rows_per_wave; rl += NT) {
            const float mean = rstat[rl * 2], rstd = rstat[rl * 2 + 1];
            float lg[20];
#pragma unroll
            for (int j = 0; j < 20; ++j) lg[j] = rstd * (rlg[rl * 20 + j] - mean * rc[j]) + rc[20 + j];
            int gi = 0; float gm = lg[0];
#pragma unroll
            for (int i = 1; i < 4; ++i) if (lg[i] > gm) { gm = lg[i]; gi = i; }
            float gs = 0.f;
#pragma unroll
            for (int i = 0; i < 4; ++i) gs += __expf(lg[i] - gm);
            const float gprob = 1.f / gs;
            float el[4];
#pragma unroll
            for (int i = 0; i < 4; ++i) { float v0 = 0.f;
#pragma unroll
                for (int g2 = 0; g2 < 4; ++g2) if (g2 == gi) v0 = lg[4 + g2 * 4 + i];
                el[i] = v0; }
            int i0 = 0; float m0 = el[0];
#pragma unroll
            for (int i = 1; i < 4; ++i) if (el[i] > m0) { m0 = el[i]; i0 = i; }
            int i1 = -1; float m1 = -INFINITY;
#pragma unroll
            for (int i = 0; i < 4; ++i) if (i != i0 && el[i] > m1) { m1 = el[i]; i1 = i; }
            const float e1 = __expf(m1 - m0), inv = 1.f / (1.f + e1);
            const int ex0 = gi * 4 + i0, ex1 = gi * 4 + i1;
            rec[rl * 4 + 0] = ex0; rec[rl * 4 + 1] = atomicAdd(&lcnt[ex0], 1); rec[rl * 4 + 2] = ex1; rec[rl * 4 + 3] = atomicAdd(&lcnt[ex1], 1);
            recw[rl * 2] = inv * gprob; recw[rl * 2 + 1] = e1 * inv * gprob;
        }
        __syncthreads();
        if (tid < 16) lbase[tid] = (int)atomicAdd(&ctl[CW_CNT + 64 * tid], (unsigned)lcnt[tid]);
        __syncthreads();
        for (int rl = tid; rl < 8 * rows_per_wave; rl += NT) {
            const int row = (bid * 8 + rl / rows_per_wave) + NGW * (rl % rows_per_wave);
            const int e0 = rec[rl * 4], e1x = rec[rl * 4 + 2];
            lists[(size_t)e0 * M + lbase[e0] + rec[rl * 4 + 1]] = row * 2; lists[(size_t)e1x * M + lbase[e1x] + rec[rl * 4 + 3]] = row * 2 + 1;
            tokw[row * 2] = recw[rl * 2]; tokw[row * 2 + 1] = recw[rl * 2 + 1];
        }
    }
    }
    GRID_SYNC(); STAMP(5);
    {   PHASE_VARS
    int* tb = (int*)(lds + 135168);
    if (tid == 0) { int a = 0; for (int e = 0; e < NEXP; ++e) { tb[e] = a; a += (int)((__hip_atomic_load(&ctl[CW_CNT + 64 * e], __ATOMIC_RELAXED, __HIP_MEMORY_SCOPE_AGENT) + 255u) >> 8); } tb[NEXP] = a; }
    __syncthreads();
    const int ntiles = tb[NEXP];
    for (int sr = launder_i(gw); sr < ntiles * 256; sr += NGW) {
        const int rt = sr >> 8; int e = 0;
#pragma unroll
        for (int j = 1; j < NEXP; ++j) if (rt >= tb[j]) e = j;
        const int slot = sr - tb[e] * 256; const int cnt_e = (int)__hip_atomic_load(&ctl[CW_CNT + 64 * e], __ATOMIC_RELAXED, __HIP_MEMORY_SCOPE_AGENT);
        const int en = (slot < cnt_e) ? lists[(size_t)e * M + slot] : -1;
        if (lane == 0) { ENT[sr] = (en >= 0) ? ((en & 1) * M + (en >> 1)) : 2 * M; WGT[sr] = (en >= 0) ? tokw[en] : 0.f; }
        u32x4 a = (u32x4){0u, 0u, 0u, 0u}, b = a;
        if (en >= 0) { const u32x4* s = (const u32x4*)(X1b + (size_t)(en >> 1) * DM); a = s[lane]; b = s[lane + 64]; }
        u32x4* d = (u32x4*)(Xs + (size_t)sr * DM); d[lane] = a; d[lane + 64] = b;
    }
    }
    GRID_SYNC(); STAMP(6);
    {   PHASE_VARS
    const LAS int* tb = (const LAS int*)((LAS unsigned char*)lds + 135168); const int ntiles = tb[NEXP];
    {
        LAS int* ul = (LAS int*)((LAS unsigned char*)lds + 135168 + 128); int n = 0;
        if (tid == 0) { for (int L = bid; L < ntiles * 2; L += G) { const int rt = L >> 1; int e = 0; for (int j = 1; j < NEXP; ++j) if (rt >= tb[j]) e = j; ul[2 * n] = rt; ul[2 * n + 1] = e * 2 + (L & 1); ++n; } ul[62] = n; }
        __syncthreads(); n = ul[62];
        pg8::Gemm g{Xs, WguT, MAXROWS, 512, DM}; MoeOrder S{n, ul};
        EpiSwiGLU E{Hid};
        pg8::gemm_phase<EpiSwiGLU, MoeOrder, true, true>((PG8_LAS unsigned char*)lds, g, S, E);
    }
    }
    GRID_SYNC(); STAMP(7);
    {   PHASE_VARS
    const LAS int* tb = (const LAS int*)((LAS unsigned char*)lds + 135168); const int ntiles = tb[NEXP];
    {
        LAS int* ul = (LAS int*)((LAS unsigned char*)lds + 135168 + 128); int n = 0;
        __syncthreads();
        if (tid == 0) { for (int L = bid; L < ntiles * 4; L += G) { const int rt = L >> 2; int e = 0; for (int j = 1; j < NEXP; ++j) if (rt >= tb[j]) e = j; ul[2 * n] = rt; ul[2 * n + 1] = e * 4 + (L & 3); ++n; } ul[62] = n; }
        __syncthreads(); n = ul[62];
        pg8::Gemm g{Hid, WdT, MAXROWS, DM, EFF}; MoeOrder S{n, ul};
        EpiDown E{ENT, WGT, Y0};
        pg8::gemm_phase<EpiDown, MoeOrder, true, true>((PG8_LAS unsigned char*)lds, g, S, E);
    }
    }
    GRID_SYNC(); STAMP(8);
    {   PHASE_VARS
    for (int row = launder_i(gw); row < M; row += NGW) {
        f32x4 v[4]; float s = 0.f;
#pragma unroll
        for (int j = 0; j < 4; ++j) { const int c0 = lane * 4 + 256 * j; const u32x2 xb = *(const u32x2*)(X1b + (size_t)row * DM + c0);
            v[j][0] = __uint_as_float(xb.x << 16) * ALPHA; v[j][1] = __uint_as_float(xb.x & 0xffff0000u) * ALPHA; v[j][2] = __uint_as_float(xb.y << 16) * ALPHA; v[j][3] = __uint_as_float(xb.y & 0xffff0000u) * ALPHA;
            const u32x2 a = *(const u32x2*)(Y0 + (size_t)row * DM + c0), b = *(const u32x2*)(Y1 + (size_t)row * DM + c0);
            v[j][0] += __uint_as_float(a.x << 16) + __uint_as_float(b.x << 16); v[j][1] += __uint_as_float(a.x & 0xffff0000u) + __uint_as_float(b.x & 0xffff0000u);
            v[j][2] += __uint_as_float(a.y << 16) + __uint_as_float(b.y << 16); v[j][3] += __uint_as_float(a.y & 0xffff0000u) + __uint_as_float(b.y & 0xffff0000u);
            s += (v[j][0] + v[j][1]) + (v[j][2] + v[j][3]); }
        const float mean = wave_sum(s) * (1.f / DM); float s2 = 0.f;
#pragma unroll
        for (int j = 0; j < 4; ++j) { v[j] = v[j] - mean; s2 += (v[j][0] * v[j][0] + v[j][1] * v[j][1]) + (v[j][2] * v[j][2] + v[j][3] * v[j][3]); }
        const float rstd = rsqrtf(wave_sum(s2) * (1.f / DM) + LN_EPS);
#pragma unroll
        for (int j = 0; j < 4; ++j) { const int c0 = lane * 4 + 256 * j;
            const f32x4 gg = *(const f32x4*)(P->ln2_g + c0), bb = *(const f32x4*)(P->ln2_b + c0);
            *(f32x4*)(P->out + (size_t)row * DM + c0) = v[j] * rstd * gg + bb; }
    }
    }
    STAMP(9);
    if (PROBE_MASK && bid == 0 && tid0 == 0) { const unsigned long long t0 = __builtin_amdgcn_s_memrealtime(), d = 8ull * pst[1]; while (__builtin_amdgcn_s_memrealtime() - t0 < d) __builtin_amdgcn_s_sleep(8); }
}

extern "C" void kernel_launch(void* const* d_in, const int* in_sizes, int n_in, void* d_out, int out_size, void* d_ws, size_t ws_size, hipStream_t stream) {
    static int grid = 0;
    if (grid == 0) {
        if (n_in != 20 || in_sizes[0] != M * DM || out_size != M * DM || ws_size < WS_END) { fprintf(stderr, "kernel_launch: unexpected shapes (n_in %d, in0 %d, out %d, ws %zu)\n", n_in, n_in > 0 ? in_sizes[0] : -1, out_size, ws_size); grid = -1; return; }
        int dev = 0, cus = 0, per_cu = 0;
        (void)hipGetDevice(&dev);
        (void)hipDeviceGetAttribute(&cus, hipDeviceAttributeMultiprocessorCount, dev);
        (void)hipFuncSetAttribute((const void*)hybrid_fwd, hipFuncAttributeMaxDynamicSharedMemorySize, LDS_BYTES);
        (void)hipOccupancyMaxActiveBlocksPerMultiprocessor(&per_cu, (const void*)hybrid_fwd, NT, LDS_BYTES);
        if (per_cu < 1) { fprintf(stderr, "kernel_launch: occupancy query says %d blocks/CU\n", per_cu); grid = -1; return; }
        grid = cus;
    }
    if (grid < 0) return;
    (void)hipMemsetAsync((char*)d_ws + WS_CTL, 0, CTL_BYTES, stream);
    Params p{};
    const float** f = (const float**)&p;
    for (int i = 0; i < 20; ++i) f[i] = (const float*)d_in[i];
    p.out = (float*)d_out; p.ws = (unsigned char*)d_ws;
    void* args[] = {&p};
    hipError_t e = hipLaunchCooperativeKernel((const void*)hybrid_fwd, dim3(grid), dim3(NT), args, LDS_BYTES, stream);
    if (e != hipSuccess) fprintf(stderr, "cooperative launch failed: %s (grid %d)\n", hipGetErrorString(e), grid);
}
```

```cpp
#include <hip/hip_runtime.h>
#include <hip/hip_cooperative_groups.h>
#include <cstdio>
#include <cstdint>
namespace cg = cooperative_groups;

constexpr int BATCH = 16, SEQ = 2048, DM = 1024, M = BATCH * SEQ;
constexpr int INW = 2252;
constexpr int C_Q = 0, C_K = 512, C_V = 576, C_IQ = 640, C_IK = 896, C_IW = 960, C_Z = 964, C_XBC = 1476, C_DT = 2244;
constexpr int NEXP = 16, EFF = 256;
constexpr float LN_EPS = 1e-5f;
constexpr float ALPHA = 1.189207115002721f;
constexpr float INDEXER_SCALE = 0.0625f;
constexpr float QSCALE = 0.125f * 1.4426950408889634f;
constexpr int TOPK = 256;
constexpr int NT = 512;
constexpr int LDS_BYTES = 147456;

constexpr size_t MiB = 1u << 20;
constexpr size_t WS_CTL = 0, CTL_BYTES = 1 * MiB;
constexpr size_t WS_ROPE = 1 * MiB;
constexpr size_t WS_TOKW = 2 * MiB;
constexpr size_t WS_LISTS = 3 * MiB;
constexpr size_t WS_WIN_T = 8 * MiB;
constexpr size_t WS_WOUT_T = 16 * MiB;
constexpr size_t WS_WGU_T = 18 * MiB;
constexpr size_t WS_WD_T = 34 * MiB;
constexpr size_t WS_RCONST = 7 * MiB;
constexpr size_t WS_ENT = 5 * MiB;
constexpr size_t WS_XS = 48 * MiB;
constexpr size_t WS_HID = 192 * MiB;
constexpr int MAXTILES = 272, MAXROWS = MAXTILES * 256;
constexpr size_t WS_XB = 256 * MiB;
constexpr int NPAD = 2304;
constexpr size_t WS_Q = 48 * MiB;
constexpr size_t WS_K = 80 * MiB, WS_V = 84 * MiB, WS_IK = 88 * MiB;
constexpr size_t WS_IW = 92 * MiB;
constexpr size_t WS_DT = 93 * MiB;
constexpr size_t WS_IQ = 96 * MiB;
constexpr size_t WS_Z = 112 * MiB;
constexpr size_t WS_XBC = 144 * MiB;
constexpr size_t WS_AS = 192 * MiB;
constexpr size_t WS_X1 = 256 * MiB;
constexpr size_t WS_X1B = 384 * MiB;
constexpr size_t WS_Y0 = 48 * MiB, WS_Y1 = 112 * MiB;
constexpr size_t WS_P32 = 224 * MiB;
constexpr size_t WS_XC = 256 * MiB;
constexpr size_t WS_SSQP = 42 * MiB;
constexpr size_t WS_END = 512 * MiB;
constexpr int CW_CNT = 8192;
constexpr int CW_BAR = 4096;
constexpr int CW_ERR = 32;
constexpr int CW_WQ = 48;
constexpr int CW_DSAQ = 128;

typedef unsigned short bf16;
typedef float f32x4 __attribute__((ext_vector_type(4)));
typedef unsigned u32x4 __attribute__((ext_vector_type(4)));
typedef unsigned u32x2 __attribute__((ext_vector_type(2)));

struct Params {
    const float* x; const float* w_in; const float* conv_w; const float* conv_b; const float* dt_bias; const float* a_log; const float* d_skip;
    const float* ssd_norm_w; const float* w_out; const float* ln1_g; const float* ln1_b; const float* w_rg; const float* b_rg; const float* w_re; const float* b_re;
    const float* w_gate; const float* w_up; const float* w_down; const float* ln2_g; const float* ln2_b;
    float* out; unsigned char* ws;
};

__device__ __forceinline__ int launder_i(int v);
__device__ __forceinline__ int lane_id() { unsigned m = ~0u; asm volatile("" : "+s"(m)); return (int)__builtin_amdgcn_mbcnt_hi(m, __builtin_amdgcn_mbcnt_lo(m, 0u)); }
typedef const __attribute__((address_space(4))) Params* KPtr;
__device__ __forceinline__ KPtr launder_k(KPtr k) { asm volatile("" : "+s"(k)); return k; }
__device__ __forceinline__ float bf2f(bf16 v) { return __uint_as_float((unsigned)v << 16); }
__device__ __forceinline__ bf16 f2bf(float f) { unsigned u = __float_as_uint(f); return (bf16)((u + 0x7fffu + ((u >> 16) & 1u)) >> 16); }
__device__ __forceinline__ float silu(float v) { return v / (1.f + __expf(-v)); }
__device__ __forceinline__ float wave_sum(float v) {
#define WS_DPP(ctrl, rm, bc) v += __int_as_float(__builtin_amdgcn_update_dpp(0, __float_as_int(v), ctrl, rm, 0xf, bc))
    WS_DPP(0xB1, 0xf, true); WS_DPP(0x4E, 0xf, true); WS_DPP(0x114, 0xf, true); WS_DPP(0x118, 0xf, true); WS_DPP(0x142, 0xa, false); WS_DPP(0x143, 0xc, false);
#undef WS_DPP
    return __int_as_float(__builtin_amdgcn_readlane(__float_as_int(v), 63));
}
__device__ __forceinline__ float wave_max(float v) {
#pragma unroll
    for (int o = 1; o < 64; o <<= 1) v = fmaxf(v, __shfl_xor(v, o));
    return v;
}
__device__ __forceinline__ int launder_i(int v) { asm volatile("" : "+v"(v)); return v; }
__device__ __forceinline__ unsigned sortkey(float f) { unsigned u = __float_as_uint(f); return (u & 0x80000000u) ? ~u : (u | 0x80000000u); }

namespace pg8 {
#define PG8_LAS __attribute__((address_space(3)))
typedef unsigned short bf16_t;
typedef short bf16x8 __attribute__((ext_vector_type(8)));
typedef float f32x4 __attribute__((ext_vector_type(4)));
typedef unsigned u32x4 __attribute__((ext_vector_type(4)));
constexpr int BM = 256, BK = 64, HALF = 128, HTB = HALF * BK * 2  , STAGE_BYTES = 8 * HTB, NXCD = 8, WGM = 8;

__host__ __device__ __forceinline__ int lds_byte(int r, int c) { const int st = (r >> 4) * 2 + (c >> 5), rr = r & 15, cc = c & 31, ob = rr * 64 + cc * 2; return st * 1024 + (ob ^ (((ob >> 9) & 1) << 5)); }
__host__ __device__ __forceinline__ void stage_rc(int b, int& R, int& C) { const int st = b / 1024, sb = b % 1024, swz = sb ^ (((sb >> 9) & 1) << 5); R = (st >> 1) * 16 + swz / 64; C = (st & 1) * 32 + (swz % 64) / 2; }
__host__ __device__ __forceinline__ int perm32(int rho) { const int n = rho >> 4, i = rho & 15; return 8 * (i >> 2) + 4 * n + (i & 3); }

struct Unit { int pm, pn; };
struct Gemm { const bf16_t* A; const bf16_t* Bt; int M, N, K; };

struct StaticOrder {
    int nM, nN, nwg, G, c;
    __host__ __device__ void init(int M, int N, int G_, int c_) { nM = M / BM; nN = N / BM; nwg = nM * nN; G = G_; c = c_; }
    __host__ __device__ bool next(int i, Unit& u) const {
        const long L = (long)i * G + c; if (L >= nwg) return false;
        int wgid = (int)L; { const int q = nwg / NXCD, r = nwg % NXCD, xcd = wgid % NXCD, off = wgid / NXCD; wgid = (xcd < r ? xcd * (q + 1) : r * (q + 1) + (xcd - r) * q) + off; }
        const int nig = WGM * nN, gid = wgid / nig, fm = gid * WGM, gsz = (nM - fm) < WGM ? (nM - fm) : WGM;
        u.pm = fm + ((wgid % nig) % gsz); u.pn = (wgid % nig) / gsz; return true;
    }
    __device__ __forceinline__ void a_ready(const Unit&) const {}
    __device__ __forceinline__ void done(const Unit&) const {}
};

__device__ __forceinline__ unsigned cvt_pk_bf16(float lo, float hi) { unsigned r; asm volatile("v_cvt_pk_bf16_f32 %0, %1, %2" : "=v"(r) : "v"(lo), "v"(hi)); return r; }
template <class Epi, class Sched, bool ALIGN_EPI = false, bool SP2 = false, bool GATHER = false>
__device__ __forceinline__ void gemm_phase(PG8_LAS unsigned char* lds, const Gemm g, const Sched& S, const Epi& E, const int wave_s, const PG8_LAS int* rtl = nullptr) {
    int tid_l = wave_s * 64 + lane_id(); asm volatile("" : "+v"(tid_l));
    const int tid = tid_l, wid = wave_s, lane = tid & 63, wr = wid >> 2, wc = wid & 3, fr = lane & 15, fq = lane >> 4;
    const int K = g.K, nt = K / BK;
    unsigned voffA[2], voffB[2];
#pragma unroll
    for (int i = 0; i < 2; ++i) { int R, C; stage_rc(tid * 16 + i * 8192, R, C); const int Rb = Epi::PERM ? ((R & ~31) + perm32(R & 31)) : R;
        voffA[i] = (unsigned)(R * K + C) * 2u; voffB[i] = (unsigned)(Rb * K + C) * 2u; }
    const size_t kstep = (size_t)(BK * 2);
    const size_t hstepB = (size_t)HALF * K * 2;
    const size_t tstep = 2 * hstepB;
    const size_t hstep = GATHER ? 0 : hstepB, tstepA = GATHER ? 0 : tstep;
    int rowA[2]; { int R, C; stage_rc(tid * 16, R, C); rowA[0] = R; stage_rc(tid * 16 + 8192, R, C); rowA[1] = R; }
    unsigned voffGc[2][2], voffGn[2][2];
#define PG8_GVOFF(dst, uidx) do { _Pragma("unroll") for (int _h = 0; _h < 2; ++_h) _Pragma("unroll") for (int _i = 0; _i < 2; ++_i) { int R_, C_; stage_rc(tid * 16 + _i * 8192, R_, C_); \
        dst[_h][_i] = (unsigned)rtl[(uidx) * 256 + _h * 128 + R_] * (unsigned)(K * 2) + (unsigned)(C_ * 2); } } while (0)
    const unsigned ldsw = (unsigned)wid * 1024u;
    const int aoff = lds_byte(wr * 64 + fr, fq * 8), boff = lds_byte(wc * 32 + fr, fq * 8);
#define PG8_SA(b, h) (((b) * 2 + (h)) * HTB)
#define PG8_SB(b, h) ((4 + (b) * 2 + (h)) * HTB)
#define PG8_STAGE(bufoff, gbase, voff) do { _Pragma("unroll") for (int _i = 0; _i < 2; ++_i) \
        __builtin_amdgcn_global_load_lds((const unsigned*)((const char*)(gbase) + (voff)[_i]), (PG8_LAS unsigned*)(lds + (bufoff) + ldsw + _i * 8192), 16, 0, 0); } while (0)
#define PG8_STAGE_A(bufoff, gbase, h, nx) do { if constexpr (GATHER) { if (nx) PG8_STAGE(bufoff, gbase, voffGn[h]); else PG8_STAGE(bufoff, gbase, voffGc[h]); } else PG8_STAGE(bufoff, gbase, voffA); } while (0)
#define PG8_LDA(dst, b, h) do { _Pragma("unroll") for (int m = 0; m < 4; ++m) _Pragma("unroll") for (int k = 0; k < 2; ++k) dst[m][k] = *(const PG8_LAS bf16x8*)(lds + PG8_SA(b, h) + aoff + m * 2048 + k * 1024); } while (0)
#define PG8_LDB(dst, b, h) do { _Pragma("unroll") for (int n = 0; n < 2; ++n) _Pragma("unroll") for (int k = 0; k < 2; ++k) dst[n][k] = *(const PG8_LAS bf16x8*)(lds + PG8_SB(b, h) + boff + n * 2048 + k * 1024); } while (0)
#define PG8_MMA(ai, bj, At, Bt) do { __builtin_amdgcn_s_setprio(1); _Pragma("unroll") for (int m = 0; m < 4; ++m) _Pragma("unroll") for (int n = 0; n < 2; ++n) _Pragma("unroll") for (int k = 0; k < 2; ++k) \
        acc[ai][bj][m][n] = __builtin_amdgcn_mfma_f32_16x16x32_bf16(Bt[n][k], At[m][k], acc[ai][bj][m][n], 0, 0, 0); __builtin_amdgcn_s_setprio(0); } while (0)
#define PG8_WAIT_V(n) asm volatile("s_waitcnt vmcnt(" #n ")" ::: "memory")
#define PG8_WAIT_L(n) asm volatile("s_waitcnt lgkmcnt(" #n ")" ::: "memory")
#define PG8_BAR __builtin_amdgcn_s_barrier()
#define PG8_SCHED __builtin_amdgcn_sched_barrier(0)
    Unit cur, nxt; int ui = 0;
    if (!S.next(0, cur)) return;
    f32x4 acc[2][2][4][2];
#pragma unroll
    for (int a = 0; a < 2; ++a)
#pragma unroll
        for (int b = 0; b < 2; ++b)
#pragma unroll
            for (int m = 0; m < 4; ++m)
#pragma unroll
                for (int n = 0; n < 2; ++n) acc[a][b][m][n] = (f32x4){0.f, 0.f, 0.f, 0.f};
    bf16x8 At[4][2], B0[2][2], B1[2][2];
    const char* cA = (const char*)g.A + (size_t)cur.pm * tstepA; const char* cB = (const char*)g.Bt + (size_t)cur.pn * tstep;
    if constexpr (GATHER) { PG8_GVOFF(voffGc, 0); _Pragma("unroll") for (int _h = 0; _h < 2; ++_h) _Pragma("unroll") for (int _i = 0; _i < 2; ++_i) voffGn[_h][_i] = voffGc[_h][_i]; }
    S.a_ready(cur);
    if constexpr (SP2) {
        PG8_STAGE(PG8_SB(0, 0), cB, voffB); PG8_STAGE(PG8_SB(0, 1), cB + hstepB, voffB); PG8_STAGE_A(PG8_SA(0, 0), cA, 0, false); PG8_STAGE_A(PG8_SA(0, 1), cA + hstep, 1, false);
        if (wr == 1) PG8_BAR;
        PG8_WAIT_V(2); PG8_BAR;
        PG8_STAGE(PG8_SB(1, 0), cB + kstep, voffB); PG8_STAGE_A(PG8_SA(1, 0), cA + kstep, 0, false); PG8_STAGE(PG8_SB(1, 1), cB + hstepB + kstep, voffB);
        PG8_WAIT_V(6); PG8_BAR;
    } else {
        PG8_STAGE(PG8_SB(0, 0), cB, voffB); PG8_STAGE_A(PG8_SA(0, 0), cA, 0, false); PG8_STAGE(PG8_SB(0, 1), cB + hstepB, voffB); PG8_STAGE_A(PG8_SA(0, 1), cA + hstep, 1, false);
        if (wr == 1) PG8_BAR;
        PG8_WAIT_V(4); PG8_BAR;
        PG8_STAGE(PG8_SB(1, 0), cB + kstep, voffB); PG8_STAGE_A(PG8_SA(1, 0), cA + kstep, 0, false); PG8_STAGE(PG8_SB(1, 1), cB + hstepB + kstep, voffB);
        PG8_WAIT_V(6); PG8_BAR;
    }
    for (;;) {
        const bool has_next = S.next(ui + 1, nxt);
        const char* nA = has_next ? (const char*)g.A + (size_t)nxt.pm * tstepA : cA; const char* nB = has_next ? (const char*)g.Bt + (size_t)nxt.pn * tstep : cB;
        for (int t = 0; t < nt; t += 2) {
            if constexpr (Epi::MID_T > 0) { if (t == Epi::MID_T) E.mid(acc, cur, wr, wc, fr, fq); }
            const bool last = (t == nt - 2);
            const char* a1 = cA + (size_t)(t + 1) * kstep;
            const char* a2 = last ? nA : cA + (size_t)(t + 2) * kstep; const char* b2 = last ? nB : cB + (size_t)(t + 2) * kstep;
            const char* a3 = a2 + kstep; const char* b3 = b2 + kstep;
            if (last && has_next) { S.a_ready(nxt); if constexpr (GATHER) PG8_GVOFF(voffGn, ui + 1); }
            if constexpr (SP2) {
            PG8_LDB(B0, 0, 0); PG8_LDB(B1, 0, 1); PG8_SCHED; PG8_LDA(At, 0, 0); PG8_STAGE_A(PG8_SA(1, 1), a1 + hstep, 1, false);
            PG8_WAIT_V(8); PG8_WAIT_L(0); PG8_BAR; PG8_MMA(0, 0, At, B0); PG8_MMA(0, 1, At, B1); PG8_BAR; PG8_SCHED;
            PG8_LDA(At, 0, 1); PG8_STAGE(PG8_SB(0, 0), b2, voffB); PG8_STAGE(PG8_SB(0, 1), b2 + hstepB, voffB); PG8_STAGE_A(PG8_SA(0, 0), a2, 0, last);
            PG8_WAIT_V(8); PG8_WAIT_L(0); PG8_BAR; PG8_MMA(1, 0, At, B0); PG8_MMA(1, 1, At, B1); PG8_BAR; PG8_SCHED;
            PG8_LDB(B0, 1, 0); PG8_LDB(B1, 1, 1); PG8_SCHED; PG8_LDA(At, 1, 0); PG8_STAGE_A(PG8_SA(0, 1), a2 + hstep, 1, last);
            PG8_WAIT_V(8); PG8_WAIT_L(0); PG8_BAR; PG8_MMA(0, 0, At, B0); PG8_MMA(0, 1, At, B1); PG8_BAR; PG8_SCHED;
            PG8_LDA(At, 1, 1); PG8_STAGE(PG8_SB(1, 0), b3, voffB); PG8_STAGE(PG8_SB(1, 1), b3 + hstepB, voffB); PG8_STAGE_A(PG8_SA(1, 0), a3, 0, last);
            PG8_WAIT_V(8); PG8_WAIT_L(0); PG8_BAR; PG8_MMA(1, 0, At, B0); PG8_MMA(1, 1, At, B1); PG8_BAR; PG8_SCHED;
            } else {
            PG8_LDB(B0, 0, 0); PG8_SCHED; PG8_LDA(At, 0, 0); PG8_STAGE_A(PG8_SA(1, 1), a1 + hstep, 1, false);
            PG8_WAIT_L(8); PG8_BAR; PG8_WAIT_L(0); PG8_MMA(0, 0, At, B0); PG8_BAR; PG8_SCHED;
            PG8_LDB(B1, 0, 1); PG8_STAGE(PG8_SB(0, 0), b2, voffB);
            PG8_BAR; PG8_WAIT_L(0); PG8_MMA(0, 1, At, B1); PG8_BAR;
            PG8_LDA(At, 0, 1); PG8_STAGE_A(PG8_SA(0, 0), a2, 0, last);
            PG8_BAR; PG8_WAIT_L(0); PG8_MMA(1, 0, At, B0); PG8_BAR; PG8_SCHED;
            PG8_STAGE(PG8_SB(0, 1), b2 + hstepB, voffB);
            PG8_WAIT_V(6); PG8_BAR; PG8_MMA(1, 1, At, B1); PG8_BAR;
            PG8_LDB(B0, 1, 0); PG8_SCHED; PG8_LDA(At, 1, 0); PG8_STAGE_A(PG8_SA(0, 1), a2 + hstep, 1, last);
            PG8_WAIT_L(8); PG8_BAR; PG8_WAIT_L(0); PG8_MMA(0, 0, At, B0); PG8_BAR; PG8_SCHED;
            PG8_LDB(B1, 1, 1); PG8_STAGE(PG8_SB(1, 0), b3, voffB);
            PG8_BAR; PG8_WAIT_L(0); PG8_MMA(0, 1, At, B1); PG8_BAR;
            PG8_LDA(At, 1, 1); PG8_STAGE_A(PG8_SA(1, 0), a3, 0, last);
            PG8_BAR; PG8_WAIT_L(0); PG8_MMA(1, 0, At, B0); PG8_BAR; PG8_SCHED;
            PG8_STAGE(PG8_SB(1, 1), b3 + hstepB, voffB);
            PG8_WAIT_V(6); PG8_BAR; PG8_MMA(1, 1, At, B1); PG8_BAR;
            }
        }
        if constexpr (ALIGN_EPI) { if (wr == 0) PG8_BAR; }
        if constexpr (!Epi::AFTER_DRAIN) { E(acc, cur, wr, wc, fr, fq); S.done(cur); }
        if (!has_next) break;
#pragma unroll
        for (int a = 0; a < 2; ++a)
#pragma unroll
            for (int b = 0; b < 2; ++b)
#pragma unroll
                for (int m = 0; m < 4; ++m)
#pragma unroll
                    for (int n = 0; n < 2; ++n) acc[a][b][m][n] = (f32x4){0.f, 0.f, 0.f, 0.f};
        cur = nxt; cA = nA; cB = nB; ++ui;
        if constexpr (GATHER) { _Pragma("unroll") for (int _h = 0; _h < 2; ++_h) _Pragma("unroll") for (int _i = 0; _i < 2; ++_i) voffGc[_h][_i] = voffGn[_h][_i]; }
        if constexpr (ALIGN_EPI) { if (wr == 1) PG8_BAR; }
    }
    PG8_WAIT_V(0);
    if constexpr (!ALIGN_EPI) { if (wr == 0) PG8_BAR; }
    PG8_BAR;
    if constexpr (Epi::AFTER_DRAIN) { E.fused(acc, cur, wr, wc, fr, fq, lds, wid, lane); S.done(cur); }
#undef PG8_SA
#undef PG8_SB
#undef PG8_STAGE
#undef PG8_STAGE_A
#undef PG8_GVOFF
#undef PG8_LDA
#undef PG8_LDB
#undef PG8_MMA
#undef PG8_WAIT_V
#undef PG8_WAIT_L
#undef PG8_BAR
#undef PG8_SCHED
}
}

#define LAS __attribute__((address_space(3)))
__host__ __device__ __forceinline__ int rope_pos(int j) { return 2 * (j & 31) + (j >> 5); }
__host__ __device__ __forceinline__ int win_dest_row(int c) {
    if (c < C_K) return (c & ~63) + rope_pos(c & 63);
    if (c < C_V) return 512 + rope_pos(c - C_K);
    if (c < C_IQ) return 512 + 64 + (c - C_V);
    if (c < C_IK) return 768 + ((c - C_IQ) & ~63) + rope_pos((c - C_IQ) & 63);
    if (c < C_IW) return 512 + 128 + rope_pos(c - C_IK);
    if (c < C_Z) return 512 + 192 + (c - C_IW);
    if (c < C_XBC) return 1024 + (c - C_Z);
    if (c < C_DT) return 1536 + (c - C_XBC);
    return 512 + 200 + (c - C_DT);
}
struct EpiInProj {
    static constexpr bool PERM = true, AFTER_DRAIN = false; static constexpr int MID_T = 0;
    bf16 *Q, *K, *V, *IK, *IQ, *Z, *XBC; float *IW, *DT; const float2* rope;
    __device__ __forceinline__ u32x4 pack8(const f32x4 a, const f32x4 b) const { u32x4 w; w.x = pg8::cvt_pk_bf16(a[0], a[1]); w.y = pg8::cvt_pk_bf16(a[2], a[3]); w.z = pg8::cvt_pk_bf16(b[0], b[1]); w.w = pg8::cvt_pk_bf16(b[2], b[3]); return w; }
    __device__ __forceinline__ u32x4 rope8(const f32x4 v0, const f32x4 v1, const f32x4 r0, const f32x4 r1, float sc) const {
        f32x4 a, b;
        a[0] = (v0[0] * r0[0] - v0[1] * r0[1]) * sc; a[1] = (v0[0] * r0[1] + v0[1] * r0[0]) * sc;
        a[2] = (v0[2] * r0[2] - v0[3] * r0[3]) * sc; a[3] = (v0[2] * r0[3] + v0[3] * r0[2]) * sc;
        b[0] = (v1[0] * r1[0] - v1[1] * r1[1]) * sc; b[1] = (v1[0] * r1[1] + v1[1] * r1[0]) * sc;
        b[2] = (v1[2] * r1[2] - v1[3] * r1[3]) * sc; b[3] = (v1[2] * r1[3] + v1[3] * r1[2]) * sc;
        return pack8(a, b);
    }
    __device__ __forceinline__ void operator()(const pg8::f32x4 (&acc)[2][2][4][2], const pg8::Unit& u, int wr, int wc, int fr, int fq) const {
        const int pn = u.pn, row0 = u.pm * 256 + wr * 64 + fr, cw = 32 * wc + 8 * fq;
        if (pn <= 1 || pn == 3) {
            bf16* dst = (pn == 3) ? IQ : Q; const int ld = (pn == 3) ? 256 : 512; const float sc = (pn == 3) ? 1.f : QSCALE; const int hb = (pn == 3) ? 0 : pn * 4;
#pragma unroll
            for (int ai = 0; ai < 2; ++ai)
#pragma unroll
                for (int m = 0; m < 4; ++m) { const int row = row0 + ai * 128 + m * 16, t = row & (SEQ - 1);
                    const f32x4* rp = (const f32x4*)(rope + t * 32 + 16 * (wc & 1) + 4 * fq); const f32x4 r0 = rp[0], r1 = rp[1];
#pragma unroll
                    for (int bj = 0; bj < 2; ++bj) { const int head = hb + 2 * bj + (wc >> 1);
                        *(u32x4*)(dst + (size_t)row * ld + head * 64 + 32 * (wc & 1) + 8 * fq) = rope8(acc[ai][bj][m][0], acc[ai][bj][m][1], r0, r1, sc); } }
        } else if (pn == 2) {
#pragma unroll
            for (int ai = 0; ai < 2; ++ai)
#pragma unroll
                for (int m = 0; m < 4; ++m) { const int row = row0 + ai * 128 + m * 16, t = row & (SEQ - 1);
                    if (wc < 2) { const f32x4* rp = (const f32x4*)(rope + t * 32 + 16 * wc + 4 * fq); const f32x4 r0 = rp[0], r1 = rp[1];
                        *(u32x4*)(K + (size_t)row * 64 + cw) = rope8(acc[ai][0][m][0], acc[ai][0][m][1], r0, r1, 1.f);
                        *(u32x4*)(IK + (size_t)row * 64 + cw) = rope8(acc[ai][1][m][0], acc[ai][1][m][1], r0, r1, 1.f);
                    } else {
                        *(u32x4*)(V + (size_t)row * 64 + (cw - 64)) = pack8(acc[ai][0][m][0], acc[ai][0][m][1]);
                        if (wc == 2 && fq == 0) *(f32x4*)(IW + (size_t)row * 4) = acc[ai][1][m][0] * INDEXER_SCALE;
                        if (wc == 2 && fq == 1) { *(f32x4*)(DT + (size_t)row * 8) = acc[ai][1][m][0]; *(f32x4*)(DT + (size_t)row * 8 + 4) = acc[ai][1][m][1]; }
                    } }
        } else {
            bf16* dst = (pn < 6) ? Z : XBC; const int ld = (pn < 6) ? 512 : 768; const int cb = (pn < 6) ? (pn - 4) * 256 : (pn - 6) * 256;
#pragma unroll
            for (int ai = 0; ai < 2; ++ai)
#pragma unroll
                for (int m = 0; m < 4; ++m) { const int row = row0 + ai * 128 + m * 16;
#pragma unroll
                    for (int bj = 0; bj < 2; ++bj) *(u32x4*)(dst + (size_t)row * ld + cb + 128 * bj + cw) = pack8(acc[ai][bj][m][0], acc[ai][bj][m][1]); }
        }
    }
};
struct EpiH1 {
    static constexpr bool PERM = false, AFTER_DRAIN = false; static constexpr int MID_T = 8;
    const float* x; float* out; const float* ssqp;
    __device__ __forceinline__ void mid(pg8::f32x4 (&acc)[2][2][4][2], const pg8::Unit& u, int wr, int wc, int fr, int fq) const {
        asm volatile("" : "+v"(fr));
        const int row0 = u.pm * 256 + wr * 64 + fr;
#pragma unroll
        for (int ai = 0; ai < 2; ++ai)
#pragma unroll
            for (int m = 0; m < 4; ++m) { const f32x4* sp = (const f32x4*)(ssqp + (size_t)(row0 + ai * 128 + m * 16) * 8); const f32x4 s0 = sp[0], s1 = sp[1];
                const float r = rsqrtf(((s0[0] + s0[1]) + (s0[2] + s0[3]) + (s1[0] + s1[1]) + (s1[2] + s1[3])) * (1.f / 512.f) + LN_EPS);
#pragma unroll
                for (int bj = 0; bj < 2; ++bj)
#pragma unroll
                    for (int n = 0; n < 2; ++n) acc[ai][bj][m][n] = acc[ai][bj][m][n] * r; }
    }
    __device__ __forceinline__ void operator()(const pg8::f32x4 (&acc)[2][2][4][2], const pg8::Unit& u, int wr, int wc, int fr, int fq) const {
        const int row0 = u.pm * 256 + wr * 64 + fr, col0 = u.pn * 256 + wc * 32 + 4 * fq;
#pragma unroll
        for (int ai = 0; ai < 2; ++ai)
#pragma unroll
            for (int m = 0; m < 4; ++m) { const size_t off = (size_t)(row0 + ai * 128 + m * 16) * DM + col0;
#pragma unroll
                for (int bj = 0; bj < 2; ++bj)
#pragma unroll
                    for (int n = 0; n < 2; ++n) { const f32x4 xv = *(const f32x4*)(x + off + bj * 128 + n * 16); *(f32x4*)(out + off + bj * 128 + n * 16) = xv * ALPHA + acc[ai][bj][m][n]; } }
    }
};
template <class DR, class KM>
__device__ __forceinline__ void transpose_item(const float* W, int K, int N, bf16* WT, LAS float* scr, int item, int lane, DR drow, KM kmap) {
    const int nblk = (N + 31) / 32, kb = item / nblk, nb = item % nblk, k0 = 64 * kb, n0 = 32 * nb;
    float tv[32];
#pragma unroll
    for (int i = 0; i < 32; ++i) { const int kk = 2 * i + (lane >> 5), col = n0 + (lane & 31); float sc = 1.f; const int ks = kmap(k0 + kk, sc); tv[i] = (col < N) ? W[(size_t)ks * N + col] * sc : 0.f; }
#pragma unroll
    for (int i = 0; i < 32; ++i) scr[(2 * i + (lane >> 5)) * 33 + (lane & 31)] = tv[i];
    asm volatile("s_waitcnt lgkmcnt(0)" ::: "memory");
    const int c = lane & 7;
#pragma unroll
    for (int j = 0; j < 4; ++j) { const int n = (lane >> 3) + 8 * j, col = n0 + n; const LAS float* s = scr + (8 * c) * 33 + n;
        u32x4 o; o.x = pg8::cvt_pk_bf16(s[0 * 33], s[1 * 33]); o.y = pg8::cvt_pk_bf16(s[2 * 33], s[3 * 33]); o.z = pg8::cvt_pk_bf16(s[4 * 33], s[5 * 33]); o.w = pg8::cvt_pk_bf16(s[6 * 33], s[7 * 33]);
        if (col < N) *(u32x4*)(WT + (size_t)drow(col) * K + k0 + 8 * c) = o; }
    asm volatile("s_waitcnt lgkmcnt(0)" ::: "memory");
}
namespace attn_body {
using bf16=unsigned short;
using bf16x8=__attribute__((ext_vector_type(8)))short;
using s16x4=__attribute__((ext_vector_type(4)))short;
using f32x16=__attribute__((ext_vector_type(16)))float;
using u32x4=__attribute__((ext_vector_type(4)))unsigned;
constexpr int SEQ=2048,D=64,QP=512,KP=64,OP=1024;
constexpr int NW=8,QBLK=32,KVBLK=64;
__device__ __forceinline__ int crow(int r,int hi){return (r&3)+8*(r>>2)+4*hi;}
#define SBAR() __builtin_amdgcn_sched_barrier(0)
__device__ __forceinline__ void amask(f32x16&p0,f32x16&p1,unsigned mlo,unsigned mhi,int hi){
  const unsigned NEGB=0xff800000u; const unsigned a=mlo>>(4*hi), b=mhi>>(4*hi);
  #pragma unroll
  for(int r=0;r<16;++r){ const int pos=(r&3)+8*(r>>2);
    const unsigned s0=(unsigned)__builtin_amdgcn_sbfe((int)a,pos,1), s1=(unsigned)__builtin_amdgcn_sbfe((int)b,pos,1);
    const float v0=p0[r], v1=p1[r];
    p0[r]=__uint_as_float((s0&__float_as_uint(v0))|(~s0&NEGB));
    p1[r]=__uint_as_float((s1&__float_as_uint(v1))|(~s1&NEGB)); }
}

constexpr int NSLOT=3, SLOTB=8192;
constexpr int LDS_K=0, LDS_V=NSLOT*SLOTB, LDS_WS=2*NSLOT*SLOTB, LDS_OST=LDS_WS+NW*64*4, LDS_BYTES=LDS_OST+NW*4096;
constexpr float C2=0.125f*1.4426950408889634f;
__device__ __forceinline__ void glds16(const void*gsrc,unsigned lds_dst){unsigned keep;
  asm volatile("s_mov_b32 %0, m0\n\ts_mov_b32 m0, %2\n\ts_nop 0\n\tglobal_load_lds_dwordx4 %1, off\n\ts_mov_b32 m0, %0":"=&s"(keep):"v"(gsrc),"s"(lds_dst):"memory");}
__device__ __forceinline__ float max3f(float a,float b,float c){float r;asm("v_max3_f32 %0, %1, %2, %3":"=v"(r):"v"(a),"v"(b),"v"(c));return r;}
__device__ __forceinline__ float max2f(float a,float b){float r;asm("v_max_f32_e32 %0, %1, %2":"=v"(r):"v"(a),"v"(b));return r;}
__device__ __forceinline__ float fadd_s(float a,float b){float r;asm("v_add_f32_e32 %0, %1, %2":"=v"(r):"v"(a),"v"(b));return r;}
__device__ __forceinline__ float fsub_s(float a,float b){float r;asm("v_sub_f32_e32 %0, %1, %2":"=v"(r):"v"(a),"v"(b));return r;}
typedef float f32x2_t __attribute__((ext_vector_type(2))); typedef __bf16 bf16x2_t __attribute__((ext_vector_type(2)));
__device__ __forceinline__ unsigned cvtpk_s(float lo,float hi){f32x2_t v={lo,hi};bf16x2_t b=__builtin_convertvector(v,bf16x2_t);return __builtin_bit_cast(unsigned,b);}
#define WAIT_BAR(N) asm volatile("s_waitcnt vmcnt(" #N ") lgkmcnt(0)\n\ts_barrier":::"memory")

__device__ __forceinline__ void qkt(f32x16&p0,f32x16&p1,const char*Kslot,const bf16x8*qr,const f32x16&negm,int r32,int hi){
  const char*kb=Kslot+hi*1024+r32*16;
  #pragma unroll
  for(int d0=0;d0<4;++d0){
    const bf16x8 b0=*reinterpret_cast<const bf16x8*>(kb+d0*2048);
    const bf16x8 b1=*reinterpret_cast<const bf16x8*>(kb+d0*2048+512);
    if(d0==0){p0=__builtin_amdgcn_mfma_f32_32x32x16_bf16(b0,qr[0],negm,0,0,0);p1=__builtin_amdgcn_mfma_f32_32x32x16_bf16(b1,qr[0],negm,0,0,0);}
    else{p0=__builtin_amdgcn_mfma_f32_32x32x16_bf16(b0,qr[d0],p0,0,0,0);p1=__builtin_amdgcn_mfma_f32_32x32x16_bf16(b1,qr[d0],p1,0,0,0);}}
}
typedef __attribute__((address_space(3))) const char* lds_cptr;
typedef short v4i16_t __attribute__((ext_vector_type(4)));
__device__ __forceinline__ void kload8(bf16x8*kf,lds_cptr kp){
  kf[0]=*(const __attribute__((address_space(3))) bf16x8*)(kp);      kf[1]=*(const __attribute__((address_space(3))) bf16x8*)(kp+512);
  kf[2]=*(const __attribute__((address_space(3))) bf16x8*)(kp+2048); kf[3]=*(const __attribute__((address_space(3))) bf16x8*)(kp+2560);
  kf[4]=*(const __attribute__((address_space(3))) bf16x8*)(kp+4096); kf[5]=*(const __attribute__((address_space(3))) bf16x8*)(kp+4608);
  kf[6]=*(const __attribute__((address_space(3))) bf16x8*)(kp+6144); kf[7]=*(const __attribute__((address_space(3))) bf16x8*)(kp+6656);
}
__device__ __forceinline__ void kload2(bf16x8*kf,lds_cptr kp,int j){ kf[2*j]=*(const __attribute__((address_space(3))) bf16x8*)(kp+j*2048); kf[2*j+1]=*(const __attribute__((address_space(3))) bf16x8*)(kp+j*2048+512); }
__device__ __forceinline__ s16x4 vtr(lds_cptr p){ return __builtin_bit_cast(s16x4,__builtin_amdgcn_ds_read_tr16_b64_v4i16((__attribute__((address_space(3))) v4i16_t*)p)); }
__device__ __forceinline__ float rowmax(const f32x16&p0,const f32x16&p1){
  float a=max3f(p0[0],p0[1],p1[0]),b=max3f(p0[2],p0[3],p1[1]);a=max3f(a,p1[2],p1[3]);
  #pragma unroll
  for(int r=4;r<16;r+=4){a=max3f(a,p0[r],p0[r+1]);b=max3f(b,p0[r+2],p0[r+3]);a=max3f(a,p1[r],p1[r+1]);b=max3f(b,p1[r+2],p1[r+3]);}
  const float m=max2f(a,b);
  auto rr=__builtin_amdgcn_permlane32_swap(__float_as_uint(m),__float_as_uint(m),false,false);
  return max2f(__uint_as_float(rr[0]),__uint_as_float(rr[1]));
}
__device__ __forceinline__ void pv(f32x16*o,int vb,bf16x8 pa0,bf16x8 pa1,bf16x8 pa2,bf16x8 pa3){
  #pragma unroll
  for(int d0=0;d0<2;++d0){s16x4 lo[4],hi[4];
    #pragma unroll
    for(int ks=0;ks<4;++ks){
      asm volatile("ds_read_b64_tr_b16 %0,%1 offset:%c2":"=&v"(lo[ks]):"v"(vb),"i"(d0*4096+ks*1024):"memory");
      asm volatile("ds_read_b64_tr_b16 %0,%1 offset:%c2":"=&v"(hi[ks]):"v"(vb),"i"(d0*4096+ks*1024+512):"memory");}
    asm volatile("s_waitcnt lgkmcnt(0)":::"memory");SBAR();
    #define PK(k) (bf16x8){lo[k][0],lo[k][1],lo[k][2],lo[k][3],hi[k][0],hi[k][1],hi[k][2],hi[k][3]}
    o[d0]=__builtin_amdgcn_mfma_f32_32x32x16_bf16(pa0,PK(0),o[d0],0,0,0);
    o[d0]=__builtin_amdgcn_mfma_f32_32x32x16_bf16(pa1,PK(1),o[d0],0,0,0);
    o[d0]=__builtin_amdgcn_mfma_f32_32x32x16_bf16(pa2,PK(2),o[d0],0,0,0);
    o[d0]=__builtin_amdgcn_mfma_f32_32x32x16_bf16(pa3,PK(3),o[d0],0,0,0);
    #undef PK
  }
}

#ifndef ATTN_STORE16
#define ATTN_STORE16(p,v) (*(u32x4*)(p)=(v))
#endif
template<int THRL> __device__ __forceinline__ void attn_unit(int b,int qb,const bf16*Q,const bf16*__restrict__ K,const bf16*__restrict__ V,bf16*O,char*shm,const char*maskb,const int wave_s){
  int lane_l=lane_id(); asm volatile("":"+v"(lane_l)); const int lane=lane_l,tid=wave_s*64+lane,r32=lane&31,hi=lane>>5; const int wid=wave_s;
  const long rowbase=(long)b*SEQ; const int q0=qb*QBLK;
  const bf16*Qw=Q+(rowbase+q0)*QP+wid*D;
  const bf16*Kh=K+rowbase*KP,*Vh=V+rowbase*KP;
  const unsigned lds0=(unsigned)(uintptr_t)shm;
  float*wsf=(float*)(shm+LDS_WS)+wid*64;
  const bf16*ksrc=Kh+(long)lane*KP+wid*8;
  const bf16*vsrc=Vh+(long)(16*(wid&3)+(lane>>2))*KP+(wid>>2)*32+(lane&3)*8;
  const unsigned kdst=lds0+LDS_K+wid*1024, vdst=lds0+LDS_V+wid*1024;
  #define DMA_K(t,slot) glds16(ksrc+(long)(t)*KVBLK*KP,(unsigned)__builtin_amdgcn_readfirstlane(kdst+(slot)))
  #define DMA_V(t,slot) glds16(vsrc+(long)(t)*KVBLK*KP,(unsigned)__builtin_amdgcn_readfirstlane(vdst+(slot)))
  const int vb0=(int)(lds0+LDS_V)+((lane>>4)&1)*32+(lane&3)*8+(4*hi+((lane&15)>>2))*64;
  const char*Kbase=shm+LDS_K; bf16x8 kf[8];
  const lds_cptr shm3=(lds_cptr)shm; const lds_cptr kp0=shm3+LDS_K+hi*1024+r32*16; const lds_cptr vp0=shm3+LDS_V+((lane>>4)&1)*32+(lane&3)*8+(4*hi+((lane&15)>>2))*64;
  const int NTr=(q0+QBLK+KVBLK-1)/KVBLK; const int NT=(NTr<4)?4:((NTr+1)&~1);
  const __attribute__((address_space(3))) unsigned*mrow=(const __attribute__((address_space(3))) unsigned*)((__attribute__((address_space(3))) const char*)maskb)+r32*66;
  DMA_K(0,0);DMA_V(0,0);DMA_K(1,SLOTB);
  bf16x8 qr[4];
  #pragma unroll
  for(int d0=0;d0<4;++d0)qr[d0]=*reinterpret_cast<const bf16x8*>(&Qw[(long)r32*QP+d0*16+hi*8]);
  float zz_=0.f; asm volatile("":"+v"(zz_)); float mhat=zz_,l_reg=zz_;f32x16 o[2];
  #pragma unroll
  for(int r=0;r<16;++r){o[0][r]=zz_;o[1][r]=zz_;}
  f32x16 negm;
  #pragma unroll
  for(int r=0;r<16;++r)negm[r]=zz_;
  asm volatile("":"+v"(negm));
  #define CMASK(P0,P1,t) do{ const unsigned ml_=mrow[2*(t)], mh_=mrow[2*(t)+1]; amask(P0,P1,ml_,mh_,hi); }while(0)
  bool resc=false;
  #define START(P0,P1) do{ const float rm=rowmax(P0,P1); resc=false; \
    { const float dl=(rm>-INFINITY)?rm:0.f; mhat=fadd_s(mhat,dl); \
      _Pragma("unroll") for(int r=0;r<16;++r){P0[r]=fsub_s(P0[r],dl);P1[r]=fsub_s(P1[r],dl);} \
      _Pragma("unroll") for(int r=0;r<16;++r)negm[r]=-mhat; asm volatile("":"+v"(negm)); } \
    _Pragma("unroll") for(int r=0;r<16;++r)P0[r]=__builtin_amdgcn_exp2f(P0[r]); }while(0)
  #define RESC() do{ if(resc){ asm volatile("s_waitcnt lgkmcnt(0)":::"memory"); \
      _Pragma("unroll") for(int d_=0;d_<2;++d_) _Pragma("unroll") for(int r=0;r<16;++r)o[d_][r]*=wsf[crow(r,hi)]; } }while(0)
  f32x16 pA0,pA1,pB0,pB1;
  int sl_prev=0,sl_cur=0,sl_next=SLOTB;
  #define ROT() do{sl_prev=sl_cur;sl_cur=sl_next;sl_next=(sl_next==(NSLOT-1)*SLOTB)?0:sl_next+SLOTB;}while(0)
  DMA_K(2,2*SLOTB);
  WAIT_BAR(3);
  qkt(pA0,pA1,Kbase,qr,negm,r32,hi);asm volatile("s_nop 15\n\ts_nop 7":"+v"(pA0),"+v"(pA1));CMASK(pA0,pA1,0);
  START(pA0,pA1);
  _Pragma("unroll") for(int r=0;r<16;++r)pA1[r]=__builtin_amdgcn_exp2f(pA1[r]);
  WAIT_BAR(0);
  DMA_K(3,0);DMA_V(1,SLOTB);
  ROT();
  kload8(kf,kp0+sl_cur);
  WAIT_BAR(2);
  s16x4 vlo[8],vhi[8]; u32x4 pw0,pw1,pw2,pw3;
  #define PKW(P,B) cvtpk_s(P[B],P[B+1])
  #define PAF(k) __builtin_bit_cast(bf16x8,pw##k)
  #define VFR(i) (bf16x8){vlo[i][0],vlo[i][1],vlo[i][2],vlo[i][3],vhi[i][0],vhi[i][1],vhi[i][2],vhi[i][3]}
  #define PIN(x) asm volatile("":"+v"(x))
  #define MX3(a,b,c) __builtin_fmaxf(__builtin_fmaxf((a),(b)),(c))
  #define GAPA(MF,A0,A1,A2,A3,W0,W1,PW) do{ MF; sacc+=A0; sacc+=A1; sacc+=A2; sacc+=A3; PIN(sacc); W0; W1; PIN(PW); SBAR(); }while(0)
  #define EX(v) __builtin_amdgcn_exp2f(v)
  #define GAPB(MF,X,B) do{ MF; X[B]=EX(X[B]); X[B+1]=EX(X[B+1]); X[B+2]=EX(X[B+2]); X[B+3]=EX(X[B+3]); PIN(X); SBAR(); }while(0)
  #define VRD(i) do{ vlo[i]=vtr(vp_+(((i)>>2)*4096+((i)&3)*1024)); vhi[i]=vtr(vp_+(((i)>>2)*4096+((i)&3)*1024+512)); }while(0)
  #define KRD(G,j) do{ if(G){ kload2(kf,kp0+sl_next,j); SBAR(); } }while(0)
  #define STEP(C0,C1,P0,P1,t,GK,GV,GL) do{ SBAR(); \
    const lds_cptr vp_=vp0+sl_prev; \
    VRD(0); SBAR(); float sacc=(P0[0]+P0[1]); \
    GAPA(C0=__builtin_amdgcn_mfma_f32_32x32x16_bf16(kf[0],qr[0],negm,0,0,0), P0[2],P0[3],P0[4],P0[5],     pw0[0]=PKW(P0,0), pw0[1]=PKW(P0,2), pw0); \
    VRD(4); SBAR(); GAPA(C1=__builtin_amdgcn_mfma_f32_32x32x16_bf16(kf[1],qr[0],negm,0,0,0), P0[6],P0[7],P0[8],P0[9],     pw0[2]=PKW(P0,4), pw0[3]=PKW(P0,6), pw0); \
    VRD(1); SBAR(); GAPA(C0=__builtin_amdgcn_mfma_f32_32x32x16_bf16(kf[2],qr[1],C0,0,0,0),   P0[10],P0[11],P0[12],P0[13], pw1[0]=PKW(P0,8), pw1[1]=PKW(P0,10), pw1); \
    VRD(5); SBAR(); GAPA(C1=__builtin_amdgcn_mfma_f32_32x32x16_bf16(kf[3],qr[1],C1,0,0,0),   P0[14],P0[15],P1[0],P1[1],   pw1[2]=PKW(P0,12),pw1[3]=PKW(P0,14), pw1); \
    VRD(2); SBAR(); GAPA(C0=__builtin_amdgcn_mfma_f32_32x32x16_bf16(kf[4],qr[2],C0,0,0,0),   P1[2],P1[3],P1[4],P1[5],     pw2[0]=PKW(P1,0), pw2[1]=PKW(P1,2), pw2); \
    VRD(6); SBAR(); GAPA(C1=__builtin_amdgcn_mfma_f32_32x32x16_bf16(kf[5],qr[2],C1,0,0,0),   P1[6],P1[7],P1[8],P1[9],     pw2[2]=PKW(P1,4), pw2[3]=PKW(P1,6), pw2); \
    VRD(3); SBAR(); GAPA(C0=__builtin_amdgcn_mfma_f32_32x32x16_bf16(kf[6],qr[3],C0,0,0,0),   P1[10],P1[11],P1[12],P1[13], pw3[0]=PKW(P1,8), pw3[1]=PKW(P1,10), pw3); \
    VRD(7); SBAR(); GAPA(C1=__builtin_amdgcn_mfma_f32_32x32x16_bf16(kf[7],qr[3],C1,0,0,0),   P1[14],P1[15],0.f,0.f,       pw3[2]=PKW(P1,12),pw3[3]=PKW(P1,14), pw3); \
    l_reg+=sacc; \
    if(GK){DMA_K((t)+3,sl_cur);} if(GV){DMA_V((t)+1,sl_next);} \
    CMASK(C0,C1,t); \
    { float a=MX3(C0[0],C0[1],C1[0]),b=MX3(C0[2],C0[3],C1[1]); a=MX3(a,C1[2],C1[3]); \
      _Pragma("unroll") for(int r=4;r<16;r+=4){a=MX3(a,C0[r],C0[r+1]);b=MX3(b,C0[r+2],C0[r+3]);a=MX3(a,C1[r],C1[r+1]);b=MX3(b,C1[r+2],C1[r+3]);} \
      float rm=__builtin_fmaxf(a,b); { auto rr=__builtin_amdgcn_permlane32_swap(__float_as_uint(rm),__float_as_uint(rm),false,false); rm=__builtin_fmaxf(__uint_as_float(rr[0]),__uint_as_float(rr[1])); } \
      resc=false; \
      if(__builtin_expect(__any(rm>(float)THRL),0)){ const float dl=__builtin_fmaxf(rm,0.f); mhat+=dl; \
        _Pragma("unroll") for(int r=0;r<16;++r){C0[r]-=dl;C1[r]-=dl;} \
        _Pragma("unroll") for(int r=0;r<16;++r)negm[r]=-mhat; asm volatile("":"+v"(negm)); \
        const float f=__builtin_amdgcn_exp2f(-dl); l_reg*=f; if(hi==0)wsf[r32]=f; resc=true; } } \
    SBAR(); \
    GAPB(o[0]=__builtin_amdgcn_mfma_f32_32x32x16_bf16(PAF(0),VFR(0),o[0],0,0,0), C0,0); \
    GAPB(o[1]=__builtin_amdgcn_mfma_f32_32x32x16_bf16(PAF(0),VFR(4),o[1],0,0,0), C0,4); \
    KRD(GL,0); GAPB(o[0]=__builtin_amdgcn_mfma_f32_32x32x16_bf16(PAF(1),VFR(1),o[0],0,0,0), C0,8); \
    KRD(GL,1); GAPB(o[1]=__builtin_amdgcn_mfma_f32_32x32x16_bf16(PAF(1),VFR(5),o[1],0,0,0), C0,12); \
    KRD(GL,2); GAPB(o[0]=__builtin_amdgcn_mfma_f32_32x32x16_bf16(PAF(2),VFR(2),o[0],0,0,0), C1,0); \
    KRD(GL,3); GAPB(o[1]=__builtin_amdgcn_mfma_f32_32x32x16_bf16(PAF(2),VFR(6),o[1],0,0,0), C1,4); \
    GAPB(o[0]=__builtin_amdgcn_mfma_f32_32x32x16_bf16(PAF(3),VFR(3),o[0],0,0,0), C1,8); \
    GAPB(o[1]=__builtin_amdgcn_mfma_f32_32x32x16_bf16(PAF(3),VFR(7),o[1],0,0,0), C1,12); \
    }while(0)
  int t=1;
  for(;t+5<NT;t+=2){
    STEP(pB0,pB1,pA0,pA1,t,true,true,true);     WAIT_BAR(2); RESC(); ROT();
    STEP(pA0,pA1,pB0,pB1,t+1,true,true,true);   WAIT_BAR(2); RESC(); ROT();
  }
  #define ENDW(tt) do{ if((tt)+3<NT){WAIT_BAR(2);} else if((tt)+2<NT){WAIT_BAR(1);} else {WAIT_BAR(0);} }while(0)
  for(;t+1<NT;t+=2){
    STEP(pB0,pB1,pA0,pA1,t,(t+3<NT),(t+1<NT),(t+1<NT));       ENDW(t);   RESC(); ROT();
    STEP(pA0,pA1,pB0,pB1,t+1,(t+4<NT),(t+2<NT),(t+2<NT));     ENDW(t+1); RESC(); ROT();
  }
  STEP(pB0,pB1,pA0,pA1,NT-1,false,false,false); RESC();
  { float sacc=pB0[0]+pB0[1]; _Pragma("unroll") for(int r=2;r<16;++r)sacc+=pB0[r]; _Pragma("unroll") for(int r=0;r<16;++r)sacc+=pB1[r]; l_reg+=sacc;
    pw0=(u32x4){PKW(pB0,0),PKW(pB0,2),PKW(pB0,4),PKW(pB0,6)};pw1=(u32x4){PKW(pB0,8),PKW(pB0,10),PKW(pB0,12),PKW(pB0,14)};pw2=(u32x4){PKW(pB1,0),PKW(pB1,2),PKW(pB1,4),PKW(pB1,6)};pw3=(u32x4){PKW(pB1,8),PKW(pB1,10),PKW(pB1,12),PKW(pB1,14)};
    SBAR(); pv(o,vb0+sl_cur,PAF(0),PAF(1),PAF(2),PAF(3)); }
  #undef PKW
  #undef PAF
  #undef VFR
  #undef PIN
  #undef MX3
  #undef GAPA
  #undef GAPB
  #undef EX
  #undef VRD
  #undef KRD
  #undef STEP
  #undef ENDW
  {auto rr=__builtin_amdgcn_permlane32_swap(__float_as_uint(l_reg),__float_as_uint(l_reg),false,false);l_reg=__uint_as_float(rr[0])+__uint_as_float(rr[1]);}
  if(hi==0)wsf[32+r32]=l_reg;asm volatile("s_waitcnt lgkmcnt(0)":::"memory");
  float rli[16];
  #pragma unroll
  for(int r=0;r<16;++r)rli[r]=__builtin_amdgcn_rcpf(wsf[32+crow(r,hi)]);
  bf16*Ow=O+(rowbase+q0)*OP+512+wid*D;
  { bf16*stg=(bf16*)(shm+LDS_OST)+wid*2048;
    #pragma unroll
    for(int r=0;r<16;++r){const int orow=crow(r,hi);
      #pragma unroll
      for(int d0=0;d0<2;++d0)stg[orow*64+d0*32+r32]=(bf16)(cvtpk_s(o[d0][r]*rli[r],0.f)&0xffffu);}
    asm volatile("s_waitcnt lgkmcnt(0)":::"memory");
    #pragma unroll
    for(int i=0;i<4;++i){const int row=i*8+(lane>>3),ch=lane&7; const u32x4 v=*(const u32x4*)(stg+row*64+ch*8); ATTN_STORE16(Ow+(long)row*OP+ch*8,v);} }
  asm volatile("s_waitcnt lgkmcnt(0)\n\ts_barrier":::"memory");
  #undef DMA_K
  #undef DMA_V
  #undef CMASK
  #undef START
  #undef RESC
  #undef ROT
}
constexpr int ATTN_LDS_BYTES=LDS_BYTES;
#undef SBAR
#undef WAIT_BAR
}

constexpr int DSA_MASK_OFF = 131072, DSA_MASK_STRIDE = 66;
typedef short bf16x8_t __attribute__((ext_vector_type(8)));
__device__ __forceinline__ int wave_sum_dpp_i(int x) {
    x += __builtin_amdgcn_update_dpp(0, x, 0xB1, 0xf, 0xf, true);
    x += __builtin_amdgcn_update_dpp(0, x, 0x4E, 0xf, 0xf, true);
    x += __builtin_amdgcn_update_dpp(0, x, 0x114, 0xf, 0xf, true);
    x += __builtin_amdgcn_update_dpp(0, x, 0x118, 0xf, 0xf, true);
    x += __builtin_amdgcn_update_dpp(0, x, 0x142, 0xa, 0xf, false);
    x += __builtin_amdgcn_update_dpp(0, x, 0x143, 0xc, 0xf, false);
    return __builtin_amdgcn_readlane(x, 63);
}
__device__ __forceinline__ int count_ge(const unsigned (&k)[32], unsigned cand, int nreg) {
    int cl = 0;
#pragma unroll
    for (int g4 = 0; g4 < 8; ++g4) if (4 * g4 < nreg) {
#pragma unroll
        for (int j = 0; j < 4; ++j) cl += (k[4 * g4 + j] >= cand) ? 1 : 0; }
    return wave_sum_dpp_i(cl);
}
template <int OPK> __device__ __forceinline__ float dpp_opf(float a, float b) { return OPK == 0 ? fmaxf(a, b) : fminf(a, b); }
template <int OPK> __device__ __forceinline__ float wave_reduce_f(float x) {
    const int id = OPK == 0 ? (int)0xff800000 : (int)0x7f800000;
    x = dpp_opf<OPK>(x, __int_as_float(__builtin_amdgcn_update_dpp(id, __float_as_int(x), 0xB1, 0xf, 0xf, false)));
    x = dpp_opf<OPK>(x, __int_as_float(__builtin_amdgcn_update_dpp(id, __float_as_int(x), 0x4E, 0xf, 0xf, false)));
    x = dpp_opf<OPK>(x, __int_as_float(__builtin_amdgcn_update_dpp(id, __float_as_int(x), 0x114, 0xf, 0xf, false)));
    x = dpp_opf<OPK>(x, __int_as_float(__builtin_amdgcn_update_dpp(id, __float_as_int(x), 0x118, 0xf, 0xf, false)));
    x = dpp_opf<OPK>(x, __int_as_float(__builtin_amdgcn_update_dpp(id, __float_as_int(x), 0x142, 0xa, 0xf, false)));
    x = dpp_opf<OPK>(x, __int_as_float(__builtin_amdgcn_update_dpp(id, __float_as_int(x), 0x143, 0xc, 0xf, false)));
    return __int_as_float(__builtin_amdgcn_readlane(__float_as_int(x), 63));
}
__device__ __forceinline__ int binof(float v, float vmin, float scale) { const int b = (int)__fmul_rn(__fsub_rn(v, vmin), scale); return b > 2047 ? 2047 : b; }
__device__ __forceinline__ unsigned long long select_topk(const float (&k)[32], int kk, int nvalid, int nreg, int lane, LAS unsigned* hist, unsigned* errw) {
    const float NINF = -INFINITY;
    unsigned long long mine = 0ull;
    if (nvalid <= kk) {
#pragma unroll
        for (int i = 0; i < 32; ++i) { const unsigned long long m = __ballot(k[i] > NINF); if (lane == i) mine = m; }
        return mine;
    }
    float T = 0.f; bool exact = false;
    float mx = NINF, mn = INFINITY;
#pragma unroll
    for (int g4 = 0; g4 < 8; ++g4) if (4 * g4 < nreg) {
#pragma unroll
        for (int j = 0; j < 4; ++j) { const float v = k[4 * g4 + j]; mx = fmaxf(mx, v); mn = fminf(mn, v > NINF ? v : INFINITY); } }
    const float vmax = wave_reduce_f<0>(mx), vmin = wave_reduce_f<1>(mn);
    if (vmax == vmin) { T = vmax; }
    else {
        const float scale = 2048.0f / (vmax - vmin);
        LAS u32x4* h4 = (LAS u32x4*)hist;
#pragma unroll
        for (int j = 0; j < 4; ++j) h4[lane + 64 * j] = (u32x4){0u, 0u, 0u, 0u};
#pragma unroll
        for (int g4 = 0; g4 < 8; ++g4) if (4 * g4 < nreg) {
#pragma unroll
            for (int j = 0; j < 4; ++j) { const float v = k[4 * g4 + j]; const bool ok = v > NINF; const unsigned bin = ok ? (unsigned)binof(v, vmin, scale) : 0u;
                __hip_atomic_fetch_add(hist + (bin >> 1), ok ? (1u << (16 * (bin & 1u))) : 0u, __ATOMIC_RELAXED, __HIP_MEMORY_SCOPE_WORKGROUP); } }
        u32x4 w[4];
#pragma unroll
        for (int j = 0; j < 4; ++j) w[j] = ((LAS u32x4*)(hist + 1008 - 16 * lane))[j];
        int s = 0;
#pragma unroll
        for (int j = 0; j < 4; ++j)
#pragma unroll
            for (int e = 0; e < 4; ++e) s += (int)(w[j][e] & 0xffffu) + (int)(w[j][e] >> 16);
        int Pinc = s;
#pragma unroll
        for (int o = 1; o < 64; o <<= 1) { const int v = __shfl_up(Pinc, o); if (lane >= o) Pinc += v; }
        const unsigned long long geb = __ballot(Pinc >= kk);
        const int Lstar = __builtin_ctzll(geb);
        int run = Pinc - s; int Bl = 0, ab = 0, cb = 0; bool found = false;
#pragma unroll
        for (int jw = 15; jw >= 0; --jw)
#pragma unroll
            for (int half = 1; half >= 0; --half) { const unsigned wd = w[jw >> 2][jw & 3]; const int cnt = half ? (int)(wd >> 16) : (int)(wd & 0xffffu);
                if (!found && run + cnt >= kk) { found = true; Bl = 2016 - 32 * lane + 2 * jw + half; ab = run; cb = cnt; } run += cnt; }
        const int Bstar = __builtin_amdgcn_readlane(Bl, Lstar), cnt_above = __builtin_amdgcn_readlane(ab, Lstar), cB = __builtin_amdgcn_readlane(cb, Lstar);
        const int r = kk - cnt_above;
        if (cB <= 64) {
            LAS unsigned* cand = hist + 1024; int base = 0;
#pragma unroll
            for (int g4 = 0; g4 < 8; ++g4) if (4 * g4 < nreg) {
#pragma unroll
                for (int j = 0; j < 4; ++j) { const float v = k[4 * g4 + j]; const bool c = (v > NINF) && (binof(v, vmin, scale) == Bstar); const unsigned long long bal = __ballot(c);
                    if (bal) { if (c) cand[base + __builtin_amdgcn_mbcnt_hi((unsigned)(bal >> 32), __builtin_amdgcn_mbcnt_lo((unsigned)bal, 0u))] = __float_as_uint(v); base += __popcll(bal); } } }
            const float myc = (lane < cB) ? __uint_as_float(cand[lane]) : NINF;
            float prev = INFINITY; int cum = 0;
            for (int it = 0; it < 64; ++it) {
                const float m = wave_reduce_f<0>(myc < prev ? myc : NINF);
                cum += __popcll(__ballot(myc == m));
                if (cum >= r) { T = m; exact = (cum == r); break; }
                prev = m;
            }
        } else {
            float prev = INFINITY; int cum = 0;
            for (int it = 0; it < 2048; ++it) {
                float lm = NINF;
#pragma unroll
                for (int i = 0; i < 32; ++i) { const float v = k[i]; if (v > NINF && v < prev && binof(v, vmin, scale) == Bstar) lm = fmaxf(lm, v); }
                const float m = wave_reduce_f<0>(lm);
                int mult = 0;
#pragma unroll
                for (int i = 0; i < 32; ++i) mult += __popcll(__ballot(k[i] == m));
                cum += mult;
                if (cum >= r) { T = m; exact = (cum == r); break; }
                prev = m;
            }
        }
    }
    if (exact) {
#pragma unroll
        for (int i = 0; i < 32; ++i) { const unsigned long long m = __ballot(k[i] >= T); if (lane == i) mine = m; }
    } else {
        int ngt = 0;
#pragma unroll
        for (int i = 0; i < 32; ++i) ngt += __popcll(__ballot(k[i] > T));
        int need = kk - ngt;
#pragma unroll
        for (int i = 0; i < 32; ++i) {
            const unsigned long long eqb = __ballot(k[i] == T);
            const int rank = __builtin_amdgcn_mbcnt_hi((unsigned)(eqb >> 32), __builtin_amdgcn_mbcnt_lo((unsigned)eqb, 0u));
            const bool sel = (k[i] > T) || ((k[i] == T) && (rank < need));
            const unsigned long long m = __ballot(sel);
            need -= __popcll(eqb); if (need < 0) need = 0;
            if (lane == i) mine = m;
        }
    }
    if (wave_sum_dpp_i(lane < 32 ? __popcll(mine) : 0) != kk && lane == 0) atomicOr(errw, 1u);
    return mine;
}
__device__ __forceinline__ void dsa_select(int b, int qb, const bf16* IQb, const bf16* IKb, const float* IW, unsigned char* lds, int lane, int wave, unsigned* errw) {
    lane = launder_i(lane);
    unsigned* keys = (unsigned*)lds; unsigned* maskw = (unsigned*)(lds + DSA_MASK_OFF);
    const size_t rb = (size_t)b * SEQ; const int q0 = qb * 32; const int ntk16 = 4 * ((qb >> 1) + 1);
    const int l15 = lane & 15, l4 = lane >> 4;
    for (int rnd = 0; rnd < 2; ++rnd) {
        const int qb0 = q0 + 16 * rnd;
        bf16x8_t a[4][2]; f32x4 wq[4];
#pragma unroll
        for (int mt = 0; mt < 4; ++mt) {
            const bf16* ar = IQb + (rb + qb0 + 4 * mt + (l15 >> 2)) * 256 + (l15 & 3) * 64 + 8 * l4;
            a[mt][0] = *(const bf16x8_t*)ar; a[mt][1] = *(const bf16x8_t*)(ar + 32);
            wq[mt] = *(const f32x4*)(IW + (rb + qb0 + 4 * mt + l4) * 4);
        }
        bf16x8_t bc[4][2], bn[4][2];
#define DSA_LOADG(dst, ntb) do { _Pragma("unroll") for (int u = 0; u < 4; ++u) { const int nt_ = (ntb) + 8 * u; \
            if (nt_ < ntk16) { const bf16* br = IKb + (rb + 16 * nt_ + l15) * 64 + 8 * l4; dst[u][0] = *(const bf16x8_t*)br; dst[u][1] = *(const bf16x8_t*)(br + 32); } \
            else { dst[u][0] = (bf16x8_t){0, 0, 0, 0, 0, 0, 0, 0}; dst[u][1] = dst[u][0]; } } } while (0)
        DSA_LOADG(bn, wave);
        for (int ntb = wave; ntb < ntk16; ntb += 32) {
#pragma unroll
            for (int u = 0; u < 4; ++u) { bc[u][0] = bn[u][0]; bc[u][1] = bn[u][1]; }
            if (ntb + 32 < ntk16) DSA_LOADG(bn, ntb + 32);
#pragma unroll
            for (int u = 0; u < 4; ++u) {
                const int nt = ntb + 8 * u;
                if (nt < ntk16) {
                    const int s = 16 * nt + l15;
#pragma unroll
                    for (int mt = 0; mt < 4; ++mt) {
                        f32x4 c = (f32x4){0.f, 0.f, 0.f, 0.f};
                        c = __builtin_amdgcn_mfma_f32_16x16x32_bf16(a[mt][0], bc[u][0], c, 0, 0, 0);
                        c = __builtin_amdgcn_mfma_f32_16x16x32_bf16(a[mt][1], bc[u][1], c, 0, 0, 0);
                        float sc = wq[mt][0] * fmaxf(c[0], 0.f); sc = fmaf(wq[mt][1], fmaxf(c[1], 0.f), sc); sc = fmaf(wq[mt][2], fmaxf(c[2], 0.f), sc); sc = fmaf(wq[mt][3], fmaxf(c[3], 0.f), sc);
                        const int ql = 4 * mt + l4, t = qb0 + ql;
                        keys[ql * 2048 + s] = (s <= t) ? __float_as_uint(sc) : 0xff800000u;
                    }
                }
            }
        }
#undef DSA_LOADG
        __syncthreads();
#pragma unroll 1
        for (int j = 0; j < 2; ++j) {
            const int ql = 2 * wave + j, t = qb0 + ql, kk = (t + 1 < TOPK) ? (t + 1) : TOPK, nreg = (t >> 6) + 1;
            float k[32];
#pragma unroll
            for (int i = 0; i < 32; ++i) k[i] = (i < nreg) ? __uint_as_float(keys[ql * 2048 + 64 * i + lane]) : -INFINITY;
            const unsigned long long mine = select_topk(k, kk, t + 1, nreg, lane, (LAS unsigned*)((LAS unsigned char*)lds) + ql * 2048, errw);
            if (lane < 32) *(unsigned long long*)(maskw + (16 * rnd + ql) * DSA_MASK_STRIDE + 2 * lane) = mine;
        }
        __syncthreads();
    }
}

constexpr int LD64 = 72, LD128 = 136;
constexpr int SSD_CM = 0, SSD_BM = 18432, SSD_XS = 36864, SSD_XDT = 55296, SSD_BDT = 72704, SSD_MT = 90112, SSD_HB = 124928, SSD_DTS = 134144, SSD_ACUM = 134656, SSD_CW = 135168;
__device__ __forceinline__ bf16x8_t ldfrag(const bf16* base, int row, int ld, int k0) { return *(const bf16x8_t*)(base + row * ld + k0); }
__device__ __forceinline__ void ssd_item(int b, int h, KPtr P, const bf16* XBC, const float* DT, const bf16* Zb, bf16* ASb, float* SSQP, unsigned char* lds, int tid) {
    tid = launder_i(tid);
    const int lane = tid & 63, w = __builtin_amdgcn_readfirstlane(tid >> 6), l15 = lane & 15, l4 = lane >> 4, g = h >> 2;
    bf16* Cm = (bf16*)(lds + SSD_CM); bf16* Bm = (bf16*)(lds + SSD_BM); bf16* xs = (bf16*)(lds + SSD_XS); bf16* XdtT = (bf16*)(lds + SSD_XDT);
    bf16* BdT = (bf16*)(lds + SSD_BDT); bf16* Mt = (bf16*)(lds + SSD_MT); bf16* Hb = (bf16*)(lds + SSD_HB);
    float* dts = (float*)(lds + SSD_DTS); float* acum = (float*)(lds + SSD_ACUM);
    const float A = -__expf(P->a_log[h]), dtb = P->dt_bias[h], Dh = P->d_skip[h];
    f32x4 Hacc[2]; Hacc[0] = (f32x4){0.f, 0.f, 0.f, 0.f}; Hacc[1] = Hacc[0];
    for (int e = tid; e < 64 * LD64 / 2; e += NT) ((unsigned*)Hb)[e] = 0u;
    float* cwl = (float*)(lds + SSD_CW);
    for (int e = tid; e < 960; e += NT) { const int T = (e < 768) ? (e >> 8) : ((e - 768) >> 6), ch = e & 63, cb = (T == 0) ? h * 64 : (T == 1 ? 512 + g * 64 : 640 + g * 64);
        cwl[e] = (e < 768) ? P->conv_w[((e >> 6) & 3) * 768 + cb + ch] : P->conv_b[cb + ch]; }
    const int pt = w >> 1, ntb = 2 * (w & 1);
    for (int c = 0; c < SEQ / 128; ++c) {
        const size_t rbase = (size_t)b * SEQ + c * 128;
        if (tid < 128) { const float v = DT[(rbase + tid) * 8 + h] + dtb; dts[tid] = (v > 20.f) ? v : log1pf(__expf(v)); }
        __syncthreads();
        if (w == 0) {
            const float a0 = dts[2 * lane] * A, a1 = dts[2 * lane + 1] * A; const float s = a0 + a1; float inc = s;
#pragma unroll
            for (int o = 1; o < 64; o <<= 1) { const float v = __shfl_up(inc, o); if (lane >= o) inc += v; }
            const float ex = inc - s; acum[2 * lane] = ex + a0; acum[2 * lane + 1] = ex + s;
        }
        __syncthreads();
        const float alast = acum[127];
        {
            const int l = tid >> 2, c0 = (tid & 3) * 16;
            const bf16* xr = XBC + (rbase + l) * 768;
            const float dtl = dts[l], dec = __expf(alast - acum[l]);
            const int tmin = 3 - (c * 128 + l);
#pragma unroll
            for (int T = 0; T < 3; ++T) {
                const int cb = (T == 0) ? h * 64 : (T == 1 ? 512 + g * 64 : 640 + g * 64);
                u32x4 u[4][2];
#pragma unroll
                for (int j = 0; j < 4; ++j) { if (j >= tmin) { u[j][0] = *(const u32x4*)(xr + (j - 3) * 768 + cb + c0); u[j][1] = *(const u32x4*)(xr + (j - 3) * 768 + cb + c0 + 8); }
                                              else { u[j][0] = (u32x4){0u, 0u, 0u, 0u}; u[j][1] = u[j][0]; } }
                float v[16];
#pragma unroll
                for (int i = 0; i < 16; ++i) v[i] = cwl[768 + T * 64 + c0 + i];
#pragma unroll
                for (int j = 0; j < 4; ++j)
#pragma unroll
                    for (int i = 0; i < 16; ++i) { const unsigned wd = u[j][i >> 3][(i >> 1) & 3]; const float xv = (i & 1) ? __uint_as_float(wd & 0xffff0000u) : __uint_as_float(wd << 16);
                        v[i] = fmaf(cwl[(T * 4 + j) * 64 + c0 + i], xv, v[i]); }
#pragma unroll
                for (int i = 0; i < 16; ++i) v[i] = silu(v[i]);
                bf16* dstm = (T == 0) ? xs : (T == 1 ? Bm : Cm);
                u32x4 o0, o1; o0.x = pg8::cvt_pk_bf16(v[0], v[1]); o0.y = pg8::cvt_pk_bf16(v[2], v[3]); o0.z = pg8::cvt_pk_bf16(v[4], v[5]); o0.w = pg8::cvt_pk_bf16(v[6], v[7]);
                o1.x = pg8::cvt_pk_bf16(v[8], v[9]); o1.y = pg8::cvt_pk_bf16(v[10], v[11]); o1.z = pg8::cvt_pk_bf16(v[12], v[13]); o1.w = pg8::cvt_pk_bf16(v[14], v[15]);
                *(u32x4*)(dstm + l * LD64 + c0) = o0; *(u32x4*)(dstm + l * LD64 + c0 + 8) = o1;
                if (T == 0) {
#pragma unroll
                    for (int i = 0; i < 16; ++i) XdtT[(c0 + i) * LD128 + l] = f2bf(v[i] * dtl); }
                if (T == 1) {
#pragma unroll
                    for (int i = 0; i < 16; ++i) BdT[(c0 + i) * LD128 + l] = f2bf(v[i] * dec); }
            }
        }
        __syncthreads();
        const int lrow = 16 * w + l15; const float al = acum[lrow];
        {
            const bf16x8_t c0f = ldfrag(Cm, lrow, LD64, 8 * l4), c1f = ldfrag(Cm, lrow, LD64, 32 + 8 * l4);
            for (int j = 0; j <= w; ++j) {
                f32x4 acc = (f32x4){0.f, 0.f, 0.f, 0.f};
                acc = __builtin_amdgcn_mfma_f32_16x16x32_bf16(ldfrag(Bm, 16 * j + l15, LD64, 8 * l4), c0f, acc, 0, 0, 0);
                acc = __builtin_amdgcn_mfma_f32_16x16x32_bf16(ldfrag(Bm, 16 * j + l15, LD64, 32 + 8 * l4), c1f, acc, 0, 0, 0);
                const int s0 = 16 * j + 4 * l4; float m[4];
#pragma unroll
                for (int r = 0; r < 4; ++r) { const int s = s0 + r; m[r] = (s <= lrow) ? acc[r] * __expf(al - acum[s]) : 0.f; }
                u32x2 o; o.x = pg8::cvt_pk_bf16(m[0], m[1]); o.y = pg8::cvt_pk_bf16(m[2], m[3]);
                *(u32x2*)(Mt + lrow * LD128 + s0) = o;
            }
            if ((w & 1) == 0) *(u32x2*)(Mt + lrow * LD128 + 16 * (w + 1) + 4 * l4) = (u32x2){0u, 0u};
        }
        {
            const bf16x8_t c0f = ldfrag(Cm, lrow, LD64, 8 * l4), c1f = ldfrag(Cm, lrow, LD64, 32 + 8 * l4);
            const float ea = __expf(al); const int nks = (w >> 1) + 1;
            float ssq = 0.f;
            bf16x8_t mf[4];
#pragma unroll
            for (int ks = 0; ks < 4; ++ks) mf[ks] = (ks < nks) ? ldfrag(Mt, lrow, LD128, 32 * ks + 8 * l4) : (bf16x8_t){0, 0, 0, 0, 0, 0, 0, 0};
#pragma unroll
            for (int jt = 0; jt < 4; ++jt) {
                f32x4 acc = (f32x4){0.f, 0.f, 0.f, 0.f};
                acc = __builtin_amdgcn_mfma_f32_16x16x32_bf16(ldfrag(Hb, 16 * jt + l15, LD64, 8 * l4), c0f, acc, 0, 0, 0);
                acc = __builtin_amdgcn_mfma_f32_16x16x32_bf16(ldfrag(Hb, 16 * jt + l15, LD64, 32 + 8 * l4), c1f, acc, 0, 0, 0);
                acc = acc * ea;
#pragma unroll
                for (int ks = 0; ks < 4; ++ks) if (ks < nks) acc = __builtin_amdgcn_mfma_f32_16x16x32_bf16(ldfrag(XdtT, 16 * jt + l15, LD128, 32 * ks + 8 * l4), mf[ks], acc, 0, 0, 0);
                const int p0 = 16 * jt + 4 * l4;
                const u32x2 xb = *(const u32x2*)(xs + lrow * LD64 + p0);
                const u32x2 zb = *(const u32x2*)(Zb + (rbase + lrow) * 512 + h * 64 + p0);
                const float x0 = __uint_as_float(xb.x << 16), x1 = __uint_as_float(xb.x & 0xffff0000u), x2 = __uint_as_float(xb.y << 16), x3 = __uint_as_float(xb.y & 0xffff0000u);
                const float z0 = __uint_as_float(zb.x << 16), z1 = __uint_as_float(zb.x & 0xffff0000u), z2 = __uint_as_float(zb.y << 16), z3 = __uint_as_float(zb.y & 0xffff0000u);
                f32x4 y; y[0] = (acc[0] + Dh * x0) * silu(z0); y[1] = (acc[1] + Dh * x1) * silu(z1); y[2] = (acc[2] + Dh * x2) * silu(z2); y[3] = (acc[3] + Dh * x3) * silu(z3);
                u32x2 yo; yo.x = pg8::cvt_pk_bf16(y[0], y[1]); yo.y = pg8::cvt_pk_bf16(y[2], y[3]);
                *(u32x2*)(ASb + (rbase + lrow) * 1024 + h * 64 + p0) = yo;
                ssq += (y[0] * y[0] + y[1] * y[1]) + (y[2] * y[2] + y[3] * y[3]);
            }
            ssq += __shfl_xor(ssq, 16); ssq += __shfl_xor(ssq, 32);
            if (l4 == 0) SSQP[(rbase + lrow) * 8 + h] = ssq;
        }
        __syncthreads();
        {
            const float el = __expf(alast);
            bf16x8_t xf[4];
#pragma unroll
            for (int ks = 0; ks < 4; ++ks) xf[ks] = ldfrag(XdtT, 16 * pt + l15, LD128, 32 * ks + 8 * l4);
#pragma unroll
            for (int i = 0; i < 2; ++i) {
                f32x4 acc = Hacc[i] * el;
#pragma unroll
                for (int ks = 0; ks < 4; ++ks) acc = __builtin_amdgcn_mfma_f32_16x16x32_bf16(xf[ks], ldfrag(BdT, 16 * (ntb + i) + l15, LD128, 32 * ks + 8 * l4), acc, 0, 0, 0);
                Hacc[i] = acc;
#pragma unroll
                for (int r = 0; r < 4; ++r) Hb[(16 * pt + 4 * l4 + r) * LD64 + 16 * (ntb + i) + l15] = f2bf(acc[r]);
            }
        }
    }
    __syncthreads();
}

struct MoeOrder {
    int n; const LAS int* ul;
    __device__ __forceinline__ bool next(int i, pg8::Unit& u) const { if (i >= n) return false; u.pm = ul[2 * i]; u.pn = ul[2 * i + 1]; return true; }
    __device__ __forceinline__ void a_ready(const pg8::Unit&) const {}
    __device__ __forceinline__ void done(const pg8::Unit&) const {}
};
struct EpiSwiGLU {
    static constexpr bool PERM = true, AFTER_DRAIN = false; static constexpr int MID_T = 0;
    bf16* Hid;
    __device__ __forceinline__ void operator()(const pg8::f32x4 (&acc)[2][2][4][2], const pg8::Unit& u, int wr, int wc, int fr, int fq) const {
        const int row0 = u.pm * 256 + wr * 64 + fr, pl = u.pn & 1, hc = 128 * pl + 16 * wc + 4 * fq;
#pragma unroll
        for (int ai = 0; ai < 2; ++ai)
#pragma unroll
            for (int m = 0; m < 4; ++m) { const int row = row0 + ai * 128 + m * 16;
#pragma unroll
                for (int bj = 0; bj < 2; ++bj) { const f32x4 g = acc[ai][bj][m][0], uu = acc[ai][bj][m][1]; f32x4 h;
#pragma unroll
                    for (int e = 0; e < 4; ++e) h[e] = g[e] / (1.f + __expf(-g[e])) * uu[e];
                    u32x2 w; w.x = pg8::cvt_pk_bf16(h[0], h[1]); w.y = pg8::cvt_pk_bf16(h[2], h[3]);
                    *(u32x2*)(Hid + (size_t)row * EFF + hc + 64 * bj) = w; } }
    }
};
struct EpiDown {
    static constexpr bool PERM = true, AFTER_DRAIN = false; static constexpr int MID_T = 0;
    const int* DSTI; const float* WGT; bf16* Y;
    __device__ __forceinline__ void operator()(const pg8::f32x4 (&acc)[2][2][4][2], const pg8::Unit& u, int wr, int wc, int fr, int fq) const {
        const int row0 = u.pm * 256 + wr * 64 + fr, col0 = (u.pn & 3) * 256 + 32 * wc + 8 * fq;
#pragma unroll
        for (int ai = 0; ai < 2; ++ai)
#pragma unroll
            for (int m = 0; m < 4; ++m) { const int row = row0 + ai * 128 + m * 16; const unsigned di = (unsigned)DSTI[row]; const float w = WGT[row];
                bf16* Yr = Y + (size_t)di * DM + col0;
#pragma unroll
                for (int bj = 0; bj < 2; ++bj) { const f32x4 a = acc[ai][bj][m][0] * w, b = acc[ai][bj][m][1] * w;
                    u32x4 o; o.x = pg8::cvt_pk_bf16(a[0], a[1]); o.y = pg8::cvt_pk_bf16(a[2], a[3]); o.z = pg8::cvt_pk_bf16(b[0], b[1]); o.w = pg8::cvt_pk_bf16(b[2], b[3]);
                    *(u32x4*)(Yr + 128 * bj) = o; }
                asm volatile("" ::: "memory"); }
    }
};


__device__ __forceinline__ unsigned wave_select(const unsigned (&keys)[32], int kk, int lane) {
    unsigned T = 0u;
    for (int bit = 31; bit >= 0; --bit) {
        const unsigned cand = T | (1u << bit);
        int c = 0;
#pragma unroll
        for (int i = 0; i < 32; ++i) c += (keys[i] >= cand) ? 1 : 0;
#pragma unroll
        for (int o = 1; o < 64; o <<= 1) c += __shfl_xor(c, o);
        if (c >= kk) T = cand;
    }
    unsigned mgt = 0u, meq = 0u;
#pragma unroll
    for (int i = 0; i < 32; ++i) { mgt |= (keys[i] > T) ? (1u << i) : 0u; meq |= (keys[i] == T) ? (1u << i) : 0u; }
    int ngt = __popc(mgt), neq = __popc(meq);
    int tgt = ngt, teq = neq;
#pragma unroll
    for (int o = 1; o < 64; o <<= 1) { tgt += __shfl_xor(tgt, o); teq += __shfl_xor(teq, o); }
    const int need = kk - tgt;
    if (teq == need) return mgt | meq;
    int pre = neq;
#pragma unroll
    for (int o = 1; o < 64; o <<= 1) { const int v = __shfl_up(pre, o); if (lane >= o) pre += v; }
    pre -= neq;
    unsigned sel = mgt; int taken = pre;
#pragma unroll
    for (int i = 0; i < 32; ++i) { if ((meq >> i) & 1u) { if (taken < need) sel |= (1u << i); ++taken; } }
    return sel;
}

#define XB_TMO      128
#define XB_XCNT(j)  (256  + 64 * (j))
#define XB_XSUB(j)  (1280 + 64 * (j))
#define XB_XGEN(j)  (2304 + 64 * (j))
#define XB_TOP      3328
#define XB_TOPGEN   3392
#define XCD_BAR_WORDS 3456
#define XB_SPIN_CAP (1u << 18)

__device__ __forceinline__ unsigned xb_ld(unsigned* p)              { return __hip_atomic_load(p, __ATOMIC_RELAXED, __HIP_MEMORY_SCOPE_AGENT); }
__device__ __forceinline__ unsigned xb_add(unsigned* p, unsigned v) { return __hip_atomic_fetch_add(p, v, __ATOMIC_RELAXED, __HIP_MEMORY_SCOPE_AGENT); }
__device__ __forceinline__ unsigned xb_xcc_id() { return (unsigned)__builtin_amdgcn_s_getreg((3 << 11) | 20) & 0xFu; }
#define XB_SPIN(cond, bar) do { unsigned _sp = 0; while (cond) { __builtin_amdgcn_s_sleep(1); \
    if ((++_sp & 255u) == 0u) { if (xb_ld(&(bar)[XB_TMO])) break; if (_sp > XB_SPIN_CAP) { atomicAdd(&(bar)[XB_TMO], 1u); break; } } } } while (0)

struct XcdBarrier {
    unsigned* bar; unsigned x;
    volatile LAS unsigned* st;
};

__device__ __forceinline__ XcdBarrier xcd_barrier_post(unsigned* bar, volatile LAS unsigned* st, const int wave_s) {
    XcdBarrier b; b.bar = bar; b.x = xb_xcc_id(); b.st = st;
    if (wave_s == 0 && lane_id() == 0) (void)xb_add(&bar[XB_XCNT(b.x)], 1u);
    return b;
}
__device__ __forceinline__ void xcd_barrier_complete(unsigned* bar, unsigned x, unsigned& nloc, unsigned& nx) {
    const unsigned G = gridDim.x * gridDim.y * gridDim.z;
    unsigned sum, cnt, mine, sp = 0u;
    for (;;) {
        sum = 0u; cnt = 0u; mine = 0u;
#pragma unroll
        for (unsigned j = 0; j < 16; ++j) { const unsigned c = xb_ld(&bar[XB_XCNT(j)]); sum += c; cnt += (c > 0u) ? 1u : 0u; mine = (j == x) ? c : mine; }
        if (sum == G) break;
        __builtin_amdgcn_s_sleep(1);
        if ((++sp & 255u) == 0u) { if (xb_ld(&bar[XB_TMO])) break; if (sp > XB_SPIN_CAP) { atomicAdd(&bar[XB_TMO], 1u); break; } }
    }
    nloc = mine > 0u ? mine : 1u; nx = cnt > 0u ? cnt : 1u;
}

__device__ __forceinline__ void xcd_barrier(const XcdBarrier& b, const int wave_s) {
    asm volatile("s_waitcnt vmcnt(0)" ::: "memory");
    __syncthreads();
    if (wave_s == 0 && lane_id() == 0) {
        unsigned* bar = b.bar;
        __builtin_amdgcn_s_waitcnt(0);
        unsigned nloc = b.st[0], nx = b.st[1];
        if (nloc == 0u) { xcd_barrier_complete(bar, b.x, nloc, nx); b.st[0] = nloc; b.st[1] = nx; }
        const unsigned old = xb_add(&bar[XB_XSUB(b.x)], 1u);
        const unsigned gen = old / nloc;
        if (old + 1u == (gen + 1u) * nloc) {
            __builtin_amdgcn_fence(__ATOMIC_RELEASE, "agent");
            asm volatile("s_waitcnt vmcnt(0)" ::: "memory");
            const unsigned og = xb_add(&bar[XB_TOP], 1u);
            const unsigned tg = og / nx;
            if (og + 1u == (tg + 1u) * nx) xb_add(&bar[XB_TOPGEN], 1u);
            else XB_SPIN(xb_ld(&bar[XB_TOPGEN]) == tg, bar);
            __builtin_amdgcn_fence(__ATOMIC_ACQUIRE, "agent");
            xb_add(&bar[XB_XGEN(b.x)], 1u);
            asm volatile("s_waitcnt vmcnt(0)" ::: "memory");
        } else {
            XB_SPIN(xb_ld(&bar[XB_XGEN(b.x)]) == gen, bar);
            __builtin_amdgcn_fence(__ATOMIC_ACQUIRE, "agent");
            asm volatile("s_waitcnt vmcnt(0)" ::: "memory");
        }
    }
    __syncthreads();
}


#define PHASE_VARS const KPtr P = launder_k(KP0); const int wave = wave_s, lane = launder_i(lane_id()), tid = wave * 64 + lane, gw = bid * 8 + wave; unsigned char* ws = P->ws; unsigned* ctl = (unsigned*)(ws + WS_CTL); float2* rope = (float2*)(ws + WS_ROPE); float* tokw = (float*)(ws + WS_TOKW); int* lists = (int*)(ws + WS_LISTS); bf16* Qb = (bf16*)(ws + WS_Q); bf16* Kb = (bf16*)(ws + WS_K); bf16* Vb = (bf16*)(ws + WS_V); bf16* IKb = (bf16*)(ws + WS_IK); float* IW = (float*)(ws + WS_IW); float* DT = (float*)(ws + WS_DT); bf16* IQb = (bf16*)(ws + WS_IQ); bf16* Zb = (bf16*)(ws + WS_Z); bf16* XBC = (bf16*)(ws + WS_XBC); bf16* ASb = (bf16*)(ws + WS_AS); float* X1 = (float*)(ws + WS_X1); bf16* X1b = (bf16*)(ws + WS_X1B); bf16* Y0 = (bf16*)(ws + WS_Y0); bf16* Y1 = (bf16*)(ws + WS_Y1); float* SSQP = (float*)(ws + WS_SSQP); bf16* WguT = (bf16*)(ws + WS_WGU_T); bf16* WdT = (bf16*)(ws + WS_WD_T); int* ENT = (int*)(ws + WS_ENT); float* WGT = (float*)(ws + WS_ENT + 512 * 1024); int* ROWT = (int*)(ws + WS_ENT + 1024 * 1024); bf16* Xs = (bf16*)(ws + WS_XS); bf16* Hid = (bf16*)(ws + WS_HID); bf16* XB = (bf16*)(ws + WS_XB); bf16* WinT = (bf16*)(ws + WS_WIN_T); bf16* WoutT = (bf16*)(ws + WS_WOUT_T);
#ifndef PROBE_MASK
#define PROBE_MASK 0
#endif
#define STAMP(k) do { if (PROBE_MASK && bid == 0 && wave_s == 0 && lane_id() == 0) { const unsigned long long now_ = __builtin_amdgcn_s_memrealtime(); if ((PROBE_MASK >> (k)) & 1) pst[1] += now_ - pst[0]; pst[0] = now_; } } while (0)
__global__ void __launch_bounds__(NT, 2) hybrid_fwd(Params p) {
    extern __shared__ __attribute__((aligned(16))) unsigned char lds[];
    cg::grid_group grid = cg::this_grid();
    const int wave_s = __builtin_amdgcn_readfirstlane((int)threadIdx.x >> 6);
    const int G = gridDim.x, bid = blockIdx.x, NGW = G * 8;
    const KPtr KP0 = (KPtr)__builtin_amdgcn_kernarg_segment_ptr();
    volatile LAS unsigned* xst = (volatile LAS unsigned*)((LAS unsigned char*)lds + LDS_BYTES - 32);
    if (wave_s == 0 && lane_id() < 4) xst[lane_id()] = 0u;
    __syncthreads();
    const XcdBarrier xbar = xcd_barrier_post((unsigned*)(KP0->ws + WS_CTL) + CW_BAR, xst, wave_s);
    if (KP0->ws == nullptr) grid.sync();
#define GRID_SYNC() xcd_barrier(xbar, wave_s)
    volatile LAS unsigned long long* pst = (volatile LAS unsigned long long*)((LAS unsigned char*)lds + LDS_BYTES - 96);
    if (PROBE_MASK && bid == 0 && wave_s == 0 && lane_id() == 0) { pst[0] = __builtin_amdgcn_s_memrealtime(); pst[1] = 0ull; }
    {   PHASE_VARS
    for (int e = bid * NT + tid; e < SEQ * 32; e += G * NT) {
        const int t = e >> 5, i = e & 31;
        const float inv = powf(10000.0f, -(float)(2 * i) / 64.0f);
        const float ang = (float)t * inv;
        float s, c; sincosf(ang, &s, &c);
        rope[e] = make_float2(c, s);
    }
    for (int e = bid * NT + tid; e < 52 * 128; e += G * NT) {
        const int r = e >> 7, c = e & 127; const int row = (r < 4) ? (512 + 196 + r) : (512 + 208 + (r - 4));
        *(u32x4*)(WinT + (size_t)row * DM + c * 8) = (u32x4){0u, 0u, 0u, 0u};
    }
    {
        LAS float* scr = (LAS float*)((LAS unsigned char*)lds + wave * 16384);
        constexpr int I_IN = (DM / 64) * ((INW + 31) / 32), I_OUT = (DM / 64) * (DM / 32), I_GU = NEXP * 2 * 128, I_D = NEXP * 128;
        for (int it = launder_i(gw); it < I_IN; it += NGW) {
            int r = it;
            if (r < I_IN) { transpose_item(P->w_in, DM, INW, WinT, scr, r, lane, [](int c) { return win_dest_row(c); }, [](int k, float&) { return k; }); continue; } r -= I_IN;
        }
    }
    if (wave == 0 && bid >= G - 20) {
        float* rc = (float*)(ws + WS_RCONST); const int j = G - 1 - bid;
        float wv[16], gv[16], bv[16];
#pragma unroll
        for (int i = 0; i < 16; ++i) { const int k = lane + 64 * i; wv[i] = (j < 4) ? P->w_rg[k * 4 + j] : P->w_re[k * 16 + (j - 4)]; gv[i] = P->ln1_g[k]; bv[i] = P->ln1_b[k]; }
        float gs = 0.f, bs = 0.f;
#pragma unroll
        for (int i = 0; i < 16; ++i) { gs = fmaf(gv[i], wv[i], gs); bs = fmaf(bv[i], wv[i], bs); }
        gs = wave_sum(gs); bs = wave_sum(bs);
        if (lane == 0) { rc[j] = gs; rc[20 + j] = bs + ((j < 4) ? P->b_rg[j] : P->b_re[j - 4]); }
    }
    {
        const size_t NP = (size_t)M * DM / 8, stride = (size_t)G * NT;
        for (size_t e0 = (size_t)bid * NT + tid; e0 < NP; e0 += 4 * stride) {
            f32x4 a[4], b[4];
#pragma unroll
            for (int u = 0; u < 4; ++u) { const size_t e = e0 + u * stride; if (e < NP) { a[u] = *(const f32x4*)(P->x + e * 8); b[u] = *(const f32x4*)(P->x + e * 8 + 4); } }
#pragma unroll
            for (int u = 0; u < 4; ++u) { const size_t e = e0 + u * stride; if (e < NP) {
                u32x4 w; w.x = pg8::cvt_pk_bf16(a[u][0], a[u][1]); w.y = pg8::cvt_pk_bf16(a[u][2], a[u][3]); w.z = pg8::cvt_pk_bf16(b[u][0], b[u][1]); w.w = pg8::cvt_pk_bf16(b[u][2], b[u][3]);
                *(u32x4*)(XB + e * 8) = w; } }
        }
    }
    }
    GRID_SYNC(); STAMP(0);
    {   PHASE_VARS
    {
        pg8::Gemm g{XB, WinT, M, NPAD, DM}; pg8::StaticOrder S; S.init(M, NPAD, G, bid);
        EpiInProj E{Qb, Kb, Vb, IKb, IQb, Zb, XBC, IW, DT, rope};
        pg8::gemm_phase<EpiInProj, pg8::StaticOrder, true, true>((PG8_LAS unsigned char*)lds, g, S, E, wave_s);
    }
    {
        LAS float* scr = (LAS float*)((LAS unsigned char*)lds + wave * 16384);
        constexpr int I_OUT = (DM / 64) * (DM / 32), I_GU = NEXP * 2 * 128, I_D = NEXP * 128, I_ALL = I_OUT + I_GU + I_D;
        for (;;) {
            int base = 0; if (lane == 0) base = (int)atomicAdd(&ctl[CW_WQ], 8u);
            base = __builtin_amdgcn_readfirstlane(base); if (base >= I_ALL) break;
            for (int it = base; it < base + 8 && it < I_ALL; ++it) {
                int r = it;
                if (r < I_OUT) { { const float* nw = P->ssd_norm_w; transpose_item(P->w_out, DM, DM, WoutT, scr, r, lane, [](int c) { return c; }, [nw](int k, float& sc) { if (k < 512) { sc = nw[k]; return k + 512; } return k - 512; }); } continue; } r -= I_OUT;
                if (r < I_GU) { const int e = r >> 8, up = (r >> 7) & 1, sub = r & 127; const float* W = (up ? P->w_up : P->w_gate) + (size_t)e * DM * EFF;
                transpose_item(W, DM, EFF, WguT + (size_t)e * 512 * DM, scr, sub, lane, [up](int c) { return 8 * (c >> 2) + 4 * up + (c & 3); }, [](int k, float&) { return k; }); continue; } r -= I_GU;
                { const int e = r >> 7, sub = r & 127; transpose_item(P->w_down + (size_t)e * EFF * DM, EFF, DM, WdT + (size_t)e * DM * EFF, scr, sub, lane, [](int c) { return c; }, [](int k, float&) { return k; }); }
            }
        }
    }
    }
    GRID_SYNC(); STAMP(1);
    {   PHASE_VARS
    for (int item = bid; item < BATCH * 8; item += G) ssd_item(__builtin_amdgcn_readfirstlane(item >> 3), __builtin_amdgcn_readfirstlane(item & 7), P, XBC, DT, Zb, ASb, SSQP, lds, tid);
    {
        volatile int* qslot = (volatile int*)(lds + LDS_BYTES - 64);
        const unsigned xcc = (unsigned)__builtin_amdgcn_s_getreg((3 << 11) | 20) & 7u;
        for (;;) {
            __syncthreads();
            if (tid == 0) { int pi = -1;
                for (unsigned a = 0; a < 8 && pi < 0; ++a) { const unsigned q = (xcc + a) & 7u; const unsigned idx = atomicAdd(&ctl[CW_DSAQ + 16 * q], 1u); if (idx < 128u) pi = (int)(q * 128u + idx); }
                *qslot = pi; }
            __syncthreads();
            const int pi = __builtin_amdgcn_readfirstlane(*qslot); if (pi < 0) break;
            const int q = pi >> 7, idx = pi & 127, b = q + 8 * (idx & 1), qb = 63 - (idx >> 1);
            dsa_select(b, qb, IQb, IKb, IW, lds, lane, wave_s, &ctl[CW_ERR]);
            attn_body::attn_unit<8>(b, qb, Qb, Kb, Vb, ASb, (char*)lds, (const char*)lds + DSA_MASK_OFF, wave_s);
        }
    }
    }
    GRID_SYNC(); STAMP(2);
    {   PHASE_VARS
    {
        pg8::Gemm g{ASb, WoutT, M, DM, DM}; pg8::StaticOrder S; S.init(M, DM, G, bid);
        EpiH1 E{P->x, X1, SSQP};
        pg8::gemm_phase<EpiH1, pg8::StaticOrder, true, true>((PG8_LAS unsigned char*)lds, g, S, E, wave_s);
    }
    }
    GRID_SYNC(); STAMP(4);
    {   PHASE_VARS
    {
        float* Wg = (float*)lds;
        int* lcnt = (int*)(lds + 81920); int* lbase = lcnt + 16; int* rec = lbase + 16;
        float* recw = (float*)(rec + 4 * 128);
        float* rlg = recw + 2 * 128;
        float* rstat = rlg + 20 * 128;
        for (int e = tid; e < DM * 20; e += NT) { const int k = e / 20, j = e - k * 20; Wg[e] = P->ln1_g[k] * ((j < 4) ? P->w_rg[k * 4 + j] : P->w_re[k * 16 + (j - 4)]); }
        if (tid < 16) lcnt[tid] = 0;
        __syncthreads();
        const int rows_per_wave = M / NGW;
        const int l15 = lane & 15, ph = lane >> 4;
        {
            const float* hr = X1 + (size_t)(gw + NGW * l15) * DM + 4 * ph;
            const float* wb0 = Wg + (4 * ph) * 20 + l15; const float* wb1 = Wg + (4 * ph) * 20 + 16 + (l15 < 4 ? l15 : 3);
            f32x4 c0 = (f32x4){0.f, 0.f, 0.f, 0.f}, c1 = c0; float s = 0.f, ss = 0.f;
#pragma unroll 1
            for (int i0 = 0; i0 < 64; i0 += 8) {
                f32x4 a[8];
#pragma unroll
                for (int u = 0; u < 8; ++u) a[u] = *(const f32x4*)(hr + 16 * (i0 + u));
#pragma unroll
                for (int u = 0; u < 8; ++u) {
                    s += (a[u][0] + a[u][1]) + (a[u][2] + a[u][3]); ss += (a[u][0] * a[u][0] + a[u][1] * a[u][1]) + (a[u][2] * a[u][2] + a[u][3] * a[u][3]);
#pragma unroll
                    for (int e = 0; e < 4; ++e) { const int ko = (16 * (i0 + u) + e) * 20;
                        c0 = __builtin_amdgcn_mfma_f32_16x16x4f32(a[u][e], wb0[ko], c0, 0, 0, 0);
                        c1 = __builtin_amdgcn_mfma_f32_16x16x4f32(a[u][e], wb1[ko], c1, 0, 0, 0); }
                }
            }
            { const int ln2 = launder_i(lane); const int i16 = (ln2 ^ 16) << 2, i32 = (ln2 ^ 32) << 2;
              s += __builtin_bit_cast(float, __builtin_amdgcn_ds_bpermute(i16, __builtin_bit_cast(int, s))); s += __builtin_bit_cast(float, __builtin_amdgcn_ds_bpermute(i32, __builtin_bit_cast(int, s)));
              ss += __builtin_bit_cast(float, __builtin_amdgcn_ds_bpermute(i16, __builtin_bit_cast(int, ss))); ss += __builtin_bit_cast(float, __builtin_amdgcn_ds_bpermute(i32, __builtin_bit_cast(int, ss))); }
            const float mean = s * (1.f / DM), var = ss * (1.f / DM) - mean * mean;
            if (ph == 0) { rstat[(wave * 16 + l15) * 2] = mean; rstat[(wave * 16 + l15) * 2 + 1] = rsqrtf(var + LN_EPS); }
#pragma unroll
            for (int r = 0; r < 4; ++r) { const int rl = wave * 16 + 4 * ph + r; rlg[rl * 20 + l15] = c0[r]; if (l15 < 4) rlg[rl * 20 + 16 + l15] = c1[r]; }
        }
        __syncthreads();
        for (int it = 0; it < rows_per_wave; ++it) {
            const int row = gw + NGW * it; const float mean = rstat[(wave * 16 + it) * 2], rstd = rstat[(wave * 16 + it) * 2 + 1];
            const float* xr = X1 + (size_t)row * DM;
#pragma unroll
            for (int j = 0; j < 4; ++j) { const int c0 = lane * 4 + 256 * j; const f32x4 v = *(const f32x4*)(xr + c0), gg = *(const f32x4*)(P->ln1_g + c0), bb = *(const f32x4*)(P->ln1_b + c0);
                const f32x4 o = (v - mean) * rstd * gg + bb; u32x2 w; w.x = pg8::cvt_pk_bf16(o[0], o[1]); w.y = pg8::cvt_pk_bf16(o[2], o[3]);
                *(u32x2*)(X1b + (size_t)row * DM + c0) = w; }
        }
        const float* rc = (const float*)(ws + WS_RCONST);
        for (int rl = tid; rl < 8 * rows_per_wave; rl += NT) {
            const float mean = rstat[rl * 2], rstd = rstat[rl * 2 + 1];
            float lg[20];
#pragma unroll
            for (int j = 0; j < 20; ++j) lg[j] = rstd * (rlg[rl * 20 + j] - mean * rc[j]) + rc[20 + j];
            int gi = 0; float gm = lg[0];
#pragma unroll
            for (int i = 1; i < 4; ++i) if (lg[i] > gm) { gm = lg[i]; gi = i; }
            float gs = 0.f;
#pragma unroll
            for (int i = 0; i < 4; ++i) gs += __expf(lg[i] - gm);
            const float gprob = 1.f / gs;
            float el[4];
#pragma unroll
            for (int i = 0; i < 4; ++i) { float v0 = 0.f;
#pragma unroll
                for (int g2 = 0; g2 < 4; ++g2) if (g2 == gi) v0 = lg[4 + g2 * 4 + i];
                el[i] = v0; }
            int i0 = 0; float m0 = el[0];
#pragma unroll
            for (int i = 1; i < 4; ++i) if (el[i] > m0) { m0 = el[i]; i0 = i; }
            int i1 = -1; float m1 = -INFINITY;
#pragma unroll
            for (int i = 0; i < 4; ++i) if (i != i0 && el[i] > m1) { m1 = el[i]; i1 = i; }
            const float e1 = __expf(m1 - m0), inv = 1.f / (1.f + e1);
            const int ex0 = gi * 4 + i0, ex1 = gi * 4 + i1;
            rec[rl * 4 + 0] = ex0; rec[rl * 4 + 1] = atomicAdd(&lcnt[ex0], 1); rec[rl * 4 + 2] = ex1; rec[rl * 4 + 3] = atomicAdd(&lcnt[ex1], 1);
            recw[rl * 2] = inv * gprob; recw[rl * 2 + 1] = e1 * inv * gprob;
        }
        __syncthreads();
        if (tid < 16) lbase[tid] = (int)atomicAdd(&ctl[CW_CNT + 64 * tid], (unsigned)lcnt[tid]);
        __syncthreads();
        for (int rl = tid; rl < 8 * rows_per_wave; rl += NT) {
            const int row = (bid * 8 + rl / rows_per_wave) + NGW * (rl % rows_per_wave);
            const int e0 = rec[rl * 4], e1x = rec[rl * 4 + 2];
            lists[(size_t)e0 * M + lbase[e0] + rec[rl * 4 + 1]] = row * 2; lists[(size_t)e1x * M + lbase[e1x] + rec[rl * 4 + 3]] = row * 2 + 1;
            tokw[row * 2] = recw[rl * 2]; tokw[row * 2 + 1] = recw[rl * 2 + 1];
        }
    }
    }
    GRID_SYNC(); STAMP(5);
    {   PHASE_VARS
    int* tb = (int*)(lds + 135168);
    if (tid < NEXP) tb[32 + tid] = (int)((__hip_atomic_load(&ctl[CW_CNT + 64 * tid], __ATOMIC_RELAXED, __HIP_MEMORY_SCOPE_AGENT) + 255u) >> 8);
    __syncthreads();
    if (tid == 0) { int a = 0; for (int e = 0; e < NEXP; ++e) { tb[e] = a; a += tb[32 + e]; } tb[NEXP] = a; }
    __syncthreads();
    const int ntiles = tb[NEXP];
    for (int sr = bid * NT + tid; sr < ntiles * 256; sr += G * NT) {
        const int rt = sr >> 8; int e = 0;
#pragma unroll
        for (int j = 1; j < NEXP; ++j) if (rt >= tb[j]) e = j;
        const int slot = sr - tb[e] * 256; const int cnt_e = (int)__hip_atomic_load(&ctl[CW_CNT + 64 * e], __ATOMIC_RELAXED, __HIP_MEMORY_SCOPE_AGENT);
        const int en = (slot < cnt_e) ? lists[(size_t)e * M + slot] : -1;
        ENT[sr] = (en >= 0) ? ((en & 1) * M + (en >> 1)) : 2 * M; WGT[sr] = (en >= 0) ? tokw[en] : 0.f; ROWT[sr] = (en >= 0) ? (en >> 1) : 0;
    }
    }
    GRID_SYNC(); STAMP(6);
    {   PHASE_VARS
    const LAS int* tb = (const LAS int*)((LAS unsigned char*)lds + 135168); const int ntiles = tb[NEXP];
    {
        LAS int* ul = (LAS int*)((LAS unsigned char*)lds + 135168 + 128); int n = 0;
        if (tid == 0) { for (int L = bid; L < ntiles * 2; L += G) { const int rt = L >> 1; int e = 0; for (int j = 1; j < NEXP; ++j) if (rt >= tb[j]) e = j; ul[2 * n] = rt; ul[2 * n + 1] = e * 2 + (L & 1); ++n; } ul[62] = n; }
        __syncthreads(); n = ul[62];
        LAS int* rtl = (LAS int*)((LAS unsigned char*)lds + 135168 + 512);
        for (int e = tid; e < n * 256; e += NT) rtl[e] = ROWT[ul[2 * (e >> 8)] * 256 + (e & 255)];
        __syncthreads();
        pg8::Gemm g{X1b, WguT, MAXROWS, 512, DM}; MoeOrder S{n, ul};
        EpiSwiGLU E{Hid};
        pg8::gemm_phase<EpiSwiGLU, MoeOrder, true, true, true>((PG8_LAS unsigned char*)lds, g, S, E, wave_s, rtl);
    }
    }
    GRID_SYNC(); STAMP(7);
    {   PHASE_VARS
    const LAS int* tb = (const LAS int*)((LAS unsigned char*)lds + 135168); const int ntiles = tb[NEXP];
    {
        LAS int* ul = (LAS int*)((LAS unsigned char*)lds + 135168 + 128); int n = 0;
        __syncthreads();
        if (tid == 0) { for (int L = bid; L < ntiles * 4; L += G) { const int rt = L >> 2; int e = 0; for (int j = 1; j < NEXP; ++j) if (rt >= tb[j]) e = j; ul[2 * n] = rt; ul[2 * n + 1] = e * 4 + (L & 3); ++n; } ul[62] = n; }
        __syncthreads(); n = ul[62];
        pg8::Gemm g{Hid, WdT, MAXROWS, DM, EFF}; MoeOrder S{n, ul};
        EpiDown E{ENT, WGT, Y0};
        pg8::gemm_phase<EpiDown, MoeOrder, true, true>((PG8_LAS unsigned char*)lds, g, S, E, wave_s);
    }
    }
    GRID_SYNC(); STAMP(8);
    {   PHASE_VARS
    const bool poison = __hip_atomic_load(&ctl[CW_ERR], __ATOMIC_RELAXED, __HIP_MEMORY_SCOPE_AGENT) != 0u; const float qnan = __builtin_nanf("");
    for (int row = launder_i(gw); row < M; row += NGW) {
        f32x4 v[4]; float s = 0.f;
#pragma unroll
        for (int j = 0; j < 4; ++j) { const int c0 = lane * 4 + 256 * j; const u32x2 xb = *(const u32x2*)(X1b + (size_t)row * DM + c0);
            v[j][0] = __uint_as_float(xb.x << 16) * ALPHA; v[j][1] = __uint_as_float(xb.x & 0xffff0000u) * ALPHA; v[j][2] = __uint_as_float(xb.y << 16) * ALPHA; v[j][3] = __uint_as_float(xb.y & 0xffff0000u) * ALPHA;
            const u32x2 a = *(const u32x2*)(Y0 + (size_t)row * DM + c0), b = *(const u32x2*)(Y1 + (size_t)row * DM + c0);
            v[j][0] += __uint_as_float(a.x << 16) + __uint_as_float(b.x << 16); v[j][1] += __uint_as_float(a.x & 0xffff0000u) + __uint_as_float(b.x & 0xffff0000u);
            v[j][2] += __uint_as_float(a.y << 16) + __uint_as_float(b.y << 16); v[j][3] += __uint_as_float(a.y & 0xffff0000u) + __uint_as_float(b.y & 0xffff0000u);
            s += (v[j][0] + v[j][1]) + (v[j][2] + v[j][3]); }
        const float mean = wave_sum(s) * (1.f / DM); float s2 = 0.f;
#pragma unroll
        for (int j = 0; j < 4; ++j) { v[j] = v[j] - mean; s2 += (v[j][0] * v[j][0] + v[j][1] * v[j][1]) + (v[j][2] * v[j][2] + v[j][3] * v[j][3]); }
        const float rstd = rsqrtf(wave_sum(s2) * (1.f / DM) + LN_EPS);
#pragma unroll
        for (int j = 0; j < 4; ++j) { const int c0 = lane * 4 + 256 * j;
            const f32x4 gg = *(const f32x4*)(P->ln2_g + c0), bb = *(const f32x4*)(P->ln2_b + c0);
            f32x4 o = v[j] * rstd * gg + bb; if (poison) o = (f32x4){qnan, qnan, qnan, qnan};
            *(f32x4*)(P->out + (size_t)row * DM + c0) = o; }
    }
    }
    STAMP(9);
    if (PROBE_MASK && bid == 0 && wave_s == 0 && lane_id() == 0) { const unsigned long long t0 = __builtin_amdgcn_s_memrealtime(), d = 8ull * pst[1]; while (__builtin_amdgcn_s_memrealtime() - t0 < d) __builtin_amdgcn_s_sleep(8); }
}

extern "C" void kernel_launch(void* const* d_in, const int* in_sizes, int n_in, void* d_out, int out_size, void* d_ws, size_t ws_size, hipStream_t stream) {
    static int grid = 0;
    if (grid == 0) {
        if (n_in != 20 || in_sizes[0] != M * DM || out_size != M * DM || ws_size < WS_END) { fprintf(stderr, "kernel_launch: unexpected shapes (n_in %d, in0 %d, out %d, ws %zu)\n", n_in, n_in > 0 ? in_sizes[0] : -1, out_size, ws_size); grid = -1; return; }
        int dev = 0, cus = 0, per_cu = 0;
        (void)hipGetDevice(&dev);
        (void)hipDeviceGetAttribute(&cus, hipDeviceAttributeMultiprocessorCount, dev);
        (void)hipFuncSetAttribute((const void*)hybrid_fwd, hipFuncAttributeMaxDynamicSharedMemorySize, LDS_BYTES);
        (void)hipOccupancyMaxActiveBlocksPerMultiprocessor(&per_cu, (const void*)hybrid_fwd, NT, LDS_BYTES);
        if (per_cu < 1) { fprintf(stderr, "kernel_launch: occupancy query says %d blocks/CU\n", per_cu); grid = -1; return; }
        grid = cus;
    }
    if (grid < 0) return;
    (void)hipMemsetAsync((char*)d_ws + WS_CTL, 0, CTL_BYTES, stream);
    Params p{};
    const float** f = (const float**)&p;
    for (int i = 0; i < 20; ++i) f[i] = (const float*)d_in[i];
    p.out = (float*)d_out; p.ws = (unsigned char*)d_ws;
    void* args[] = {&p};
    hipError_t e = hipLaunchCooperativeKernel((const void*)hybrid_fwd, dim3(grid), dim3(NT), args, LDS_BYTES, stream);
    if (e != hipSuccess) fprintf(stderr, "cooperative launch failed: %s (grid %d)\n", hipGetErrorString(e), grid);
}
```

```cpp
#include <hip/hip_runtime.h>
#include <hip/hip_cooperative_groups.h>
#include <cstdio>
#include <cstdint>
namespace cg = cooperative_groups;

constexpr int BATCH = 16, SEQ = 2048, DM = 1024, M = BATCH * SEQ;
constexpr int INW = 2252;
constexpr int C_Q = 0, C_K = 512, C_V = 576, C_IQ = 640, C_IK = 896, C_IW = 960, C_Z = 964, C_XBC = 1476, C_DT = 2244;
constexpr int NEXP = 16, EFF = 256;
constexpr float LN_EPS = 1e-5f;
constexpr float ALPHA = 1.189207115002721f;
constexpr float INDEXER_SCALE = 0.0625f;
constexpr float QSCALE = 0.125f * 1.4426950408889634f;
constexpr int TOPK = 256;
constexpr int NT = 512;
constexpr int LDS_BYTES = 147456;

constexpr size_t MiB = 1u << 20;
constexpr size_t WS_CTL = 0, CTL_BYTES = 1 * MiB;
constexpr size_t WS_ROPE = 1 * MiB;
constexpr size_t WS_TOKW = 2 * MiB;
constexpr size_t WS_LISTS = 3 * MiB;
constexpr size_t WS_WIN_T = 8 * MiB;
constexpr size_t WS_WOUT_T = 16 * MiB;
constexpr size_t WS_WGU_T = 18 * MiB;
constexpr size_t WS_WD_T = 34 * MiB;
constexpr size_t WS_RCONST = 7 * MiB;
constexpr size_t WS_ENT = 5 * MiB;
constexpr size_t WS_XS = 48 * MiB;
constexpr size_t WS_HID = 192 * MiB;
constexpr int MAXTILES = 272, MAXROWS = MAXTILES * 256;
constexpr size_t WS_XB = 256 * MiB;
constexpr int NPAD = 2304;
constexpr size_t WS_Q = 48 * MiB;
constexpr size_t WS_K = 80 * MiB, WS_V = 84 * MiB, WS_IK = 88 * MiB;
constexpr size_t WS_IW = 92 * MiB;
constexpr size_t WS_DT = 93 * MiB;
constexpr size_t WS_IQ = 96 * MiB;
constexpr size_t WS_Z = 112 * MiB;
constexpr size_t WS_XBC = 144 * MiB;
constexpr size_t WS_AS = 192 * MiB;
constexpr size_t WS_X1 = 256 * MiB;
constexpr size_t WS_X1B = 384 * MiB;
constexpr size_t WS_Y0 = 48 * MiB, WS_Y1 = 112 * MiB;
constexpr size_t WS_P32 = 224 * MiB;
constexpr size_t WS_XC = 256 * MiB;
constexpr size_t WS_SSQP = 42 * MiB;
constexpr size_t WS_END = 512 * MiB;
constexpr int CW_CNT = 8192;
constexpr int CW_BAR = 4096;
constexpr int CW_ERR = 32;
constexpr int CW_WQ = 48;
constexpr int CW_DSAQ = 128;

typedef unsigned short bf16;
typedef float f32x4 __attribute__((ext_vector_type(4)));
typedef unsigned u32x4 __attribute__((ext_vector_type(4)));
typedef unsigned u32x2 __attribute__((ext_vector_type(2)));

struct Params {
    const float* x; const float* w_in; const float* conv_w; const float* conv_b; const float* dt_bias; const float* a_log; const float* d_skip;
    const float* ssd_norm_w; const float* w_out; const float* ln1_g; const float* ln1_b; const float* w_rg; const float* b_rg; const float* w_re; const float* b_re;
    const float* w_gate; const float* w_up; const float* w_down; const float* ln2_g; const float* ln2_b;
    float* out; unsigned char* ws;
};

__device__ __forceinline__ int launder_i(int v);
__device__ __forceinline__ int lane_id() { unsigned m = ~0u; asm volatile("" : "+s"(m)); return (int)__builtin_amdgcn_mbcnt_hi(m, __builtin_amdgcn_mbcnt_lo(m, 0u)); }
typedef const __attribute__((address_space(4))) Params* KPtr;
__device__ __forceinline__ KPtr launder_k(KPtr k) { asm volatile("" : "+s"(k)); return k; }
__device__ __forceinline__ float bf2f(bf16 v) { return __uint_as_float((unsigned)v << 16); }
__device__ __forceinline__ bf16 f2bf(float f) { unsigned u = __float_as_uint(f); return (bf16)((u + 0x7fffu + ((u >> 16) & 1u)) >> 16); }
__device__ __forceinline__ float silu(float v) { return v * __builtin_amdgcn_rcpf(1.f + __expf(-v)); }
__device__ __forceinline__ float wave_sum(float v) {
#define WS_DPP(ctrl, rm, bc) v += __int_as_float(__builtin_amdgcn_update_dpp(0, __float_as_int(v), ctrl, rm, 0xf, bc))
    WS_DPP(0xB1, 0xf, true); WS_DPP(0x4E, 0xf, true); WS_DPP(0x114, 0xf, true); WS_DPP(0x118, 0xf, true); WS_DPP(0x142, 0xa, false); WS_DPP(0x143, 0xc, false);
#undef WS_DPP
    return __int_as_float(__builtin_amdgcn_readlane(__float_as_int(v), 63));
}
__device__ __forceinline__ float wave_max(float v) {
#pragma unroll
    for (int o = 1; o < 64; o <<= 1) v = fmaxf(v, __shfl_xor(v, o));
    return v;
}
__device__ __forceinline__ int launder_i(int v) { asm volatile("" : "+v"(v)); return v; }
__device__ __forceinline__ unsigned sortkey(float f) { unsigned u = __float_as_uint(f); return (u & 0x80000000u) ? ~u : (u | 0x80000000u); }

namespace pg8 {
#define PG8_LAS __attribute__((address_space(3)))
typedef unsigned short bf16_t;
typedef short bf16x8 __attribute__((ext_vector_type(8)));
typedef float f32x4 __attribute__((ext_vector_type(4)));
typedef unsigned u32x4 __attribute__((ext_vector_type(4)));
constexpr int BM = 256, BK = 64, HALF = 128, HTB = HALF * BK * 2  , STAGE_BYTES = 8 * HTB, NXCD = 8, WGM = 8;

__host__ __device__ __forceinline__ int lds_byte(int r, int c) { const int st = (r >> 4) * 2 + (c >> 5), rr = r & 15, cc = c & 31, ob = rr * 64 + cc * 2; return st * 1024 + (ob ^ (((ob >> 9) & 1) << 5)); }
__host__ __device__ __forceinline__ void stage_rc(int b, int& R, int& C) { const int st = b / 1024, sb = b % 1024, swz = sb ^ (((sb >> 9) & 1) << 5); R = (st >> 1) * 16 + swz / 64; C = (st & 1) * 32 + (swz % 64) / 2; }
__host__ __device__ __forceinline__ int perm32(int rho) { const int n = rho >> 4, i = rho & 15; return 8 * (i >> 2) + 4 * n + (i & 3); }

struct Unit { int pm, pn; };
struct Gemm { const bf16_t* A; const bf16_t* Bt; int M, N, K; };

struct StaticOrder {
    int nM, nN, nwg, G, c;
    __host__ __device__ void init(int M, int N, int G_, int c_) { nM = M / BM; nN = N / BM; nwg = nM * nN; G = G_; c = c_; }
    __host__ __device__ bool next(int i, Unit& u) const {
        const long L = (long)i * G + c; if (L >= nwg) return false;
        int wgid = (int)L; { const int q = nwg / NXCD, r = nwg % NXCD, xcd = wgid % NXCD, off = wgid / NXCD; wgid = (xcd < r ? xcd * (q + 1) : r * (q + 1) + (xcd - r) * q) + off; }
        const int nig = WGM * nN, gid = wgid / nig, fm = gid * WGM, gsz = (nM - fm) < WGM ? (nM - fm) : WGM;
        u.pm = fm + ((wgid % nig) % gsz); u.pn = (wgid % nig) / gsz; return true;
    }
    __device__ __forceinline__ void a_ready(const Unit&) const {}
    __device__ __forceinline__ void done(const Unit&) const {}
};

__device__ __forceinline__ unsigned cvt_pk_bf16(float lo, float hi) { unsigned r; asm volatile("v_cvt_pk_bf16_f32 %0, %1, %2" : "=v"(r) : "v"(lo), "v"(hi)); return r; }
template <class Epi, class Sched, bool ALIGN_EPI = false, bool SP2 = false, bool GATHER = false>
__device__ __forceinline__ void gemm_phase(PG8_LAS unsigned char* lds, const Gemm g, const Sched& S, const Epi& E, const int wave_s, const PG8_LAS int* rtl = nullptr) {
    int tid_l = wave_s * 64 + lane_id(); asm volatile("" : "+v"(tid_l));
    const int tid = tid_l, wid = wave_s, lane = tid & 63, wr = wid >> 2, wc = wid & 3, fr = lane & 15, fq = lane >> 4;
    const int K = g.K, nt = K / BK;
    unsigned voffA[2], voffB[2];
#pragma unroll
    for (int i = 0; i < 2; ++i) { int R, C; stage_rc(tid * 16 + i * 8192, R, C); const int Rb = Epi::PERM ? ((R & ~31) + perm32(R & 31)) : R;
        voffA[i] = (unsigned)(R * K + C) * 2u; voffB[i] = (unsigned)(Rb * K + C) * 2u; }
    const size_t kstep = (size_t)(BK * 2);
    const size_t hstepB = (size_t)HALF * K * 2;
    const size_t tstep = 2 * hstepB;
    const size_t hstep = GATHER ? 0 : hstepB, tstepA = GATHER ? 0 : tstep;
    int rowA[2]; { int R, C; stage_rc(tid * 16, R, C); rowA[0] = R; stage_rc(tid * 16 + 8192, R, C); rowA[1] = R; }
    unsigned voffGc[2][2], voffGn[2][2];
#define PG8_GVOFF(dst, uidx) do { _Pragma("unroll") for (int _h = 0; _h < 2; ++_h) _Pragma("unroll") for (int _i = 0; _i < 2; ++_i) { int R_, C_; stage_rc(tid * 16 + _i * 8192, R_, C_); \
        dst[_h][_i] = (unsigned)rtl[(uidx) * 256 + _h * 128 + R_] * (unsigned)(K * 2) + (unsigned)(C_ * 2); } } while (0)
    const unsigned ldsw = (unsigned)wid * 1024u;
    const int aoff = lds_byte(wr * 64 + fr, fq * 8), boff = lds_byte(wc * 32 + fr, fq * 8);
#define PG8_SA(b, h) (((b) * 2 + (h)) * HTB)
#define PG8_SB(b, h) ((4 + (b) * 2 + (h)) * HTB)
#define PG8_STAGE(bufoff, gbase, voff) do { _Pragma("unroll") for (int _i = 0; _i < 2; ++_i) \
        __builtin_amdgcn_global_load_lds((const unsigned*)((const char*)(gbase) + (voff)[_i]), (PG8_LAS unsigned*)(lds + (bufoff) + ldsw + _i * 8192), 16, 0, 0); } while (0)
#define PG8_STAGE_A(bufoff, gbase, h, nx) do { if constexpr (GATHER) { if (nx) PG8_STAGE(bufoff, gbase, voffGn[h]); else PG8_STAGE(bufoff, gbase, voffGc[h]); } else PG8_STAGE(bufoff, gbase, voffA); } while (0)
#define PG8_LDA(dst, b, h) do { _Pragma("unroll") for (int m = 0; m < 4; ++m) _Pragma("unroll") for (int k = 0; k < 2; ++k) dst[m][k] = *(const PG8_LAS bf16x8*)(lds + PG8_SA(b, h) + aoff + m * 2048 + k * 1024); } while (0)
#define PG8_LDB(dst, b, h) do { _Pragma("unroll") for (int n = 0; n < 2; ++n) _Pragma("unroll") for (int k = 0; k < 2; ++k) dst[n][k] = *(const PG8_LAS bf16x8*)(lds + PG8_SB(b, h) + boff + n * 2048 + k * 1024); } while (0)
#define PG8_MMA(ai, bj, At, Bt) do { __builtin_amdgcn_s_setprio(1); _Pragma("unroll") for (int m = 0; m < 4; ++m) _Pragma("unroll") for (int n = 0; n < 2; ++n) _Pragma("unroll") for (int k = 0; k < 2; ++k) \
        acc[ai][bj][m][n] = __builtin_amdgcn_mfma_f32_16x16x32_bf16(Bt[n][k], At[m][k], acc[ai][bj][m][n], 0, 0, 0); __builtin_amdgcn_s_setprio(0); } while (0)
#define PG8_WAIT_V(n) asm volatile("s_waitcnt vmcnt(" #n ")" ::: "memory")
#define PG8_WAIT_L(n) asm volatile("s_waitcnt lgkmcnt(" #n ")" ::: "memory")
#define PG8_BAR __builtin_amdgcn_s_barrier()
#define PG8_SCHED __builtin_amdgcn_sched_barrier(0)
    Unit cur, nxt; int ui = 0;
    if (!S.next(0, cur)) return;
    f32x4 acc[2][2][4][2];
#pragma unroll
    for (int a = 0; a < 2; ++a)
#pragma unroll
        for (int b = 0; b < 2; ++b)
#pragma unroll
            for (int m = 0; m < 4; ++m)
#pragma unroll
                for (int n = 0; n < 2; ++n) acc[a][b][m][n] = (f32x4){0.f, 0.f, 0.f, 0.f};
    bf16x8 At[4][2], B0[2][2], B1[2][2];
    const char* cA = (const char*)g.A + (size_t)cur.pm * tstepA; const char* cB = (const char*)g.Bt + (size_t)cur.pn * tstep;
    if constexpr (GATHER) { PG8_GVOFF(voffGc, 0); _Pragma("unroll") for (int _h = 0; _h < 2; ++_h) _Pragma("unroll") for (int _i = 0; _i < 2; ++_i) voffGn[_h][_i] = voffGc[_h][_i]; }
    S.a_ready(cur);
    if constexpr (SP2) {
        PG8_STAGE(PG8_SB(0, 0), cB, voffB); PG8_STAGE(PG8_SB(0, 1), cB + hstepB, voffB); PG8_STAGE_A(PG8_SA(0, 0), cA, 0, false); PG8_STAGE_A(PG8_SA(0, 1), cA + hstep, 1, false);
        if (wr == 1) PG8_BAR;
        PG8_WAIT_V(2); PG8_BAR;
        PG8_STAGE(PG8_SB(1, 0), cB + kstep, voffB); PG8_STAGE_A(PG8_SA(1, 0), cA + kstep, 0, false); PG8_STAGE(PG8_SB(1, 1), cB + hstepB + kstep, voffB);
        PG8_WAIT_V(6); PG8_BAR;
    } else {
        PG8_STAGE(PG8_SB(0, 0), cB, voffB); PG8_STAGE_A(PG8_SA(0, 0), cA, 0, false); PG8_STAGE(PG8_SB(0, 1), cB + hstepB, voffB); PG8_STAGE_A(PG8_SA(0, 1), cA + hstep, 1, false);
        if (wr == 1) PG8_BAR;
        PG8_WAIT_V(4); PG8_BAR;
        PG8_STAGE(PG8_SB(1, 0), cB + kstep, voffB); PG8_STAGE_A(PG8_SA(1, 0), cA + kstep, 0, false); PG8_STAGE(PG8_SB(1, 1), cB + hstepB + kstep, voffB);
        PG8_WAIT_V(6); PG8_BAR;
    }
    for (;;) {
        const bool has_next = S.next(ui + 1, nxt);
        const char* nA = has_next ? (const char*)g.A + (size_t)nxt.pm * tstepA : cA; const char* nB = has_next ? (const char*)g.Bt + (size_t)nxt.pn * tstep : cB;
        for (int t = 0; t < nt; t += 2) {
            if constexpr (Epi::MID_T > 0) { if (t == Epi::MID_T) E.mid(acc, cur, wr, wc, fr, fq); }
            const bool last = (t == nt - 2);
            const char* a1 = cA + (size_t)(t + 1) * kstep;
            const char* a2 = last ? nA : cA + (size_t)(t + 2) * kstep; const char* b2 = last ? nB : cB + (size_t)(t + 2) * kstep;
            const char* a3 = a2 + kstep; const char* b3 = b2 + kstep;
            if (last && has_next) { S.a_ready(nxt); if constexpr (GATHER) PG8_GVOFF(voffGn, ui + 1); }
            if constexpr (SP2) {
            PG8_LDB(B0, 0, 0); PG8_LDB(B1, 0, 1); PG8_SCHED; PG8_LDA(At, 0, 0); PG8_STAGE_A(PG8_SA(1, 1), a1 + hstep, 1, false);
            PG8_WAIT_V(8); PG8_WAIT_L(0); PG8_BAR; PG8_MMA(0, 0, At, B0); PG8_MMA(0, 1, At, B1); PG8_BAR; PG8_SCHED;
            PG8_LDA(At, 0, 1); PG8_STAGE(PG8_SB(0, 0), b2, voffB); PG8_STAGE(PG8_SB(0, 1), b2 + hstepB, voffB); PG8_STAGE_A(PG8_SA(0, 0), a2, 0, last);
            PG8_WAIT_V(8); PG8_WAIT_L(0); PG8_BAR; PG8_MMA(1, 0, At, B0); PG8_MMA(1, 1, At, B1); PG8_BAR; PG8_SCHED;
            PG8_LDB(B0, 1, 0); PG8_LDB(B1, 1, 1); PG8_SCHED; PG8_LDA(At, 1, 0); PG8_STAGE_A(PG8_SA(0, 1), a2 + hstep, 1, last);
            PG8_WAIT_V(8); PG8_WAIT_L(0); PG8_BAR; PG8_MMA(0, 0, At, B0); PG8_MMA(0, 1, At, B1); PG8_BAR; PG8_SCHED;
            PG8_LDA(At, 1, 1); PG8_STAGE(PG8_SB(1, 0), b3, voffB); PG8_STAGE(PG8_SB(1, 1), b3 + hstepB, voffB); PG8_STAGE_A(PG8_SA(1, 0), a3, 0, last);
            PG8_WAIT_V(8); PG8_WAIT_L(0); PG8_BAR; PG8_MMA(1, 0, At, B0); PG8_MMA(1, 1, At, B1); PG8_BAR; PG8_SCHED;
            } else {
            PG8_LDB(B0, 0, 0); PG8_SCHED; PG8_LDA(At, 0, 0); PG8_STAGE_A(PG8_SA(1, 1), a1 + hstep, 1, false);
            PG8_WAIT_L(8); PG8_BAR; PG8_WAIT_L(0); PG8_MMA(0, 0, At, B0); PG8_BAR; PG8_SCHED;
            PG8_LDB(B1, 0, 1); PG8_STAGE(PG8_SB(0, 0), b2, voffB);
            PG8_BAR; PG8_WAIT_L(0); PG8_MMA(0, 1, At, B1); PG8_BAR;
            PG8_LDA(At, 0, 1); PG8_STAGE_A(PG8_SA(0, 0), a2, 0, last);
            PG8_BAR; PG8_WAIT_L(0); PG8_MMA(1, 0, At, B0); PG8_BAR; PG8_SCHED;
            PG8_STAGE(PG8_SB(0, 1), b2 + hstepB, voffB);
            PG8_WAIT_V(6); PG8_BAR; PG8_MMA(1, 1, At, B1); PG8_BAR;
            PG8_LDB(B0, 1, 0); PG8_SCHED; PG8_LDA(At, 1, 0); PG8_STAGE_A(PG8_SA(0, 1), a2 + hstep, 1, last);
            PG8_WAIT_L(8); PG8_BAR; PG8_WAIT_L(0); PG8_MMA(0, 0, At, B0); PG8_BAR; PG8_SCHED;
            PG8_LDB(B1, 1, 1); PG8_STAGE(PG8_SB(1, 0), b3, voffB);
            PG8_BAR; PG8_WAIT_L(0); PG8_MMA(0, 1, At, B1); PG8_BAR;
            PG8_LDA(At, 1, 1); PG8_STAGE_A(PG8_SA(1, 0), a3, 0, last);
            PG8_BAR; PG8_WAIT_L(0); PG8_MMA(1, 0, At, B0); PG8_BAR; PG8_SCHED;
            PG8_STAGE(PG8_SB(1, 1), b3 + hstepB, voffB);
            PG8_WAIT_V(6); PG8_BAR; PG8_MMA(1, 1, At, B1); PG8_BAR;
            }
        }
        if constexpr (ALIGN_EPI) { if (wr == 0) PG8_BAR; }
        if constexpr (!Epi::AFTER_DRAIN) { E(acc, cur, wr, wc, fr, fq); S.done(cur); }
        if (!has_next) break;
#pragma unroll
        for (int a = 0; a < 2; ++a)
#pragma unroll
            for (int b = 0; b < 2; ++b)
#pragma unroll
                for (int m = 0; m < 4; ++m)
#pragma unroll
                    for (int n = 0; n < 2; ++n) acc[a][b][m][n] = (f32x4){0.f, 0.f, 0.f, 0.f};
        cur = nxt; cA = nA; cB = nB; ++ui;
        if constexpr (GATHER) { _Pragma("unroll") for (int _h = 0; _h < 2; ++_h) _Pragma("unroll") for (int _i = 0; _i < 2; ++_i) voffGc[_h][_i] = voffGn[_h][_i]; }
        if constexpr (ALIGN_EPI) { if (wr == 1) PG8_BAR; }
    }
    PG8_WAIT_V(0);
    if constexpr (!ALIGN_EPI) { if (wr == 0) PG8_BAR; }
    PG8_BAR;
    if constexpr (Epi::AFTER_DRAIN) { E.fused(acc, cur, wr, wc, fr, fq, lds, wid, lane); S.done(cur); }
#undef PG8_SA
#undef PG8_SB
#undef PG8_STAGE
#undef PG8_STAGE_A
#undef PG8_GVOFF
#undef PG8_LDA
#undef PG8_LDB
#undef PG8_MMA
#undef PG8_WAIT_V
#undef PG8_WAIT_L
#undef PG8_BAR
#undef PG8_SCHED
}
}

#define LAS __attribute__((address_space(3)))
__host__ __device__ __forceinline__ int rope_pos(int j) { return 2 * (j & 31) + (j >> 5); }
__host__ __device__ __forceinline__ int win_dest_row(int c) {
    if (c < C_K) return (c & ~63) + rope_pos(c & 63);
    if (c < C_V) return 512 + rope_pos(c - C_K);
    if (c < C_IQ) return 512 + 64 + (c - C_V);
    if (c < C_IK) return 768 + ((c - C_IQ) & ~63) + rope_pos((c - C_IQ) & 63);
    if (c < C_IW) return 512 + 128 + rope_pos(c - C_IK);
    if (c < C_Z) return 512 + 192 + (c - C_IW);
    if (c < C_XBC) return 1024 + (c - C_Z);
    if (c < C_DT) return 1536 + (c - C_XBC);
    return 512 + 200 + (c - C_DT);
}
struct EpiInProj {
    static constexpr bool PERM = true, AFTER_DRAIN = false; static constexpr int MID_T = 0;
    bf16 *Q, *K, *V, *IK, *IQ, *Z, *XBC; float *IW, *DT; const float2* rope;
    __device__ __forceinline__ u32x4 pack8(const f32x4 a, const f32x4 b) const { u32x4 w; w.x = pg8::cvt_pk_bf16(a[0], a[1]); w.y = pg8::cvt_pk_bf16(a[2], a[3]); w.z = pg8::cvt_pk_bf16(b[0], b[1]); w.w = pg8::cvt_pk_bf16(b[2], b[3]); return w; }
    __device__ __forceinline__ u32x4 rope8(const f32x4 v0, const f32x4 v1, const f32x4 r0, const f32x4 r1, float sc) const {
        f32x4 a, b;
        a[0] = (v0[0] * r0[0] - v0[1] * r0[1]) * sc; a[1] = (v0[0] * r0[1] + v0[1] * r0[0]) * sc;
        a[2] = (v0[2] * r0[2] - v0[3] * r0[3]) * sc; a[3] = (v0[2] * r0[3] + v0[3] * r0[2]) * sc;
        b[0] = (v1[0] * r1[0] - v1[1] * r1[1]) * sc; b[1] = (v1[0] * r1[1] + v1[1] * r1[0]) * sc;
        b[2] = (v1[2] * r1[2] - v1[3] * r1[3]) * sc; b[3] = (v1[2] * r1[3] + v1[3] * r1[2]) * sc;
        return pack8(a, b);
    }
    __device__ __forceinline__ void operator()(const pg8::f32x4 (&acc)[2][2][4][2], const pg8::Unit& u, int wr, int wc, int fr, int fq) const {
        const int pn = u.pn, row0 = u.pm * 256 + wr * 64 + fr, cw = 32 * wc + 8 * fq;
        if (pn <= 1 || pn == 3) {
            bf16* dst = (pn == 3) ? IQ : Q; const int ld = (pn == 3) ? 256 : 512; const float sc = (pn == 3) ? 1.f : QSCALE; const int hb = (pn == 3) ? 0 : pn * 4;
#pragma unroll
            for (int ai = 0; ai < 2; ++ai)
#pragma unroll
                for (int m = 0; m < 4; ++m) { const int row = row0 + ai * 128 + m * 16, t = row & (SEQ - 1);
                    const f32x4* rp = (const f32x4*)(rope + t * 32 + 16 * (wc & 1) + 4 * fq); const f32x4 r0 = rp[0], r1 = rp[1];
#pragma unroll
                    for (int bj = 0; bj < 2; ++bj) { const int head = hb + 2 * bj + (wc >> 1);
                        *(u32x4*)(dst + (size_t)row * ld + head * 64 + 32 * (wc & 1) + 8 * fq) = rope8(acc[ai][bj][m][0], acc[ai][bj][m][1], r0, r1, sc); } }
        } else if (pn == 2) {
#pragma unroll
            for (int ai = 0; ai < 2; ++ai)
#pragma unroll
                for (int m = 0; m < 4; ++m) { const int row = row0 + ai * 128 + m * 16, t = row & (SEQ - 1);
                    if (wc < 2) { const f32x4* rp = (const f32x4*)(rope + t * 32 + 16 * wc + 4 * fq); const f32x4 r0 = rp[0], r1 = rp[1];
                        *(u32x4*)(K + (size_t)row * 64 + cw) = rope8(acc[ai][0][m][0], acc[ai][0][m][1], r0, r1, 1.f);
                        *(u32x4*)(IK + (size_t)row * 64 + cw) = rope8(acc[ai][1][m][0], acc[ai][1][m][1], r0, r1, 1.f);
                    } else {
                        *(u32x4*)(V + (size_t)row * 64 + (cw - 64)) = pack8(acc[ai][0][m][0], acc[ai][0][m][1]);
                        if (wc == 2 && fq == 0) *(f32x4*)(IW + (size_t)row * 4) = acc[ai][1][m][0] * INDEXER_SCALE;
                        if (wc == 2 && fq == 1) { *(f32x4*)(DT + (size_t)row * 8) = acc[ai][1][m][0]; *(f32x4*)(DT + (size_t)row * 8 + 4) = acc[ai][1][m][1]; }
                    } }
        } else {
            bf16* dst = (pn < 6) ? Z : XBC; const int ld = (pn < 6) ? 512 : 768; const int cb = (pn < 6) ? (pn - 4) * 256 : (pn - 6) * 256;
#pragma unroll
            for (int ai = 0; ai < 2; ++ai)
#pragma unroll
                for (int m = 0; m < 4; ++m) { const int row = row0 + ai * 128 + m * 16;
#pragma unroll
                    for (int bj = 0; bj < 2; ++bj) *(u32x4*)(dst + (size_t)row * ld + cb + 128 * bj + cw) = pack8(acc[ai][bj][m][0], acc[ai][bj][m][1]); }
        }
    }
};
struct EpiH1 {
    static constexpr bool PERM = false, AFTER_DRAIN = false; static constexpr int MID_T = 8;
    const float* x; bf16* out; const float* ssqp;
    __device__ __forceinline__ void mid(pg8::f32x4 (&acc)[2][2][4][2], const pg8::Unit& u, int wr, int wc, int fr, int fq) const {
        asm volatile("" : "+v"(fr));
        const int row0 = u.pm * 256 + wr * 64 + fr;
#pragma unroll
        for (int ai = 0; ai < 2; ++ai)
#pragma unroll
            for (int m = 0; m < 4; ++m) { const f32x4* sp = (const f32x4*)(ssqp + (size_t)(row0 + ai * 128 + m * 16) * 8); const f32x4 s0 = sp[0], s1 = sp[1];
                const float r = rsqrtf(((s0[0] + s0[1]) + (s0[2] + s0[3]) + (s1[0] + s1[1]) + (s1[2] + s1[3])) * (1.f / 512.f) + LN_EPS);
#pragma unroll
                for (int bj = 0; bj < 2; ++bj)
#pragma unroll
                    for (int n = 0; n < 2; ++n) acc[ai][bj][m][n] = acc[ai][bj][m][n] * r; }
    }
    __device__ __forceinline__ void operator()(const pg8::f32x4 (&acc)[2][2][4][2], const pg8::Unit& u, int wr, int wc, int fr, int fq) const {
        const int row0 = u.pm * 256 + wr * 64 + fr, col0 = u.pn * 256 + wc * 32 + 4 * fq;
#pragma unroll
        for (int ai = 0; ai < 2; ++ai)
#pragma unroll
            for (int m = 0; m < 4; ++m) { const size_t off = (size_t)(row0 + ai * 128 + m * 16) * DM + col0;
#pragma unroll
                for (int bj = 0; bj < 2; ++bj)
#pragma unroll
                    for (int n = 0; n < 2; ++n) { const f32x4 xv = *(const f32x4*)(x + off + bj * 128 + n * 16); const f32x4 hv = xv * ALPHA + acc[ai][bj][m][n];
                        u32x2 w; w.x = pg8::cvt_pk_bf16(hv[0], hv[1]); w.y = pg8::cvt_pk_bf16(hv[2], hv[3]); *(u32x2*)(out + off + bj * 128 + n * 16) = w; } }
    }
};
template <class DR, class KM>
__device__ __forceinline__ void transpose_item(const float* W, int K, int N, bf16* WT, LAS float* scr, int item, int lane, DR drow, KM kmap) {
    const int nblk = (N + 31) / 32, kb = item / nblk, nb = item % nblk, k0 = 64 * kb, n0 = 32 * nb;
    float tv[32];
#pragma unroll
    for (int i = 0; i < 32; ++i) { const int kk = 2 * i + (lane >> 5), col = n0 + (lane & 31); float sc = 1.f; const int ks = kmap(k0 + kk, sc); tv[i] = (col < N) ? W[(size_t)ks * N + col] * sc : 0.f; }
#pragma unroll
    for (int i = 0; i < 32; ++i) scr[(2 * i + (lane >> 5)) * 33 + (lane & 31)] = tv[i];
    asm volatile("s_waitcnt lgkmcnt(0)" ::: "memory");
    const int c = lane & 7;
#pragma unroll
    for (int j = 0; j < 4; ++j) { const int n = (lane >> 3) + 8 * j, col = n0 + n; const LAS float* s = scr + (8 * c) * 33 + n;
        u32x4 o; o.x = pg8::cvt_pk_bf16(s[0 * 33], s[1 * 33]); o.y = pg8::cvt_pk_bf16(s[2 * 33], s[3 * 33]); o.z = pg8::cvt_pk_bf16(s[4 * 33], s[5 * 33]); o.w = pg8::cvt_pk_bf16(s[6 * 33], s[7 * 33]);
        if (col < N) *(u32x4*)(WT + (size_t)drow(col) * K + k0 + 8 * c) = o; }
    asm volatile("s_waitcnt lgkmcnt(0)" ::: "memory");
}
namespace attn_body {
using bf16=unsigned short;
using bf16x8=__attribute__((ext_vector_type(8)))short;
using s16x4=__attribute__((ext_vector_type(4)))short;
using f32x16=__attribute__((ext_vector_type(16)))float;
using u32x4=__attribute__((ext_vector_type(4)))unsigned;
constexpr int SEQ=2048,D=64,QP=512,KP=64,OP=1024;
constexpr int NW=8,QBLK=32,KVBLK=64;
__device__ __forceinline__ int crow(int r,int hi){return (r&3)+8*(r>>2)+4*hi;}
#define SBAR() __builtin_amdgcn_sched_barrier(0)
__device__ __forceinline__ void amask(f32x16&p0,f32x16&p1,unsigned mlo,unsigned mhi,int hi){
  const unsigned NEGB=0xff800000u; const unsigned a=mlo>>(4*hi), b=mhi>>(4*hi);
  #pragma unroll
  for(int r=0;r<16;++r){ const int pos=(r&3)+8*(r>>2);
    const unsigned s0=(unsigned)__builtin_amdgcn_sbfe((int)a,pos,1), s1=(unsigned)__builtin_amdgcn_sbfe((int)b,pos,1);
    const float v0=p0[r], v1=p1[r];
    p0[r]=__uint_as_float((s0&__float_as_uint(v0))|(~s0&NEGB));
    p1[r]=__uint_as_float((s1&__float_as_uint(v1))|(~s1&NEGB)); }
}

constexpr int NSLOT=3, SLOTB=8192;
constexpr int LDS_K=0, LDS_V=NSLOT*SLOTB, LDS_WS=2*NSLOT*SLOTB, LDS_OST=LDS_WS+NW*64*4, LDS_BYTES=LDS_OST+NW*4096;
constexpr float C2=0.125f*1.4426950408889634f;
__device__ __forceinline__ void glds16(const void*gsrc,unsigned lds_dst){unsigned keep;
  asm volatile("s_mov_b32 %0, m0\n\ts_mov_b32 m0, %2\n\ts_nop 0\n\tglobal_load_lds_dwordx4 %1, off\n\ts_mov_b32 m0, %0":"=&s"(keep):"v"(gsrc),"s"(lds_dst):"memory");}
__device__ __forceinline__ float max3f(float a,float b,float c){float r;asm("v_max3_f32 %0, %1, %2, %3":"=v"(r):"v"(a),"v"(b),"v"(c));return r;}
__device__ __forceinline__ float max2f(float a,float b){float r;asm("v_max_f32_e32 %0, %1, %2":"=v"(r):"v"(a),"v"(b));return r;}
__device__ __forceinline__ float fadd_s(float a,float b){float r;asm("v_add_f32_e32 %0, %1, %2":"=v"(r):"v"(a),"v"(b));return r;}
__device__ __forceinline__ float fsub_s(float a,float b){float r;asm("v_sub_f32_e32 %0, %1, %2":"=v"(r):"v"(a),"v"(b));return r;}
typedef float f32x2_t __attribute__((ext_vector_type(2))); typedef __bf16 bf16x2_t __attribute__((ext_vector_type(2)));
__device__ __forceinline__ unsigned cvtpk_s(float lo,float hi){f32x2_t v={lo,hi};bf16x2_t b=__builtin_convertvector(v,bf16x2_t);return __builtin_bit_cast(unsigned,b);}
#define WAIT_BAR(N) asm volatile("s_waitcnt vmcnt(" #N ") lgkmcnt(0)\n\ts_barrier":::"memory")

__device__ __forceinline__ void qkt(f32x16&p0,f32x16&p1,const char*Kslot,const bf16x8*qr,const f32x16&negm,int r32,int hi){
  const char*kb=Kslot+hi*1024+r32*16;
  #pragma unroll
  for(int d0=0;d0<4;++d0){
    const bf16x8 b0=*reinterpret_cast<const bf16x8*>(kb+d0*2048);
    const bf16x8 b1=*reinterpret_cast<const bf16x8*>(kb+d0*2048+512);
    if(d0==0){p0=__builtin_amdgcn_mfma_f32_32x32x16_bf16(b0,qr[0],negm,0,0,0);p1=__builtin_amdgcn_mfma_f32_32x32x16_bf16(b1,qr[0],negm,0,0,0);}
    else{p0=__builtin_amdgcn_mfma_f32_32x32x16_bf16(b0,qr[d0],p0,0,0,0);p1=__builtin_amdgcn_mfma_f32_32x32x16_bf16(b1,qr[d0],p1,0,0,0);}}
}
typedef __attribute__((address_space(3))) const char* lds_cptr;
typedef short v4i16_t __attribute__((ext_vector_type(4)));
__device__ __forceinline__ void kload8(bf16x8*kf,lds_cptr kp){
  kf[0]=*(const __attribute__((address_space(3))) bf16x8*)(kp);      kf[1]=*(const __attribute__((address_space(3))) bf16x8*)(kp+512);
  kf[2]=*(const __attribute__((address_space(3))) bf16x8*)(kp+2048); kf[3]=*(const __attribute__((address_space(3))) bf16x8*)(kp+2560);
  kf[4]=*(const __attribute__((address_space(3))) bf16x8*)(kp+4096); kf[5]=*(const __attribute__((address_space(3))) bf16x8*)(kp+4608);
  kf[6]=*(const __attribute__((address_space(3))) bf16x8*)(kp+6144); kf[7]=*(const __attribute__((address_space(3))) bf16x8*)(kp+6656);
}
__device__ __forceinline__ void kload2(bf16x8*kf,lds_cptr kp,int j){ kf[2*j]=*(const __attribute__((address_space(3))) bf16x8*)(kp+j*2048); kf[2*j+1]=*(const __attribute__((address_space(3))) bf16x8*)(kp+j*2048+512); }
__device__ __forceinline__ s16x4 vtr(lds_cptr p){ return __builtin_bit_cast(s16x4,__builtin_amdgcn_ds_read_tr16_b64_v4i16((__attribute__((address_space(3))) v4i16_t*)p)); }
__device__ __forceinline__ float rowmax(const f32x16&p0,const f32x16&p1){
  float a=max3f(p0[0],p0[1],p1[0]),b=max3f(p0[2],p0[3],p1[1]);a=max3f(a,p1[2],p1[3]);
  #pragma unroll
  for(int r=4;r<16;r+=4){a=max3f(a,p0[r],p0[r+1]);b=max3f(b,p0[r+2],p0[r+3]);a=max3f(a,p1[r],p1[r+1]);b=max3f(b,p1[r+2],p1[r+3]);}
  const float m=max2f(a,b);
  auto rr=__builtin_amdgcn_permlane32_swap(__float_as_uint(m),__float_as_uint(m),false,false);
  return max2f(__uint_as_float(rr[0]),__uint_as_float(rr[1]));
}
__device__ __forceinline__ void pv(f32x16*o,int vb,bf16x8 pa0,bf16x8 pa1,bf16x8 pa2,bf16x8 pa3){
  #pragma unroll
  for(int d0=0;d0<2;++d0){s16x4 lo[4],hi[4];
    #pragma unroll
    for(int ks=0;ks<4;++ks){
      asm volatile("ds_read_b64_tr_b16 %0,%1 offset:%c2":"=&v"(lo[ks]):"v"(vb),"i"(d0*4096+ks*1024):"memory");
      asm volatile("ds_read_b64_tr_b16 %0,%1 offset:%c2":"=&v"(hi[ks]):"v"(vb),"i"(d0*4096+ks*1024+512):"memory");}
    asm volatile("s_waitcnt lgkmcnt(0)":::"memory");SBAR();
    #define PK(k) (bf16x8){lo[k][0],lo[k][1],lo[k][2],lo[k][3],hi[k][0],hi[k][1],hi[k][2],hi[k][3]}
    o[d0]=__builtin_amdgcn_mfma_f32_32x32x16_bf16(pa0,PK(0),o[d0],0,0,0);
    o[d0]=__builtin_amdgcn_mfma_f32_32x32x16_bf16(pa1,PK(1),o[d0],0,0,0);
    o[d0]=__builtin_amdgcn_mfma_f32_32x32x16_bf16(pa2,PK(2),o[d0],0,0,0);
    o[d0]=__builtin_amdgcn_mfma_f32_32x32x16_bf16(pa3,PK(3),o[d0],0,0,0);
    #undef PK
  }
}

#ifndef ATTN_STORE16
#define ATTN_STORE16(p,v) (*(u32x4*)(p)=(v))
#endif
template<int THRL> __device__ __forceinline__ void attn_unit(int b,int qb,const bf16*Q,const bf16*__restrict__ K,const bf16*__restrict__ V,bf16*O,char*shm,const char*maskb,const int wave_s){
  int lane_l=lane_id(); asm volatile("":"+v"(lane_l)); const int lane=lane_l,tid=wave_s*64+lane,r32=lane&31,hi=lane>>5; const int wid=wave_s;
  const long rowbase=(long)b*SEQ; const int q0=qb*QBLK;
  const bf16*Qw=Q+(rowbase+q0)*QP+wid*D;
  const bf16*Kh=K+rowbase*KP,*Vh=V+rowbase*KP;
  const unsigned lds0=(unsigned)(uintptr_t)shm;
  float*wsf=(float*)(shm+LDS_WS)+wid*64;
  const bf16*ksrc=Kh+(long)lane*KP+wid*8;
  const bf16*vsrc=Vh+(long)(16*(wid&3)+(lane>>2))*KP+(wid>>2)*32+(lane&3)*8;
  const unsigned kdst=lds0+LDS_K+wid*1024, vdst=lds0+LDS_V+wid*1024;
  #define DMA_K(t,slot) glds16(ksrc+(long)(t)*KVBLK*KP,(unsigned)__builtin_amdgcn_readfirstlane(kdst+(slot)))
  #define DMA_V(t,slot) glds16(vsrc+(long)(t)*KVBLK*KP,(unsigned)__builtin_amdgcn_readfirstlane(vdst+(slot)))
  const int vb0=(int)(lds0+LDS_V)+((lane>>4)&1)*32+(lane&3)*8+(4*hi+((lane&15)>>2))*64;
  const char*Kbase=shm+LDS_K; bf16x8 kf[8];
  const lds_cptr shm3=(lds_cptr)shm; const lds_cptr kp0=shm3+LDS_K+hi*1024+r32*16; const lds_cptr vp0=shm3+LDS_V+((lane>>4)&1)*32+(lane&3)*8+(4*hi+((lane&15)>>2))*64;
  const int NTr=(q0+QBLK+KVBLK-1)/KVBLK; const int NT=(NTr<4)?4:((NTr+1)&~1);
  const __attribute__((address_space(3))) unsigned*mrow=(const __attribute__((address_space(3))) unsigned*)((__attribute__((address_space(3))) const char*)maskb)+r32*66;
  DMA_K(0,0);DMA_V(0,0);DMA_K(1,SLOTB);
  bf16x8 qr[4];
  #pragma unroll
  for(int d0=0;d0<4;++d0)qr[d0]=*reinterpret_cast<const bf16x8*>(&Qw[(long)r32*QP+d0*16+hi*8]);
  float zz_=0.f; asm volatile("":"+v"(zz_)); float mhat=zz_,l_reg=zz_;f32x16 o[2];
  #pragma unroll
  for(int r=0;r<16;++r){o[0][r]=zz_;o[1][r]=zz_;}
  f32x16 negm;
  #pragma unroll
  for(int r=0;r<16;++r)negm[r]=zz_;
  asm volatile("":"+v"(negm));
  #define CMASK(P0,P1,t) do{ const unsigned ml_=mrow[2*(t)], mh_=mrow[2*(t)+1]; amask(P0,P1,ml_,mh_,hi); }while(0)
  bool resc=false;
  #define START(P0,P1) do{ const float rm=rowmax(P0,P1); resc=false; \
    { const float dl=(rm>-INFINITY)?rm:0.f; mhat=fadd_s(mhat,dl); \
      _Pragma("unroll") for(int r=0;r<16;++r){P0[r]=fsub_s(P0[r],dl);P1[r]=fsub_s(P1[r],dl);} \
      _Pragma("unroll") for(int r=0;r<16;++r)negm[r]=-mhat; asm volatile("":"+v"(negm)); } \
    _Pragma("unroll") for(int r=0;r<16;++r)P0[r]=__builtin_amdgcn_exp2f(P0[r]); }while(0)
  #define RESC() do{ if(resc){ asm volatile("s_waitcnt lgkmcnt(0)":::"memory"); \
      _Pragma("unroll") for(int d_=0;d_<2;++d_) _Pragma("unroll") for(int r=0;r<16;++r)o[d_][r]*=wsf[crow(r,hi)]; } }while(0)
  f32x16 pA0,pA1,pB0,pB1;
  int sl_prev=0,sl_cur=0,sl_next=SLOTB;
  #define ROT() do{sl_prev=sl_cur;sl_cur=sl_next;sl_next=(sl_next==(NSLOT-1)*SLOTB)?0:sl_next+SLOTB;}while(0)
  DMA_K(2,2*SLOTB);
  WAIT_BAR(3);
  qkt(pA0,pA1,Kbase,qr,negm,r32,hi);asm volatile("s_nop 15\n\ts_nop 7":"+v"(pA0),"+v"(pA1));CMASK(pA0,pA1,0);
  START(pA0,pA1);
  _Pragma("unroll") for(int r=0;r<16;++r)pA1[r]=__builtin_amdgcn_exp2f(pA1[r]);
  WAIT_BAR(0);
  DMA_K(3,0);DMA_V(1,SLOTB);
  ROT();
  kload8(kf,kp0+sl_cur);
  WAIT_BAR(2);
  s16x4 vlo[8],vhi[8]; u32x4 pw0,pw1,pw2,pw3;
  #define PKW(P,B) cvtpk_s(P[B],P[B+1])
  #define PAF(k) __builtin_bit_cast(bf16x8,pw##k)
  #define VFR(i) (bf16x8){vlo[i][0],vlo[i][1],vlo[i][2],vlo[i][3],vhi[i][0],vhi[i][1],vhi[i][2],vhi[i][3]}
  #define PIN(x) asm volatile("":"+v"(x))
  #define MX3(a,b,c) __builtin_fmaxf(__builtin_fmaxf((a),(b)),(c))
  #define GAPA(MF,A0,A1,A2,A3,W0,W1,PW) do{ MF; sacc+=A0; sacc+=A1; sacc+=A2; sacc+=A3; PIN(sacc); W0; W1; PIN(PW); SBAR(); }while(0)
  #define EX(v) __builtin_amdgcn_exp2f(v)
  #define GAPB(MF,X,B) do{ MF; X[B]=EX(X[B]); X[B+1]=EX(X[B+1]); X[B+2]=EX(X[B+2]); X[B+3]=EX(X[B+3]); PIN(X); SBAR(); }while(0)
  #define VRD(i) do{ vlo[i]=vtr(vp_+(((i)>>2)*4096+((i)&3)*1024)); vhi[i]=vtr(vp_+(((i)>>2)*4096+((i)&3)*1024+512)); }while(0)
  #define KRD(G,j) do{ if(G){ kload2(kf,kp0+sl_next,j); SBAR(); } }while(0)
  #define STEP(C0,C1,P0,P1,t,GK,GV,GL) do{ SBAR(); \
    const lds_cptr vp_=vp0+sl_prev; \
    VRD(0); SBAR(); float sacc=(P0[0]+P0[1]); \
    GAPA(C0=__builtin_amdgcn_mfma_f32_32x32x16_bf16(kf[0],qr[0],negm,0,0,0), P0[2],P0[3],P0[4],P0[5],     pw0[0]=PKW(P0,0), pw0[1]=PKW(P0,2), pw0); \
    VRD(4); SBAR(); GAPA(C1=__builtin_amdgcn_mfma_f32_32x32x16_bf16(kf[1],qr[0],negm,0,0,0), P0[6],P0[7],P0[8],P0[9],     pw0[2]=PKW(P0,4), pw0[3]=PKW(P0,6), pw0); \
    VRD(1); SBAR(); GAPA(C0=__builtin_amdgcn_mfma_f32_32x32x16_bf16(kf[2],qr[1],C0,0,0,0),   P0[10],P0[11],P0[12],P0[13], pw1[0]=PKW(P0,8), pw1[1]=PKW(P0,10), pw1); \
    VRD(5); SBAR(); GAPA(C1=__builtin_amdgcn_mfma_f32_32x32x16_bf16(kf[3],qr[1],C1,0,0,0),   P0[14],P0[15],P1[0],P1[1],   pw1[2]=PKW(P0,12),pw1[3]=PKW(P0,14), pw1); \
    VRD(2); SBAR(); GAPA(C0=__builtin_amdgcn_mfma_f32_32x32x16_bf16(kf[4],qr[2],C0,0,0,0),   P1[2],P1[3],P1[4],P1[5],     pw2[0]=PKW(P1,0), pw2[1]=PKW(P1,2), pw2); \
    VRD(6); SBAR(); GAPA(C1=__builtin_amdgcn_mfma_f32_32x32x16_bf16(kf[5],qr[2],C1,0,0,0),   P1[6],P1[7],P1[8],P1[9],     pw2[2]=PKW(P1,4), pw2[3]=PKW(P1,6), pw2); \
    VRD(3); SBAR(); GAPA(C0=__builtin_amdgcn_mfma_f32_32x32x16_bf16(kf[6],qr[3],C0,0,0,0),   P1[10],P1[11],P1[12],P1[13], pw3[0]=PKW(P1,8), pw3[1]=PKW(P1,10), pw3); \
    VRD(7); SBAR(); GAPA(C1=__builtin_amdgcn_mfma_f32_32x32x16_bf16(kf[7],qr[3],C1,0,0,0),   P1[14],P1[15],0.f,0.f,       pw3[2]=PKW(P1,12),pw3[3]=PKW(P1,14), pw3); \
    l_reg+=sacc; \
    if(GK){DMA_K((t)+3,sl_cur);} if(GV){DMA_V((t)+1,sl_next);} \
    CMASK(C0,C1,t); \
    { float a=MX3(C0[0],C0[1],C1[0]),b=MX3(C0[2],C0[3],C1[1]); a=MX3(a,C1[2],C1[3]); \
      _Pragma("unroll") for(int r=4;r<16;r+=4){a=MX3(a,C0[r],C0[r+1]);b=MX3(b,C0[r+2],C0[r+3]);a=MX3(a,C1[r],C1[r+1]);b=MX3(b,C1[r+2],C1[r+3]);} \
      float rm=__builtin_fmaxf(a,b); { auto rr=__builtin_amdgcn_permlane32_swap(__float_as_uint(rm),__float_as_uint(rm),false,false); rm=__builtin_fmaxf(__uint_as_float(rr[0]),__uint_as_float(rr[1])); } \
      resc=false; \
      if(__builtin_expect(__any(rm>(float)THRL),0)){ const float dl=__builtin_fmaxf(rm,0.f); mhat+=dl; \
        _Pragma("unroll") for(int r=0;r<16;++r){C0[r]-=dl;C1[r]-=dl;} \
        _Pragma("unroll") for(int r=0;r<16;++r)negm[r]=-mhat; asm volatile("":"+v"(negm)); \
        const float f=__builtin_amdgcn_exp2f(-dl); l_reg*=f; if(hi==0)wsf[r32]=f; resc=true; } } \
    SBAR(); \
    GAPB(o[0]=__builtin_amdgcn_mfma_f32_32x32x16_bf16(PAF(0),VFR(0),o[0],0,0,0), C0,0); \
    GAPB(o[1]=__builtin_amdgcn_mfma_f32_32x32x16_bf16(PAF(0),VFR(4),o[1],0,0,0), C0,4); \
    KRD(GL,0); GAPB(o[0]=__builtin_amdgcn_mfma_f32_32x32x16_bf16(PAF(1),VFR(1),o[0],0,0,0), C0,8); \
    KRD(GL,1); GAPB(o[1]=__builtin_amdgcn_mfma_f32_32x32x16_bf16(PAF(1),VFR(5),o[1],0,0,0), C0,12); \
    KRD(GL,2); GAPB(o[0]=__builtin_amdgcn_mfma_f32_32x32x16_bf16(PAF(2),VFR(2),o[0],0,0,0), C1,0); \
    KRD(GL,3); GAPB(o[1]=__builtin_amdgcn_mfma_f32_32x32x16_bf16(PAF(2),VFR(6),o[1],0,0,0), C1,4); \
    GAPB(o[0]=__builtin_amdgcn_mfma_f32_32x32x16_bf16(PAF(3),VFR(3),o[0],0,0,0), C1,8); \
    GAPB(o[1]=__builtin_amdgcn_mfma_f32_32x32x16_bf16(PAF(3),VFR(7),o[1],0,0,0), C1,12); \
    }while(0)
  int t=1;
  for(;t+5<NT;t+=2){
    STEP(pB0,pB1,pA0,pA1,t,true,true,true);     WAIT_BAR(2); RESC(); ROT();
    STEP(pA0,pA1,pB0,pB1,t+1,true,true,true);   WAIT_BAR(2); RESC(); ROT();
  }
  #define ENDW(tt) do{ if((tt)+3<NT){WAIT_BAR(2);} else if((tt)+2<NT){WAIT_BAR(1);} else {WAIT_BAR(0);} }while(0)
  for(;t+1<NT;t+=2){
    STEP(pB0,pB1,pA0,pA1,t,(t+3<NT),(t+1<NT),(t+1<NT));       ENDW(t);   RESC(); ROT();
    STEP(pA0,pA1,pB0,pB1,t+1,(t+4<NT),(t+2<NT),(t+2<NT));     ENDW(t+1); RESC(); ROT();
  }
  STEP(pB0,pB1,pA0,pA1,NT-1,false,false,false); RESC();
  { float sacc=pB0[0]+pB0[1]; _Pragma("unroll") for(int r=2;r<16;++r)sacc+=pB0[r]; _Pragma("unroll") for(int r=0;r<16;++r)sacc+=pB1[r]; l_reg+=sacc;
    pw0=(u32x4){PKW(pB0,0),PKW(pB0,2),PKW(pB0,4),PKW(pB0,6)};pw1=(u32x4){PKW(pB0,8),PKW(pB0,10),PKW(pB0,12),PKW(pB0,14)};pw2=(u32x4){PKW(pB1,0),PKW(pB1,2),PKW(pB1,4),PKW(pB1,6)};pw3=(u32x4){PKW(pB1,8),PKW(pB1,10),PKW(pB1,12),PKW(pB1,14)};
    SBAR(); pv(o,vb0+sl_cur,PAF(0),PAF(1),PAF(2),PAF(3)); }
  #undef PKW
  #undef PAF
  #undef VFR
  #undef PIN
  #undef MX3
  #undef GAPA
  #undef GAPB
  #undef EX
  #undef VRD
  #undef KRD
  #undef STEP
  #undef ENDW
  {auto rr=__builtin_amdgcn_permlane32_swap(__float_as_uint(l_reg),__float_as_uint(l_reg),false,false);l_reg=__uint_as_float(rr[0])+__uint_as_float(rr[1]);}
  if(hi==0)wsf[32+r32]=l_reg;asm volatile("s_waitcnt lgkmcnt(0)":::"memory");
  float rli[16];
  #pragma unroll
  for(int r=0;r<16;++r)rli[r]=__builtin_amdgcn_rcpf(wsf[32+crow(r,hi)]);
  bf16*Ow=O+(rowbase+q0)*OP+512+wid*D;
  { bf16*stg=(bf16*)(shm+LDS_OST)+wid*2048;
    #pragma unroll
    for(int r=0;r<16;++r){const int orow=crow(r,hi);
      #pragma unroll
      for(int d0=0;d0<2;++d0)stg[orow*64+d0*32+r32]=(bf16)(cvtpk_s(o[d0][r]*rli[r],0.f)&0xffffu);}
    asm volatile("s_waitcnt lgkmcnt(0)":::"memory");
    #pragma unroll
    for(int i=0;i<4;++i){const int row=i*8+(lane>>3),ch=lane&7; const u32x4 v=*(const u32x4*)(stg+row*64+ch*8); ATTN_STORE16(Ow+(long)row*OP+ch*8,v);} }
  asm volatile("s_waitcnt lgkmcnt(0)\n\ts_barrier":::"memory");
  #undef DMA_K
  #undef DMA_V
  #undef CMASK
  #undef START
  #undef RESC
  #undef ROT
}
constexpr int ATTN_LDS_BYTES=LDS_BYTES;
#undef SBAR
#undef WAIT_BAR
}

constexpr int DSA_MASK_OFF = 131072, DSA_MASK_STRIDE = 66;
typedef short bf16x8_t __attribute__((ext_vector_type(8)));
__device__ __forceinline__ int wave_sum_dpp_i(int x) {
    x += __builtin_amdgcn_update_dpp(0, x, 0xB1, 0xf, 0xf, true);
    x += __builtin_amdgcn_update_dpp(0, x, 0x4E, 0xf, 0xf, true);
    x += __builtin_amdgcn_update_dpp(0, x, 0x114, 0xf, 0xf, true);
    x += __builtin_amdgcn_update_dpp(0, x, 0x118, 0xf, 0xf, true);
    x += __builtin_amdgcn_update_dpp(0, x, 0x142, 0xa, 0xf, false);
    x += __builtin_amdgcn_update_dpp(0, x, 0x143, 0xc, 0xf, false);
    return __builtin_amdgcn_readlane(x, 63);
}
__device__ __forceinline__ int count_ge(const unsigned (&k)[32], unsigned cand, int nreg) {
    int cl = 0;
#pragma unroll
    for (int g4 = 0; g4 < 8; ++g4) if (4 * g4 < nreg) {
#pragma unroll
        for (int j = 0; j < 4; ++j) cl += (k[4 * g4 + j] >= cand) ? 1 : 0; }
    return wave_sum_dpp_i(cl);
}
template <int OPK> __device__ __forceinline__ float dpp_opf(float a, float b) { return OPK == 0 ? fmaxf(a, b) : fminf(a, b); }
template <int OPK> __device__ __forceinline__ float wave_reduce_f(float x) {
    const int id = OPK == 0 ? (int)0xff800000 : (int)0x7f800000;
    x = dpp_opf<OPK>(x, __int_as_float(__builtin_amdgcn_update_dpp(id, __float_as_int(x), 0xB1, 0xf, 0xf, false)));
    x = dpp_opf<OPK>(x, __int_as_float(__builtin_amdgcn_update_dpp(id, __float_as_int(x), 0x4E, 0xf, 0xf, false)));
    x = dpp_opf<OPK>(x, __int_as_float(__builtin_amdgcn_update_dpp(id, __float_as_int(x), 0x114, 0xf, 0xf, false)));
    x = dpp_opf<OPK>(x, __int_as_float(__builtin_amdgcn_update_dpp(id, __float_as_int(x), 0x118, 0xf, 0xf, false)));
    x = dpp_opf<OPK>(x, __int_as_float(__builtin_amdgcn_update_dpp(id, __float_as_int(x), 0x142, 0xa, 0xf, false)));
    x = dpp_opf<OPK>(x, __int_as_float(__builtin_amdgcn_update_dpp(id, __float_as_int(x), 0x143, 0xc, 0xf, false)));
    return __int_as_float(__builtin_amdgcn_readlane(__float_as_int(x), 63));
}
__device__ __forceinline__ int binof(float v, float vmin, float scale) { const int b = (int)__fmul_rn(__fsub_rn(v, vmin), scale); return b > 2047 ? 2047 : b; }
__device__ __forceinline__ unsigned long long select_topk(const float (&k)[32], int kk, int nvalid, int nreg, int lane, LAS unsigned* hist, unsigned* errw) {
    const float NINF = -INFINITY;
    int mlo = 0, mhi = 0;
#define SEL_PUT(i, m) do { if (lane == (i)) { mlo = (int)(unsigned)(m); mhi = (int)(unsigned)((m) >> 32); } } while (0)
#define SEL_MINE (((unsigned long long)(unsigned)mhi << 32) | (unsigned long long)(unsigned)mlo)
    if (nvalid <= kk) {
#pragma unroll
        for (int i = 0; i < 32; ++i) { const unsigned long long m = __ballot(k[i] > NINF); SEL_PUT(i, m); }
        return SEL_MINE;
    }
    float T = 0.f; bool exact = false;
    float mx = NINF, mn = INFINITY;
#pragma unroll
    for (int g4 = 0; g4 < 8; ++g4) if (4 * g4 < nreg) {
#pragma unroll
        for (int j = 0; j < 4; ++j) { const float v = k[4 * g4 + j]; mx = fmaxf(mx, v); mn = fminf(mn, v > NINF ? v : INFINITY); } }
    const float vmax = wave_reduce_f<0>(mx), vmin = wave_reduce_f<1>(mn);
    if (vmax == vmin) { T = vmax; }
    else {
        const float scale = 2048.0f / (vmax - vmin);
        LAS u32x4* h4 = (LAS u32x4*)hist;
#pragma unroll
        for (int j = 0; j < 4; ++j) h4[lane + 64 * j] = (u32x4){0u, 0u, 0u, 0u};
#pragma unroll
        for (int g4 = 0; g4 < 8; ++g4) if (4 * g4 < nreg) {
#pragma unroll
            for (int j = 0; j < 4; ++j) { const float v = k[4 * g4 + j]; const bool ok = v > NINF; const unsigned bin = ok ? (unsigned)binof(v, vmin, scale) : 0u;
                __hip_atomic_fetch_add(hist + (bin >> 1), ok ? (1u << (16 * (bin & 1u))) : 0u, __ATOMIC_RELAXED, __HIP_MEMORY_SCOPE_WORKGROUP); } }
        u32x4 w[4];
#pragma unroll
        for (int j = 0; j < 4; ++j) w[j] = ((LAS u32x4*)(hist + 1008 - 16 * lane))[j];
        int s = 0;
#pragma unroll
        for (int j = 0; j < 4; ++j)
#pragma unroll
            for (int e = 0; e < 4; ++e) s += (int)(w[j][e] & 0xffffu) + (int)(w[j][e] >> 16);
        int Pinc = s;
#pragma unroll
        for (int o = 1; o < 64; o <<= 1) { const int v = __shfl_up(Pinc, o); if (lane >= o) Pinc += v; }
        const unsigned long long geb = __ballot(Pinc >= kk);
        const int Lstar = __builtin_ctzll(geb);
        const int above_l = __builtin_amdgcn_readlane(Pinc - s, Lstar);
        const int binj = 2047 - 32 * Lstar - (lane & 31);
        const unsigned wdj = hist[binj >> 1]; const int cntj = (binj & 1) ? (int)(wdj >> 16) : (int)(wdj & 0xffffu);
        int P2 = cntj;
#pragma unroll
        for (int o = 1; o < 32; o <<= 1) { const int v = __shfl_up(P2, o); if ((lane & 31) >= o) P2 += v; }
        P2 += above_l;
        const int jst = __builtin_ctzll(__ballot(P2 >= kk));
        const int Bstar = 2047 - 32 * Lstar - jst, cnt_above = __builtin_amdgcn_readlane(P2 - cntj, jst), cB = __builtin_amdgcn_readlane(cntj, jst);
        const int r = kk - cnt_above;
        if (cB <= 64) {
            LAS unsigned* cand = hist + 1024; int base = 0;
#pragma unroll
            for (int g4 = 0; g4 < 8; ++g4) if (4 * g4 < nreg) {
#pragma unroll
                for (int j = 0; j < 4; ++j) { const float v = k[4 * g4 + j]; const bool c = (v > NINF) && (binof(v, vmin, scale) == Bstar); const unsigned long long bal = __ballot(c);
                    if (bal) { if (c) cand[base + __builtin_amdgcn_mbcnt_hi((unsigned)(bal >> 32), __builtin_amdgcn_mbcnt_lo((unsigned)bal, 0u))] = __float_as_uint(v); base += __popcll(bal); } } }
            const float myc = (lane < cB) ? __uint_as_float(cand[lane]) : NINF;
            float prev = INFINITY; int cum = 0;
            for (int it = 0; it < 64; ++it) {
                const float m = wave_reduce_f<0>(myc < prev ? myc : NINF);
                cum += __popcll(__ballot(myc == m));
                if (cum >= r) { T = m; exact = (cum == r); break; }
                prev = m;
            }
        } else {
            float prev = INFINITY; int cum = 0;
            for (int it = 0; it < 2048; ++it) {
                float lm = NINF;
#pragma unroll
                for (int i = 0; i < 32; ++i) { const float v = k[i]; if (v > NINF && v < prev && binof(v, vmin, scale) == Bstar) lm = fmaxf(lm, v); }
                const float m = wave_reduce_f<0>(lm);
                int mult = 0;
#pragma unroll
                for (int i = 0; i < 32; ++i) mult += __popcll(__ballot(k[i] == m));
                cum += mult;
                if (cum >= r) { T = m; exact = (cum == r); break; }
                prev = m;
            }
        }
    }
    if (exact) {
#pragma unroll
        for (int i = 0; i < 32; ++i) { const unsigned long long m = __ballot(k[i] >= T); SEL_PUT(i, m); }
    } else {
        int ngt = 0;
#pragma unroll
        for (int i = 0; i < 32; ++i) ngt += __popcll(__ballot(k[i] > T));
        int need = kk - ngt;
#pragma unroll
        for (int i = 0; i < 32; ++i) {
            const unsigned long long eqb = __ballot(k[i] == T);
            const int rank = __builtin_amdgcn_mbcnt_hi((unsigned)(eqb >> 32), __builtin_amdgcn_mbcnt_lo((unsigned)eqb, 0u));
            const bool sel = (k[i] > T) || ((k[i] == T) && (rank < need));
            const unsigned long long m = __ballot(sel);
            need -= __popcll(eqb); if (need < 0) need = 0;
            SEL_PUT(i, m);
        }
    }
    const unsigned long long mine = SEL_MINE;
    if (wave_sum_dpp_i(lane < 32 ? __popcll(mine) : 0) != kk && lane == 0) atomicOr(errw, 1u);
    return mine;
#undef SEL_PUT
#undef SEL_MINE
}
__device__ __forceinline__ void dsa_select(int b, int qb, const bf16* IQb, const bf16* IKb, const float* IW, unsigned char* lds, int lane, int wave, unsigned* errw) {
    lane = launder_i(lane);
    unsigned* keys = (unsigned*)lds; unsigned* maskw = (unsigned*)(lds + DSA_MASK_OFF);
    const size_t rb = (size_t)b * SEQ; const int q0 = qb * 32; const int ntk16 = 4 * ((qb >> 1) + 1);
    const int l15 = lane & 15, l4 = lane >> 4;
    for (int rnd = 0; rnd < 2; ++rnd) {
        const int qb0 = q0 + 16 * rnd;
        bf16x8_t a[4][2]; f32x4 wq[4];
#pragma unroll
        for (int mt = 0; mt < 4; ++mt) {
            const bf16* ar = IQb + (rb + qb0 + 4 * mt + (l15 >> 2)) * 256 + (l15 & 3) * 64 + 8 * l4;
            a[mt][0] = *(const bf16x8_t*)ar; a[mt][1] = *(const bf16x8_t*)(ar + 32);
            wq[mt] = *(const f32x4*)(IW + (rb + qb0 + 4 * mt + l4) * 4);
        }
        bf16x8_t bc[4][2], bn[4][2];
#define DSA_LOADG(dst, ntb) do { _Pragma("unroll") for (int u = 0; u < 4; ++u) { const int nt_ = (ntb) + 8 * u; \
            if (nt_ < ntk16) { const bf16* br = IKb + (rb + 16 * nt_ + l15) * 64 + 8 * l4; dst[u][0] = *(const bf16x8_t*)br; dst[u][1] = *(const bf16x8_t*)(br + 32); } \
            else { dst[u][0] = (bf16x8_t){0, 0, 0, 0, 0, 0, 0, 0}; dst[u][1] = dst[u][0]; } } } while (0)
        DSA_LOADG(bn, wave);
        for (int ntb = wave; ntb < ntk16; ntb += 32) {
#pragma unroll
            for (int u = 0; u < 4; ++u) { bc[u][0] = bn[u][0]; bc[u][1] = bn[u][1]; }
            if (ntb + 32 < ntk16) DSA_LOADG(bn, ntb + 32);
#pragma unroll
            for (int u = 0; u < 4; ++u) {
                const int nt = ntb + 8 * u;
                if (nt < ntk16) {
                    const int s = 16 * nt + l15;
#pragma unroll
                    for (int mt = 0; mt < 4; ++mt) {
                        f32x4 c = (f32x4){0.f, 0.f, 0.f, 0.f};
                        c = __builtin_amdgcn_mfma_f32_16x16x32_bf16(a[mt][0], bc[u][0], c, 0, 0, 0);
                        c = __builtin_amdgcn_mfma_f32_16x16x32_bf16(a[mt][1], bc[u][1], c, 0, 0, 0);
                        float sc = wq[mt][0] * fmaxf(c[0], 0.f); sc = fmaf(wq[mt][1], fmaxf(c[1], 0.f), sc); sc = fmaf(wq[mt][2], fmaxf(c[2], 0.f), sc); sc = fmaf(wq[mt][3], fmaxf(c[3], 0.f), sc);
                        const int ql = 4 * mt + l4, t = qb0 + ql;
                        keys[ql * 2048 + s] = (s <= t) ? __float_as_uint(sc) : 0xff800000u;
                    }
                }
            }
        }
#undef DSA_LOADG
        __syncthreads();
#pragma unroll 1
        for (int j = 0; j < 2; ++j) {
            const int ql = 2 * wave + j, t = qb0 + ql, kk = (t + 1 < TOPK) ? (t + 1) : TOPK, nreg = (t >> 6) + 1;
            float k[32];
#pragma unroll
            for (int i = 0; i < 32; ++i) k[i] = (i < nreg) ? __uint_as_float(keys[ql * 2048 + 64 * i + lane]) : -INFINITY;
            const unsigned long long mine = select_topk(k, kk, t + 1, nreg, lane, (LAS unsigned*)((LAS unsigned char*)lds) + ql * 2048, errw);
            if (lane < 32) *(unsigned long long*)(maskw + (16 * rnd + ql) * DSA_MASK_STRIDE + 2 * lane) = mine;
        }
        __syncthreads();
    }
}

constexpr int LD64 = 72, LD128 = 136;
constexpr int SSD_CM = 0, SSD_BM = 18432, SSD_XS = 36864, SSD_XDT = 55296, SSD_BDT = 72704, SSD_MT = 90112, SSD_HB = 124928, SSD_DTS = 134144, SSD_ACUM = 134656, SSD_CW = 135168;
__device__ __forceinline__ bf16x8_t ldfrag(const bf16* base, int row, int ld, int k0) { return *(const bf16x8_t*)(base + row * ld + k0); }
__device__ __forceinline__ void ssd_item(int b, int h, KPtr P, const bf16* XBC, const float* DT, const bf16* Zb, bf16* ASb, float* SSQP, unsigned char* lds, int tid) {
    tid = launder_i(tid);
    const int lane = tid & 63, w = __builtin_amdgcn_readfirstlane(tid >> 6), l15 = lane & 15, l4 = lane >> 4, g = h >> 2;
    bf16* Cm = (bf16*)(lds + SSD_CM); bf16* Bm = (bf16*)(lds + SSD_BM); bf16* xs = (bf16*)(lds + SSD_XS); bf16* XdtT = (bf16*)(lds + SSD_XDT);
    bf16* BdT = (bf16*)(lds + SSD_BDT); bf16* Mt = (bf16*)(lds + SSD_MT); bf16* Hb = (bf16*)(lds + SSD_HB);
    float* dts = (float*)(lds + SSD_DTS); float* acum = (float*)(lds + SSD_ACUM);
    const float A = -__expf(P->a_log[h]), dtb = P->dt_bias[h], Dh = P->d_skip[h];
    f32x4 Hacc[2]; Hacc[0] = (f32x4){0.f, 0.f, 0.f, 0.f}; Hacc[1] = Hacc[0];
    for (int e = tid; e < 64 * LD64 / 2; e += NT) ((unsigned*)Hb)[e] = 0u;
    float* cwl = (float*)(lds + SSD_CW);
    for (int e = tid; e < 960; e += NT) { const int T = (e < 768) ? (e >> 8) : ((e - 768) >> 6), ch = e & 63, cb = (T == 0) ? h * 64 : (T == 1 ? 512 + g * 64 : 640 + g * 64);
        cwl[e] = (e < 768) ? P->conv_w[((e >> 6) & 3) * 768 + cb + ch] : P->conv_b[cb + ch]; }
    const int pt = w >> 1, ntb = 2 * (w & 1);
    const int sl = tid >> 2, sc0 = (tid & 3) * 16;
    u32x4 raw[3][4][2]; float dtraw = 0.f; u32x2 zc[4], zn[4];
#define SSD_LOADRAW(cc) do { const size_t rb_ = (size_t)b * SEQ + (cc) * 128; const bf16* xr_ = XBC + (rb_ + sl) * 768; \
        _Pragma("unroll") for (int T_ = 0; T_ < 3; ++T_) { const int cb_ = (T_ == 0) ? h * 64 : (T_ == 1 ? 512 + g * 64 : 640 + g * 64); \
            _Pragma("unroll") for (int j_ = 0; j_ < 4; ++j_) { raw[T_][j_][0] = *(const u32x4*)(xr_ + (j_ - 3) * 768 + cb_ + sc0); raw[T_][j_][1] = *(const u32x4*)(xr_ + (j_ - 3) * 768 + cb_ + sc0 + 8); } } } while (0)
#define SSD_PREFETCH(cc, ZD) do { const size_t rb_ = (size_t)b * SEQ + (cc) * 128; \
        if (tid < 128) dtraw = DT[(rb_ + tid) * 8 + h]; \
        _Pragma("unroll") for (int jt_ = 0; jt_ < 4; ++jt_) ZD[jt_] = *(const u32x2*)(Zb + (rb_ + 16 * w + l15) * 512 + h * 64 + 16 * jt_ + 4 * l4); } while (0)
    SSD_PREFETCH(0, zc);
    for (int c = 0; c < SEQ / 128; ++c) {
        const size_t rbase = (size_t)b * SEQ + c * 128;
        SSD_LOADRAW(c);
        if (tid < 128) { const float v = dtraw + dtb; dts[tid] = (v > 20.f) ? v : log1pf(__expf(v)); }
        __syncthreads();
        if (w == 0) {
            const float a0 = dts[2 * lane] * A, a1 = dts[2 * lane + 1] * A; const float s = a0 + a1; float inc = s;
#pragma unroll
            for (int o = 1; o < 64; o <<= 1) { const float v = __shfl_up(inc, o); if (lane >= o) inc += v; }
            const float ex = inc - s; acum[2 * lane] = ex + a0; acum[2 * lane + 1] = ex + s;
        }
        __syncthreads();
        const float alast = acum[127];
        {
            const int l = sl, c0 = sc0;
            const float dtl = dts[l], dec = __expf(alast - acum[l]);
            const int tmin = 3 - (c * 128 + l);
#pragma unroll
            for (int T = 0; T < 3; ++T) {
                u32x4 u[4][2];
#pragma unroll
                for (int j = 0; j < 4; ++j) { u[j][0] = raw[T][j][0]; u[j][1] = raw[T][j][1]; }
                if (c == 0) {
#pragma unroll
                    for (int j = 0; j < 3; ++j) if (j < tmin) { u[j][0] = (u32x4){0u, 0u, 0u, 0u}; u[j][1] = u[j][0]; } }
                float v[16];
#pragma unroll
                for (int i = 0; i < 16; ++i) v[i] = cwl[768 + T * 64 + c0 + i];
#pragma unroll
                for (int j = 0; j < 4; ++j)
#pragma unroll
                    for (int i = 0; i < 16; ++i) { const unsigned wd = u[j][i >> 3][(i >> 1) & 3]; const float xv = (i & 1) ? __uint_as_float(wd & 0xffff0000u) : __uint_as_float(wd << 16);
                        v[i] = fmaf(cwl[(T * 4 + j) * 64 + c0 + i], xv, v[i]); }
#pragma unroll
                for (int i = 0; i < 16; ++i) v[i] = silu(v[i]);
                bf16* dstm = (T == 0) ? xs : (T == 1 ? Bm : Cm);
                u32x4 o0, o1; o0.x = pg8::cvt_pk_bf16(v[0], v[1]); o0.y = pg8::cvt_pk_bf16(v[2], v[3]); o0.z = pg8::cvt_pk_bf16(v[4], v[5]); o0.w = pg8::cvt_pk_bf16(v[6], v[7]);
                o1.x = pg8::cvt_pk_bf16(v[8], v[9]); o1.y = pg8::cvt_pk_bf16(v[10], v[11]); o1.z = pg8::cvt_pk_bf16(v[12], v[13]); o1.w = pg8::cvt_pk_bf16(v[14], v[15]);
                *(u32x4*)(dstm + l * LD64 + c0) = o0; *(u32x4*)(dstm + l * LD64 + c0 + 8) = o1;
                if (T == 0) {
#pragma unroll
                    for (int i = 0; i < 16; ++i) XdtT[(c0 + i) * LD128 + l] = f2bf(v[i] * dtl); }
                if (T == 1) {
#pragma unroll
                    for (int i = 0; i < 16; ++i) BdT[(c0 + i) * LD128 + l] = f2bf(v[i] * dec); }
            }
        }
        if (c + 1 < SEQ / 128) SSD_PREFETCH(c + 1, zn);
        __syncthreads();
        const int lrow = 16 * w + l15; const float al = acum[lrow];
        {
            const bf16x8_t c0f = ldfrag(Cm, lrow, LD64, 8 * l4), c1f = ldfrag(Cm, lrow, LD64, 32 + 8 * l4);
            for (int j = 0; j <= w; ++j) {
                const bf16x8_t bf0 = ldfrag(Bm, 16 * j + l15, LD64, 8 * l4), bf1 = ldfrag(Bm, 16 * j + l15, LD64, 32 + 8 * l4);
                f32x4 acc = (f32x4){0.f, 0.f, 0.f, 0.f};
                acc = __builtin_amdgcn_mfma_f32_16x16x32_bf16(bf0, c0f, acc, 0, 0, 0);
                acc = __builtin_amdgcn_mfma_f32_16x16x32_bf16(bf1, c1f, acc, 0, 0, 0);
                const int s0 = 16 * j + 4 * l4; float m[4];
#pragma unroll
                for (int r = 0; r < 4; ++r) { const int s = s0 + r; m[r] = (s <= lrow) ? acc[r] * __expf(al - acum[s]) : 0.f; }
                u32x2 o; o.x = pg8::cvt_pk_bf16(m[0], m[1]); o.y = pg8::cvt_pk_bf16(m[2], m[3]);
                *(u32x2*)(Mt + lrow * LD128 + s0) = o;
            }
            if ((w & 1) == 0) *(u32x2*)(Mt + lrow * LD128 + 16 * (w + 1) + 4 * l4) = (u32x2){0u, 0u};
        }
        {
            const bf16x8_t c0f = ldfrag(Cm, lrow, LD64, 8 * l4), c1f = ldfrag(Cm, lrow, LD64, 32 + 8 * l4);
            const float ea = __expf(al); const int nks = (w >> 1) + 1;
            float ssq = 0.f;
            bf16x8_t mf[4];
#pragma unroll
            for (int ks = 0; ks < 4; ++ks) mf[ks] = (ks < nks) ? ldfrag(Mt, lrow, LD128, 32 * ks + 8 * l4) : (bf16x8_t){0, 0, 0, 0, 0, 0, 0, 0};
#pragma unroll
            for (int jt = 0; jt < 4; ++jt) {
                bf16x8_t hb0 = ldfrag(Hb, 16 * jt + l15, LD64, 8 * l4), hb1 = ldfrag(Hb, 16 * jt + l15, LD64, 32 + 8 * l4), xd[4];
#pragma unroll
                for (int ks = 0; ks < 4; ++ks) if (ks < nks) xd[ks] = ldfrag(XdtT, 16 * jt + l15, LD128, 32 * ks + 8 * l4);
                f32x4 acc = (f32x4){0.f, 0.f, 0.f, 0.f};
                acc = __builtin_amdgcn_mfma_f32_16x16x32_bf16(hb0, c0f, acc, 0, 0, 0);
                acc = __builtin_amdgcn_mfma_f32_16x16x32_bf16(hb1, c1f, acc, 0, 0, 0);
                acc = acc * ea;
#pragma unroll
                for (int ks = 0; ks < 4; ++ks) if (ks < nks) acc = __builtin_amdgcn_mfma_f32_16x16x32_bf16(xd[ks], mf[ks], acc, 0, 0, 0);
                const int p0 = 16 * jt + 4 * l4;
                const u32x2 xb = *(const u32x2*)(xs + lrow * LD64 + p0);
                const u32x2 zb = zc[jt];
                const float x0 = __uint_as_float(xb.x << 16), x1 = __uint_as_float(xb.x & 0xffff0000u), x2 = __uint_as_float(xb.y << 16), x3 = __uint_as_float(xb.y & 0xffff0000u);
                const float z0 = __uint_as_float(zb.x << 16), z1 = __uint_as_float(zb.x & 0xffff0000u), z2 = __uint_as_float(zb.y << 16), z3 = __uint_as_float(zb.y & 0xffff0000u);
                f32x4 y; y[0] = (acc[0] + Dh * x0) * silu(z0); y[1] = (acc[1] + Dh * x1) * silu(z1); y[2] = (acc[2] + Dh * x2) * silu(z2); y[3] = (acc[3] + Dh * x3) * silu(z3);
                u32x2 yo; yo.x = pg8::cvt_pk_bf16(y[0], y[1]); yo.y = pg8::cvt_pk_bf16(y[2], y[3]);
                *(u32x2*)(ASb + (rbase + lrow) * 1024 + h * 64 + p0) = yo;
                ssq += (y[0] * y[0] + y[1] * y[1]) + (y[2] * y[2] + y[3] * y[3]);
            }
            ssq += __shfl_xor(ssq, 16); ssq += __shfl_xor(ssq, 32);
            if (l4 == 0) SSQP[(rbase + lrow) * 8 + h] = ssq;
        }
        __syncthreads();
        {
            const float el = __expf(alast);
            bf16x8_t xf[4];
#pragma unroll
            for (int ks = 0; ks < 4; ++ks) xf[ks] = ldfrag(XdtT, 16 * pt + l15, LD128, 32 * ks + 8 * l4);
#pragma unroll
            for (int i = 0; i < 2; ++i) {
                bf16x8_t bd[4];
#pragma unroll
                for (int ks = 0; ks < 4; ++ks) bd[ks] = ldfrag(BdT, 16 * (ntb + i) + l15, LD128, 32 * ks + 8 * l4);
                f32x4 acc = Hacc[i] * el;
#pragma unroll
                for (int ks = 0; ks < 4; ++ks) acc = __builtin_amdgcn_mfma_f32_16x16x32_bf16(xf[ks], bd[ks], acc, 0, 0, 0);
                Hacc[i] = acc;
#pragma unroll
                for (int r = 0; r < 4; ++r) Hb[(16 * pt + 4 * l4 + r) * LD64 + 16 * (ntb + i) + l15] = f2bf(acc[r]);
            }
        }
#pragma unroll
        for (int jt = 0; jt < 4; ++jt) zc[jt] = zn[jt];
    }
    __syncthreads();
#undef SSD_PREFETCH
#undef SSD_LOADRAW
}

struct MoeOrder {
    int n; const LAS int* ul;
    __device__ __forceinline__ bool next(int i, pg8::Unit& u) const { if (i >= n) return false; u.pm = ul[2 * i]; u.pn = ul[2 * i + 1]; return true; }
    __device__ __forceinline__ void a_ready(const pg8::Unit&) const {}
    __device__ __forceinline__ void done(const pg8::Unit&) const {}
};
struct EpiSwiGLU {
    static constexpr bool PERM = true, AFTER_DRAIN = false; static constexpr int MID_T = 0;
    bf16* Hid;
    __device__ __forceinline__ void operator()(const pg8::f32x4 (&acc)[2][2][4][2], const pg8::Unit& u, int wr, int wc, int fr, int fq) const {
        const int row0 = u.pm * 256 + wr * 64 + fr, pl = u.pn & 1, hc = 128 * pl + 16 * wc + 4 * fq;
#pragma unroll
        for (int ai = 0; ai < 2; ++ai)
#pragma unroll
            for (int m = 0; m < 4; ++m) { const int row = row0 + ai * 128 + m * 16;
#pragma unroll
                for (int bj = 0; bj < 2; ++bj) { const f32x4 g = acc[ai][bj][m][0], uu = acc[ai][bj][m][1]; f32x4 h;
#pragma unroll
                    for (int e = 0; e < 4; ++e) h[e] = silu(g[e]) * uu[e];
                    u32x2 w; w.x = pg8::cvt_pk_bf16(h[0], h[1]); w.y = pg8::cvt_pk_bf16(h[2], h[3]);
                    *(u32x2*)(Hid + (size_t)row * EFF + hc + 64 * bj) = w; } }
    }
};
struct EpiDown {
    static constexpr bool PERM = true, AFTER_DRAIN = false; static constexpr int MID_T = 0;
    const int* DSTI; const float* WGT; bf16* Y;
    __device__ __forceinline__ void operator()(const pg8::f32x4 (&acc)[2][2][4][2], const pg8::Unit& u, int wr, int wc, int fr, int fq) const {
        const int row0 = u.pm * 256 + wr * 64 + fr, col0 = (u.pn & 3) * 256 + 32 * wc + 8 * fq;
#pragma unroll
        for (int ai = 0; ai < 2; ++ai)
#pragma unroll
            for (int m = 0; m < 4; ++m) { const int row = row0 + ai * 128 + m * 16; const unsigned di = (unsigned)DSTI[row]; const float w = WGT[row];
                bf16* Yr = Y + (size_t)di * DM + col0;
#pragma unroll
                for (int bj = 0; bj < 2; ++bj) { const f32x4 a = acc[ai][bj][m][0] * w, b = acc[ai][bj][m][1] * w;
                    u32x4 o; o.x = pg8::cvt_pk_bf16(a[0], a[1]); o.y = pg8::cvt_pk_bf16(a[2], a[3]); o.z = pg8::cvt_pk_bf16(b[0], b[1]); o.w = pg8::cvt_pk_bf16(b[2], b[3]);
                    *(u32x4*)(Yr + 128 * bj) = o; }
                asm volatile("" ::: "memory"); }
    }
};


__device__ __forceinline__ unsigned wave_select(const unsigned (&keys)[32], int kk, int lane) {
    unsigned T = 0u;
    for (int bit = 31; bit >= 0; --bit) {
        const unsigned cand = T | (1u << bit);
        int c = 0;
#pragma unroll
        for (int i = 0; i < 32; ++i) c += (keys[i] >= cand) ? 1 : 0;
#pragma unroll
        for (int o = 1; o < 64; o <<= 1) c += __shfl_xor(c, o);
        if (c >= kk) T = cand;
    }
    unsigned mgt = 0u, meq = 0u;
#pragma unroll
    for (int i = 0; i < 32; ++i) { mgt |= (keys[i] > T) ? (1u << i) : 0u; meq |= (keys[i] == T) ? (1u << i) : 0u; }
    int ngt = __popc(mgt), neq = __popc(meq);
    int tgt = ngt, teq = neq;
#pragma unroll
    for (int o = 1; o < 64; o <<= 1) { tgt += __shfl_xor(tgt, o); teq += __shfl_xor(teq, o); }
    const int need = kk - tgt;
    if (teq == need) return mgt | meq;
    int pre = neq;
#pragma unroll
    for (int o = 1; o < 64; o <<= 1) { const int v = __shfl_up(pre, o); if (lane >= o) pre += v; }
    pre -= neq;
    unsigned sel = mgt; int taken = pre;
#pragma unroll
    for (int i = 0; i < 32; ++i) { if ((meq >> i) & 1u) { if (taken < need) sel |= (1u << i); ++taken; } }
    return sel;
}

#define XB_TMO      128
#define XB_XCNT(j)  (256  + 64 * (j))
#define XB_XSUB(j)  (1280 + 64 * (j))
#define XB_XGEN(j)  (2304 + 64 * (j))
#define XB_TOP      3328
#define XB_TOPGEN   3392
#define XCD_BAR_WORDS 3456
#define XB_SPIN_CAP (1u << 18)

__device__ __forceinline__ unsigned xb_ld(unsigned* p)              { return __hip_atomic_load(p, __ATOMIC_RELAXED, __HIP_MEMORY_SCOPE_AGENT); }
__device__ __forceinline__ unsigned xb_add(unsigned* p, unsigned v) { return __hip_atomic_fetch_add(p, v, __ATOMIC_RELAXED, __HIP_MEMORY_SCOPE_AGENT); }
__device__ __forceinline__ unsigned xb_xcc_id() { return (unsigned)__builtin_amdgcn_s_getreg((3 << 11) | 20) & 0xFu; }
#define XB_SPIN(cond, bar) do { unsigned _sp = 0; while (cond) { __builtin_amdgcn_s_sleep(1); \
    if ((++_sp & 255u) == 0u) { if (xb_ld(&(bar)[XB_TMO])) break; if (_sp > XB_SPIN_CAP) { atomicAdd(&(bar)[XB_TMO], 1u); break; } } } } while (0)

struct XcdBarrier {
    unsigned* bar; unsigned x;
    volatile LAS unsigned* st;
};

__device__ __forceinline__ XcdBarrier xcd_barrier_post(unsigned* bar, volatile LAS unsigned* st, const int wave_s) {
    XcdBarrier b; b.bar = bar; b.x = xb_xcc_id(); b.st = st;
    if (wave_s == 0 && lane_id() == 0) (void)xb_add(&bar[XB_XCNT(b.x)], 1u);
    return b;
}
__device__ __forceinline__ void xcd_barrier_complete(unsigned* bar, unsigned x, unsigned& nloc, unsigned& nx) {
    const unsigned G = gridDim.x * gridDim.y * gridDim.z;
    unsigned sum, cnt, mine, sp = 0u;
    for (;;) {
        sum = 0u; cnt = 0u; mine = 0u;
#pragma unroll
        for (unsigned j = 0; j < 16; ++j) { const unsigned c = xb_ld(&bar[XB_XCNT(j)]); sum += c; cnt += (c > 0u) ? 1u : 0u; mine = (j == x) ? c : mine; }
        if (sum == G) break;
        __builtin_amdgcn_s_sleep(1);
        if ((++sp & 255u) == 0u) { if (xb_ld(&bar[XB_TMO])) break; if (sp > XB_SPIN_CAP) { atomicAdd(&bar[XB_TMO], 1u); break; } }
    }
    nloc = mine > 0u ? mine : 1u; nx = cnt > 0u ? cnt : 1u;
}

__device__ __forceinline__ void xcd_barrier(const XcdBarrier& b, const int wave_s) {
    asm volatile("s_waitcnt vmcnt(0)" ::: "memory");
    __syncthreads();
    if (wave_s == 0 && lane_id() == 0) {
        unsigned* bar = b.bar;
        __builtin_amdgcn_s_waitcnt(0);
        unsigned nloc = b.st[0], nx = b.st[1];
        if (nloc == 0u) { xcd_barrier_complete(bar, b.x, nloc, nx); b.st[0] = nloc; b.st[1] = nx; }
        const unsigned old = xb_add(&bar[XB_XSUB(b.x)], 1u);
        const unsigned gen = old / nloc;
        if (old + 1u == (gen + 1u) * nloc) {
            __builtin_amdgcn_fence(__ATOMIC_RELEASE, "agent");
            asm volatile("s_waitcnt vmcnt(0)" ::: "memory");
            const unsigned og = xb_add(&bar[XB_TOP], 1u);
            const unsigned tg = og / nx;
            if (og + 1u == (tg + 1u) * nx) xb_add(&bar[XB_TOPGEN], 1u);
            else XB_SPIN(xb_ld(&bar[XB_TOPGEN]) == tg, bar);
            __builtin_amdgcn_fence(__ATOMIC_ACQUIRE, "agent");
            xb_add(&bar[XB_XGEN(b.x)], 1u);
            asm volatile("s_waitcnt vmcnt(0)" ::: "memory");
        } else {
            XB_SPIN(xb_ld(&bar[XB_XGEN(b.x)]) == gen, bar);
            __builtin_amdgcn_fence(__ATOMIC_ACQUIRE, "agent");
            asm volatile("s_waitcnt vmcnt(0)" ::: "memory");
        }
    }
    __syncthreads();
}


#define PHASE_VARS const KPtr P = launder_k(KP0); const int wave = wave_s, lane = launder_i(lane_id()), tid = wave * 64 + lane, gw = bid * 8 + wave; unsigned char* ws = P->ws; unsigned* ctl = (unsigned*)(ws + WS_CTL); float2* rope = (float2*)(ws + WS_ROPE); float* tokw = (float*)(ws + WS_TOKW); int* lists = (int*)(ws + WS_LISTS); bf16* Qb = (bf16*)(ws + WS_Q); bf16* Kb = (bf16*)(ws + WS_K); bf16* Vb = (bf16*)(ws + WS_V); bf16* IKb = (bf16*)(ws + WS_IK); float* IW = (float*)(ws + WS_IW); float* DT = (float*)(ws + WS_DT); bf16* IQb = (bf16*)(ws + WS_IQ); bf16* Zb = (bf16*)(ws + WS_Z); bf16* XBC = (bf16*)(ws + WS_XBC); bf16* ASb = (bf16*)(ws + WS_AS); float* X1 = (float*)(ws + WS_X1); bf16* X1b = (bf16*)(ws + WS_X1B); bf16* Y0 = (bf16*)(ws + WS_Y0); bf16* Y1 = (bf16*)(ws + WS_Y1); float* SSQP = (float*)(ws + WS_SSQP); bf16* H1b = (bf16*)(ws + WS_X1); float* WGG = (float*)(ws + WS_RCONST + 4096); bf16* WguT = (bf16*)(ws + WS_WGU_T); bf16* WdT = (bf16*)(ws + WS_WD_T); int* ENT = (int*)(ws + WS_ENT); float* WGT = (float*)(ws + WS_ENT + 512 * 1024); int* ROWT = (int*)(ws + WS_ENT + 1024 * 1024); bf16* Xs = (bf16*)(ws + WS_XS); bf16* Hid = (bf16*)(ws + WS_HID); bf16* XB = (bf16*)(ws + WS_XB); bf16* WinT = (bf16*)(ws + WS_WIN_T); bf16* WoutT = (bf16*)(ws + WS_WOUT_T);
#ifndef PROBE_MASK
#define PROBE_MASK 0
#endif
#define STAMP(k) do { if (PROBE_MASK && bid == 0 && wave_s == 0 && lane_id() == 0) { const unsigned long long now_ = __builtin_amdgcn_s_memrealtime(); if ((PROBE_MASK >> (k)) & 1) pst[1] += now_ - pst[0]; pst[0] = now_; } } while (0)
__global__ void __launch_bounds__(NT, 2) hybrid_fwd(Params p) {
    extern __shared__ __attribute__((aligned(16))) unsigned char lds[];
    cg::grid_group grid = cg::this_grid();
    const int wave_s = __builtin_amdgcn_readfirstlane((int)threadIdx.x >> 6);
    const int G = gridDim.x, bid = blockIdx.x, NGW = G * 8;
    const KPtr KP0 = (KPtr)__builtin_amdgcn_kernarg_segment_ptr();
    volatile LAS unsigned* xst = (volatile LAS unsigned*)((LAS unsigned char*)lds + LDS_BYTES - 32);
    if (wave_s == 0 && lane_id() < 4) xst[lane_id()] = 0u;
    __syncthreads();
    const XcdBarrier xbar = xcd_barrier_post((unsigned*)(KP0->ws + WS_CTL) + CW_BAR, xst, wave_s);
    if (KP0->ws == nullptr) grid.sync();
#define GRID_SYNC() xcd_barrier(xbar, wave_s)
    volatile LAS unsigned long long* pst = (volatile LAS unsigned long long*)((LAS unsigned char*)lds + LDS_BYTES - 96);
    if (PROBE_MASK && bid == 0 && wave_s == 0 && lane_id() == 0) { pst[0] = __builtin_amdgcn_s_memrealtime(); pst[1] = 0ull; }
    {   PHASE_VARS
    for (int e = bid * NT + tid; e < SEQ * 32; e += G * NT) {
        const int t = e >> 5, i = e & 31;
        const float inv = powf(10000.0f, -(float)(2 * i) / 64.0f);
        const float ang = (float)t * inv;
        float s, c; sincosf(ang, &s, &c);
        rope[e] = make_float2(c, s);
    }
    for (int e = bid * NT + tid; e < 52 * 128; e += G * NT) {
        const int r = e >> 7, c = e & 127; const int row = (r < 4) ? (512 + 196 + r) : (512 + 208 + (r - 4));
        *(u32x4*)(WinT + (size_t)row * DM + c * 8) = (u32x4){0u, 0u, 0u, 0u};
    }
    {
        LAS float* scr = (LAS float*)((LAS unsigned char*)lds + wave * 16384);
        constexpr int I_IN = (DM / 64) * ((INW + 31) / 32), I_OUT = (DM / 64) * (DM / 32), I_GU = NEXP * 2 * 128, I_D = NEXP * 128;
        for (int it = launder_i(gw); it < I_IN; it += NGW) {
            int r = it;
            if (r < I_IN) { transpose_item(P->w_in, DM, INW, WinT, scr, r, lane, [](int c) { return win_dest_row(c); }, [](int k, float&) { return k; }); continue; } r -= I_IN;
        }
    }
    for (int e = bid * NT + tid; e < DM * 20; e += G * NT) { const int k = e / 20, j = e - k * 20; WGG[e] = P->ln1_g[k] * ((j < 4) ? P->w_rg[k * 4 + j] : P->w_re[k * 16 + (j - 4)]); }
    if (wave == 0 && bid >= G - 20) {
        float* rc = (float*)(ws + WS_RCONST); const int j = G - 1 - bid;
        float wv[16], gv[16], bv[16];
#pragma unroll
        for (int i = 0; i < 16; ++i) { const int k = lane + 64 * i; wv[i] = (j < 4) ? P->w_rg[k * 4 + j] : P->w_re[k * 16 + (j - 4)]; gv[i] = P->ln1_g[k]; bv[i] = P->ln1_b[k]; }
        float gs = 0.f, bs = 0.f;
#pragma unroll
        for (int i = 0; i < 16; ++i) { gs = fmaf(gv[i], wv[i], gs); bs = fmaf(bv[i], wv[i], bs); }
        gs = wave_sum(gs); bs = wave_sum(bs);
        if (lane == 0) { rc[j] = gs; rc[20 + j] = bs + ((j < 4) ? P->b_rg[j] : P->b_re[j - 4]); }
    }
    {
        const size_t NP = (size_t)M * DM / 8, stride = (size_t)G * NT;
        for (size_t e0 = (size_t)bid * NT + tid; e0 < NP; e0 += 4 * stride) {
            f32x4 a[4], b[4];
#pragma unroll
            for (int u = 0; u < 4; ++u) { const size_t e = e0 + u * stride; if (e < NP) { a[u] = *(const f32x4*)(P->x + e * 8); b[u] = *(const f32x4*)(P->x + e * 8 + 4); } }
#pragma unroll
            for (int u = 0; u < 4; ++u) { const size_t e = e0 + u * stride; if (e < NP) {
                u32x4 w; w.x = pg8::cvt_pk_bf16(a[u][0], a[u][1]); w.y = pg8::cvt_pk_bf16(a[u][2], a[u][3]); w.z = pg8::cvt_pk_bf16(b[u][0], b[u][1]); w.w = pg8::cvt_pk_bf16(b[u][2], b[u][3]);
                *(u32x4*)(XB + e * 8) = w; } }
        }
    }
    }
    GRID_SYNC(); STAMP(0);
    {   PHASE_VARS
    {
        pg8::Gemm g{XB, WinT, M, NPAD, DM}; pg8::StaticOrder S; S.init(M, NPAD, G, bid);
        EpiInProj E{Qb, Kb, Vb, IKb, IQb, Zb, XBC, IW, DT, rope};
        pg8::gemm_phase<EpiInProj, pg8::StaticOrder, true, true>((PG8_LAS unsigned char*)lds, g, S, E, wave_s);
    }
    {
        LAS float* scr = (LAS float*)((LAS unsigned char*)lds + wave * 16384);
        constexpr int I_OUT = (DM / 64) * (DM / 32), I_GU = NEXP * 2 * 128, I_D = NEXP * 128, I_ALL = I_OUT + I_GU + I_D;
        for (;;) {
            int base = 0; if (lane == 0) base = (int)atomicAdd(&ctl[CW_WQ], 8u);
            base = __builtin_amdgcn_readfirstlane(base); if (base >= I_ALL) break;
            for (int it = base; it < base + 8 && it < I_ALL; ++it) {
                int r = it;
                if (r < I_OUT) { { const float* nw = P->ssd_norm_w; transpose_item(P->w_out, DM, DM, WoutT, scr, r, lane, [](int c) { return c; }, [nw](int k, float& sc) { if (k < 512) { sc = nw[k]; return k + 512; } return k - 512; }); } continue; } r -= I_OUT;
                if (r < I_GU) { const int e = r >> 8, up = (r >> 7) & 1, sub = r & 127; const float* W = (up ? P->w_up : P->w_gate) + (size_t)e * DM * EFF;
                transpose_item(W, DM, EFF, WguT + (size_t)e * 512 * DM, scr, sub, lane, [up](int c) { return 8 * (c >> 2) + 4 * up + (c & 3); }, [](int k, float&) { return k; }); continue; } r -= I_GU;
                { const int e = r >> 7, sub = r & 127; transpose_item(P->w_down + (size_t)e * EFF * DM, EFF, DM, WdT + (size_t)e * DM * EFF, scr, sub, lane, [](int c) { return c; }, [](int k, float&) { return k; }); }
            }
        }
    }
    }
    GRID_SYNC(); STAMP(1);
    {   PHASE_VARS
    for (int item = bid; item < BATCH * 8; item += G) ssd_item(__builtin_amdgcn_readfirstlane(item >> 3), __builtin_amdgcn_readfirstlane(item & 7), P, XBC, DT, Zb, ASb, SSQP, lds, tid);
    {
        volatile int* qslot = (volatile int*)(lds + LDS_BYTES - 64);
        const unsigned xcc = (unsigned)__builtin_amdgcn_s_getreg((3 << 11) | 20) & 7u;
        for (;;) {
            __syncthreads();
            if (tid == 0) { int pi = -1;
                for (unsigned a = 0; a < 8 && pi < 0; ++a) { const unsigned q = (xcc + a) & 7u; const unsigned idx = atomicAdd(&ctl[CW_DSAQ + 16 * q], 1u); if (idx < 128u) pi = (int)(q * 128u + idx); }
                *qslot = pi; }
            __syncthreads();
            const int pi = __builtin_amdgcn_readfirstlane(*qslot); if (pi < 0) break;
            const int q = pi >> 7, idx = pi & 127, b = q + 8 * (idx & 1), qb = 63 - (idx >> 1);
            dsa_select(b, qb, IQb, IKb, IW, lds, lane, wave_s, &ctl[CW_ERR]);
            attn_body::attn_unit<8>(b, qb, Qb, Kb, Vb, ASb, (char*)lds, (const char*)lds + DSA_MASK_OFF, wave_s);
        }
    }
    }
    GRID_SYNC(); STAMP(2);
    {   PHASE_VARS
    {
        pg8::Gemm g{ASb, WoutT, M, DM, DM}; pg8::StaticOrder S; S.init(M, DM, G, bid);
        EpiH1 E{P->x, H1b, SSQP};
        pg8::gemm_phase<EpiH1, pg8::StaticOrder, true, true>((PG8_LAS unsigned char*)lds, g, S, E, wave_s);
    }
    }
    GRID_SYNC(); STAMP(4);
    {   PHASE_VARS
    {
        float* Wg = (float*)lds;
        int* lcnt = (int*)(lds + 81920); int* lbase = lcnt + 16; int* rec = lbase + 16;
        float* recw = (float*)(rec + 4 * 128);
        float* rlg = recw + 2 * 128;
        float* rstat = rlg + 20 * 128;
        { f32x4 t4[10];
#pragma unroll
          for (int i = 0; i < 10; ++i) t4[i] = ((const f32x4*)WGG)[tid + NT * i];
#pragma unroll
          for (int i = 0; i < 10; ++i) ((f32x4*)Wg)[tid + NT * i] = t4[i]; }
        if (tid < 16) lcnt[tid] = 0;
        __syncthreads();
        const int rows_per_wave = M / NGW;
        const int l15 = lane & 15, ph = lane >> 4;
        {
            const bf16* hr = H1b + (size_t)(gw + NGW * l15) * DM + 4 * ph;
            const float* wb0 = Wg + (4 * ph) * 20 + l15; const float* wb1 = Wg + (4 * ph) * 20 + 16 + (l15 < 4 ? l15 : 3);
            f32x4 c0 = (f32x4){0.f, 0.f, 0.f, 0.f}, c1 = c0; float s = 0.f, ss = 0.f;
            u32x2 an[8];
#pragma unroll
            for (int u = 0; u < 8; ++u) an[u] = *(const u32x2*)(hr + 16 * u);
#pragma unroll 1
            for (int i0 = 0; i0 < 64; i0 += 8) {
                f32x4 a[8];
#pragma unroll
                for (int u = 0; u < 8; ++u) { a[u][0] = __uint_as_float(an[u].x << 16); a[u][1] = __uint_as_float(an[u].x & 0xffff0000u); a[u][2] = __uint_as_float(an[u].y << 16); a[u][3] = __uint_as_float(an[u].y & 0xffff0000u); }
                if (i0 + 8 < 64) {
#pragma unroll
                    for (int u = 0; u < 8; ++u) an[u] = *(const u32x2*)(hr + 16 * (i0 + 8 + u)); }
#pragma unroll
                for (int u = 0; u < 8; ++u) {
                    s += (a[u][0] + a[u][1]) + (a[u][2] + a[u][3]); ss += (a[u][0] * a[u][0] + a[u][1] * a[u][1]) + (a[u][2] * a[u][2] + a[u][3] * a[u][3]);
#pragma unroll
                    for (int e = 0; e < 4; ++e) { const int ko = (16 * (i0 + u) + e) * 20;
                        c0 = __builtin_amdgcn_mfma_f32_16x16x4f32(a[u][e], wb0[ko], c0, 0, 0, 0);
                        c1 = __builtin_amdgcn_mfma_f32_16x16x4f32(a[u][e], wb1[ko], c1, 0, 0, 0); }
                }
            }
            { const int ln2 = launder_i(lane); const int i16 = (ln2 ^ 16) << 2, i32 = (ln2 ^ 32) << 2;
              s += __builtin_bit_cast(float, __builtin_amdgcn_ds_bpermute(i16, __builtin_bit_cast(int, s))); s += __builtin_bit_cast(float, __builtin_amdgcn_ds_bpermute(i32, __builtin_bit_cast(int, s)));
              ss += __builtin_bit_cast(float, __builtin_amdgcn_ds_bpermute(i16, __builtin_bit_cast(int, ss))); ss += __builtin_bit_cast(float, __builtin_amdgcn_ds_bpermute(i32, __builtin_bit_cast(int, ss))); }
            const float mean = s * (1.f / DM), var = ss * (1.f / DM) - mean * mean;
            if (ph == 0) { rstat[(wave * 16 + l15) * 2] = mean; rstat[(wave * 16 + l15) * 2 + 1] = rsqrtf(var + LN_EPS); }
#pragma unroll
            for (int r = 0; r < 4; ++r) { const int rl = wave * 16 + 4 * ph + r; rlg[rl * 20 + l15] = c0[r]; if (l15 < 4) rlg[rl * 20 + 16 + l15] = c1[r]; }
        }
        __syncthreads();
        {
            f32x4 gg[4], bb[4];
#pragma unroll
            for (int j = 0; j < 4; ++j) { gg[j] = *(const f32x4*)(P->ln1_g + lane * 4 + 256 * j); bb[j] = *(const f32x4*)(P->ln1_b + lane * 4 + 256 * j); }
            for (int it = 0; it < rows_per_wave; it += 4) {
                f32x4 v[4][4];
#pragma unroll
                for (int r = 0; r < 4; ++r)
#pragma unroll
                    for (int j = 0; j < 4; ++j) { const u32x2 hb = *(const u32x2*)(H1b + (size_t)(gw + NGW * (it + r)) * DM + lane * 4 + 256 * j);
                        v[r][j][0] = __uint_as_float(hb.x << 16); v[r][j][1] = __uint_as_float(hb.x & 0xffff0000u); v[r][j][2] = __uint_as_float(hb.y << 16); v[r][j][3] = __uint_as_float(hb.y & 0xffff0000u); }
#pragma unroll
                for (int r = 0; r < 4; ++r) { const float mean = rstat[(wave * 16 + it + r) * 2], rstd = rstat[(wave * 16 + it + r) * 2 + 1];
#pragma unroll
                    for (int j = 0; j < 4; ++j) { const f32x4 o = (v[r][j] - mean) * rstd * gg[j] + bb[j]; u32x2 w; w.x = pg8::cvt_pk_bf16(o[0], o[1]); w.y = pg8::cvt_pk_bf16(o[2], o[3]);
                        *(u32x2*)(X1b + (size_t)(gw + NGW * (it + r)) * DM + lane * 4 + 256 * j) = w; } }
            }
        }
        const float* rc = (const float*)(ws + WS_RCONST);
        for (int rl = tid; rl < 8 * rows_per_wave; rl += NT) {
            const float mean = rstat[rl * 2], rstd = rstat[rl * 2 + 1];
            float lg[20];
#pragma unroll
            for (int j = 0; j < 20; ++j) lg[j] = rstd * (rlg[rl * 20 + j] - mean * rc[j]) + rc[20 + j];
            int gi = 0; float gm = lg[0];
#pragma unroll
            for (int i = 1; i < 4; ++i) if (lg[i] > gm) { gm = lg[i]; gi = i; }
            float gs = 0.f;
#pragma unroll
            for (int i = 0; i < 4; ++i) gs += __expf(lg[i] - gm);
            const float gprob = 1.f / gs;
            float el[4];
#pragma unroll
            for (int i = 0; i < 4; ++i) { float v0 = 0.f;
#pragma unroll
                for (int g2 = 0; g2 < 4; ++g2) if (g2 == gi) v0 = lg[4 + g2 * 4 + i];
                el[i] = v0; }
            int i0 = 0; float m0 = el[0];
#pragma unroll
            for (int i = 1; i < 4; ++i) if (el[i] > m0) { m0 = el[i]; i0 = i; }
            int i1 = -1; float m1 = -INFINITY;
#pragma unroll
            for (int i = 0; i < 4; ++i) if (i != i0 && el[i] > m1) { m1 = el[i]; i1 = i; }
            const float e1 = __expf(m1 - m0), inv = 1.f / (1.f + e1);
            const int ex0 = gi * 4 + i0, ex1 = gi * 4 + i1;
            rec[rl * 4 + 0] = ex0; rec[rl * 4 + 1] = atomicAdd(&lcnt[ex0], 1); rec[rl * 4 + 2] = ex1; rec[rl * 4 + 3] = atomicAdd(&lcnt[ex1], 1);
            recw[rl * 2] = inv * gprob; recw[rl * 2 + 1] = e1 * inv * gprob;
        }
        __syncthreads();
        if (tid < 16) lbase[tid] = (int)atomicAdd(&ctl[CW_CNT + 64 * tid], (unsigned)lcnt[tid]);
        __syncthreads();
        for (int rl = tid; rl < 8 * rows_per_wave; rl += NT) {
            const int row = (bid * 8 + rl / rows_per_wave) + NGW * (rl % rows_per_wave);
            const int e0 = rec[rl * 4], e1x = rec[rl * 4 + 2];
            lists[(size_t)e0 * M + lbase[e0] + rec[rl * 4 + 1]] = row * 2; lists[(size_t)e1x * M + lbase[e1x] + rec[rl * 4 + 3]] = row * 2 + 1;
            tokw[row * 2] = recw[rl * 2]; tokw[row * 2 + 1] = recw[rl * 2 + 1];
        }
    }
    }
    GRID_SYNC(); STAMP(5);
    {   PHASE_VARS
    int* tb = (int*)(lds + 135168);
    if (tid < NEXP) tb[32 + tid] = (int)((__hip_atomic_load(&ctl[CW_CNT + 64 * tid], __ATOMIC_RELAXED, __HIP_MEMORY_SCOPE_AGENT) + 255u) >> 8);
    __syncthreads();
    if (tid == 0) { int a = 0; for (int e = 0; e < NEXP; ++e) { tb[e] = a; a += tb[32 + e]; } tb[NEXP] = a; }
    __syncthreads();
    const int ntiles = tb[NEXP];
    for (int sr = bid * NT + tid; sr < ntiles * 256; sr += G * NT) {
        const int rt = sr >> 8; int e = 0;
#pragma unroll
        for (int j = 1; j < NEXP; ++j) if (rt >= tb[j]) e = j;
        const int slot = sr - tb[e] * 256; const int cnt_e = (int)__hip_atomic_load(&ctl[CW_CNT + 64 * e], __ATOMIC_RELAXED, __HIP_MEMORY_SCOPE_AGENT);
        const int en = (slot < cnt_e) ? lists[(size_t)e * M + slot] : -1;
        ENT[sr] = (en >= 0) ? ((en & 1) * M + (en >> 1)) : 2 * M; WGT[sr] = (en >= 0) ? tokw[en] : 0.f; ROWT[sr] = (en >= 0) ? (en >> 1) : 0;
    }
    }
    GRID_SYNC(); STAMP(6);
    {   PHASE_VARS
    const LAS int* tb = (const LAS int*)((LAS unsigned char*)lds + 135168); const int ntiles = tb[NEXP];
    {
        LAS int* ul = (LAS int*)((LAS unsigned char*)lds + 135168 + 128); int n = 0;
        if (tid == 0) { for (int L = bid; L < ntiles * 2; L += G) { const int rt = L >> 1; int e = 0; for (int j = 1; j < NEXP; ++j) if (rt >= tb[j]) e = j; ul[2 * n] = rt; ul[2 * n + 1] = e * 2 + (L & 1); ++n; } ul[62] = n; }
        __syncthreads(); n = ul[62];
        LAS int* rtl = (LAS int*)((LAS unsigned char*)lds + 135168 + 512);
        for (int e = tid; e < n * 256; e += NT) rtl[e] = ROWT[ul[2 * (e >> 8)] * 256 + (e & 255)];
        __syncthreads();
        pg8::Gemm g{X1b, WguT, MAXROWS, 512, DM}; MoeOrder S{n, ul};
        EpiSwiGLU E{Hid};
        pg8::gemm_phase<EpiSwiGLU, MoeOrder, true, true, true>((PG8_LAS unsigned char*)lds, g, S, E, wave_s, rtl);
    }
    }
    GRID_SYNC(); STAMP(7);
    {   PHASE_VARS
    const LAS int* tb = (const LAS int*)((LAS unsigned char*)lds + 135168); const int ntiles = tb[NEXP];
    {
        LAS int* ul = (LAS int*)((LAS unsigned char*)lds + 135168 + 128); int n = 0;
        __syncthreads();
        if (tid == 0) { for (int L = bid; L < ntiles * 4; L += G) { const int rt = L >> 2; int e = 0; for (int j = 1; j < NEXP; ++j) if (rt >= tb[j]) e = j; ul[2 * n] = rt; ul[2 * n + 1] = e * 4 + (L & 3); ++n; } ul[62] = n; }
        __syncthreads(); n = ul[62];
        pg8::Gemm g{Hid, WdT, MAXROWS, DM, EFF}; MoeOrder S{n, ul};
        EpiDown E{ENT, WGT, Y0};
        pg8::gemm_phase<EpiDown, MoeOrder, true, true>((PG8_LAS unsigned char*)lds, g, S, E, wave_s);
    }
    }
    GRID_SYNC(); STAMP(8);
    {   PHASE_VARS
    const bool poison = __hip_atomic_load(&ctl[CW_ERR], __ATOMIC_RELAXED, __HIP_MEMORY_SCOPE_AGENT) != 0u; const float qnan = __builtin_nanf("");
    for (int row = launder_i(gw); row < M; row += NGW) {
        f32x4 v[4]; float s = 0.f;
#pragma unroll
        for (int j = 0; j < 4; ++j) { const int c0 = lane * 4 + 256 * j; const u32x2 xb = *(const u32x2*)(X1b + (size_t)row * DM + c0);
            v[j][0] = __uint_as_float(xb.x << 16) * ALPHA; v[j][1] = __uint_as_float(xb.x & 0xffff0000u) * ALPHA; v[j][2] = __uint_as_float(xb.y << 16) * ALPHA; v[j][3] = __uint_as_float(xb.y & 0xffff0000u) * ALPHA;
            const u32x2 a = *(const u32x2*)(Y0 + (size_t)row * DM + c0), b = *(const u32x2*)(Y1 + (size_t)row * DM + c0);
            v[j][0] += __uint_as_float(a.x << 16) + __uint_as_float(b.x << 16); v[j][1] += __uint_as_float(a.x & 0xffff0000u) + __uint_as_float(b.x & 0xffff0000u);
            v[j][2] += __uint_as_float(a.y << 16) + __uint_as_float(b.y << 16); v[j][3] += __uint_as_float(a.y & 0xffff0000u) + __uint_as_float(b.y & 0xffff0000u);
            s += (v[j][0] + v[j][1]) + (v[j][2] + v[j][3]); }
        const float mean = wave_sum(s) * (1.f / DM); float s2 = 0.f;
#pragma unroll
        for (int j = 0; j < 4; ++j) { v[j] = v[j] - mean; s2 += (v[j][0] * v[j][0] + v[j][1] * v[j][1]) + (v[j][2] * v[j][2] + v[j][3] * v[j][3]); }
        const float rstd = rsqrtf(wave_sum(s2) * (1.f / DM) + LN_EPS);
#pragma unroll
        for (int j = 0; j < 4; ++j) { const int c0 = lane * 4 + 256 * j;
            const f32x4 gg = *(const f32x4*)(P->ln2_g + c0), bb = *(const f32x4*)(P->ln2_b + c0);
            f32x4 o = v[j] * rstd * gg + bb; if (poison) o = (f32x4){qnan, qnan, qnan, qnan};
            *(f32x4*)(P->out + (size_t)row * DM + c0) = o; }
    }
    }
    STAMP(9);
    if (PROBE_MASK && bid == 0 && wave_s == 0 && lane_id() == 0) { const unsigned long long t0 = __builtin_amdgcn_s_memrealtime(), d = 8ull * pst[1]; while (__builtin_amdgcn_s_memrealtime() - t0 < d) __builtin_amdgcn_s_sleep(8); }
}

extern "C" void kernel_launch(void* const* d_in, const int* in_sizes, int n_in, void* d_out, int out_size, void* d_ws, size_t ws_size, hipStream_t stream) {
    static int grid = 0;
    if (grid == 0) {
        if (n_in != 20 || in_sizes[0] != M * DM || out_size != M * DM || ws_size < WS_END) { fprintf(stderr, "kernel_launch: unexpected shapes (n_in %d, in0 %d, out %d, ws %zu)\n", n_in, n_in > 0 ? in_sizes[0] : -1, out_size, ws_size); grid = -1; return; }
        int dev = 0, cus = 0, per_cu = 0;
        (void)hipGetDevice(&dev);
        (void)hipDeviceGetAttribute(&cus, hipDeviceAttributeMultiprocessorCount, dev);
        (void)hipFuncSetAttribute((const void*)hybrid_fwd, hipFuncAttributeMaxDynamicSharedMemorySize, LDS_BYTES);
        (void)hipOccupancyMaxActiveBlocksPerMultiprocessor(&per_cu, (const void*)hybrid_fwd, NT, LDS_BYTES);
        if (per_cu < 1) { fprintf(stderr, "kernel_launch: occupancy query says %d blocks/CU\n", per_cu); grid = -1; return; }
        grid = cus;
    }
    if (grid < 0) return;
    (void)hipMemsetAsync((char*)d_ws + WS_CTL, 0, CTL_BYTES, stream);
    Params p{};
    const float** f = (const float**)&p;
    for (int i = 0; i < 20; ++i) f[i] = (const float*)d_in[i];
    p.out = (float*)d_out; p.ws = (unsigned char*)d_ws;
    void* args[] = {&p};
    hipError_t e = hipLaunchCooperativeKernel((const void*)hybrid_fwd, dim3(grid), dim3(NT), args, LDS_BYTES, stream);
    if (e != hipSuccess) fprintf(stderr, "cooperative launch failed: %s (grid %d)\n", hipGetErrorString(e), grid);
}
```

```cpp
#include <hip/hip_runtime.h>
#include <hip/hip_cooperative_groups.h>
#include <cstdio>
#include <cstdint>
namespace cg = cooperative_groups;

constexpr int BATCH = 16, SEQ = 2048, DM = 1024, M = BATCH * SEQ;
constexpr int INW = 2252;
constexpr int C_Q = 0, C_K = 512, C_V = 576, C_IQ = 640, C_IK = 896, C_IW = 960, C_Z = 964, C_XBC = 1476, C_DT = 2244;
constexpr int NEXP = 16, EFF = 256;
constexpr float LN_EPS = 1e-5f;
constexpr float ALPHA = 1.189207115002721f;
constexpr float INDEXER_SCALE = 0.0625f;
constexpr float QSCALE = 0.125f * 1.4426950408889634f;
constexpr int TOPK = 256;
constexpr int NT = 512;
constexpr int LDS_BYTES = 147456;

constexpr size_t MiB = 1u << 20;
constexpr size_t WS_CTL = 0, CTL_BYTES = 1 * MiB;
constexpr size_t WS_ROPE = 1 * MiB;
constexpr size_t WS_TOKW = 2 * MiB;
constexpr size_t WS_LISTS = 3 * MiB;
constexpr size_t WS_WIN_T = 8 * MiB;
constexpr size_t WS_WOUT_T = 16 * MiB;
constexpr size_t WS_WGU_T = 18 * MiB;
constexpr size_t WS_WD_T = 34 * MiB;
constexpr size_t WS_RCONST = 7 * MiB;
constexpr size_t WS_ENT = 5 * MiB;
constexpr size_t WS_XS = 48 * MiB;
constexpr size_t WS_HID = 192 * MiB;
constexpr int MAXTILES = 272, MAXROWS = MAXTILES * 256;
constexpr size_t WS_XB = 256 * MiB;
constexpr int NPAD = 2304;
constexpr size_t WS_Q = 48 * MiB;
constexpr size_t WS_K = 80 * MiB, WS_V = 84 * MiB, WS_IK = 88 * MiB;
constexpr size_t WS_IW = 92 * MiB;
constexpr size_t WS_DT = 93 * MiB;
constexpr size_t WS_IQ = 96 * MiB;
constexpr size_t WS_Z = 112 * MiB;
constexpr size_t WS_XBC = 144 * MiB;
constexpr size_t WS_AS = 192 * MiB;
constexpr size_t WS_X1 = 256 * MiB;
constexpr size_t WS_X1B = 384 * MiB;
constexpr size_t WS_Y0 = 48 * MiB, WS_Y1 = 112 * MiB;
constexpr size_t WS_P32 = 224 * MiB;
constexpr size_t WS_XC = 256 * MiB;
constexpr size_t WS_SSQP = 42 * MiB;
constexpr size_t WS_END = 512 * MiB;
constexpr int CW_CNT = 8192;
constexpr int CW_BAR = 4096;
constexpr int CW_ERR = 32;
constexpr int CW_WQ = 48;
constexpr int CW_DSAQ = 128;

typedef unsigned short bf16;
typedef float f32x4 __attribute__((ext_vector_type(4)));
typedef unsigned u32x4 __attribute__((ext_vector_type(4)));
typedef unsigned u32x2 __attribute__((ext_vector_type(2)));

struct Params {
    const float* x; const float* w_in; const float* conv_w; const float* conv_b; const float* dt_bias; const float* a_log; const float* d_skip;
    const float* ssd_norm_w; const float* w_out; const float* ln1_g; const float* ln1_b; const float* w_rg; const float* b_rg; const float* w_re; const float* b_re;
    const float* w_gate; const float* w_up; const float* w_down; const float* ln2_g; const float* ln2_b;
    float* out; unsigned char* ws;
};

__device__ __forceinline__ int launder_i(int v);
__device__ __forceinline__ int lane_id() { unsigned m = ~0u; asm volatile("" : "+s"(m)); return (int)__builtin_amdgcn_mbcnt_hi(m, __builtin_amdgcn_mbcnt_lo(m, 0u)); }
typedef const __attribute__((address_space(4))) Params* KPtr;
__device__ __forceinline__ KPtr launder_k(KPtr k) { asm volatile("" : "+s"(k)); return k; }
__device__ __forceinline__ float bf2f(bf16 v) { return __uint_as_float((unsigned)v << 16); }
__device__ __forceinline__ bf16 f2bf(float f) { unsigned u = __float_as_uint(f); return (bf16)((u + 0x7fffu + ((u >> 16) & 1u)) >> 16); }
__device__ __forceinline__ float silu(float v) { return v * __builtin_amdgcn_rcpf(1.f + __expf(-v)); }
__device__ __forceinline__ float wave_sum(float v) {
#define WS_DPP(ctrl, rm, bc) v += __int_as_float(__builtin_amdgcn_update_dpp(0, __float_as_int(v), ctrl, rm, 0xf, bc))
    WS_DPP(0xB1, 0xf, true); WS_DPP(0x4E, 0xf, true); WS_DPP(0x114, 0xf, true); WS_DPP(0x118, 0xf, true); WS_DPP(0x142, 0xa, false); WS_DPP(0x143, 0xc, false);
#undef WS_DPP
    return __int_as_float(__builtin_amdgcn_readlane(__float_as_int(v), 63));
}
__device__ __forceinline__ float wave_max(float v) {
#pragma unroll
    for (int o = 1; o < 64; o <<= 1) v = fmaxf(v, __shfl_xor(v, o));
    return v;
}
__device__ __forceinline__ int launder_i(int v) { asm volatile("" : "+v"(v)); return v; }
__device__ __forceinline__ unsigned sortkey(float f) { unsigned u = __float_as_uint(f); return (u & 0x80000000u) ? ~u : (u | 0x80000000u); }

namespace pg8 {
#define PG8_LAS __attribute__((address_space(3)))
typedef unsigned short bf16_t;
typedef short bf16x8 __attribute__((ext_vector_type(8)));
typedef float f32x4 __attribute__((ext_vector_type(4)));
typedef unsigned u32x4 __attribute__((ext_vector_type(4)));
constexpr int BM = 256, BK = 64, HALF = 128, HTB = HALF * BK * 2  , STAGE_BYTES = 8 * HTB, NXCD = 8, WGM = 8;

__host__ __device__ __forceinline__ int lds_byte(int r, int c) { const int st = (r >> 4) * 2 + (c >> 5), rr = r & 15, cc = c & 31, ob = rr * 64 + cc * 2; return st * 1024 + (ob ^ (((ob >> 9) & 1) << 5)); }
__host__ __device__ __forceinline__ void stage_rc(int b, int& R, int& C) { const int st = b / 1024, sb = b % 1024, swz = sb ^ (((sb >> 9) & 1) << 5); R = (st >> 1) * 16 + swz / 64; C = (st & 1) * 32 + (swz % 64) / 2; }
__host__ __device__ __forceinline__ int perm32(int rho) { const int n = rho >> 4, i = rho & 15; return 8 * (i >> 2) + 4 * n + (i & 3); }

struct Unit { int pm, pn; };
struct Gemm { const bf16_t* A; const bf16_t* Bt; int M, N, K; };

struct StaticOrder {
    int nM, nN, nwg, G, c;
    __host__ __device__ void init(int M, int N, int G_, int c_) { nM = M / BM; nN = N / BM; nwg = nM * nN; G = G_; c = c_; }
    __host__ __device__ bool next(int i, Unit& u) const {
        const long L = (long)i * G + c; if (L >= nwg) return false;
        int wgid = (int)L; { const int q = nwg / NXCD, r = nwg % NXCD, xcd = wgid % NXCD, off = wgid / NXCD; wgid = (xcd < r ? xcd * (q + 1) : r * (q + 1) + (xcd - r) * q) + off; }
        const int nig = WGM * nN, gid = wgid / nig, fm = gid * WGM, gsz = (nM - fm) < WGM ? (nM - fm) : WGM;
        u.pm = fm + ((wgid % nig) % gsz); u.pn = (wgid % nig) / gsz; return true;
    }
    __device__ __forceinline__ void a_ready(const Unit&) const {}
    __device__ __forceinline__ void done(const Unit&) const {}
};

__device__ __forceinline__ unsigned cvt_pk_bf16(float lo, float hi) { unsigned r; asm volatile("v_cvt_pk_bf16_f32 %0, %1, %2" : "=v"(r) : "v"(lo), "v"(hi)); return r; }
template <class Epi, class Sched, bool ALIGN_EPI = false, bool SP2 = false, bool GATHER = false>
__device__ __forceinline__ void gemm_phase(PG8_LAS unsigned char* lds, const Gemm g, const Sched& S, const Epi& E, const int wave_s, const PG8_LAS int* rtl = nullptr) {
    int tid_l = wave_s * 64 + lane_id(); asm volatile("" : "+v"(tid_l));
    const int tid = tid_l, wid = wave_s, lane = tid & 63, wr = wid >> 2, wc = wid & 3, fr = lane & 15, fq = lane >> 4;
    const int K = g.K, nt = K / BK;
    unsigned voffA[2], voffB[2];
#pragma unroll
    for (int i = 0; i < 2; ++i) { int R, C; stage_rc(tid * 16 + i * 8192, R, C); const int Rb = Epi::PERM ? ((R & ~31) + perm32(R & 31)) : R;
        voffA[i] = (unsigned)(R * K + C) * 2u; voffB[i] = (unsigned)(Rb * K + C) * 2u; }
    const size_t kstep = (size_t)(BK * 2);
    const size_t hstepB = (size_t)HALF * K * 2;
    const size_t tstep = 2 * hstepB;
    const size_t hstep = GATHER ? 0 : hstepB, tstepA = GATHER ? 0 : tstep;
    int rowA[2]; { int R, C; stage_rc(tid * 16, R, C); rowA[0] = R; stage_rc(tid * 16 + 8192, R, C); rowA[1] = R; }
    unsigned voffGc[2][2], voffGn[2][2];
#define PG8_GVOFF(dst, uidx) do { _Pragma("unroll") for (int _h = 0; _h < 2; ++_h) _Pragma("unroll") for (int _i = 0; _i < 2; ++_i) { int R_, C_; stage_rc(tid * 16 + _i * 8192, R_, C_); \
        dst[_h][_i] = (unsigned)rtl[(uidx) * 256 + _h * 128 + R_] * (unsigned)(K * 2) + (unsigned)(C_ * 2); } } while (0)
    const unsigned ldsw = (unsigned)wid * 1024u;
    const int aoff = lds_byte(wr * 64 + fr, fq * 8), boff = lds_byte(wc * 32 + fr, fq * 8);
#define PG8_SA(b, h) (((b) * 2 + (h)) * HTB)
#define PG8_SB(b, h) ((4 + (b) * 2 + (h)) * HTB)
#define PG8_STAGE(bufoff, gbase, voff) do { _Pragma("unroll") for (int _i = 0; _i < 2; ++_i) \
        __builtin_amdgcn_global_load_lds((const unsigned*)((const char*)(gbase) + (voff)[_i]), (PG8_LAS unsigned*)(lds + (bufoff) + ldsw + _i * 8192), 16, 0, 0); } while (0)
#define PG8_STAGE_A(bufoff, gbase, h, nx) do { if constexpr (GATHER) { if (nx) PG8_STAGE(bufoff, gbase, voffGn[h]); else PG8_STAGE(bufoff, gbase, voffGc[h]); } else PG8_STAGE(bufoff, gbase, voffA); } while (0)
#define PG8_LDA(dst, b, h) do { _Pragma("unroll") for (int m = 0; m < 4; ++m) _Pragma("unroll") for (int k = 0; k < 2; ++k) dst[m][k] = *(const PG8_LAS bf16x8*)(lds + PG8_SA(b, h) + aoff + m * 2048 + k * 1024); } while (0)
#define PG8_LDB(dst, b, h) do { _Pragma("unroll") for (int n = 0; n < 2; ++n) _Pragma("unroll") for (int k = 0; k < 2; ++k) dst[n][k] = *(const PG8_LAS bf16x8*)(lds + PG8_SB(b, h) + boff + n * 2048 + k * 1024); } while (0)
#define PG8_MMA(ai, bj, At, Bt) do { __builtin_amdgcn_s_setprio(1); _Pragma("unroll") for (int m = 0; m < 4; ++m) _Pragma("unroll") for (int n = 0; n < 2; ++n) _Pragma("unroll") for (int k = 0; k < 2; ++k) \
        acc[ai][bj][m][n] = __builtin_amdgcn_mfma_f32_16x16x32_bf16(Bt[n][k], At[m][k], acc[ai][bj][m][n], 0, 0, 0); __builtin_amdgcn_s_setprio(0); } while (0)
#define PG8_WAIT_V(n) asm volatile("s_waitcnt vmcnt(" #n ")" ::: "memory")
#define PG8_WAIT_L(n) asm volatile("s_waitcnt lgkmcnt(" #n ")" ::: "memory")
#define PG8_BAR __builtin_amdgcn_s_barrier()
#define PG8_SCHED __builtin_amdgcn_sched_barrier(0)
    Unit cur, nxt; int ui = 0;
    if (!S.next(0, cur)) return;
    f32x4 acc[2][2][4][2];
#pragma unroll
    for (int a = 0; a < 2; ++a)
#pragma unroll
        for (int b = 0; b < 2; ++b)
#pragma unroll
            for (int m = 0; m < 4; ++m)
#pragma unroll
                for (int n = 0; n < 2; ++n) acc[a][b][m][n] = (f32x4){0.f, 0.f, 0.f, 0.f};
    bf16x8 At[4][2], B0[2][2], B1[2][2];
    const char* cA = (const char*)g.A + (size_t)cur.pm * tstepA; const char* cB = (const char*)g.Bt + (size_t)cur.pn * tstep;
    if constexpr (GATHER) { PG8_GVOFF(voffGc, 0); _Pragma("unroll") for (int _h = 0; _h < 2; ++_h) _Pragma("unroll") for (int _i = 0; _i < 2; ++_i) voffGn[_h][_i] = voffGc[_h][_i]; }
    S.a_ready(cur);
    if constexpr (SP2) {
        PG8_STAGE(PG8_SB(0, 0), cB, voffB); PG8_STAGE(PG8_SB(0, 1), cB + hstepB, voffB); PG8_STAGE_A(PG8_SA(0, 0), cA, 0, false); PG8_STAGE_A(PG8_SA(0, 1), cA + hstep, 1, false);
        if (wr == 1) PG8_BAR;
        PG8_WAIT_V(2); PG8_BAR;
        PG8_STAGE(PG8_SB(1, 0), cB + kstep, voffB); PG8_STAGE_A(PG8_SA(1, 0), cA + kstep, 0, false); PG8_STAGE(PG8_SB(1, 1), cB + hstepB + kstep, voffB);
        PG8_WAIT_V(6); PG8_BAR;
    } else {
        PG8_STAGE(PG8_SB(0, 0), cB, voffB); PG8_STAGE_A(PG8_SA(0, 0), cA, 0, false); PG8_STAGE(PG8_SB(0, 1), cB + hstepB, voffB); PG8_STAGE_A(PG8_SA(0, 1), cA + hstep, 1, false);
        if (wr == 1) PG8_BAR;
        PG8_WAIT_V(4); PG8_BAR;
        PG8_STAGE(PG8_SB(1, 0), cB + kstep, voffB); PG8_STAGE_A(PG8_SA(1, 0), cA + kstep, 0, false); PG8_STAGE(PG8_SB(1, 1), cB + hstepB + kstep, voffB);
        PG8_WAIT_V(6); PG8_BAR;
    }
    for (;;) {
        const bool has_next = S.next(ui + 1, nxt);
        const char* nA = has_next ? (const char*)g.A + (size_t)nxt.pm * tstepA : cA; const char* nB = has_next ? (const char*)g.Bt + (size_t)nxt.pn * tstep : cB;
        for (int t = 0; t < nt; t += 2) {
            if constexpr (Epi::MID_T > 0) { if (t == Epi::MID_T) E.mid(acc, cur, wr, wc, fr, fq); }
            const bool last = (t == nt - 2);
            const char* a1 = cA + (size_t)(t + 1) * kstep;
            const char* a2 = last ? nA : cA + (size_t)(t + 2) * kstep; const char* b2 = last ? nB : cB + (size_t)(t + 2) * kstep;
            const char* a3 = a2 + kstep; const char* b3 = b2 + kstep;
            if (last && has_next) { S.a_ready(nxt); if constexpr (GATHER) PG8_GVOFF(voffGn, ui + 1); }
            if constexpr (SP2) {
            PG8_LDB(B0, 0, 0); PG8_LDB(B1, 0, 1); PG8_SCHED; PG8_LDA(At, 0, 0); PG8_STAGE_A(PG8_SA(1, 1), a1 + hstep, 1, false);
            PG8_WAIT_V(8); PG8_WAIT_L(0); PG8_BAR; PG8_MMA(0, 0, At, B0); PG8_MMA(0, 1, At, B1); PG8_BAR; PG8_SCHED;
            PG8_LDA(At, 0, 1); PG8_STAGE(PG8_SB(0, 0), b2, voffB); PG8_STAGE(PG8_SB(0, 1), b2 + hstepB, voffB); PG8_STAGE_A(PG8_SA(0, 0), a2, 0, last);
            PG8_WAIT_V(8); PG8_WAIT_L(0); PG8_BAR; PG8_MMA(1, 0, At, B0); PG8_MMA(1, 1, At, B1); PG8_BAR; PG8_SCHED;
            PG8_LDB(B0, 1, 0); PG8_LDB(B1, 1, 1); PG8_SCHED; PG8_LDA(At, 1, 0); PG8_STAGE_A(PG8_SA(0, 1), a2 + hstep, 1, last);
            PG8_WAIT_V(8); PG8_WAIT_L(0); PG8_BAR; PG8_MMA(0, 0, At, B0); PG8_MMA(0, 1, At, B1); PG8_BAR; PG8_SCHED;
            PG8_LDA(At, 1, 1); PG8_STAGE(PG8_SB(1, 0), b3, voffB); PG8_STAGE(PG8_SB(1, 1), b3 + hstepB, voffB); PG8_STAGE_A(PG8_SA(1, 0), a3, 0, last);
            PG8_WAIT_V(8); PG8_WAIT_L(0); PG8_BAR; PG8_MMA(1, 0, At, B0); PG8_MMA(1, 1, At, B1); PG8_BAR; PG8_SCHED;
            } else {
            PG8_LDB(B0, 0, 0); PG8_SCHED; PG8_LDA(At, 0, 0); PG8_STAGE_A(PG8_SA(1, 1), a1 + hstep, 1, false);
            PG8_WAIT_L(8); PG8_BAR; PG8_WAIT_L(0); PG8_MMA(0, 0, At, B0); PG8_BAR; PG8_SCHED;
            PG8_LDB(B1, 0, 1); PG8_STAGE(PG8_SB(0, 0), b2, voffB);
            PG8_BAR; PG8_WAIT_L(0); PG8_MMA(0, 1, At, B1); PG8_BAR;
            PG8_LDA(At, 0, 1); PG8_STAGE_A(PG8_SA(0, 0), a2, 0, last);
            PG8_BAR; PG8_WAIT_L(0); PG8_MMA(1, 0, At, B0); PG8_BAR; PG8_SCHED;
            PG8_STAGE(PG8_SB(0, 1), b2 + hstepB, voffB);
            PG8_WAIT_V(6); PG8_BAR; PG8_MMA(1, 1, At, B1); PG8_BAR;
            PG8_LDB(B0, 1, 0); PG8_SCHED; PG8_LDA(At, 1, 0); PG8_STAGE_A(PG8_SA(0, 1), a2 + hstep, 1, last);
            PG8_WAIT_L(8); PG8_BAR; PG8_WAIT_L(0); PG8_MMA(0, 0, At, B0); PG8_BAR; PG8_SCHED;
            PG8_LDB(B1, 1, 1); PG8_STAGE(PG8_SB(1, 0), b3, voffB);
            PG8_BAR; PG8_WAIT_L(0); PG8_MMA(0, 1, At, B1); PG8_BAR;
            PG8_LDA(At, 1, 1); PG8_STAGE_A(PG8_SA(1, 0), a3, 0, last);
            PG8_BAR; PG8_WAIT_L(0); PG8_MMA(1, 0, At, B0); PG8_BAR; PG8_SCHED;
            PG8_STAGE(PG8_SB(1, 1), b3 + hstepB, voffB);
            PG8_WAIT_V(6); PG8_BAR; PG8_MMA(1, 1, At, B1); PG8_BAR;
            }
        }
        if constexpr (ALIGN_EPI) { if (wr == 0) PG8_BAR; }
        if constexpr (!Epi::AFTER_DRAIN) { E(acc, cur, wr, wc, fr, fq); S.done(cur); }
        if (!has_next) break;
#pragma unroll
        for (int a = 0; a < 2; ++a)
#pragma unroll
            for (int b = 0; b < 2; ++b)
#pragma unroll
                for (int m = 0; m < 4; ++m)
#pragma unroll
                    for (int n = 0; n < 2; ++n) acc[a][b][m][n] = (f32x4){0.f, 0.f, 0.f, 0.f};
        cur = nxt; cA = nA; cB = nB; ++ui;
        if constexpr (GATHER) { _Pragma("unroll") for (int _h = 0; _h < 2; ++_h) _Pragma("unroll") for (int _i = 0; _i < 2; ++_i) voffGc[_h][_i] = voffGn[_h][_i]; }
        if constexpr (ALIGN_EPI) { if (wr == 1) PG8_BAR; }
    }
    PG8_WAIT_V(0);
    if constexpr (!ALIGN_EPI) { if (wr == 0) PG8_BAR; }
    PG8_BAR;
    if constexpr (Epi::AFTER_DRAIN) { E.fused(acc, cur, wr, wc, fr, fq, lds, wid, lane); S.done(cur); }
#undef PG8_SA
#undef PG8_SB
#undef PG8_STAGE
#undef PG8_STAGE_A
#undef PG8_GVOFF
#undef PG8_LDA
#undef PG8_LDB
#undef PG8_MMA
#undef PG8_WAIT_V
#undef PG8_WAIT_L
#undef PG8_BAR
#undef PG8_SCHED
}
}

#define LAS __attribute__((address_space(3)))
__host__ __device__ __forceinline__ int rope_pos(int j) { return 2 * (j & 31) + (j >> 5); }
__host__ __device__ __forceinline__ int win_dest_row(int c) {
    if (c < C_K) return (c & ~63) + rope_pos(c & 63);
    if (c < C_V) return 512 + rope_pos(c - C_K);
    if (c < C_IQ) return 512 + 64 + (c - C_V);
    if (c < C_IK) return 768 + ((c - C_IQ) & ~63) + rope_pos((c - C_IQ) & 63);
    if (c < C_IW) return 512 + 128 + rope_pos(c - C_IK);
    if (c < C_Z) return 512 + 192 + (c - C_IW);
    if (c < C_XBC) return 1024 + (c - C_Z);
    if (c < C_DT) return 1536 + (c - C_XBC);
    return 512 + 200 + (c - C_DT);
}
struct EpiInProj {
    static constexpr bool PERM = true, AFTER_DRAIN = false; static constexpr int MID_T = 0;
    bf16 *Q, *K, *V, *IK, *IQ, *Z, *XBC; float *IW, *DT; const float2* rope;
    __device__ __forceinline__ u32x4 pack8(const f32x4 a, const f32x4 b) const { u32x4 w; w.x = pg8::cvt_pk_bf16(a[0], a[1]); w.y = pg8::cvt_pk_bf16(a[2], a[3]); w.z = pg8::cvt_pk_bf16(b[0], b[1]); w.w = pg8::cvt_pk_bf16(b[2], b[3]); return w; }
    __device__ __forceinline__ u32x4 rope8(const f32x4 v0, const f32x4 v1, const f32x4 r0, const f32x4 r1, float sc) const {
        f32x4 a, b;
        a[0] = (v0[0] * r0[0] - v0[1] * r0[1]) * sc; a[1] = (v0[0] * r0[1] + v0[1] * r0[0]) * sc;
        a[2] = (v0[2] * r0[2] - v0[3] * r0[3]) * sc; a[3] = (v0[2] * r0[3] + v0[3] * r0[2]) * sc;
        b[0] = (v1[0] * r1[0] - v1[1] * r1[1]) * sc; b[1] = (v1[0] * r1[1] + v1[1] * r1[0]) * sc;
        b[2] = (v1[2] * r1[2] - v1[3] * r1[3]) * sc; b[3] = (v1[2] * r1[3] + v1[3] * r1[2]) * sc;
        return pack8(a, b);
    }
    __device__ __forceinline__ void operator()(const pg8::f32x4 (&acc)[2][2][4][2], const pg8::Unit& u, int wr, int wc, int fr, int fq) const {
        const int pn = u.pn, row0 = u.pm * 256 + wr * 64 + fr, cw = 32 * wc + 8 * fq;
        if (pn <= 1 || pn == 3) {
            bf16* dst = (pn == 3) ? IQ : Q; const int ld = (pn == 3) ? 256 : 512; const float sc = (pn == 3) ? 1.f : QSCALE; const int hb = (pn == 3) ? 0 : pn * 4;
#pragma unroll
            for (int ai = 0; ai < 2; ++ai)
#pragma unroll
                for (int m = 0; m < 4; ++m) { const int row = row0 + ai * 128 + m * 16, t = row & (SEQ - 1);
                    const f32x4* rp = (const f32x4*)(rope + t * 32 + 16 * (wc & 1) + 4 * fq); const f32x4 r0 = rp[0], r1 = rp[1];
#pragma unroll
                    for (int bj = 0; bj < 2; ++bj) { const int head = hb + 2 * bj + (wc >> 1);
                        *(u32x4*)(dst + (size_t)row * ld + head * 64 + 32 * (wc & 1) + 8 * fq) = rope8(acc[ai][bj][m][0], acc[ai][bj][m][1], r0, r1, sc); } }
        } else if (pn == 2) {
#pragma unroll
            for (int ai = 0; ai < 2; ++ai)
#pragma unroll
                for (int m = 0; m < 4; ++m) { const int row = row0 + ai * 128 + m * 16, t = row & (SEQ - 1);
                    if (wc < 2) { const f32x4* rp = (const f32x4*)(rope + t * 32 + 16 * wc + 4 * fq); const f32x4 r0 = rp[0], r1 = rp[1];
                        *(u32x4*)(K + (size_t)row * 64 + cw) = rope8(acc[ai][0][m][0], acc[ai][0][m][1], r0, r1, 1.f);
                        *(u32x4*)(IK + (size_t)row * 64 + cw) = rope8(acc[ai][1][m][0], acc[ai][1][m][1], r0, r1, 1.f);
                    } else {
                        *(u32x4*)(V + (size_t)row * 64 + (cw - 64)) = pack8(acc[ai][0][m][0], acc[ai][0][m][1]);
                        if (wc == 2 && fq == 0) *(f32x4*)(IW + (size_t)row * 4) = acc[ai][1][m][0] * INDEXER_SCALE;
                        if (wc == 2 && fq == 1) { *(f32x4*)(DT + (size_t)row * 8) = acc[ai][1][m][0]; *(f32x4*)(DT + (size_t)row * 8 + 4) = acc[ai][1][m][1]; }
                    } }
        } else {
            bf16* dst = (pn < 6) ? Z : XBC; const int ld = (pn < 6) ? 512 : 768; const int cb = (pn < 6) ? (pn - 4) * 256 : (pn - 6) * 256;
#pragma unroll
            for (int ai = 0; ai < 2; ++ai)
#pragma unroll
                for (int m = 0; m < 4; ++m) { const int row = row0 + ai * 128 + m * 16;
#pragma unroll
                    for (int bj = 0; bj < 2; ++bj) *(u32x4*)(dst + (size_t)row * ld + cb + 128 * bj + cw) = pack8(acc[ai][bj][m][0], acc[ai][bj][m][1]); }
        }
    }
};
struct EpiH1 {
    static constexpr bool PERM = false, AFTER_DRAIN = false; static constexpr int MID_T = 8;
    const float* x; bf16* out; const float* ssqp;
    __device__ __forceinline__ void mid(pg8::f32x4 (&acc)[2][2][4][2], const pg8::Unit& u, int wr, int wc, int fr, int fq) const {
        asm volatile("" : "+v"(fr));
        const int row0 = u.pm * 256 + wr * 64 + fr;
#pragma unroll
        for (int ai = 0; ai < 2; ++ai)
#pragma unroll
            for (int m = 0; m < 4; ++m) { const f32x4* sp = (const f32x4*)(ssqp + (size_t)(row0 + ai * 128 + m * 16) * 8); const f32x4 s0 = sp[0], s1 = sp[1];
                const float r = rsqrtf(((s0[0] + s0[1]) + (s0[2] + s0[3]) + (s1[0] + s1[1]) + (s1[2] + s1[3])) * (1.f / 512.f) + LN_EPS);
#pragma unroll
                for (int bj = 0; bj < 2; ++bj)
#pragma unroll
                    for (int n = 0; n < 2; ++n) acc[ai][bj][m][n] = acc[ai][bj][m][n] * r; }
    }
    __device__ __forceinline__ void operator()(const pg8::f32x4 (&acc)[2][2][4][2], const pg8::Unit& u, int wr, int wc, int fr, int fq) const {
        const int row0 = u.pm * 256 + wr * 64 + fr, col0 = u.pn * 256 + wc * 32 + 4 * fq;
#pragma unroll
        for (int ai = 0; ai < 2; ++ai)
#pragma unroll
            for (int m = 0; m < 4; ++m) { const size_t off = (size_t)(row0 + ai * 128 + m * 16) * DM + col0;
#pragma unroll
                for (int bj = 0; bj < 2; ++bj)
#pragma unroll
                    for (int n = 0; n < 2; ++n) { const u32x2 xb = *(const u32x2*)(out + off + bj * 128 + n * 16);
                        f32x4 xv; xv[0] = __uint_as_float(xb.x << 16); xv[1] = __uint_as_float(xb.x & 0xffff0000u); xv[2] = __uint_as_float(xb.y << 16); xv[3] = __uint_as_float(xb.y & 0xffff0000u);
                        const f32x4 hv = xv * ALPHA + acc[ai][bj][m][n];
                        u32x2 w; w.x = pg8::cvt_pk_bf16(hv[0], hv[1]); w.y = pg8::cvt_pk_bf16(hv[2], hv[3]); *(u32x2*)(out + off + bj * 128 + n * 16) = w; } }
    }
};
template <class DR, class KM>
__device__ __forceinline__ void transpose_item(const float* W, int K, int N, bf16* WT, LAS float* scr, int item, int lane, DR drow, KM kmap) {
    const int nblk = (N + 31) / 32, kb = item / nblk, nb = item % nblk, k0 = 64 * kb, n0 = 32 * nb;
    float tv[32];
#pragma unroll
    for (int i = 0; i < 32; ++i) { const int kk = 2 * i + (lane >> 5), col = n0 + (lane & 31); float sc = 1.f; const int ks = kmap(k0 + kk, sc); tv[i] = (col < N) ? W[(size_t)ks * N + col] * sc : 0.f; }
#pragma unroll
    for (int i = 0; i < 32; ++i) scr[(2 * i + (lane >> 5)) * 33 + (lane & 31)] = tv[i];
    asm volatile("s_waitcnt lgkmcnt(0)" ::: "memory");
    const int c = lane & 7;
#pragma unroll
    for (int j = 0; j < 4; ++j) { const int n = (lane >> 3) + 8 * j, col = n0 + n; const LAS float* s = scr + (8 * c) * 33 + n;
        u32x4 o; o.x = pg8::cvt_pk_bf16(s[0 * 33], s[1 * 33]); o.y = pg8::cvt_pk_bf16(s[2 * 33], s[3 * 33]); o.z = pg8::cvt_pk_bf16(s[4 * 33], s[5 * 33]); o.w = pg8::cvt_pk_bf16(s[6 * 33], s[7 * 33]);
        if (col < N) *(u32x4*)(WT + (size_t)drow(col) * K + k0 + 8 * c) = o; }
    asm volatile("s_waitcnt lgkmcnt(0)" ::: "memory");
}
namespace attn_body {
using bf16=unsigned short;
using bf16x8=__attribute__((ext_vector_type(8)))short;
using s16x4=__attribute__((ext_vector_type(4)))short;
using f32x16=__attribute__((ext_vector_type(16)))float;
using u32x4=__attribute__((ext_vector_type(4)))unsigned;
constexpr int SEQ=2048,D=64,QP=512,KP=64,OP=1024;
constexpr int NW=8,QBLK=32,KVBLK=64;
__device__ __forceinline__ int crow(int r,int hi){return (r&3)+8*(r>>2)+4*hi;}
#define SBAR() __builtin_amdgcn_sched_barrier(0)
__device__ __forceinline__ void amask(f32x16&p0,f32x16&p1,unsigned mlo,unsigned mhi,int hi){
  const unsigned NEGB=0xff800000u; const unsigned a=mlo>>(4*hi), b=mhi>>(4*hi);
  #pragma unroll
  for(int r=0;r<16;++r){ const int pos=(r&3)+8*(r>>2);
    const unsigned s0=(unsigned)__builtin_amdgcn_sbfe((int)a,pos,1), s1=(unsigned)__builtin_amdgcn_sbfe((int)b,pos,1);
    const float v0=p0[r], v1=p1[r];
    p0[r]=__uint_as_float((s0&__float_as_uint(v0))|(~s0&NEGB));
    p1[r]=__uint_as_float((s1&__float_as_uint(v1))|(~s1&NEGB)); }
}

constexpr int NSLOT=3, SLOTB=8192;
constexpr int LDS_K=0, LDS_V=NSLOT*SLOTB, LDS_WS=2*NSLOT*SLOTB, LDS_OST=LDS_WS+NW*64*4, LDS_BYTES=LDS_OST+NW*4096;
constexpr float C2=0.125f*1.4426950408889634f;
__device__ __forceinline__ void glds16(const void*gsrc,unsigned lds_dst){unsigned keep;
  asm volatile("s_mov_b32 %0, m0\n\ts_mov_b32 m0, %2\n\ts_nop 0\n\tglobal_load_lds_dwordx4 %1, off\n\ts_mov_b32 m0, %0":"=&s"(keep):"v"(gsrc),"s"(lds_dst):"memory");}
__device__ __forceinline__ float max3f(float a,float b,float c){float r;asm("v_max3_f32 %0, %1, %2, %3":"=v"(r):"v"(a),"v"(b),"v"(c));return r;}
__device__ __forceinline__ float max2f(float a,float b){float r;asm("v_max_f32_e32 %0, %1, %2":"=v"(r):"v"(a),"v"(b));return r;}
__device__ __forceinline__ float fadd_s(float a,float b){float r;asm("v_add_f32_e32 %0, %1, %2":"=v"(r):"v"(a),"v"(b));return r;}
__device__ __forceinline__ float fsub_s(float a,float b){float r;asm("v_sub_f32_e32 %0, %1, %2":"=v"(r):"v"(a),"v"(b));return r;}
typedef float f32x2_t __attribute__((ext_vector_type(2))); typedef __bf16 bf16x2_t __attribute__((ext_vector_type(2)));
__device__ __forceinline__ unsigned cvtpk_s(float lo,float hi){f32x2_t v={lo,hi};bf16x2_t b=__builtin_convertvector(v,bf16x2_t);return __builtin_bit_cast(unsigned,b);}
#define WAIT_BAR(N) asm volatile("s_waitcnt vmcnt(" #N ") lgkmcnt(0)\n\ts_barrier":::"memory")

__device__ __forceinline__ void qkt(f32x16&p0,f32x16&p1,const char*Kslot,const bf16x8*qr,const f32x16&negm,int r32,int hi){
  const char*kb=Kslot+hi*1024+r32*16;
  #pragma unroll
  for(int d0=0;d0<4;++d0){
    const bf16x8 b0=*reinterpret_cast<const bf16x8*>(kb+d0*2048);
    const bf16x8 b1=*reinterpret_cast<const bf16x8*>(kb+d0*2048+512);
    if(d0==0){p0=__builtin_amdgcn_mfma_f32_32x32x16_bf16(b0,qr[0],negm,0,0,0);p1=__builtin_amdgcn_mfma_f32_32x32x16_bf16(b1,qr[0],negm,0,0,0);}
    else{p0=__builtin_amdgcn_mfma_f32_32x32x16_bf16(b0,qr[d0],p0,0,0,0);p1=__builtin_amdgcn_mfma_f32_32x32x16_bf16(b1,qr[d0],p1,0,0,0);}}
}
typedef __attribute__((address_space(3))) const char* lds_cptr;
typedef short v4i16_t __attribute__((ext_vector_type(4)));
__device__ __forceinline__ void kload8(bf16x8*kf,lds_cptr kp){
  kf[0]=*(const __attribute__((address_space(3))) bf16x8*)(kp);      kf[1]=*(const __attribute__((address_space(3))) bf16x8*)(kp+512);
  kf[2]=*(const __attribute__((address_space(3))) bf16x8*)(kp+2048); kf[3]=*(const __attribute__((address_space(3))) bf16x8*)(kp+2560);
  kf[4]=*(const __attribute__((address_space(3))) bf16x8*)(kp+4096); kf[5]=*(const __attribute__((address_space(3))) bf16x8*)(kp+4608);
  kf[6]=*(const __attribute__((address_space(3))) bf16x8*)(kp+6144); kf[7]=*(const __attribute__((address_space(3))) bf16x8*)(kp+6656);
}
__device__ __forceinline__ void kload2(bf16x8*kf,lds_cptr kp,int j){ kf[2*j]=*(const __attribute__((address_space(3))) bf16x8*)(kp+j*2048); kf[2*j+1]=*(const __attribute__((address_space(3))) bf16x8*)(kp+j*2048+512); }
__device__ __forceinline__ s16x4 vtr(lds_cptr p){ return __builtin_bit_cast(s16x4,__builtin_amdgcn_ds_read_tr16_b64_v4i16((__attribute__((address_space(3))) v4i16_t*)p)); }
__device__ __forceinline__ float rowmax(const f32x16&p0,const f32x16&p1){
  float a=max3f(p0[0],p0[1],p1[0]),b=max3f(p0[2],p0[3],p1[1]);a=max3f(a,p1[2],p1[3]);
  #pragma unroll
  for(int r=4;r<16;r+=4){a=max3f(a,p0[r],p0[r+1]);b=max3f(b,p0[r+2],p0[r+3]);a=max3f(a,p1[r],p1[r+1]);b=max3f(b,p1[r+2],p1[r+3]);}
  const float m=max2f(a,b);
  auto rr=__builtin_amdgcn_permlane32_swap(__float_as_uint(m),__float_as_uint(m),false,false);
  return max2f(__uint_as_float(rr[0]),__uint_as_float(rr[1]));
}
__device__ __forceinline__ void pv(f32x16*o,int vb,bf16x8 pa0,bf16x8 pa1,bf16x8 pa2,bf16x8 pa3){
  #pragma unroll
  for(int d0=0;d0<2;++d0){s16x4 lo[4],hi[4];
    #pragma unroll
    for(int ks=0;ks<4;++ks){
      asm volatile("ds_read_b64_tr_b16 %0,%1 offset:%c2":"=&v"(lo[ks]):"v"(vb),"i"(d0*4096+ks*1024):"memory");
      asm volatile("ds_read_b64_tr_b16 %0,%1 offset:%c2":"=&v"(hi[ks]):"v"(vb),"i"(d0*4096+ks*1024+512):"memory");}
    asm volatile("s_waitcnt lgkmcnt(0)":::"memory");SBAR();
    #define PK(k) (bf16x8){lo[k][0],lo[k][1],lo[k][2],lo[k][3],hi[k][0],hi[k][1],hi[k][2],hi[k][3]}
    o[d0]=__builtin_amdgcn_mfma_f32_32x32x16_bf16(pa0,PK(0),o[d0],0,0,0);
    o[d0]=__builtin_amdgcn_mfma_f32_32x32x16_bf16(pa1,PK(1),o[d0],0,0,0);
    o[d0]=__builtin_amdgcn_mfma_f32_32x32x16_bf16(pa2,PK(2),o[d0],0,0,0);
    o[d0]=__builtin_amdgcn_mfma_f32_32x32x16_bf16(pa3,PK(3),o[d0],0,0,0);
    #undef PK
  }
}

#ifndef ATTN_STORE16
#define ATTN_STORE16(p,v) (*(u32x4*)(p)=(v))
#endif
template<int THRL> __device__ __forceinline__ void attn_unit(int b,int qb,const bf16*Q,const bf16*__restrict__ K,const bf16*__restrict__ V,bf16*O,char*shm,const char*maskb,const int wave_s){
  int lane_l=lane_id(); asm volatile("":"+v"(lane_l)); const int lane=lane_l,tid=wave_s*64+lane,r32=lane&31,hi=lane>>5; const int wid=wave_s;
  const long rowbase=(long)b*SEQ; const int q0=qb*QBLK;
  const bf16*Qw=Q+(rowbase+q0)*QP+wid*D;
  const bf16*Kh=K+rowbase*KP,*Vh=V+rowbase*KP;
  const unsigned lds0=(unsigned)(uintptr_t)shm;
  float*wsf=(float*)(shm+LDS_WS)+wid*64;
  const bf16*ksrc=Kh+(long)lane*KP+wid*8;
  const bf16*vsrc=Vh+(long)(16*(wid&3)+(lane>>2))*KP+(wid>>2)*32+(lane&3)*8;
  const unsigned kdst=lds0+LDS_K+wid*1024, vdst=lds0+LDS_V+wid*1024;
  #define DMA_K(t,slot) glds16(ksrc+(long)(t)*KVBLK*KP,(unsigned)__builtin_amdgcn_readfirstlane(kdst+(slot)))
  #define DMA_V(t,slot) glds16(vsrc+(long)(t)*KVBLK*KP,(unsigned)__builtin_amdgcn_readfirstlane(vdst+(slot)))
  const int vb0=(int)(lds0+LDS_V)+((lane>>4)&1)*32+(lane&3)*8+(4*hi+((lane&15)>>2))*64;
  const char*Kbase=shm+LDS_K; bf16x8 kf[8];
  const lds_cptr shm3=(lds_cptr)shm; const lds_cptr kp0=shm3+LDS_K+hi*1024+r32*16; const lds_cptr vp0=shm3+LDS_V+((lane>>4)&1)*32+(lane&3)*8+(4*hi+((lane&15)>>2))*64;
  const int NTr=(q0+QBLK+KVBLK-1)/KVBLK; const int NT=(NTr<4)?4:((NTr+1)&~1);
  const __attribute__((address_space(3))) unsigned*mrow=(const __attribute__((address_space(3))) unsigned*)((__attribute__((address_space(3))) const char*)maskb)+r32*66;
  DMA_K(0,0);DMA_V(0,0);DMA_K(1,SLOTB);
  bf16x8 qr[4];
  #pragma unroll
  for(int d0=0;d0<4;++d0)qr[d0]=*reinterpret_cast<const bf16x8*>(&Qw[(long)r32*QP+d0*16+hi*8]);
  float zz_=0.f; asm volatile("":"+v"(zz_)); float mhat=zz_,l_reg=zz_;f32x16 o[2];
  #pragma unroll
  for(int r=0;r<16;++r){o[0][r]=zz_;o[1][r]=zz_;}
  f32x16 negm;
  #pragma unroll
  for(int r=0;r<16;++r)negm[r]=zz_;
  asm volatile("":"+v"(negm));
  #define CMASK(P0,P1,t) do{ const unsigned ml_=mrow[2*(t)], mh_=mrow[2*(t)+1]; amask(P0,P1,ml_,mh_,hi); }while(0)
  bool resc=false;
  #define START(P0,P1) do{ const float rm=rowmax(P0,P1); resc=false; \
    { const float dl=(rm>-INFINITY)?rm:0.f; mhat=fadd_s(mhat,dl); \
      _Pragma("unroll") for(int r=0;r<16;++r){P0[r]=fsub_s(P0[r],dl);P1[r]=fsub_s(P1[r],dl);} \
      _Pragma("unroll") for(int r=0;r<16;++r)negm[r]=-mhat; asm volatile("":"+v"(negm)); } \
    _Pragma("unroll") for(int r=0;r<16;++r)P0[r]=__builtin_amdgcn_exp2f(P0[r]); }while(0)
  #define RESC() do{ if(resc){ asm volatile("s_waitcnt lgkmcnt(0)":::"memory"); \
      _Pragma("unroll") for(int d_=0;d_<2;++d_) _Pragma("unroll") for(int r=0;r<16;++r)o[d_][r]*=wsf[crow(r,hi)]; } }while(0)
  f32x16 pA0,pA1,pB0,pB1;
  int sl_prev=0,sl_cur=0,sl_next=SLOTB;
  #define ROT() do{sl_prev=sl_cur;sl_cur=sl_next;sl_next=(sl_next==(NSLOT-1)*SLOTB)?0:sl_next+SLOTB;}while(0)
  DMA_K(2,2*SLOTB);
  WAIT_BAR(3);
  qkt(pA0,pA1,Kbase,qr,negm,r32,hi);asm volatile("s_nop 15\n\ts_nop 7":"+v"(pA0),"+v"(pA1));CMASK(pA0,pA1,0);
  START(pA0,pA1);
  _Pragma("unroll") for(int r=0;r<16;++r)pA1[r]=__builtin_amdgcn_exp2f(pA1[r]);
  WAIT_BAR(0);
  DMA_K(3,0);DMA_V(1,SLOTB);
  ROT();
  kload8(kf,kp0+sl_cur);
  WAIT_BAR(2);
  s16x4 vlo[8],vhi[8]; u32x4 pw0,pw1,pw2,pw3;
  #define PKW(P,B) cvtpk_s(P[B],P[B+1])
  #define PAF(k) __builtin_bit_cast(bf16x8,pw##k)
  #define VFR(i) (bf16x8){vlo[i][0],vlo[i][1],vlo[i][2],vlo[i][3],vhi[i][0],vhi[i][1],vhi[i][2],vhi[i][3]}
  #define PIN(x) asm volatile("":"+v"(x))
  #define MX3(a,b,c) __builtin_fmaxf(__builtin_fmaxf((a),(b)),(c))
  #define GAPA(MF,A0,A1,A2,A3,W0,W1,PW) do{ MF; sacc+=A0; sacc+=A1; sacc+=A2; sacc+=A3; PIN(sacc); W0; W1; PIN(PW); SBAR(); }while(0)
  #define EX(v) __builtin_amdgcn_exp2f(v)
  #define GAPB(MF,X,B) do{ MF; X[B]=EX(X[B]); X[B+1]=EX(X[B+1]); X[B+2]=EX(X[B+2]); X[B+3]=EX(X[B+3]); PIN(X); SBAR(); }while(0)
  #define VRD(i) do{ vlo[i]=vtr(vp_+(((i)>>2)*4096+((i)&3)*1024)); vhi[i]=vtr(vp_+(((i)>>2)*4096+((i)&3)*1024+512)); }while(0)
  #define KRD(G,j) do{ if(G){ kload2(kf,kp0+sl_next,j); SBAR(); } }while(0)
  #define STEP(C0,C1,P0,P1,t,GK,GV,GL) do{ SBAR(); \
    const lds_cptr vp_=vp0+sl_prev; \
    VRD(0); SBAR(); float sacc=(P0[0]+P0[1]); \
    GAPA(C0=__builtin_amdgcn_mfma_f32_32x32x16_bf16(kf[0],qr[0],negm,0,0,0), P0[2],P0[3],P0[4],P0[5],     pw0[0]=PKW(P0,0), pw0[1]=PKW(P0,2), pw0); \
    VRD(4); SBAR(); GAPA(C1=__builtin_amdgcn_mfma_f32_32x32x16_bf16(kf[1],qr[0],negm,0,0,0), P0[6],P0[7],P0[8],P0[9],     pw0[2]=PKW(P0,4), pw0[3]=PKW(P0,6), pw0); \
    VRD(1); SBAR(); GAPA(C0=__builtin_amdgcn_mfma_f32_32x32x16_bf16(kf[2],qr[1],C0,0,0,0),   P0[10],P0[11],P0[12],P0[13], pw1[0]=PKW(P0,8), pw1[1]=PKW(P0,10), pw1); \
    VRD(5); SBAR(); GAPA(C1=__builtin_amdgcn_mfma_f32_32x32x16_bf16(kf[3],qr[1],C1,0,0,0),   P0[14],P0[15],P1[0],P1[1],   pw1[2]=PKW(P0,12),pw1[3]=PKW(P0,14), pw1); \
    VRD(2); SBAR(); GAPA(C0=__builtin_amdgcn_mfma_f32_32x32x16_bf16(kf[4],qr[2],C0,0,0,0),   P1[2],P1[3],P1[4],P1[5],     pw2[0]=PKW(P1,0), pw2[1]=PKW(P1,2), pw2); \
    VRD(6); SBAR(); GAPA(C1=__builtin_amdgcn_mfma_f32_32x32x16_bf16(kf[5],qr[2],C1,0,0,0),   P1[6],P1[7],P1[8],P1[9],     pw2[2]=PKW(P1,4), pw2[3]=PKW(P1,6), pw2); \
    VRD(3); SBAR(); GAPA(C0=__builtin_amdgcn_mfma_f32_32x32x16_bf16(kf[6],qr[3],C0,0,0,0),   P1[10],P1[11],P1[12],P1[13], pw3[0]=PKW(P1,8), pw3[1]=PKW(P1,10), pw3); \
    VRD(7); SBAR(); GAPA(C1=__builtin_amdgcn_mfma_f32_32x32x16_bf16(kf[7],qr[3],C1,0,0,0),   P1[14],P1[15],0.f,0.f,       pw3[2]=PKW(P1,12),pw3[3]=PKW(P1,14), pw3); \
    l_reg+=sacc; \
    if(GK){DMA_K((t)+3,sl_cur);} if(GV){DMA_V((t)+1,sl_next);} \
    CMASK(C0,C1,t); \
    { float a=MX3(C0[0],C0[1],C1[0]),b=MX3(C0[2],C0[3],C1[1]); a=MX3(a,C1[2],C1[3]); \
      _Pragma("unroll") for(int r=4;r<16;r+=4){a=MX3(a,C0[r],C0[r+1]);b=MX3(b,C0[r+2],C0[r+3]);a=MX3(a,C1[r],C1[r+1]);b=MX3(b,C1[r+2],C1[r+3]);} \
      float rm=__builtin_fmaxf(a,b); { auto rr=__builtin_amdgcn_permlane32_swap(__float_as_uint(rm),__float_as_uint(rm),false,false); rm=__builtin_fmaxf(__uint_as_float(rr[0]),__uint_as_float(rr[1])); } \
      resc=false; \
      if(__builtin_expect(__any(rm>(float)THRL),0)){ const float dl=__builtin_fmaxf(rm,0.f); mhat+=dl; \
        _Pragma("unroll") for(int r=0;r<16;++r){C0[r]-=dl;C1[r]-=dl;} \
        _Pragma("unroll") for(int r=0;r<16;++r)negm[r]=-mhat; asm volatile("":"+v"(negm)); \
        const float f=__builtin_amdgcn_exp2f(-dl); l_reg*=f; if(hi==0)wsf[r32]=f; resc=true; } } \
    SBAR(); \
    GAPB(o[0]=__builtin_amdgcn_mfma_f32_32x32x16_bf16(PAF(0),VFR(0),o[0],0,0,0), C0,0); \
    GAPB(o[1]=__builtin_amdgcn_mfma_f32_32x32x16_bf16(PAF(0),VFR(4),o[1],0,0,0), C0,4); \
    KRD(GL,0); GAPB(o[0]=__builtin_amdgcn_mfma_f32_32x32x16_bf16(PAF(1),VFR(1),o[0],0,0,0), C0,8); \
    KRD(GL,1); GAPB(o[1]=__builtin_amdgcn_mfma_f32_32x32x16_bf16(PAF(1),VFR(5),o[1],0,0,0), C0,12); \
    KRD(GL,2); GAPB(o[0]=__builtin_amdgcn_mfma_f32_32x32x16_bf16(PAF(2),VFR(2),o[0],0,0,0), C1,0); \
    KRD(GL,3); GAPB(o[1]=__builtin_amdgcn_mfma_f32_32x32x16_bf16(PAF(2),VFR(6),o[1],0,0,0), C1,4); \
    GAPB(o[0]=__builtin_amdgcn_mfma_f32_32x32x16_bf16(PAF(3),VFR(3),o[0],0,0,0), C1,8); \
    GAPB(o[1]=__builtin_amdgcn_mfma_f32_32x32x16_bf16(PAF(3),VFR(7),o[1],0,0,0), C1,12); \
    }while(0)
  int t=1;
  for(;t+5<NT;t+=2){
    STEP(pB0,pB1,pA0,pA1,t,true,true,true);     WAIT_BAR(2); RESC(); ROT();
    STEP(pA0,pA1,pB0,pB1,t+1,true,true,true);   WAIT_BAR(2); RESC(); ROT();
  }
  #define ENDW(tt) do{ if((tt)+3<NT){WAIT_BAR(2);} else if((tt)+2<NT){WAIT_BAR(1);} else {WAIT_BAR(0);} }while(0)
  for(;t+1<NT;t+=2){
    STEP(pB0,pB1,pA0,pA1,t,(t+3<NT),(t+1<NT),(t+1<NT));       ENDW(t);   RESC(); ROT();
    STEP(pA0,pA1,pB0,pB1,t+1,(t+4<NT),(t+2<NT),(t+2<NT));     ENDW(t+1); RESC(); ROT();
  }
  STEP(pB0,pB1,pA0,pA1,NT-1,false,false,false); RESC();
  { float sacc=pB0[0]+pB0[1]; _Pragma("unroll") for(int r=2;r<16;++r)sacc+=pB0[r]; _Pragma("unroll") for(int r=0;r<16;++r)sacc+=pB1[r]; l_reg+=sacc;
    pw0=(u32x4){PKW(pB0,0),PKW(pB0,2),PKW(pB0,4),PKW(pB0,6)};pw1=(u32x4){PKW(pB0,8),PKW(pB0,10),PKW(pB0,12),PKW(pB0,14)};pw2=(u32x4){PKW(pB1,0),PKW(pB1,2),PKW(pB1,4),PKW(pB1,6)};pw3=(u32x4){PKW(pB1,8),PKW(pB1,10),PKW(pB1,12),PKW(pB1,14)};
    SBAR(); pv(o,vb0+sl_cur,PAF(0),PAF(1),PAF(2),PAF(3)); }
  #undef PKW
  #undef PAF
  #undef VFR
  #undef PIN
  #undef MX3
  #undef GAPA
  #undef GAPB
  #undef EX
  #undef VRD
  #undef KRD
  #undef STEP
  #undef ENDW
  {auto rr=__builtin_amdgcn_permlane32_swap(__float_as_uint(l_reg),__float_as_uint(l_reg),false,false);l_reg=__uint_as_float(rr[0])+__uint_as_float(rr[1]);}
  if(hi==0)wsf[32+r32]=l_reg;asm volatile("s_waitcnt lgkmcnt(0)":::"memory");
  float rli[16];
  #pragma unroll
  for(int r=0;r<16;++r)rli[r]=__builtin_amdgcn_rcpf(wsf[32+crow(r,hi)]);
  bf16*Ow=O+(rowbase+q0)*OP+512+wid*D;
  { bf16*stg=(bf16*)(shm+LDS_OST)+wid*2048;
    #pragma unroll
    for(int r=0;r<16;++r){const int orow=crow(r,hi);
      #pragma unroll
      for(int d0=0;d0<2;++d0)stg[orow*64+d0*32+r32]=(bf16)(cvtpk_s(o[d0][r]*rli[r],0.f)&0xffffu);}
    asm volatile("s_waitcnt lgkmcnt(0)":::"memory");
    #pragma unroll
    for(int i=0;i<4;++i){const int row=i*8+(lane>>3),ch=lane&7; const u32x4 v=*(const u32x4*)(stg+row*64+ch*8); ATTN_STORE16(Ow+(long)row*OP+ch*8,v);} }
  asm volatile("s_waitcnt lgkmcnt(0)\n\ts_barrier":::"memory");
  #undef DMA_K
  #undef DMA_V
  #undef CMASK
  #undef START
  #undef RESC
  #undef ROT
}
constexpr int ATTN_LDS_BYTES=LDS_BYTES;
#undef SBAR
#undef WAIT_BAR
}

constexpr int DSA_MASK_OFF = 131072, DSA_MASK_STRIDE = 66;
typedef short bf16x8_t __attribute__((ext_vector_type(8)));
__device__ __forceinline__ int wave_sum_dpp_i(int x) {
    x += __builtin_amdgcn_update_dpp(0, x, 0xB1, 0xf, 0xf, true);
    x += __builtin_amdgcn_update_dpp(0, x, 0x4E, 0xf, 0xf, true);
    x += __builtin_amdgcn_update_dpp(0, x, 0x114, 0xf, 0xf, true);
    x += __builtin_amdgcn_update_dpp(0, x, 0x118, 0xf, 0xf, true);
    x += __builtin_amdgcn_update_dpp(0, x, 0x142, 0xa, 0xf, false);
    x += __builtin_amdgcn_update_dpp(0, x, 0x143, 0xc, 0xf, false);
    return __builtin_amdgcn_readlane(x, 63);
}
__device__ __forceinline__ int count_ge(const unsigned (&k)[32], unsigned cand, int nreg) {
    int cl = 0;
#pragma unroll
    for (int g4 = 0; g4 < 8; ++g4) if (4 * g4 < nreg) {
#pragma unroll
        for (int j = 0; j < 4; ++j) cl += (k[4 * g4 + j] >= cand) ? 1 : 0; }
    return wave_sum_dpp_i(cl);
}
template <int OPK> __device__ __forceinline__ float dpp_opf(float a, float b) { return OPK == 0 ? fmaxf(a, b) : fminf(a, b); }
template <int OPK> __device__ __forceinline__ float wave_reduce_f(float x) {
    const int id = OPK == 0 ? (int)0xff800000 : (int)0x7f800000;
    x = dpp_opf<OPK>(x, __int_as_float(__builtin_amdgcn_update_dpp(id, __float_as_int(x), 0xB1, 0xf, 0xf, false)));
    x = dpp_opf<OPK>(x, __int_as_float(__builtin_amdgcn_update_dpp(id, __float_as_int(x), 0x4E, 0xf, 0xf, false)));
    x = dpp_opf<OPK>(x, __int_as_float(__builtin_amdgcn_update_dpp(id, __float_as_int(x), 0x114, 0xf, 0xf, false)));
    x = dpp_opf<OPK>(x, __int_as_float(__builtin_amdgcn_update_dpp(id, __float_as_int(x), 0x118, 0xf, 0xf, false)));
    x = dpp_opf<OPK>(x, __int_as_float(__builtin_amdgcn_update_dpp(id, __float_as_int(x), 0x142, 0xa, 0xf, false)));
    x = dpp_opf<OPK>(x, __int_as_float(__builtin_amdgcn_update_dpp(id, __float_as_int(x), 0x143, 0xc, 0xf, false)));
    return __int_as_float(__builtin_amdgcn_readlane(__float_as_int(x), 63));
}
__device__ __forceinline__ int binof(float v, float vmin, float scale) { const int b = (int)__fmul_rn(__fsub_rn(v, vmin), scale); return b > 2047 ? 2047 : b; }
__device__ __forceinline__ unsigned long long select_topk(const float (&k)[32], int kk, int nvalid, int nreg, int lane, LAS unsigned* hist, unsigned* errw) {
    const float NINF = -INFINITY;
    int mlo = 0, mhi = 0;
#define SEL_PUT(i, m) do { if (lane == (i)) { mlo = (int)(unsigned)(m); mhi = (int)(unsigned)((m) >> 32); } } while (0)
#define SEL_MINE (((unsigned long long)(unsigned)mhi << 32) | (unsigned long long)(unsigned)mlo)
    if (nvalid <= kk) {
#pragma unroll
        for (int i = 0; i < 32; ++i) { const unsigned long long m = __ballot(k[i] > NINF); SEL_PUT(i, m); }
        return SEL_MINE;
    }
    float T = 0.f; bool exact = false;
    float mx = NINF, mn = INFINITY;
#pragma unroll
    for (int g4 = 0; g4 < 8; ++g4) if (4 * g4 < nreg) {
#pragma unroll
        for (int j = 0; j < 4; ++j) { const float v = k[4 * g4 + j]; mx = fmaxf(mx, v); mn = fminf(mn, v > NINF ? v : INFINITY); } }
    const float vmax = wave_reduce_f<0>(mx), vmin = wave_reduce_f<1>(mn);
    if (vmax == vmin) { T = vmax; }
    else {
        const float scale = 2048.0f / (vmax - vmin);
        LAS u32x4* h4 = (LAS u32x4*)hist;
#pragma unroll
        for (int j = 0; j < 4; ++j) h4[lane + 64 * j] = (u32x4){0u, 0u, 0u, 0u};
#pragma unroll
        for (int g4 = 0; g4 < 8; ++g4) if (4 * g4 < nreg) {
#pragma unroll
            for (int j = 0; j < 4; ++j) { const float v = k[4 * g4 + j]; const bool ok = v > NINF; const unsigned bin = ok ? (unsigned)binof(v, vmin, scale) : 0u;
                __hip_atomic_fetch_add(hist + (bin >> 1), ok ? (1u << (16 * (bin & 1u))) : 0u, __ATOMIC_RELAXED, __HIP_MEMORY_SCOPE_WORKGROUP); } }
        u32x4 w[4];
#pragma unroll
        for (int j = 0; j < 4; ++j) w[j] = ((LAS u32x4*)(hist + 1008 - 16 * lane))[j];
        int s = 0;
#pragma unroll
        for (int j = 0; j < 4; ++j)
#pragma unroll
            for (int e = 0; e < 4; ++e) s += (int)(w[j][e] & 0xffffu) + (int)(w[j][e] >> 16);
        int Pinc = s;
#pragma unroll
        for (int o = 1; o < 64; o <<= 1) { const int v = __shfl_up(Pinc, o); if (lane >= o) Pinc += v; }
        const unsigned long long geb = __ballot(Pinc >= kk);
        const int Lstar = __builtin_ctzll(geb);
        const int above_l = __builtin_amdgcn_readlane(Pinc - s, Lstar);
        const int binj = 2047 - 32 * Lstar - (lane & 31);
        const unsigned wdj = hist[binj >> 1]; const int cntj = (binj & 1) ? (int)(wdj >> 16) : (int)(wdj & 0xffffu);
        int P2 = cntj;
#pragma unroll
        for (int o = 1; o < 32; o <<= 1) { const int v = __shfl_up(P2, o); if ((lane & 31) >= o) P2 += v; }
        P2 += above_l;
        const int jst = __builtin_ctzll(__ballot(P2 >= kk));
        const int Bstar = 2047 - 32 * Lstar - jst, cnt_above = __builtin_amdgcn_readlane(P2 - cntj, jst), cB = __builtin_amdgcn_readlane(cntj, jst);
        const int r = kk - cnt_above;
        if (cB <= 64) {
            LAS unsigned* cand = hist + 1024; int base = 0;
#pragma unroll
            for (int g4 = 0; g4 < 8; ++g4) if (4 * g4 < nreg) {
#pragma unroll
                for (int j = 0; j < 4; ++j) { const float v = k[4 * g4 + j]; const bool c = (v > NINF) && (binof(v, vmin, scale) == Bstar); const unsigned long long bal = __ballot(c);
                    if (bal) { if (c) cand[base + __builtin_amdgcn_mbcnt_hi((unsigned)(bal >> 32), __builtin_amdgcn_mbcnt_lo((unsigned)bal, 0u))] = __float_as_uint(v); base += __popcll(bal); } } }
            const float myc = (lane < cB) ? __uint_as_float(cand[lane]) : NINF;
            float prev = INFINITY; int cum = 0;
            for (int it = 0; it < 64; ++it) {
                const float m = wave_reduce_f<0>(myc < prev ? myc : NINF);
                cum += __popcll(__ballot(myc == m));
                if (cum >= r) { T = m; exact = (cum == r); break; }
                prev = m;
            }
        } else {
            float prev = INFINITY; int cum = 0;
            for (int it = 0; it < 2048; ++it) {
                float lm = NINF;
#pragma unroll
                for (int i = 0; i < 32; ++i) { const float v = k[i]; if (v > NINF && v < prev && binof(v, vmin, scale) == Bstar) lm = fmaxf(lm, v); }
                const float m = wave_reduce_f<0>(lm);
                int mult = 0;
#pragma unroll
                for (int i = 0; i < 32; ++i) mult += __popcll(__ballot(k[i] == m));
                cum += mult;
                if (cum >= r) { T = m; exact = (cum == r); break; }
                prev = m;
            }
        }
    }
    if (exact) {
#pragma unroll
        for (int i = 0; i < 32; ++i) { const unsigned long long m = __ballot(k[i] >= T); SEL_PUT(i, m); }
    } else {
        int ngt = 0;
#pragma unroll
        for (int i = 0; i < 32; ++i) ngt += __popcll(__ballot(k[i] > T));
        int need = kk - ngt;
#pragma unroll
        for (int i = 0; i < 32; ++i) {
            const unsigned long long eqb = __ballot(k[i] == T);
            const int rank = __builtin_amdgcn_mbcnt_hi((unsigned)(eqb >> 32), __builtin_amdgcn_mbcnt_lo((unsigned)eqb, 0u));
            const bool sel = (k[i] > T) || ((k[i] == T) && (rank < need));
            const unsigned long long m = __ballot(sel);
            need -= __popcll(eqb); if (need < 0) need = 0;
            SEL_PUT(i, m);
        }
    }
    const unsigned long long mine = SEL_MINE;
    if (wave_sum_dpp_i(lane < 32 ? __popcll(mine) : 0) != kk && lane == 0) atomicOr(errw, 1u);
    return mine;
#undef SEL_PUT
#undef SEL_MINE
}
__device__ __forceinline__ void dsa_select(int b, int qb, const bf16* IQb, const bf16* IKb, const float* IW, unsigned char* lds, int lane, int wave, unsigned* errw) {
    lane = launder_i(lane);
    unsigned* keys = (unsigned*)lds; unsigned* maskw = (unsigned*)(lds + DSA_MASK_OFF);
    if (qb < TOPK / 32) {
#pragma unroll 1
        for (int j = 0; j < 4; ++j) { const int q = 4 * wave + j, t = qb * 32 + q;
            if (lane < 32) { const int lo = 64 * lane; unsigned long long m = 0ull; if (t >= lo + 63) m = ~0ull; else if (t >= lo) m = (2ull << (t - lo)) - 1ull;
                *(unsigned long long*)(maskw + q * DSA_MASK_STRIDE + 2 * lane) = m; } }
        __syncthreads();
        return;
    }
    const size_t rb = (size_t)b * SEQ; const int q0 = qb * 32; const int ntk16 = 4 * ((qb >> 1) + 1);
    const int l15 = lane & 15, l4 = lane >> 4;
    bf16x8_t a2[2][4][2]; f32x4 wq2[2][4];
#pragma unroll
    for (int rr = 0; rr < 2; ++rr)
#pragma unroll
        for (int mt = 0; mt < 4; ++mt) {
            const bf16* ar = IQb + (rb + q0 + 16 * rr + 4 * mt + (l15 >> 2)) * 256 + (l15 & 3) * 64 + 8 * l4;
            a2[rr][mt][0] = *(const bf16x8_t*)ar; a2[rr][mt][1] = *(const bf16x8_t*)(ar + 32);
            wq2[rr][mt] = *(const f32x4*)(IW + (rb + q0 + 16 * rr + 4 * mt + l4) * 4);
        }
#pragma unroll
    for (int rnd = 0; rnd < 2; ++rnd) {
        const int qb0 = q0 + 16 * rnd;
        bf16x8_t a[4][2]; f32x4 wq[4];
#pragma unroll
        for (int mt = 0; mt < 4; ++mt) { a[mt][0] = a2[rnd][mt][0]; a[mt][1] = a2[rnd][mt][1]; wq[mt] = wq2[rnd][mt]; }
        bf16x8_t bc[4][2], bn[4][2];
#define DSA_LOADG(dst, ntb) do { _Pragma("unroll") for (int u = 0; u < 4; ++u) { const int nt_ = (ntb) + 8 * u; \
            if (nt_ < ntk16) { const bf16* br = IKb + (rb + 16 * nt_ + l15) * 64 + 8 * l4; dst[u][0] = *(const bf16x8_t*)br; dst[u][1] = *(const bf16x8_t*)(br + 32); } \
            else { dst[u][0] = (bf16x8_t){0, 0, 0, 0, 0, 0, 0, 0}; dst[u][1] = dst[u][0]; } } } while (0)
        DSA_LOADG(bn, wave);
        for (int ntb = wave; ntb < ntk16; ntb += 32) {
#pragma unroll
            for (int u = 0; u < 4; ++u) { bc[u][0] = bn[u][0]; bc[u][1] = bn[u][1]; }
            if (ntb + 32 < ntk16) DSA_LOADG(bn, ntb + 32);
#pragma unroll
            for (int u = 0; u < 4; ++u) {
                const int nt = ntb + 8 * u;
                if (nt < ntk16) {
                    const int s = 16 * nt + l15;
#pragma unroll
                    for (int mt = 0; mt < 4; ++mt) {
                        f32x4 c = (f32x4){0.f, 0.f, 0.f, 0.f};
                        c = __builtin_amdgcn_mfma_f32_16x16x32_bf16(a[mt][0], bc[u][0], c, 0, 0, 0);
                        c = __builtin_amdgcn_mfma_f32_16x16x32_bf16(a[mt][1], bc[u][1], c, 0, 0, 0);
                        const float r0 = __int_as_float(max(__float_as_int(c[0]), 0)), r1 = __int_as_float(max(__float_as_int(c[1]), 0)), r2 = __int_as_float(max(__float_as_int(c[2]), 0)), r3 = __int_as_float(max(__float_as_int(c[3]), 0));
                        float sc = wq[mt][0] * r0; sc = fmaf(wq[mt][1], r1, sc); sc = fmaf(wq[mt][2], r2, sc); sc = fmaf(wq[mt][3], r3, sc);
                        const int ql = 4 * mt + l4, t = qb0 + ql;
                        keys[ql * 2048 + s] = (s <= t) ? __float_as_uint(sc) : 0xff800000u;
                    }
                }
            }
        }
#undef DSA_LOADG
        __syncthreads();
#pragma unroll 1
        for (int j = 0; j < 2; ++j) {
            const int ql = 2 * wave + j, t = qb0 + ql, kk = (t + 1 < TOPK) ? (t + 1) : TOPK, nreg = (t >> 6) + 1;
            float k[32];
#pragma unroll
            for (int i = 0; i < 32; ++i) k[i] = (i < nreg) ? __uint_as_float(keys[ql * 2048 + 64 * i + lane]) : -INFINITY;
            const unsigned long long mine = select_topk(k, kk, t + 1, nreg, lane, (LAS unsigned*)((LAS unsigned char*)lds) + ql * 2048, errw);
            if (lane < 32) *(unsigned long long*)(maskw + (16 * rnd + ql) * DSA_MASK_STRIDE + 2 * lane) = mine;
        }
        __syncthreads();
    }
}

constexpr int LD64 = 72, LD128 = 136;
constexpr int SSD_CM = 0, SSD_BM = 18432, SSD_XS = 36864, SSD_XDT = 55296, SSD_BDT = 72704, SSD_MT = 90112, SSD_HB = 124928, SSD_DTS = 134144, SSD_ACUM = 134656, SSD_CW = 135168;
__device__ __forceinline__ bf16x8_t ldfrag(const bf16* base, int row, int ld, int k0) { return *(const bf16x8_t*)(base + row * ld + k0); }
__device__ __forceinline__ void ssd_item(int b, int h, KPtr P, const bf16* XBC, const float* DT, const bf16* Zb, bf16* ASb, float* SSQP, unsigned char* lds, int tid) {
    tid = launder_i(tid);
    const int lane = tid & 63, w = __builtin_amdgcn_readfirstlane(tid >> 6), l15 = lane & 15, l4 = lane >> 4, g = h >> 2;
    bf16* Cm = (bf16*)(lds + SSD_CM); bf16* Bm = (bf16*)(lds + SSD_BM); bf16* xs = (bf16*)(lds + SSD_XS); bf16* XdtT = (bf16*)(lds + SSD_XDT);
    bf16* BdT = (bf16*)(lds + SSD_BDT); bf16* Mt = (bf16*)(lds + SSD_MT); bf16* Hb = (bf16*)(lds + SSD_HB);
    float* dts = (float*)(lds + SSD_DTS); float* acum = (float*)(lds + SSD_ACUM);
    const float A = -__expf(P->a_log[h]), dtb = P->dt_bias[h], Dh = P->d_skip[h];
    f32x4 Hacc[2]; Hacc[0] = (f32x4){0.f, 0.f, 0.f, 0.f}; Hacc[1] = Hacc[0];
    for (int e = tid; e < 64 * LD64 / 2; e += NT) ((unsigned*)Hb)[e] = 0u;
    float* cwl = (float*)(lds + SSD_CW);
    for (int e = tid; e < 960; e += NT) { const int T = (e < 768) ? (e >> 8) : ((e - 768) >> 6), ch = e & 63, cb = (T == 0) ? h * 64 : (T == 1 ? 512 + g * 64 : 640 + g * 64);
        cwl[e] = (e < 768) ? P->conv_w[((e >> 6) & 3) * 768 + cb + ch] : P->conv_b[cb + ch]; }
    const int pt = w >> 1, ntb = 2 * (w & 1);
    const int sl = tid >> 2, sc0 = (tid & 3) * 16;
    u32x4 raw[3][4][2]; float dtraw = 0.f; u32x2 zc[4], zn[4];
#define SSD_LOADRAW(cc) do { const size_t rb_ = (size_t)b * SEQ + (cc) * 128; const bf16* xr_ = XBC + (rb_ + sl) * 768; \
        _Pragma("unroll") for (int T_ = 0; T_ < 3; ++T_) { const int cb_ = (T_ == 0) ? h * 64 : (T_ == 1 ? 512 + g * 64 : 640 + g * 64); \
            _Pragma("unroll") for (int j_ = 0; j_ < 4; ++j_) { raw[T_][j_][0] = *(const u32x4*)(xr_ + (j_ - 3) * 768 + cb_ + sc0); raw[T_][j_][1] = *(const u32x4*)(xr_ + (j_ - 3) * 768 + cb_ + sc0 + 8); } } } while (0)
#define SSD_PREFETCH(cc, ZD) do { const size_t rb_ = (size_t)b * SEQ + (cc) * 128; \
        if (tid < 128) dtraw = DT[(rb_ + tid) * 8 + h]; \
        _Pragma("unroll") for (int jt_ = 0; jt_ < 4; ++jt_) ZD[jt_] = *(const u32x2*)(Zb + (rb_ + 16 * w + l15) * 512 + h * 64 + 16 * jt_ + 4 * l4); } while (0)
    SSD_PREFETCH(0, zc);
    for (int c = 0; c < SEQ / 128; ++c) {
        const size_t rbase = (size_t)b * SEQ + c * 128;
        SSD_LOADRAW(c);
        if (tid < 128) { const float v = dtraw + dtb; dts[tid] = (v > 20.f) ? v : log1pf(__expf(v)); }
        __syncthreads();
        if (w == 0) {
            const float a0 = dts[2 * lane] * A, a1 = dts[2 * lane + 1] * A; const float s = a0 + a1; float inc = s;
#pragma unroll
            for (int o = 1; o < 64; o <<= 1) { const float v = __shfl_up(inc, o); if (lane >= o) inc += v; }
            const float ex = inc - s; acum[2 * lane] = ex + a0; acum[2 * lane + 1] = ex + s;
        }
        __syncthreads();
        const float alast = acum[127];
        {
            const int l = sl, c0 = sc0;
            const float dtl = dts[l], dec = __expf(alast - acum[l]);
            const int tmin = 3 - (c * 128 + l);
#pragma unroll
            for (int T = 0; T < 3; ++T) {
                u32x4 u[4][2];
#pragma unroll
                for (int j = 0; j < 4; ++j) { u[j][0] = raw[T][j][0]; u[j][1] = raw[T][j][1]; }
                if (c == 0) {
#pragma unroll
                    for (int j = 0; j < 3; ++j) if (j < tmin) { u[j][0] = (u32x4){0u, 0u, 0u, 0u}; u[j][1] = u[j][0]; } }
                float v[16];
#pragma unroll
                for (int i = 0; i < 16; ++i) v[i] = cwl[768 + T * 64 + c0 + i];
#pragma unroll
                for (int j = 0; j < 4; ++j)
#pragma unroll
                    for (int i = 0; i < 16; ++i) { const unsigned wd = u[j][i >> 3][(i >> 1) & 3]; const float xv = (i & 1) ? __uint_as_float(wd & 0xffff0000u) : __uint_as_float(wd << 16);
                        v[i] = fmaf(cwl[(T * 4 + j) * 64 + c0 + i], xv, v[i]); }
#pragma unroll
                for (int i = 0; i < 16; ++i) v[i] = silu(v[i]);
                bf16* dstm = (T == 0) ? xs : (T == 1 ? Bm : Cm);
                u32x4 o0, o1; o0.x = pg8::cvt_pk_bf16(v[0], v[1]); o0.y = pg8::cvt_pk_bf16(v[2], v[3]); o0.z = pg8::cvt_pk_bf16(v[4], v[5]); o0.w = pg8::cvt_pk_bf16(v[6], v[7]);
                o1.x = pg8::cvt_pk_bf16(v[8], v[9]); o1.y = pg8::cvt_pk_bf16(v[10], v[11]); o1.z = pg8::cvt_pk_bf16(v[12], v[13]); o1.w = pg8::cvt_pk_bf16(v[14], v[15]);
                *(u32x4*)(dstm + l * LD64 + c0) = o0; *(u32x4*)(dstm + l * LD64 + c0 + 8) = o1;
                if (T == 0) {
#pragma unroll
                    for (int i = 0; i < 16; ++i) XdtT[(c0 + i) * LD128 + l] = f2bf(v[i] * dtl); }
                if (T == 1) {
#pragma unroll
                    for (int i = 0; i < 16; ++i) BdT[(c0 + i) * LD128 + l] = f2bf(v[i] * dec); }
            }
        }
        if (c + 1 < SEQ / 128) SSD_PREFETCH(c + 1, zn);
        __syncthreads();
        const int lrow = 16 * w + l15; const float al = acum[lrow];
        {
            const bf16x8_t c0f = ldfrag(Cm, lrow, LD64, 8 * l4), c1f = ldfrag(Cm, lrow, LD64, 32 + 8 * l4);
            for (int j = 0; j <= w; ++j) {
                const bf16x8_t bf0 = ldfrag(Bm, 16 * j + l15, LD64, 8 * l4), bf1 = ldfrag(Bm, 16 * j + l15, LD64, 32 + 8 * l4);
                f32x4 acc = (f32x4){0.f, 0.f, 0.f, 0.f};
                acc = __builtin_amdgcn_mfma_f32_16x16x32_bf16(bf0, c0f, acc, 0, 0, 0);
                acc = __builtin_amdgcn_mfma_f32_16x16x32_bf16(bf1, c1f, acc, 0, 0, 0);
                const int s0 = 16 * j + 4 * l4; float m[4];
#pragma unroll
                for (int r = 0; r < 4; ++r) { const int s = s0 + r; m[r] = (s <= lrow) ? acc[r] * __expf(al - acum[s]) : 0.f; }
                u32x2 o; o.x = pg8::cvt_pk_bf16(m[0], m[1]); o.y = pg8::cvt_pk_bf16(m[2], m[3]);
                *(u32x2*)(Mt + lrow * LD128 + s0) = o;
            }
            if ((w & 1) == 0) *(u32x2*)(Mt + lrow * LD128 + 16 * (w + 1) + 4 * l4) = (u32x2){0u, 0u};
        }
        {
            const bf16x8_t c0f = ldfrag(Cm, lrow, LD64, 8 * l4), c1f = ldfrag(Cm, lrow, LD64, 32 + 8 * l4);
            const float ea = __expf(al); const int nks = (w >> 1) + 1;
            float ssq = 0.f;
            bf16x8_t mf[4];
#pragma unroll
            for (int ks = 0; ks < 4; ++ks) mf[ks] = (ks < nks) ? ldfrag(Mt, lrow, LD128, 32 * ks + 8 * l4) : (bf16x8_t){0, 0, 0, 0, 0, 0, 0, 0};
#pragma unroll
            for (int jt = 0; jt < 4; ++jt) {
                bf16x8_t hb0 = ldfrag(Hb, 16 * jt + l15, LD64, 8 * l4), hb1 = ldfrag(Hb, 16 * jt + l15, LD64, 32 + 8 * l4), xd[4];
#pragma unroll
                for (int ks = 0; ks < 4; ++ks) if (ks < nks) xd[ks] = ldfrag(XdtT, 16 * jt + l15, LD128, 32 * ks + 8 * l4);
                f32x4 acc = (f32x4){0.f, 0.f, 0.f, 0.f};
                acc = __builtin_amdgcn_mfma_f32_16x16x32_bf16(hb0, c0f, acc, 0, 0, 0);
                acc = __builtin_amdgcn_mfma_f32_16x16x32_bf16(hb1, c1f, acc, 0, 0, 0);
                acc = acc * ea;
#pragma unroll
                for (int ks = 0; ks < 4; ++ks) if (ks < nks) acc = __builtin_amdgcn_mfma_f32_16x16x32_bf16(xd[ks], mf[ks], acc, 0, 0, 0);
                const int p0 = 16 * jt + 4 * l4;
                const u32x2 xb = *(const u32x2*)(xs + lrow * LD64 + p0);
                const u32x2 zb = zc[jt];
                const float x0 = __uint_as_float(xb.x << 16), x1 = __uint_as_float(xb.x & 0xffff0000u), x2 = __uint_as_float(xb.y << 16), x3 = __uint_as_float(xb.y & 0xffff0000u);
                const float z0 = __uint_as_float(zb.x << 16), z1 = __uint_as_float(zb.x & 0xffff0000u), z2 = __uint_as_float(zb.y << 16), z3 = __uint_as_float(zb.y & 0xffff0000u);
                f32x4 y; y[0] = (acc[0] + Dh * x0) * silu(z0); y[1] = (acc[1] + Dh * x1) * silu(z1); y[2] = (acc[2] + Dh * x2) * silu(z2); y[3] = (acc[3] + Dh * x3) * silu(z3);
                u32x2 yo; yo.x = pg8::cvt_pk_bf16(y[0], y[1]); yo.y = pg8::cvt_pk_bf16(y[2], y[3]);
                *(u32x2*)(ASb + (rbase + lrow) * 1024 + h * 64 + p0) = yo;
                ssq += (y[0] * y[0] + y[1] * y[1]) + (y[2] * y[2] + y[3] * y[3]);
            }
            ssq += __shfl_xor(ssq, 16); ssq += __shfl_xor(ssq, 32);
            if (l4 == 0) SSQP[(rbase + lrow) * 8 + h] = ssq;
        }
        __syncthreads();
        {
            const float el = __expf(alast);
            bf16x8_t xf[4];
#pragma unroll
            for (int ks = 0; ks < 4; ++ks) xf[ks] = ldfrag(XdtT, 16 * pt + l15, LD128, 32 * ks + 8 * l4);
#pragma unroll
            for (int i = 0; i < 2; ++i) {
                bf16x8_t bd[4];
#pragma unroll
                for (int ks = 0; ks < 4; ++ks) bd[ks] = ldfrag(BdT, 16 * (ntb + i) + l15, LD128, 32 * ks + 8 * l4);
                f32x4 acc = Hacc[i] * el;
#pragma unroll
                for (int ks = 0; ks < 4; ++ks) acc = __builtin_amdgcn_mfma_f32_16x16x32_bf16(xf[ks], bd[ks], acc, 0, 0, 0);
                Hacc[i] = acc;
#pragma unroll
                for (int r = 0; r < 4; ++r) Hb[(16 * pt + 4 * l4 + r) * LD64 + 16 * (ntb + i) + l15] = f2bf(acc[r]);
            }
        }
#pragma unroll
        for (int jt = 0; jt < 4; ++jt) zc[jt] = zn[jt];
    }
    __syncthreads();
#undef SSD_PREFETCH
#undef SSD_LOADRAW
}

struct MoeOrder {
    int n; const LAS int* ul;
    __device__ __forceinline__ bool next(int i, pg8::Unit& u) const { if (i >= n) return false; u.pm = ul[2 * i]; u.pn = ul[2 * i + 1]; return true; }
    __device__ __forceinline__ void a_ready(const pg8::Unit&) const {}
    __device__ __forceinline__ void done(const pg8::Unit&) const {}
};
struct EpiSwiGLU {
    static constexpr bool PERM = true, AFTER_DRAIN = false; static constexpr int MID_T = 0;
    bf16* Hid;
    __device__ __forceinline__ void operator()(const pg8::f32x4 (&acc)[2][2][4][2], const pg8::Unit& u, int wr, int wc, int fr, int fq) const {
        const int row0 = u.pm * 256 + wr * 64 + fr, pl = u.pn & 1, hc = 128 * pl + 16 * wc + 4 * fq;
#pragma unroll
        for (int ai = 0; ai < 2; ++ai)
#pragma unroll
            for (int m = 0; m < 4; ++m) { const int row = row0 + ai * 128 + m * 16;
#pragma unroll
                for (int bj = 0; bj < 2; ++bj) { const f32x4 g = acc[ai][bj][m][0], uu = acc[ai][bj][m][1]; f32x4 h;
#pragma unroll
                    for (int e = 0; e < 4; ++e) h[e] = silu(g[e]) * uu[e];
                    u32x2 w; w.x = pg8::cvt_pk_bf16(h[0], h[1]); w.y = pg8::cvt_pk_bf16(h[2], h[3]);
                    *(u32x2*)(Hid + (size_t)row * EFF + hc + 64 * bj) = w; } }
    }
};
struct EpiDown {
    static constexpr bool PERM = true, AFTER_DRAIN = false; static constexpr int MID_T = 0;
    const int* DSTI; const float* WGT; bf16* Y;
    __device__ __forceinline__ void operator()(const pg8::f32x4 (&acc)[2][2][4][2], const pg8::Unit& u, int wr, int wc, int fr, int fq) const {
        const int row0 = u.pm * 256 + wr * 64 + fr, col0 = (u.pn & 3) * 256 + 32 * wc + 8 * fq;
#pragma unroll
        for (int ai = 0; ai < 2; ++ai)
#pragma unroll
            for (int m = 0; m < 4; ++m) { const int row = row0 + ai * 128 + m * 16; const unsigned di = (unsigned)DSTI[row]; const float w = WGT[row];
                bf16* Yr = Y + (size_t)di * DM + col0;
#pragma unroll
                for (int bj = 0; bj < 2; ++bj) { const f32x4 a = acc[ai][bj][m][0] * w, b = acc[ai][bj][m][1] * w;
                    u32x4 o; o.x = pg8::cvt_pk_bf16(a[0], a[1]); o.y = pg8::cvt_pk_bf16(a[2], a[3]); o.z = pg8::cvt_pk_bf16(b[0], b[1]); o.w = pg8::cvt_pk_bf16(b[2], b[3]);
                    *(u32x4*)(Yr + 128 * bj) = o; }
                asm volatile("" ::: "memory"); }
    }
};


__device__ __forceinline__ unsigned wave_select(const unsigned (&keys)[32], int kk, int lane) {
    unsigned T = 0u;
    for (int bit = 31; bit >= 0; --bit) {
        const unsigned cand = T | (1u << bit);
        int c = 0;
#pragma unroll
        for (int i = 0; i < 32; ++i) c += (keys[i] >= cand) ? 1 : 0;
#pragma unroll
        for (int o = 1; o < 64; o <<= 1) c += __shfl_xor(c, o);
        if (c >= kk) T = cand;
    }
    unsigned mgt = 0u, meq = 0u;
#pragma unroll
    for (int i = 0; i < 32; ++i) { mgt |= (keys[i] > T) ? (1u << i) : 0u; meq |= (keys[i] == T) ? (1u << i) : 0u; }
    int ngt = __popc(mgt), neq = __popc(meq);
    int tgt = ngt, teq = neq;
#pragma unroll
    for (int o = 1; o < 64; o <<= 1) { tgt += __shfl_xor(tgt, o); teq += __shfl_xor(teq, o); }
    const int need = kk - tgt;
    if (teq == need) return mgt | meq;
    int pre = neq;
#pragma unroll
    for (int o = 1; o < 64; o <<= 1) { const int v = __shfl_up(pre, o); if (lane >= o) pre += v; }
    pre -= neq;
    unsigned sel = mgt; int taken = pre;
#pragma unroll
    for (int i = 0; i < 32; ++i) { if ((meq >> i) & 1u) { if (taken < need) sel |= (1u << i); ++taken; } }
    return sel;
}

#define XB_TMO      128
#define XB_XCNT(j)  (256  + 64 * (j))
#define XB_XSUB(j)  (1280 + 64 * (j))
#define XB_XGEN(j)  (2304 + 64 * (j))
#define XB_TOP      3328
#define XB_TOPGEN   3392
#define XCD_BAR_WORDS 3456
#define XB_SPIN_CAP (1u << 18)

__device__ __forceinline__ unsigned xb_ld(unsigned* p)              { return __hip_atomic_load(p, __ATOMIC_RELAXED, __HIP_MEMORY_SCOPE_AGENT); }
__device__ __forceinline__ unsigned xb_add(unsigned* p, unsigned v) { return __hip_atomic_fetch_add(p, v, __ATOMIC_RELAXED, __HIP_MEMORY_SCOPE_AGENT); }
__device__ __forceinline__ unsigned xb_xcc_id() { return (unsigned)__builtin_amdgcn_s_getreg((3 << 11) | 20) & 0xFu; }
#define XB_SPIN(cond, bar) do { unsigned _sp = 0; while (cond) { __builtin_amdgcn_s_sleep(1); \
    if ((++_sp & 255u) == 0u) { if (xb_ld(&(bar)[XB_TMO])) break; if (_sp > XB_SPIN_CAP) { atomicAdd(&(bar)[XB_TMO], 1u); break; } } } } while (0)

struct XcdBarrier {
    unsigned* bar; unsigned x;
    volatile LAS unsigned* st;
};

__device__ __forceinline__ XcdBarrier xcd_barrier_post(unsigned* bar, volatile LAS unsigned* st, const int wave_s) {
    XcdBarrier b; b.bar = bar; b.x = xb_xcc_id(); b.st = st;
    if (wave_s == 0 && lane_id() == 0) (void)xb_add(&bar[XB_XCNT(b.x)], 1u);
    return b;
}
__device__ __forceinline__ void xcd_barrier_complete(unsigned* bar, unsigned x, unsigned& nloc, unsigned& nx) {
    const unsigned G = gridDim.x * gridDim.y * gridDim.z;
    unsigned sum, cnt, mine, sp = 0u;
    for (;;) {
        sum = 0u; cnt = 0u; mine = 0u;
#pragma unroll
        for (unsigned j = 0; j < 16; ++j) { const unsigned c = xb_ld(&bar[XB_XCNT(j)]); sum += c; cnt += (c > 0u) ? 1u : 0u; mine = (j == x) ? c : mine; }
        if (sum == G) break;
        __builtin_amdgcn_s_sleep(1);
        if ((++sp & 255u) == 0u) { if (xb_ld(&bar[XB_TMO])) break; if (sp > XB_SPIN_CAP) { atomicAdd(&bar[XB_TMO], 1u); break; } }
    }
    nloc = mine > 0u ? mine : 1u; nx = cnt > 0u ? cnt : 1u;
}

__device__ __forceinline__ void xcd_barrier(const XcdBarrier& b, const int wave_s) {
    asm volatile("s_waitcnt vmcnt(0)" ::: "memory");
    __syncthreads();
    if (wave_s == 0 && lane_id() == 0) {
        unsigned* bar = b.bar;
        __builtin_amdgcn_s_waitcnt(0);
        unsigned nloc = b.st[0], nx = b.st[1];
        if (nloc == 0u) { xcd_barrier_complete(bar, b.x, nloc, nx); b.st[0] = nloc; b.st[1] = nx; }
        const unsigned old = xb_add(&bar[XB_XSUB(b.x)], 1u);
        const unsigned gen = old / nloc;
        if (old + 1u == (gen + 1u) * nloc) {
            __builtin_amdgcn_fence(__ATOMIC_RELEASE, "agent");
            asm volatile("s_waitcnt vmcnt(0)" ::: "memory");
            const unsigned og = xb_add(&bar[XB_TOP], 1u);
            const unsigned tg = og / nx;
            if (og + 1u == (tg + 1u) * nx) xb_add(&bar[XB_TOPGEN], 1u);
            else XB_SPIN(xb_ld(&bar[XB_TOPGEN]) == tg, bar);
            __builtin_amdgcn_fence(__ATOMIC_ACQUIRE, "agent");
            xb_add(&bar[XB_XGEN(b.x)], 1u);
            asm volatile("s_waitcnt vmcnt(0)" ::: "memory");
        } else {
            XB_SPIN(xb_ld(&bar[XB_XGEN(b.x)]) == gen, bar);
            __builtin_amdgcn_fence(__ATOMIC_ACQUIRE, "agent");
            asm volatile("s_waitcnt vmcnt(0)" ::: "memory");
        }
    }
    __syncthreads();
}


#define PHASE_VARS const KPtr P = launder_k(KP0); const int wave = wave_s, lane = launder_i(lane_id()), tid = wave * 64 + lane, gw = bid * 8 + wave; unsigned char* ws = P->ws; unsigned* ctl = (unsigned*)(ws + WS_CTL); float2* rope = (float2*)(ws + WS_ROPE); float* tokw = (float*)(ws + WS_TOKW); int* lists = (int*)(ws + WS_LISTS); bf16* Qb = (bf16*)(ws + WS_Q); bf16* Kb = (bf16*)(ws + WS_K); bf16* Vb = (bf16*)(ws + WS_V); bf16* IKb = (bf16*)(ws + WS_IK); float* IW = (float*)(ws + WS_IW); float* DT = (float*)(ws + WS_DT); bf16* IQb = (bf16*)(ws + WS_IQ); bf16* Zb = (bf16*)(ws + WS_Z); bf16* XBC = (bf16*)(ws + WS_XBC); bf16* ASb = (bf16*)(ws + WS_AS); float* X1 = (float*)(ws + WS_X1); bf16* X1b = (bf16*)(ws + WS_X1B); bf16* Y0 = (bf16*)(ws + WS_Y0); bf16* Y1 = (bf16*)(ws + WS_Y1); float* SSQP = (float*)(ws + WS_SSQP); bf16* H1b = (bf16*)(ws + WS_X1); float* WGG = (float*)(ws + WS_RCONST + 4096); bf16* WguT = (bf16*)(ws + WS_WGU_T); bf16* WdT = (bf16*)(ws + WS_WD_T); int* ENT = (int*)(ws + WS_ENT); float* WGT = (float*)(ws + WS_ENT + 512 * 1024); int* ROWT = (int*)(ws + WS_ENT + 1024 * 1024); bf16* Xs = (bf16*)(ws + WS_XS); bf16* Hid = (bf16*)(ws + WS_HID); bf16* XB = (bf16*)(ws + WS_XB); bf16* WinT = (bf16*)(ws + WS_WIN_T); bf16* WoutT = (bf16*)(ws + WS_WOUT_T);
#ifndef PROBE_MASK
#define PROBE_MASK 0
#endif
#define STAMP(k) do { if (PROBE_MASK && bid == 0 && wave_s == 0 && lane_id() == 0) { const unsigned long long now_ = __builtin_amdgcn_s_memrealtime(); if ((PROBE_MASK >> (k)) & 1) pst[1] += now_ - pst[0]; pst[0] = now_; } } while (0)
__global__ void __launch_bounds__(NT, 2) hybrid_fwd(Params p) {
    extern __shared__ __attribute__((aligned(16))) unsigned char lds[];
    cg::grid_group grid = cg::this_grid();
    const int wave_s = __builtin_amdgcn_readfirstlane((int)threadIdx.x >> 6);
    const int G = gridDim.x, bid = blockIdx.x, NGW = G * 8;
    const KPtr KP0 = (KPtr)__builtin_amdgcn_kernarg_segment_ptr();
    volatile LAS unsigned* xst = (volatile LAS unsigned*)((LAS unsigned char*)lds + LDS_BYTES - 32);
    if (wave_s == 0 && lane_id() < 4) xst[lane_id()] = 0u;
    __syncthreads();
    const XcdBarrier xbar = xcd_barrier_post((unsigned*)(KP0->ws + WS_CTL) + CW_BAR, xst, wave_s);
    if (KP0->ws == nullptr) grid.sync();
#define GRID_SYNC() xcd_barrier(xbar, wave_s)
    volatile LAS unsigned long long* pst = (volatile LAS unsigned long long*)((LAS unsigned char*)lds + LDS_BYTES - 96);
    if (PROBE_MASK && bid == 0 && wave_s == 0 && lane_id() == 0) { pst[0] = __builtin_amdgcn_s_memrealtime(); pst[1] = 0ull; }
    {   PHASE_VARS
    for (int e = bid * NT + tid; e < SEQ * 32; e += G * NT) {
        const int t = e >> 5, i = e & 31;
        const float inv = powf(10000.0f, -(float)(2 * i) / 64.0f);
        const float ang = (float)t * inv;
        float s, c; sincosf(ang, &s, &c);
        rope[e] = make_float2(c, s);
    }
    for (int e = bid * NT + tid; e < 52 * 128; e += G * NT) {
        const int r = e >> 7, c = e & 127; const int row = (r < 4) ? (512 + 196 + r) : (512 + 208 + (r - 4));
        *(u32x4*)(WinT + (size_t)row * DM + c * 8) = (u32x4){0u, 0u, 0u, 0u};
    }
    {
        LAS float* scr = (LAS float*)((LAS unsigned char*)lds + wave * 16384);
        constexpr int I_IN = (DM / 64) * ((INW + 31) / 32), I_OUT = (DM / 64) * (DM / 32), I_GU = NEXP * 2 * 128, I_D = NEXP * 128;
        for (int it = launder_i(gw); it < I_IN; it += NGW) {
            int r = it;
            if (r < I_IN) { transpose_item(P->w_in, DM, INW, WinT, scr, r, lane, [](int c) { return win_dest_row(c); }, [](int k, float&) { return k; }); continue; } r -= I_IN;
        }
    }
    for (int e = bid * NT + tid; e < DM * 20; e += G * NT) { const int k = e / 20, j = e - k * 20; WGG[e] = P->ln1_g[k] * ((j < 4) ? P->w_rg[k * 4 + j] : P->w_re[k * 16 + (j - 4)]); }
    if (wave == 0 && bid >= G - 20) {
        float* rc = (float*)(ws + WS_RCONST); const int j = G - 1 - bid;
        float wv[16], gv[16], bv[16];
#pragma unroll
        for (int i = 0; i < 16; ++i) { const int k = lane + 64 * i; wv[i] = (j < 4) ? P->w_rg[k * 4 + j] : P->w_re[k * 16 + (j - 4)]; gv[i] = P->ln1_g[k]; bv[i] = P->ln1_b[k]; }
        float gs = 0.f, bs = 0.f;
#pragma unroll
        for (int i = 0; i < 16; ++i) { gs = fmaf(gv[i], wv[i], gs); bs = fmaf(bv[i], wv[i], bs); }
        gs = wave_sum(gs); bs = wave_sum(bs);
        if (lane == 0) { rc[j] = gs; rc[20 + j] = bs + ((j < 4) ? P->b_rg[j] : P->b_re[j - 4]); }
    }
    {
        const size_t NP = (size_t)M * DM / 8, stride = (size_t)G * NT;
        for (size_t e0 = (size_t)bid * NT + tid; e0 < NP; e0 += 4 * stride) {
            f32x4 a[4], b[4];
#pragma unroll
            for (int u = 0; u < 4; ++u) { const size_t e = e0 + u * stride; if (e < NP) { a[u] = *(const f32x4*)(P->x + e * 8); b[u] = *(const f32x4*)(P->x + e * 8 + 4); } }
#pragma unroll
            for (int u = 0; u < 4; ++u) { const size_t e = e0 + u * stride; if (e < NP) {
                u32x4 w; w.x = pg8::cvt_pk_bf16(a[u][0], a[u][1]); w.y = pg8::cvt_pk_bf16(a[u][2], a[u][3]); w.z = pg8::cvt_pk_bf16(b[u][0], b[u][1]); w.w = pg8::cvt_pk_bf16(b[u][2], b[u][3]);
                *(u32x4*)(XB + e * 8) = w; } }
        }
    }
    }
    GRID_SYNC(); STAMP(0);
    {   PHASE_VARS
    {
        pg8::Gemm g{XB, WinT, M, NPAD, DM}; pg8::StaticOrder S; S.init(M, NPAD, G, bid);
        EpiInProj E{Qb, Kb, Vb, IKb, IQb, Zb, XBC, IW, DT, rope};
        pg8::gemm_phase<EpiInProj, pg8::StaticOrder, true, true>((PG8_LAS unsigned char*)lds, g, S, E, wave_s);
    }
    }
    GRID_SYNC(); STAMP(1);
    {   PHASE_VARS
    for (int item = bid; item < BATCH * 8; item += G) ssd_item(__builtin_amdgcn_readfirstlane(item >> 3), __builtin_amdgcn_readfirstlane(item & 7), P, XBC, DT, Zb, ASb, SSQP, lds, tid);
    {
        volatile int* qslot = (volatile int*)(lds + LDS_BYTES - 64);
        const unsigned xcc = (unsigned)__builtin_amdgcn_s_getreg((3 << 11) | 20) & 7u;
        for (;;) {
            __syncthreads();
            if (tid == 0) { int pi = -1;
                for (unsigned a = 0; a < 8 && pi < 0; ++a) { const unsigned q = (xcc + a) & 7u; const unsigned idx = atomicAdd(&ctl[CW_DSAQ + 16 * q], 1u); if (idx < 128u) pi = (int)(q * 128u + idx); }
                *qslot = pi; }
            __syncthreads();
            const int pi = __builtin_amdgcn_readfirstlane(*qslot); if (pi < 0) break;
            const int q = pi >> 7, idx = pi & 127, b = q + 8 * (idx & 1), qb = 63 - (idx >> 1);
            dsa_select(b, qb, IQb, IKb, IW, lds, lane, wave_s, &ctl[CW_ERR]);
            attn_body::attn_unit<8>(b, qb, Qb, Kb, Vb, ASb, (char*)lds, (const char*)lds + DSA_MASK_OFF, wave_s);
        }
    }
    __syncthreads();
    {
        LAS float* scr = (LAS float*)((LAS unsigned char*)lds + wave * 16384);
        constexpr int I_OUT = (DM / 64) * (DM / 32), I_GU = NEXP * 2 * 128, I_D = NEXP * 128, I_ALL = I_OUT + I_GU + I_D;
        for (;;) {
            int base = 0; if (lane == 0) base = (int)atomicAdd(&ctl[CW_WQ], 8u);
            base = __builtin_amdgcn_readfirstlane(base); if (base >= I_ALL) break;
            for (int it = base; it < base + 8 && it < I_ALL; ++it) {
                int r = it;
                if (r < I_OUT) { { const float* nw = P->ssd_norm_w; transpose_item(P->w_out, DM, DM, WoutT, scr, r, lane, [](int c) { return c; }, [nw](int k, float& sc) { if (k < 512) { sc = nw[k]; return k + 512; } return k - 512; }); } continue; } r -= I_OUT;
                if (r < I_GU) { const int e = r >> 8, up = (r >> 7) & 1, sub = r & 127; const float* W = (up ? P->w_up : P->w_gate) + (size_t)e * DM * EFF;
                transpose_item(W, DM, EFF, WguT + (size_t)e * 512 * DM, scr, sub, lane, [up](int c) { return 8 * (c >> 2) + 4 * up + (c & 3); }, [](int k, float&) { return k; }); continue; } r -= I_GU;
                { const int e = r >> 7, sub = r & 127; transpose_item(P->w_down + (size_t)e * EFF * DM, EFF, DM, WdT + (size_t)e * DM * EFF, scr, sub, lane, [](int c) { return c; }, [](int k, float&) { return k; }); }
            }
        }
    }
    }
    GRID_SYNC(); STAMP(2);
    {   PHASE_VARS
    {
        pg8::Gemm g{ASb, WoutT, M, DM, DM}; pg8::StaticOrder S; S.init(M, DM, G, bid);
        EpiH1 E{P->x, H1b, SSQP};
        pg8::gemm_phase<EpiH1, pg8::StaticOrder, true, true>((PG8_LAS unsigned char*)lds, g, S, E, wave_s);
    }
    }
    GRID_SYNC(); STAMP(4);
    {   PHASE_VARS
    {
        float* Wg = (float*)lds;
        int* lcnt = (int*)(lds + 81920); int* lbase = lcnt + 16; int* rec = lbase + 16;
        float* recw = (float*)(rec + 4 * 128);
        float* rlg = recw + 2 * 128;
        float* rstat = rlg + 20 * 128;
        { f32x4 t4[10];
#pragma unroll
          for (int i = 0; i < 10; ++i) t4[i] = ((const f32x4*)WGG)[tid + NT * i];
#pragma unroll
          for (int i = 0; i < 10; ++i) ((f32x4*)Wg)[tid + NT * i] = t4[i]; }
        if (tid < 16) lcnt[tid] = 0;
        __syncthreads();
        const int rows_per_wave = M / NGW;
        const int l15 = lane & 15, ph = lane >> 4;
        {
            const bf16* hr = H1b + (size_t)(gw + NGW * l15) * DM + 4 * ph;
            const float* wb0 = Wg + (4 * ph) * 20 + l15; const float* wb1 = Wg + (4 * ph) * 20 + 16 + (l15 < 4 ? l15 : 3);
            f32x4 c0 = (f32x4){0.f, 0.f, 0.f, 0.f}, c1 = c0; float s = 0.f, ss = 0.f;
            u32x2 an[8];
#pragma unroll
            for (int u = 0; u < 8; ++u) an[u] = *(const u32x2*)(hr + 16 * u);
#pragma unroll 1
            for (int i0 = 0; i0 < 64; i0 += 8) {
                f32x4 a[8];
#pragma unroll
                for (int u = 0; u < 8; ++u) { a[u][0] = __uint_as_float(an[u].x << 16); a[u][1] = __uint_as_float(an[u].x & 0xffff0000u); a[u][2] = __uint_as_float(an[u].y << 16); a[u][3] = __uint_as_float(an[u].y & 0xffff0000u); }
                if (i0 + 8 < 64) {
#pragma unroll
                    for (int u = 0; u < 8; ++u) an[u] = *(const u32x2*)(hr + 16 * (i0 + 8 + u)); }
#pragma unroll
                for (int u = 0; u < 8; ++u) {
                    s += (a[u][0] + a[u][1]) + (a[u][2] + a[u][3]); ss += (a[u][0] * a[u][0] + a[u][1] * a[u][1]) + (a[u][2] * a[u][2] + a[u][3] * a[u][3]);
#pragma unroll
                    for (int e = 0; e < 4; ++e) { const int ko = (16 * (i0 + u) + e) * 20;
                        c0 = __builtin_amdgcn_mfma_f32_16x16x4f32(a[u][e], wb0[ko], c0, 0, 0, 0);
                        c1 = __builtin_amdgcn_mfma_f32_16x16x4f32(a[u][e], wb1[ko], c1, 0, 0, 0); }
                }
            }
            { const int ln2 = launder_i(lane); const int i16 = (ln2 ^ 16) << 2, i32 = (ln2 ^ 32) << 2;
              s += __builtin_bit_cast(float, __builtin_amdgcn_ds_bpermute(i16, __builtin_bit_cast(int, s))); s += __builtin_bit_cast(float, __builtin_amdgcn_ds_bpermute(i32, __builtin_bit_cast(int, s)));
              ss += __builtin_bit_cast(float, __builtin_amdgcn_ds_bpermute(i16, __builtin_bit_cast(int, ss))); ss += __builtin_bit_cast(float, __builtin_amdgcn_ds_bpermute(i32, __builtin_bit_cast(int, ss))); }
            const float mean = s * (1.f / DM), var = ss * (1.f / DM) - mean * mean;
            if (ph == 0) { rstat[(wave * 16 + l15) * 2] = mean; rstat[(wave * 16 + l15) * 2 + 1] = rsqrtf(var + LN_EPS); }
#pragma unroll
            for (int r = 0; r < 4; ++r) { const int rl = wave * 16 + 4 * ph + r; rlg[rl * 20 + l15] = c0[r]; if (l15 < 4) rlg[rl * 20 + 16 + l15] = c1[r]; }
        }
        __syncthreads();
        {
            f32x4 gg[4], bb[4];
#pragma unroll
            for (int j = 0; j < 4; ++j) { gg[j] = *(const f32x4*)(P->ln1_g + lane * 4 + 256 * j); bb[j] = *(const f32x4*)(P->ln1_b + lane * 4 + 256 * j); }
            for (int it = 0; it < rows_per_wave; it += 4) {
                f32x4 v[4][4];
#pragma unroll
                for (int r = 0; r < 4; ++r)
#pragma unroll
                    for (int j = 0; j < 4; ++j) { const u32x2 hb = *(const u32x2*)(H1b + (size_t)(gw + NGW * (it + r)) * DM + lane * 4 + 256 * j);
                        v[r][j][0] = __uint_as_float(hb.x << 16); v[r][j][1] = __uint_as_float(hb.x & 0xffff0000u); v[r][j][2] = __uint_as_float(hb.y << 16); v[r][j][3] = __uint_as_float(hb.y & 0xffff0000u); }
#pragma unroll
                for (int r = 0; r < 4; ++r) { const float mean = rstat[(wave * 16 + it + r) * 2], rstd = rstat[(wave * 16 + it + r) * 2 + 1];
#pragma unroll
                    for (int j = 0; j < 4; ++j) { const f32x4 o = (v[r][j] - mean) * rstd * gg[j] + bb[j]; u32x2 w; w.x = pg8::cvt_pk_bf16(o[0], o[1]); w.y = pg8::cvt_pk_bf16(o[2], o[3]);
                        *(u32x2*)(X1b + (size_t)(gw + NGW * (it + r)) * DM + lane * 4 + 256 * j) = w; } }
            }
        }
        const float* rc = (const float*)(ws + WS_RCONST);
        for (int rl = tid; rl < 8 * rows_per_wave; rl += NT) {
            const float mean = rstat[rl * 2], rstd = rstat[rl * 2 + 1];
            float lg[20];
#pragma unroll
            for (int j = 0; j < 20; ++j) lg[j] = rstd * (rlg[rl * 20 + j] - mean * rc[j]) + rc[20 + j];
            int gi = 0; float gm = lg[0];
#pragma unroll
            for (int i = 1; i < 4; ++i) if (lg[i] > gm) { gm = lg[i]; gi = i; }
            float gs = 0.f;
#pragma unroll
            for (int i = 0; i < 4; ++i) gs += __expf(lg[i] - gm);
            const float gprob = 1.f / gs;
            float el[4];
#pragma unroll
            for (int i = 0; i < 4; ++i) { float v0 = 0.f;
#pragma unroll
                for (int g2 = 0; g2 < 4; ++g2) if (g2 == gi) v0 = lg[4 + g2 * 4 + i];
                el[i] = v0; }
            int i0 = 0; float m0 = el[0];
#pragma unroll
            for (int i = 1; i < 4; ++i) if (el[i] > m0) { m0 = el[i]; i0 = i; }
            int i1 = -1; float m1 = -INFINITY;
#pragma unroll
            for (int i = 0; i < 4; ++i) if (i != i0 && el[i] > m1) { m1 = el[i]; i1 = i; }
            const float e1 = __expf(m1 - m0), inv = 1.f / (1.f + e1);
            const int ex0 = gi * 4 + i0, ex1 = gi * 4 + i1;
            rec[rl * 4 + 0] = ex0; rec[rl * 4 + 1] = atomicAdd(&lcnt[ex0], 1); rec[rl * 4 + 2] = ex1; rec[rl * 4 + 3] = atomicAdd(&lcnt[ex1], 1);
            recw[rl * 2] = inv * gprob; recw[rl * 2 + 1] = e1 * inv * gprob;
        }
        __syncthreads();
        if (tid < 16) lbase[tid] = (int)atomicAdd(&ctl[CW_CNT + 64 * tid], (unsigned)lcnt[tid]);
        __syncthreads();
        for (int rl = tid; rl < 8 * rows_per_wave; rl += NT) {
            const int row = (bid * 8 + rl / rows_per_wave) + NGW * (rl % rows_per_wave);
            const int e0 = rec[rl * 4], e1x = rec[rl * 4 + 2];
            lists[(size_t)e0 * M + lbase[e0] + rec[rl * 4 + 1]] = row * 2; lists[(size_t)e1x * M + lbase[e1x] + rec[rl * 4 + 3]] = row * 2 + 1;
            tokw[row * 2] = recw[rl * 2]; tokw[row * 2 + 1] = recw[rl * 2 + 1];
        }
    }
    }
    GRID_SYNC(); STAMP(5);
    {   PHASE_VARS
    int* tb = (int*)(lds + 135168);
    if (tid < NEXP) tb[32 + tid] = (int)((__hip_atomic_load(&ctl[CW_CNT + 64 * tid], __ATOMIC_RELAXED, __HIP_MEMORY_SCOPE_AGENT) + 255u) >> 8);
    __syncthreads();
    if (tid == 0) { int a = 0; for (int e = 0; e < NEXP; ++e) { tb[e] = a; a += tb[32 + e]; } tb[NEXP] = a; }
    __syncthreads();
    const int ntiles = tb[NEXP];
    for (int sr = bid * NT + tid; sr < ntiles * 256; sr += G * NT) {
        const int rt = sr >> 8; int e = 0;
#pragma unroll
        for (int j = 1; j < NEXP; ++j) if (rt >= tb[j]) e = j;
        const int slot = sr - tb[e] * 256; const int cnt_e = (int)__hip_atomic_load(&ctl[CW_CNT + 64 * e], __ATOMIC_RELAXED, __HIP_MEMORY_SCOPE_AGENT);
        const int en = (slot < cnt_e) ? lists[(size_t)e * M + slot] : -1;
        ENT[sr] = (en >= 0) ? ((en & 1) * M + (en >> 1)) : 2 * M; WGT[sr] = (en >= 0) ? tokw[en] : 0.f;
    }
    {
        LAS int* ul = (LAS int*)((LAS unsigned char*)lds + 135168 + 128); int n = 0;
        if (tid == 0) { for (int L = bid; L < ntiles * 2; L += G) { const int rt = L >> 1; int e = 0; for (int j = 1; j < NEXP; ++j) if (rt >= tb[j]) e = j; ul[2 * n] = rt; ul[2 * n + 1] = e * 2 + (L & 1); ++n; } ul[62] = n; }
        __syncthreads(); n = ul[62];
        LAS int* rtl = (LAS int*)((LAS unsigned char*)lds + 135168 + 512);
        for (int e = tid; e < n * 256; e += NT) { const int rt = ul[2 * (e >> 8)], ex = ul[2 * (e >> 8) + 1] >> 1, slot = (rt - tb[ex]) * 256 + (e & 255);
            const int cnt_e = (int)__hip_atomic_load(&ctl[CW_CNT + 64 * ex], __ATOMIC_RELAXED, __HIP_MEMORY_SCOPE_AGENT); rtl[e] = (slot < cnt_e) ? (lists[(size_t)ex * M + slot] >> 1) : 0; }
        __syncthreads();
        pg8::Gemm g{X1b, WguT, MAXROWS, 512, DM}; MoeOrder S{n, ul};
        EpiSwiGLU E{Hid};
        pg8::gemm_phase<EpiSwiGLU, MoeOrder, true, true, true>((PG8_LAS unsigned char*)lds, g, S, E, wave_s, rtl);
    }
    }
    GRID_SYNC(); STAMP(7);
    {   PHASE_VARS
    const LAS int* tb = (const LAS int*)((LAS unsigned char*)lds + 135168); const int ntiles = tb[NEXP];
    {
        LAS int* ul = (LAS int*)((LAS unsigned char*)lds + 135168 + 128); int n = 0;
        __syncthreads();
        if (tid == 0) { for (int L = bid; L < ntiles * 4; L += G) { const int rt = L >> 2; int e = 0; for (int j = 1; j < NEXP; ++j) if (rt >= tb[j]) e = j; ul[2 * n] = rt; ul[2 * n + 1] = e * 4 + (L & 3); ++n; } ul[62] = n; }
        __syncthreads(); n = ul[62];
        pg8::Gemm g{Hid, WdT, MAXROWS, DM, EFF}; MoeOrder S{n, ul};
        EpiDown E{ENT, WGT, Y0};
        pg8::gemm_phase<EpiDown, MoeOrder, true, true>((PG8_LAS unsigned char*)lds, g, S, E, wave_s);
    }
    }
    GRID_SYNC(); STAMP(8);
    {   PHASE_VARS
    const bool poison = __hip_atomic_load(&ctl[CW_ERR], __ATOMIC_RELAXED, __HIP_MEMORY_SCOPE_AGENT) != 0u; const float qnan = __builtin_nanf("");
    for (int row = launder_i(gw); row < M; row += NGW) {
        f32x4 v[4]; float s = 0.f;
#pragma unroll
        for (int j = 0; j < 4; ++j) { const int c0 = lane * 4 + 256 * j; const u32x2 xb = *(const u32x2*)(X1b + (size_t)row * DM + c0);
            v[j][0] = __uint_as_float(xb.x << 16) * ALPHA; v[j][1] = __uint_as_float(xb.x & 0xffff0000u) * ALPHA; v[j][2] = __uint_as_float(xb.y << 16) * ALPHA; v[j][3] = __uint_as_float(xb.y & 0xffff0000u) * ALPHA;
            const u32x2 a = *(const u32x2*)(Y0 + (size_t)row * DM + c0), b = *(const u32x2*)(Y1 + (size_t)row * DM + c0);
            v[j][0] += __uint_as_float(a.x << 16) + __uint_as_float(b.x << 16); v[j][1] += __uint_as_float(a.x & 0xffff0000u) + __uint_as_float(b.x & 0xffff0000u);
            v[j][2] += __uint_as_float(a.y << 16) + __uint_as_float(b.y << 16); v[j][3] += __uint_as_float(a.y & 0xffff0000u) + __uint_as_float(b.y & 0xffff0000u);
            s += (v[j][0] + v[j][1]) + (v[j][2] + v[j][3]); }
        const float mean = wave_sum(s) * (1.f / DM); float s2 = 0.f;
#pragma unroll
        for (int j = 0; j < 4; ++j) { v[j] = v[j] - mean; s2 += (v[j][0] * v[j][0] + v[j][1] * v[j][1]) + (v[j][2] * v[j][2] + v[j][3] * v[j][3]); }
        const float rstd = rsqrtf(wave_sum(s2) * (1.f / DM) + LN_EPS);
#pragma unroll
        for (int j = 0; j < 4; ++j) { const int c0 = lane * 4 + 256 * j;
            const f32x4 gg = *(const f32x4*)(P->ln2_g + c0), bb = *(const f32x4*)(P->ln2_b + c0);
            f32x4 o = v[j] * rstd * gg + bb; if (poison) o = (f32x4){qnan, qnan, qnan, qnan};
            *(f32x4*)(P->out + (size_t)row * DM + c0) = o; }
    }
    }
    STAMP(9);
    if (PROBE_MASK && bid == 0 && wave_s == 0 && lane_id() == 0) { const unsigned long long t0 = __builtin_amdgcn_s_memrealtime(), d = 8ull * pst[1]; while (__builtin_amdgcn_s_memrealtime() - t0 < d) __builtin_amdgcn_s_sleep(8); }
}

extern "C" void kernel_launch(void* const* d_in, const int* in_sizes, int n_in, void* d_out, int out_size, void* d_ws, size_t ws_size, hipStream_t stream) {
    static int grid = 0;
    if (grid == 0) {
        if (n_in != 20 || in_sizes[0] != M * DM || out_size != M * DM || ws_size < WS_END) { fprintf(stderr, "kernel_launch: unexpected shapes (n_in %d, in0 %d, out %d, ws %zu)\n", n_in, n_in > 0 ? in_sizes[0] : -1, out_size, ws_size); grid = -1; return; }
        int dev = 0, cus = 0, per_cu = 0;
        (void)hipGetDevice(&dev);
        (void)hipDeviceGetAttribute(&cus, hipDeviceAttributeMultiprocessorCount, dev);
        (void)hipFuncSetAttribute((const void*)hybrid_fwd, hipFuncAttributeMaxDynamicSharedMemorySize, LDS_BYTES);
        (void)hipOccupancyMaxActiveBlocksPerMultiprocessor(&per_cu, (const void*)hybrid_fwd, NT, LDS_BYTES);
        if (per_cu < 1) { fprintf(stderr, "kernel_launch: occupancy query says %d blocks/CU\n", per_cu); grid = -1; return; }
        grid = cus;
    }
    if (grid < 0) return;
    (void)hipMemsetAsync((char*)d_ws + WS_CTL, 0, CTL_BYTES, stream);
    Params p{};
    const float** f = (const float**)&p;
    for (int i = 0; i < 20; ++i) f[i] = (const float*)d_in[i];
    p.out = (float*)d_out; p.ws = (unsigned char*)d_ws;
    void* args[] = {&p};
    hipError_t e = hipLaunchCooperativeKernel((const void*)hybrid_fwd, dim3(grid), dim3(NT), args, LDS_BYTES, stream);
    if (e != hipSuccess) fprintf(stderr, "cooperative launch failed: %s (grid %d)\n", hipGetErrorString(e), grid);
}
```

```cpp
#include <hip/hip_runtime.h>
#include <hip/hip_cooperative_groups.h>
#include <cstdio>
#include <cstdint>
namespace cg = cooperative_groups;

constexpr int BATCH = 16, SEQ = 2048, DM = 1024, M = BATCH * SEQ;
constexpr int INW = 2252;
constexpr int C_Q = 0, C_K = 512, C_V = 576, C_IQ = 640, C_IK = 896, C_IW = 960, C_Z = 964, C_XBC = 1476, C_DT = 2244;
constexpr int NEXP = 16, EFF = 256;
constexpr float LN_EPS = 1e-5f;
constexpr float ALPHA = 1.189207115002721f;
constexpr float INDEXER_SCALE = 0.0625f;
constexpr float QSCALE = 0.125f * 1.4426950408889634f;
constexpr int TOPK = 256;
constexpr int NT = 512;
constexpr int LDS_BYTES = 147456;

constexpr size_t MiB = 1u << 20;
constexpr size_t WS_CTL = 0, CTL_BYTES = 1 * MiB;
constexpr size_t WS_ROPE = 1 * MiB;
constexpr size_t WS_TOKW = 2 * MiB;
constexpr size_t WS_LISTS = 3 * MiB;
constexpr size_t WS_WIN_T = 8 * MiB;
constexpr size_t WS_WOUT_T = 16 * MiB;
constexpr size_t WS_WGU_T = 18 * MiB;
constexpr size_t WS_WD_T = 34 * MiB;
constexpr size_t WS_RCONST = 7 * MiB;
constexpr size_t WS_ENT = 5 * MiB;
constexpr size_t WS_XS = 48 * MiB;
constexpr size_t WS_HID = 192 * MiB;
constexpr int MAXTILES = 272, MAXROWS = MAXTILES * 256;
constexpr size_t WS_XB = 256 * MiB;
constexpr int NPAD = 2304;
constexpr size_t WS_Q = 48 * MiB;
constexpr size_t WS_K = 80 * MiB, WS_V = 84 * MiB, WS_IK = 88 * MiB;
constexpr size_t WS_IW = 92 * MiB;
constexpr size_t WS_DT = 93 * MiB;
constexpr size_t WS_IQ = 96 * MiB;
constexpr size_t WS_Z = 112 * MiB;
constexpr size_t WS_XBC = 144 * MiB;
constexpr size_t WS_AS = 192 * MiB;
constexpr size_t WS_X1 = 256 * MiB;
constexpr size_t WS_X1B = 384 * MiB;
constexpr size_t WS_Y0 = 48 * MiB, WS_Y1 = 112 * MiB;
constexpr size_t WS_P32 = 224 * MiB;
constexpr size_t WS_XC = 256 * MiB;
constexpr size_t WS_SSQP = 42 * MiB;
constexpr size_t WS_END = 512 * MiB;
constexpr int CW_CNT = 8192;
constexpr int CW_BAR = 4096;
constexpr int CW_ERR = 32;
constexpr int CW_WQ = 48;
constexpr int CW_DSAQ = 128;

typedef unsigned short bf16;
typedef float f32x4 __attribute__((ext_vector_type(4)));
typedef unsigned u32x4 __attribute__((ext_vector_type(4)));
typedef unsigned u32x2 __attribute__((ext_vector_type(2)));

struct Params {
    const float* x; const float* w_in; const float* conv_w; const float* conv_b; const float* dt_bias; const float* a_log; const float* d_skip;
    const float* ssd_norm_w; const float* w_out; const float* ln1_g; const float* ln1_b; const float* w_rg; const float* b_rg; const float* w_re; const float* b_re;
    const float* w_gate; const float* w_up; const float* w_down; const float* ln2_g; const float* ln2_b;
    float* out; unsigned char* ws;
};

__device__ __forceinline__ int launder_i(int v);
__device__ __forceinline__ int lane_id() { unsigned m = ~0u; asm volatile("" : "+s"(m)); return (int)__builtin_amdgcn_mbcnt_hi(m, __builtin_amdgcn_mbcnt_lo(m, 0u)); }
typedef const __attribute__((address_space(4))) Params* KPtr;
__device__ __forceinline__ KPtr launder_k(KPtr k) { asm volatile("" : "+s"(k)); return k; }
__device__ __forceinline__ float bf2f(bf16 v) { return __uint_as_float((unsigned)v << 16); }
__device__ __forceinline__ bf16 f2bf(float f) { unsigned u = __float_as_uint(f); return (bf16)((u + 0x7fffu + ((u >> 16) & 1u)) >> 16); }
__device__ __forceinline__ float silu(float v) { return v * __builtin_amdgcn_rcpf(1.f + __expf(-v)); }
__device__ __forceinline__ float wave_sum(float v) {
#define WS_DPP(ctrl, rm, bc) v += __int_as_float(__builtin_amdgcn_update_dpp(0, __float_as_int(v), ctrl, rm, 0xf, bc))
    WS_DPP(0xB1, 0xf, true); WS_DPP(0x4E, 0xf, true); WS_DPP(0x114, 0xf, true); WS_DPP(0x118, 0xf, true); WS_DPP(0x142, 0xa, false); WS_DPP(0x143, 0xc, false);
#undef WS_DPP
    return __int_as_float(__builtin_amdgcn_readlane(__float_as_int(v), 63));
}
__device__ __forceinline__ float wave_max(float v) {
#pragma unroll
    for (int o = 1; o < 64; o <<= 1) v = fmaxf(v, __shfl_xor(v, o));
    return v;
}
__device__ __forceinline__ int launder_i(int v) { asm volatile("" : "+v"(v)); return v; }
__device__ __forceinline__ unsigned sortkey(float f) { unsigned u = __float_as_uint(f); return (u & 0x80000000u) ? ~u : (u | 0x80000000u); }

namespace pg8 {
#define PG8_LAS __attribute__((address_space(3)))
typedef unsigned short bf16_t;
typedef short bf16x8 __attribute__((ext_vector_type(8)));
typedef float f32x4 __attribute__((ext_vector_type(4)));
typedef unsigned u32x4 __attribute__((ext_vector_type(4)));
constexpr int BM = 256, BK = 64, HALF = 128, HTB = HALF * BK * 2  , STAGE_BYTES = 8 * HTB, NXCD = 8, WGM = 8;

__host__ __device__ __forceinline__ int lds_byte(int r, int c) { const int st = (r >> 4) * 2 + (c >> 5), rr = r & 15, cc = c & 31, ob = rr * 64 + cc * 2; return st * 1024 + (ob ^ (((ob >> 9) & 1) << 5)); }
__host__ __device__ __forceinline__ void stage_rc(int b, int& R, int& C) { const int st = b / 1024, sb = b % 1024, swz = sb ^ (((sb >> 9) & 1) << 5); R = (st >> 1) * 16 + swz / 64; C = (st & 1) * 32 + (swz % 64) / 2; }
__host__ __device__ __forceinline__ int perm32(int rho) { const int n = rho >> 4, i = rho & 15; return 8 * (i >> 2) + 4 * n + (i & 3); }

struct Unit { int pm, pn; };
struct Gemm { const bf16_t* A; const bf16_t* Bt; int M, N, K; };

struct StaticOrder {
    int nM, nN, nwg, G, c;
    __host__ __device__ void init(int M, int N, int G_, int c_) { nM = M / BM; nN = N / BM; nwg = nM * nN; G = G_; c = c_; }
    __host__ __device__ bool next(int i, Unit& u) const {
        const long L = (long)i * G + c; if (L >= nwg) return false;
        int wgid = (int)L; { const int q = nwg / NXCD, r = nwg % NXCD, xcd = wgid % NXCD, off = wgid / NXCD; wgid = (xcd < r ? xcd * (q + 1) : r * (q + 1) + (xcd - r) * q) + off; }
        const int nig = WGM * nN, gid = wgid / nig, fm = gid * WGM, gsz = (nM - fm) < WGM ? (nM - fm) : WGM;
        u.pm = fm + ((wgid % nig) % gsz); u.pn = (wgid % nig) / gsz; return true;
    }
    __device__ __forceinline__ void a_ready(const Unit&) const {}
    __device__ __forceinline__ void done(const Unit&) const {}
};

__device__ __forceinline__ unsigned cvt_pk_bf16(float lo, float hi) { unsigned r; asm volatile("v_cvt_pk_bf16_f32 %0, %1, %2" : "=v"(r) : "v"(lo), "v"(hi)); return r; }
template <class Epi, class Sched, bool ALIGN_EPI = false, bool SP2 = false, bool GATHER = false>
__device__ __forceinline__ void gemm_phase(PG8_LAS unsigned char* lds, const Gemm g, const Sched& S, const Epi& E, const int wave_s, const PG8_LAS int* rtl = nullptr) {
    int tid_l = wave_s * 64 + lane_id(); asm volatile("" : "+v"(tid_l));
    const int tid = tid_l, wid = wave_s, lane = tid & 63, wr = wid >> 2, wc = wid & 3, fr = lane & 15, fq = lane >> 4;
    const int K = g.K, nt = K / BK;
    unsigned voffA[2], voffB[2];
#pragma unroll
    for (int i = 0; i < 2; ++i) { int R, C; stage_rc(tid * 16 + i * 8192, R, C); const int Rb = Epi::PERM ? ((R & ~31) + perm32(R & 31)) : R;
        voffA[i] = (unsigned)(R * K + C) * 2u; voffB[i] = (unsigned)(Rb * K + C) * 2u; }
    const size_t kstep = (size_t)(BK * 2);
    const size_t hstepB = (size_t)HALF * K * 2;
    const size_t tstep = 2 * hstepB;
    const size_t hstep = GATHER ? 0 : hstepB, tstepA = GATHER ? 0 : tstep;
    int rowA[2]; { int R, C; stage_rc(tid * 16, R, C); rowA[0] = R; stage_rc(tid * 16 + 8192, R, C); rowA[1] = R; }
    unsigned voffGc[2][2], voffGn[2][2];
#define PG8_GVOFF(dst, uidx) do { _Pragma("unroll") for (int _h = 0; _h < 2; ++_h) _Pragma("unroll") for (int _i = 0; _i < 2; ++_i) { int R_, C_; stage_rc(tid * 16 + _i * 8192, R_, C_); \
        dst[_h][_i] = (unsigned)rtl[(uidx) * 256 + _h * 128 + R_] * (unsigned)(K * 2) + (unsigned)(C_ * 2); } } while (0)
    const unsigned ldsw = (unsigned)wid * 1024u;
    const int aoff = lds_byte(wr * 64 + fr, fq * 8), boff = lds_byte(wc * 32 + fr, fq * 8);
#define PG8_SA(b, h) (((b) * 2 + (h)) * HTB)
#define PG8_SB(b, h) ((4 + (b) * 2 + (h)) * HTB)
#define PG8_STAGE(bufoff, gbase, voff) do { _Pragma("unroll") for (int _i = 0; _i < 2; ++_i) \
        __builtin_amdgcn_global_load_lds((const unsigned*)((const char*)(gbase) + (voff)[_i]), (PG8_LAS unsigned*)(lds + (bufoff) + ldsw + _i * 8192), 16, 0, 0); } while (0)
#define PG8_STAGE_A(bufoff, gbase, h, nx) do { if constexpr (GATHER) { if (nx) PG8_STAGE(bufoff, gbase, voffGn[h]); else PG8_STAGE(bufoff, gbase, voffGc[h]); } else PG8_STAGE(bufoff, gbase, voffA); } while (0)
#define PG8_LDA(dst, b, h) do { _Pragma("unroll") for (int m = 0; m < 4; ++m) _Pragma("unroll") for (int k = 0; k < 2; ++k) dst[m][k] = *(const PG8_LAS bf16x8*)(lds + PG8_SA(b, h) + aoff + m * 2048 + k * 1024); } while (0)
#define PG8_LDB(dst, b, h) do { _Pragma("unroll") for (int n = 0; n < 2; ++n) _Pragma("unroll") for (int k = 0; k < 2; ++k) dst[n][k] = *(const PG8_LAS bf16x8*)(lds + PG8_SB(b, h) + boff + n * 2048 + k * 1024); } while (0)
#define PG8_MMA(ai, bj, At, Bt) do { __builtin_amdgcn_s_setprio(1); _Pragma("unroll") for (int m = 0; m < 4; ++m) _Pragma("unroll") for (int n = 0; n < 2; ++n) _Pragma("unroll") for (int k = 0; k < 2; ++k) \
        acc[ai][bj][m][n] = __builtin_amdgcn_mfma_f32_16x16x32_bf16(Bt[n][k], At[m][k], acc[ai][bj][m][n], 0, 0, 0); __builtin_amdgcn_s_setprio(0); } while (0)
#define PG8_WAIT_V(n) asm volatile("s_waitcnt vmcnt(" #n ")" ::: "memory")
#define PG8_WAIT_L(n) asm volatile("s_waitcnt lgkmcnt(" #n ")" ::: "memory")
#define PG8_BAR __builtin_amdgcn_s_barrier()
#define PG8_SCHED __builtin_amdgcn_sched_barrier(0)
    Unit cur, nxt; int ui = 0;
    if (!S.next(0, cur)) return;
    f32x4 acc[2][2][4][2];
#pragma unroll
    for (int a = 0; a < 2; ++a)
#pragma unroll
        for (int b = 0; b < 2; ++b)
#pragma unroll
            for (int m = 0; m < 4; ++m)
#pragma unroll
                for (int n = 0; n < 2; ++n) acc[a][b][m][n] = (f32x4){0.f, 0.f, 0.f, 0.f};
    bf16x8 At[4][2], B0[2][2], B1[2][2];
    const char* cA = (const char*)g.A + (size_t)cur.pm * tstepA; const char* cB = (const char*)g.Bt + (size_t)cur.pn * tstep;
    if constexpr (GATHER) { PG8_GVOFF(voffGc, 0); _Pragma("unroll") for (int _h = 0; _h < 2; ++_h) _Pragma("unroll") for (int _i = 0; _i < 2; ++_i) voffGn[_h][_i] = voffGc[_h][_i]; }
    S.a_ready(cur);
    if constexpr (SP2) {
        PG8_STAGE(PG8_SB(0, 0), cB, voffB); PG8_STAGE(PG8_SB(0, 1), cB + hstepB, voffB); PG8_STAGE_A(PG8_SA(0, 0), cA, 0, false); PG8_STAGE_A(PG8_SA(0, 1), cA + hstep, 1, false);
        if (wr == 1) PG8_BAR;
        PG8_WAIT_V(2); PG8_BAR;
        PG8_STAGE(PG8_SB(1, 0), cB + kstep, voffB); PG8_STAGE_A(PG8_SA(1, 0), cA + kstep, 0, false); PG8_STAGE(PG8_SB(1, 1), cB + hstepB + kstep, voffB);
        PG8_WAIT_V(6); PG8_BAR;
    } else {
        PG8_STAGE(PG8_SB(0, 0), cB, voffB); PG8_STAGE_A(PG8_SA(0, 0), cA, 0, false); PG8_STAGE(PG8_SB(0, 1), cB + hstepB, voffB); PG8_STAGE_A(PG8_SA(0, 1), cA + hstep, 1, false);
        if (wr == 1) PG8_BAR;
        PG8_WAIT_V(4); PG8_BAR;
        PG8_STAGE(PG8_SB(1, 0), cB + kstep, voffB); PG8_STAGE_A(PG8_SA(1, 0), cA + kstep, 0, false); PG8_STAGE(PG8_SB(1, 1), cB + hstepB + kstep, voffB);
        PG8_WAIT_V(6); PG8_BAR;
    }
    for (;;) {
        const bool has_next = S.next(ui + 1, nxt);
        const char* nA = has_next ? (const char*)g.A + (size_t)nxt.pm * tstepA : cA; const char* nB = has_next ? (const char*)g.Bt + (size_t)nxt.pn * tstep : cB;
        for (int t = 0; t < nt; t += 2) {
            if constexpr (Epi::MID_T > 0) { if (t == Epi::MID_T) E.mid(acc, cur, wr, wc, fr, fq); }
            const bool last = (t == nt - 2);
            const char* a1 = cA + (size_t)(t + 1) * kstep;
            const char* a2 = last ? nA : cA + (size_t)(t + 2) * kstep; const char* b2 = last ? nB : cB + (size_t)(t + 2) * kstep;
            const char* a3 = a2 + kstep; const char* b3 = b2 + kstep;
            if (last && has_next) { S.a_ready(nxt); if constexpr (GATHER) PG8_GVOFF(voffGn, ui + 1); }
            if constexpr (SP2) {
            PG8_LDB(B0, 0, 0); PG8_LDB(B1, 0, 1); PG8_SCHED; PG8_LDA(At, 0, 0); PG8_STAGE_A(PG8_SA(1, 1), a1 + hstep, 1, false);
            PG8_WAIT_V(8); PG8_WAIT_L(0); PG8_BAR; PG8_MMA(0, 0, At, B0); PG8_MMA(0, 1, At, B1); PG8_BAR; PG8_SCHED;
            PG8_LDA(At, 0, 1); PG8_STAGE(PG8_SB(0, 0), b2, voffB); PG8_STAGE(PG8_SB(0, 1), b2 + hstepB, voffB); PG8_STAGE_A(PG8_SA(0, 0), a2, 0, last);
            PG8_WAIT_V(8); PG8_WAIT_L(0); PG8_BAR; PG8_MMA(1, 0, At, B0); PG8_MMA(1, 1, At, B1); PG8_BAR; PG8_SCHED;
            PG8_LDB(B0, 1, 0); PG8_LDB(B1, 1, 1); PG8_SCHED; PG8_LDA(At, 1, 0); PG8_STAGE_A(PG8_SA(0, 1), a2 + hstep, 1, last);
            PG8_WAIT_V(8); PG8_WAIT_L(0); PG8_BAR; PG8_MMA(0, 0, At, B0); PG8_MMA(0, 1, At, B1); PG8_BAR; PG8_SCHED;
            PG8_LDA(At, 1, 1); PG8_STAGE(PG8_SB(1, 0), b3, voffB); PG8_STAGE(PG8_SB(1, 1), b3 + hstepB, voffB); PG8_STAGE_A(PG8_SA(1, 0), a3, 0, last);
            PG8_WAIT_V(8); PG8_WAIT_L(0); PG8_BAR; PG8_MMA(1, 0, At, B0); PG8_MMA(1, 1, At, B1); PG8_BAR; PG8_SCHED;
            } else {
            PG8_LDB(B0, 0, 0); PG8_SCHED; PG8_LDA(At, 0, 0); PG8_STAGE_A(PG8_SA(1, 1), a1 + hstep, 1, false);
            PG8_WAIT_L(8); PG8_BAR; PG8_WAIT_L(0); PG8_MMA(0, 0, At, B0); PG8_BAR; PG8_SCHED;
            PG8_LDB(B1, 0, 1); PG8_STAGE(PG8_SB(0, 0), b2, voffB);
            PG8_BAR; PG8_WAIT_L(0); PG8_MMA(0, 1, At, B1); PG8_BAR;
            PG8_LDA(At, 0, 1); PG8_STAGE_A(PG8_SA(0, 0), a2, 0, last);
            PG8_BAR; PG8_WAIT_L(0); PG8_MMA(1, 0, At, B0); PG8_BAR; PG8_SCHED;
            PG8_STAGE(PG8_SB(0, 1), b2 + hstepB, voffB);
            PG8_WAIT_V(6); PG8_BAR; PG8_MMA(1, 1, At, B1); PG8_BAR;
            PG8_LDB(B0, 1, 0); PG8_SCHED; PG8_LDA(At, 1, 0); PG8_STAGE_A(PG8_SA(0, 1), a2 + hstep, 1, last);
            PG8_WAIT_L(8); PG8_BAR; PG8_WAIT_L(0); PG8_MMA(0, 0, At, B0); PG8_BAR; PG8_SCHED;
            PG8_LDB(B1, 1, 1); PG8_STAGE(PG8_SB(1, 0), b3, voffB);
            PG8_BAR; PG8_WAIT_L(0); PG8_MMA(0, 1, At, B1); PG8_BAR;
            PG8_LDA(At, 1, 1); PG8_STAGE_A(PG8_SA(1, 0), a3, 0, last);
            PG8_BAR; PG8_WAIT_L(0); PG8_MMA(1, 0, At, B0); PG8_BAR; PG8_SCHED;
            PG8_STAGE(PG8_SB(1, 1), b3 + hstepB, voffB);
            PG8_WAIT_V(6); PG8_BAR; PG8_MMA(1, 1, At, B1); PG8_BAR;
            }
        }
        if constexpr (ALIGN_EPI) { if (wr == 0) PG8_BAR; }
        if constexpr (!Epi::AFTER_DRAIN) { E(acc, cur, wr, wc, fr, fq); S.done(cur); }
        if (!has_next) break;
#pragma unroll
        for (int a = 0; a < 2; ++a)
#pragma unroll
            for (int b = 0; b < 2; ++b)
#pragma unroll
                for (int m = 0; m < 4; ++m)
#pragma unroll
                    for (int n = 0; n < 2; ++n) acc[a][b][m][n] = (f32x4){0.f, 0.f, 0.f, 0.f};
        cur = nxt; cA = nA; cB = nB; ++ui;
        if constexpr (GATHER) { _Pragma("unroll") for (int _h = 0; _h < 2; ++_h) _Pragma("unroll") for (int _i = 0; _i < 2; ++_i) voffGc[_h][_i] = voffGn[_h][_i]; }
        if constexpr (ALIGN_EPI) { if (wr == 1) PG8_BAR; }
    }
    PG8_WAIT_V(0);
    if constexpr (!ALIGN_EPI) { if (wr == 0) PG8_BAR; }
    PG8_BAR;
    if constexpr (Epi::AFTER_DRAIN) { E.fused(acc, cur, wr, wc, fr, fq, lds, wid, lane); S.done(cur); }
#undef PG8_SA
#undef PG8_SB
#undef PG8_STAGE
#undef PG8_STAGE_A
#undef PG8_GVOFF
#undef PG8_LDA
#undef PG8_LDB
#undef PG8_MMA
#undef PG8_WAIT_V
#undef PG8_WAIT_L
#undef PG8_BAR
#undef PG8_SCHED
}
}

#define LAS __attribute__((address_space(3)))
__host__ __device__ __forceinline__ int rope_pos(int j) { return 2 * (j & 31) + (j >> 5); }
__host__ __device__ __forceinline__ int win_dest_row(int c) {
    if (c < C_K) return (c & ~63) + rope_pos(c & 63);
    if (c < C_V) return 512 + rope_pos(c - C_K);
    if (c < C_IQ) return 512 + 64 + (c - C_V);
    if (c < C_IK) return 768 + ((c - C_IQ) & ~63) + rope_pos((c - C_IQ) & 63);
    if (c < C_IW) return 512 + 128 + rope_pos(c - C_IK);
    if (c < C_Z) return 512 + 192 + (c - C_IW);
    if (c < C_XBC) return 1024 + (c - C_Z);
    if (c < C_DT) return 1536 + (c - C_XBC);
    return 512 + 200 + (c - C_DT);
}
struct EpiInProj {
    static constexpr bool PERM = true, AFTER_DRAIN = false; static constexpr int MID_T = 0;
    bf16 *Q, *K, *V, *IK, *IQ, *Z, *XBC; float *IW, *DT; const float2* rope;
    __device__ __forceinline__ u32x4 pack8(const f32x4 a, const f32x4 b) const { u32x4 w; w.x = pg8::cvt_pk_bf16(a[0], a[1]); w.y = pg8::cvt_pk_bf16(a[2], a[3]); w.z = pg8::cvt_pk_bf16(b[0], b[1]); w.w = pg8::cvt_pk_bf16(b[2], b[3]); return w; }
    __device__ __forceinline__ u32x4 rope8(const f32x4 v0, const f32x4 v1, const f32x4 r0, const f32x4 r1, float sc) const {
        f32x4 a, b;
        a[0] = (v0[0] * r0[0] - v0[1] * r0[1]) * sc; a[1] = (v0[0] * r0[1] + v0[1] * r0[0]) * sc;
        a[2] = (v0[2] * r0[2] - v0[3] * r0[3]) * sc; a[3] = (v0[2] * r0[3] + v0[3] * r0[2]) * sc;
        b[0] = (v1[0] * r1[0] - v1[1] * r1[1]) * sc; b[1] = (v1[0] * r1[1] + v1[1] * r1[0]) * sc;
        b[2] = (v1[2] * r1[2] - v1[3] * r1[3]) * sc; b[3] = (v1[2] * r1[3] + v1[3] * r1[2]) * sc;
        return pack8(a, b);
    }
    __device__ __forceinline__ void operator()(const pg8::f32x4 (&acc)[2][2][4][2], const pg8::Unit& u, int wr, int wc, int fr, int fq) const {
        const int pn = u.pn, row0 = u.pm * 256 + wr * 64 + fr, cw = 32 * wc + 8 * fq;
        if (pn <= 1 || pn == 3) {
            bf16* dst = (pn == 3) ? IQ : Q; const int ld = (pn == 3) ? 256 : 512; const float sc = (pn == 3) ? 1.f : QSCALE; const int hb = (pn == 3) ? 0 : pn * 4;
#pragma unroll
            for (int ai = 0; ai < 2; ++ai)
#pragma unroll
                for (int m = 0; m < 4; ++m) { const int row = row0 + ai * 128 + m * 16, t = row & (SEQ - 1);
                    const f32x4* rp = (const f32x4*)(rope + t * 32 + 16 * (wc & 1) + 4 * fq); const f32x4 r0 = rp[0], r1 = rp[1];
#pragma unroll
                    for (int bj = 0; bj < 2; ++bj) { const int head = hb + 2 * bj + (wc >> 1);
                        *(u32x4*)(dst + (size_t)row * ld + head * 64 + 32 * (wc & 1) + 8 * fq) = rope8(acc[ai][bj][m][0], acc[ai][bj][m][1], r0, r1, sc); } }
        } else if (pn == 2) {
#pragma unroll
            for (int ai = 0; ai < 2; ++ai)
#pragma unroll
                for (int m = 0; m < 4; ++m) { const int row = row0 + ai * 128 + m * 16, t = row & (SEQ - 1);
                    if (wc < 2) { const f32x4* rp = (const f32x4*)(rope + t * 32 + 16 * wc + 4 * fq); const f32x4 r0 = rp[0], r1 = rp[1];
                        *(u32x4*)(K + (size_t)row * 64 + cw) = rope8(acc[ai][0][m][0], acc[ai][0][m][1], r0, r1, 1.f);
                        *(u32x4*)(IK + (size_t)row * 64 + cw) = rope8(acc[ai][1][m][0], acc[ai][1][m][1], r0, r1, 1.f);
                    } else {
                        *(u32x4*)(V + (size_t)row * 64 + (cw - 64)) = pack8(acc[ai][0][m][0], acc[ai][0][m][1]);
                        if (wc == 2 && fq == 0) *(f32x4*)(IW + (size_t)row * 4) = acc[ai][1][m][0] * INDEXER_SCALE;
                        if (wc == 2 && fq == 1) { *(f32x4*)(DT + (size_t)row * 8) = acc[ai][1][m][0]; *(f32x4*)(DT + (size_t)row * 8 + 4) = acc[ai][1][m][1]; }
                    } }
        } else {
            bf16* dst = (pn < 6) ? Z : XBC; const int ld = (pn < 6) ? 512 : 768; const int cb = (pn < 6) ? (pn - 4) * 256 : (pn - 6) * 256;
#pragma unroll
            for (int ai = 0; ai < 2; ++ai)
#pragma unroll
                for (int m = 0; m < 4; ++m) { const int row = row0 + ai * 128 + m * 16;
#pragma unroll
                    for (int bj = 0; bj < 2; ++bj) *(u32x4*)(dst + (size_t)row * ld + cb + 128 * bj + cw) = pack8(acc[ai][bj][m][0], acc[ai][bj][m][1]); }
        }
    }
};
struct EpiH1 {
    static constexpr bool PERM = true, AFTER_DRAIN = false; static constexpr int MID_T = 8;
    const float* x; bf16* out; const float* ssqp;
    __device__ __forceinline__ void mid(pg8::f32x4 (&acc)[2][2][4][2], const pg8::Unit& u, int wr, int wc, int fr, int fq) const {
        asm volatile("" : "+v"(fr));
        const int row0 = u.pm * 256 + wr * 64 + fr;
#pragma unroll
        for (int ai = 0; ai < 2; ++ai)
#pragma unroll
            for (int m = 0; m < 4; ++m) { const f32x4* sp = (const f32x4*)(ssqp + (size_t)(row0 + ai * 128 + m * 16) * 8); const f32x4 s0 = sp[0], s1 = sp[1];
                const float r = rsqrtf(((s0[0] + s0[1]) + (s0[2] + s0[3]) + (s1[0] + s1[1]) + (s1[2] + s1[3])) * (1.f / 512.f) + LN_EPS);
#pragma unroll
                for (int bj = 0; bj < 2; ++bj)
#pragma unroll
                    for (int n = 0; n < 2; ++n) acc[ai][bj][m][n] = acc[ai][bj][m][n] * r; }
    }
    __device__ __forceinline__ void operator()(const pg8::f32x4 (&acc)[2][2][4][2], const pg8::Unit& u, int wr, int wc, int fr, int fq) const {
        const int row0 = u.pm * 256 + wr * 64 + fr, col0 = u.pn * 256 + wc * 32 + 8 * fq;
#pragma unroll
        for (int ai = 0; ai < 2; ++ai)
#pragma unroll
            for (int m = 0; m < 4; ++m) { const size_t off = (size_t)(row0 + ai * 128 + m * 16) * DM + col0;
#pragma unroll
                for (int bj = 0; bj < 2; ++bj) { const u32x4 xb = *(const u32x4*)(out + off + bj * 128);
                    f32x4 h0, h1v;
                    h0[0] = __uint_as_float(xb.x << 16); h0[1] = __uint_as_float(xb.x & 0xffff0000u); h0[2] = __uint_as_float(xb.y << 16); h0[3] = __uint_as_float(xb.y & 0xffff0000u);
                    h1v[0] = __uint_as_float(xb.z << 16); h1v[1] = __uint_as_float(xb.z & 0xffff0000u); h1v[2] = __uint_as_float(xb.w << 16); h1v[3] = __uint_as_float(xb.w & 0xffff0000u);
                    h0 = h0 * ALPHA + acc[ai][bj][m][0]; h1v = h1v * ALPHA + acc[ai][bj][m][1];
                    u32x4 w; w.x = pg8::cvt_pk_bf16(h0[0], h0[1]); w.y = pg8::cvt_pk_bf16(h0[2], h0[3]); w.z = pg8::cvt_pk_bf16(h1v[0], h1v[1]); w.w = pg8::cvt_pk_bf16(h1v[2], h1v[3]);
                    *(u32x4*)(out + off + bj * 128) = w; } }
    }
};
template <class DR, class KM>
__device__ __forceinline__ void transpose_item(const float* W, int K, int N, bf16* WT, LAS float* scr, int item, int lane, DR drow, KM kmap) {
    const int nblk = (N + 31) / 32, kb = item / nblk, nb = item % nblk, k0 = 64 * kb, n0 = 32 * nb;
    float tv[32];
#pragma unroll
    for (int i = 0; i < 32; ++i) { const int kk = 2 * i + (lane >> 5), col = n0 + (lane & 31); float sc = 1.f; const int ks = kmap(k0 + kk, sc); tv[i] = (col < N) ? W[(size_t)ks * N + col] * sc : 0.f; }
#pragma unroll
    for (int i = 0; i < 32; ++i) scr[(2 * i + (lane >> 5)) * 33 + (lane & 31)] = tv[i];
    asm volatile("s_waitcnt lgkmcnt(0)" ::: "memory");
    const int c = lane & 7;
#pragma unroll
    for (int j = 0; j < 4; ++j) { const int n = (lane >> 3) + 8 * j, col = n0 + n; const LAS float* s = scr + (8 * c) * 33 + n;
        u32x4 o; o.x = pg8::cvt_pk_bf16(s[0 * 33], s[1 * 33]); o.y = pg8::cvt_pk_bf16(s[2 * 33], s[3 * 33]); o.z = pg8::cvt_pk_bf16(s[4 * 33], s[5 * 33]); o.w = pg8::cvt_pk_bf16(s[6 * 33], s[7 * 33]);
        if (col < N) *(u32x4*)(WT + (size_t)drow(col) * K + k0 + 8 * c) = o; }
    asm volatile("s_waitcnt lgkmcnt(0)" ::: "memory");
}
namespace attn_body {
using bf16=unsigned short;
using bf16x8=__attribute__((ext_vector_type(8)))short;
using s16x4=__attribute__((ext_vector_type(4)))short;
using f32x16=__attribute__((ext_vector_type(16)))float;
using u32x4=__attribute__((ext_vector_type(4)))unsigned;
constexpr int SEQ=2048,D=64,QP=512,KP=64,OP=1024;
constexpr int NW=8,QBLK=32,KVBLK=64;
__device__ __forceinline__ int crow(int r,int hi){return (r&3)+8*(r>>2)+4*hi;}
#define SBAR() __builtin_amdgcn_sched_barrier(0)
__device__ __forceinline__ void amask(f32x16&p0,f32x16&p1,unsigned mlo,unsigned mhi,int hi){
  const unsigned NEGB=0xff800000u; const unsigned a=mlo>>(4*hi), b=mhi>>(4*hi);
  #pragma unroll
  for(int r=0;r<16;++r){ const int pos=(r&3)+8*(r>>2);
    const unsigned s0=(unsigned)__builtin_amdgcn_sbfe((int)a,pos,1), s1=(unsigned)__builtin_amdgcn_sbfe((int)b,pos,1);
    const float v0=p0[r], v1=p1[r];
    p0[r]=__uint_as_float((s0&__float_as_uint(v0))|(~s0&NEGB));
    p1[r]=__uint_as_float((s1&__float_as_uint(v1))|(~s1&NEGB)); }
}

constexpr int NSLOT=3, SLOTB=8192;
constexpr int LDS_K=0, LDS_V=NSLOT*SLOTB, LDS_WS=2*NSLOT*SLOTB, LDS_OST=LDS_WS+NW*64*4, LDS_BYTES=LDS_OST+NW*4096;
constexpr float C2=0.125f*1.4426950408889634f;
__device__ __forceinline__ void glds16(const void*gsrc,unsigned lds_dst){unsigned keep;
  asm volatile("s_mov_b32 %0, m0\n\ts_mov_b32 m0, %2\n\ts_nop 0\n\tglobal_load_lds_dwordx4 %1, off\n\ts_mov_b32 m0, %0":"=&s"(keep):"v"(gsrc),"s"(lds_dst):"memory");}
__device__ __forceinline__ float max3f(float a,float b,float c){float r;asm("v_max3_f32 %0, %1, %2, %3":"=v"(r):"v"(a),"v"(b),"v"(c));return r;}
__device__ __forceinline__ float max2f(float a,float b){float r;asm("v_max_f32_e32 %0, %1, %2":"=v"(r):"v"(a),"v"(b));return r;}
__device__ __forceinline__ float fadd_s(float a,float b){float r;asm("v_add_f32_e32 %0, %1, %2":"=v"(r):"v"(a),"v"(b));return r;}
__device__ __forceinline__ float fsub_s(float a,float b){float r;asm("v_sub_f32_e32 %0, %1, %2":"=v"(r):"v"(a),"v"(b));return r;}
typedef float f32x2_t __attribute__((ext_vector_type(2))); typedef __bf16 bf16x2_t __attribute__((ext_vector_type(2)));
__device__ __forceinline__ unsigned cvtpk_s(float lo,float hi){f32x2_t v={lo,hi};bf16x2_t b=__builtin_convertvector(v,bf16x2_t);return __builtin_bit_cast(unsigned,b);}
#define WAIT_BAR(N) asm volatile("s_waitcnt vmcnt(" #N ") lgkmcnt(0)\n\ts_barrier":::"memory")

__device__ __forceinline__ void qkt(f32x16&p0,f32x16&p1,const char*Kslot,const bf16x8*qr,const f32x16&negm,int r32,int hi){
  const char*kb=Kslot+hi*1024+r32*16;
  #pragma unroll
  for(int d0=0;d0<4;++d0){
    const bf16x8 b0=*reinterpret_cast<const bf16x8*>(kb+d0*2048);
    const bf16x8 b1=*reinterpret_cast<const bf16x8*>(kb+d0*2048+512);
    if(d0==0){p0=__builtin_amdgcn_mfma_f32_32x32x16_bf16(b0,qr[0],negm,0,0,0);p1=__builtin_amdgcn_mfma_f32_32x32x16_bf16(b1,qr[0],negm,0,0,0);}
    else{p0=__builtin_amdgcn_mfma_f32_32x32x16_bf16(b0,qr[d0],p0,0,0,0);p1=__builtin_amdgcn_mfma_f32_32x32x16_bf16(b1,qr[d0],p1,0,0,0);}}
}
typedef __attribute__((address_space(3))) const char* lds_cptr;
typedef short v4i16_t __attribute__((ext_vector_type(4)));
__device__ __forceinline__ void kload8(bf16x8*kf,lds_cptr kp){
  kf[0]=*(const __attribute__((address_space(3))) bf16x8*)(kp);      kf[1]=*(const __attribute__((address_space(3))) bf16x8*)(kp+512);
  kf[2]=*(const __attribute__((address_space(3))) bf16x8*)(kp+2048); kf[3]=*(const __attribute__((address_space(3))) bf16x8*)(kp+2560);
  kf[4]=*(const __attribute__((address_space(3))) bf16x8*)(kp+4096); kf[5]=*(const __attribute__((address_space(3))) bf16x8*)(kp+4608);
  kf[6]=*(const __attribute__((address_space(3))) bf16x8*)(kp+6144); kf[7]=*(const __attribute__((address_space(3))) bf16x8*)(kp+6656);
}
__device__ __forceinline__ void kload2(bf16x8*kf,lds_cptr kp,int j){ kf[2*j]=*(const __attribute__((address_space(3))) bf16x8*)(kp+j*2048); kf[2*j+1]=*(const __attribute__((address_space(3))) bf16x8*)(kp+j*2048+512); }
__device__ __forceinline__ s16x4 vtr(lds_cptr p){ return __builtin_bit_cast(s16x4,__builtin_amdgcn_ds_read_tr16_b64_v4i16((__attribute__((address_space(3))) v4i16_t*)p)); }
__device__ __forceinline__ float rowmax(const f32x16&p0,const f32x16&p1){
  float a=max3f(p0[0],p0[1],p1[0]),b=max3f(p0[2],p0[3],p1[1]);a=max3f(a,p1[2],p1[3]);
  #pragma unroll
  for(int r=4;r<16;r+=4){a=max3f(a,p0[r],p0[r+1]);b=max3f(b,p0[r+2],p0[r+3]);a=max3f(a,p1[r],p1[r+1]);b=max3f(b,p1[r+2],p1[r+3]);}
  const float m=max2f(a,b);
  auto rr=__builtin_amdgcn_permlane32_swap(__float_as_uint(m),__float_as_uint(m),false,false);
  return max2f(__uint_as_float(rr[0]),__uint_as_float(rr[1]));
}
__device__ __forceinline__ void pv(f32x16*o,int vb,bf16x8 pa0,bf16x8 pa1,bf16x8 pa2,bf16x8 pa3){
  #pragma unroll
  for(int d0=0;d0<2;++d0){s16x4 lo[4],hi[4];
    #pragma unroll
    for(int ks=0;ks<4;++ks){
      asm volatile("ds_read_b64_tr_b16 %0,%1 offset:%c2":"=&v"(lo[ks]):"v"(vb),"i"(d0*4096+ks*1024):"memory");
      asm volatile("ds_read_b64_tr_b16 %0,%1 offset:%c2":"=&v"(hi[ks]):"v"(vb),"i"(d0*4096+ks*1024+512):"memory");}
    asm volatile("s_waitcnt lgkmcnt(0)":::"memory");SBAR();
    #define PK(k) (bf16x8){lo[k][0],lo[k][1],lo[k][2],lo[k][3],hi[k][0],hi[k][1],hi[k][2],hi[k][3]}
    o[d0]=__builtin_amdgcn_mfma_f32_32x32x16_bf16(pa0,PK(0),o[d0],0,0,0);
    o[d0]=__builtin_amdgcn_mfma_f32_32x32x16_bf16(pa1,PK(1),o[d0],0,0,0);
    o[d0]=__builtin_amdgcn_mfma_f32_32x32x16_bf16(pa2,PK(2),o[d0],0,0,0);
    o[d0]=__builtin_amdgcn_mfma_f32_32x32x16_bf16(pa3,PK(3),o[d0],0,0,0);
    #undef PK
  }
}

#ifndef ATTN_STORE16
#define ATTN_STORE16(p,v) (*(u32x4*)(p)=(v))
#endif
template<int THRL> __device__ __forceinline__ void attn_unit(int b,int qb,const bf16*Q,const bf16*__restrict__ K,const bf16*__restrict__ V,bf16*O,char*shm,const char*maskb,const int wave_s){
  int lane_l=lane_id(); asm volatile("":"+v"(lane_l)); const int lane=lane_l,tid=wave_s*64+lane,r32=lane&31,hi=lane>>5; const int wid=wave_s;
  const long rowbase=(long)b*SEQ; const int q0=qb*QBLK;
  const bf16*Qw=Q+(rowbase+q0)*QP+wid*D;
  const bf16*Kh=K+rowbase*KP,*Vh=V+rowbase*KP;
  const unsigned lds0=(unsigned)(uintptr_t)shm;
  float*wsf=(float*)(shm+LDS_WS)+wid*64;
  const bf16*ksrc=Kh+(long)lane*KP+wid*8;
  const bf16*vsrc=Vh+(long)(16*(wid&3)+(lane>>2))*KP+(wid>>2)*32+(lane&3)*8;
  const unsigned kdst=lds0+LDS_K+wid*1024, vdst=lds0+LDS_V+wid*1024;
  #define DMA_K(t,slot) glds16(ksrc+(long)(t)*KVBLK*KP,(unsigned)__builtin_amdgcn_readfirstlane(kdst+(slot)))
  #define DMA_V(t,slot) glds16(vsrc+(long)(t)*KVBLK*KP,(unsigned)__builtin_amdgcn_readfirstlane(vdst+(slot)))
  const int vb0=(int)(lds0+LDS_V)+((lane>>4)&1)*32+(lane&3)*8+(4*hi+((lane&15)>>2))*64;
  const char*Kbase=shm+LDS_K; bf16x8 kf[8];
  const lds_cptr shm3=(lds_cptr)shm; const lds_cptr kp0=shm3+LDS_K+hi*1024+r32*16; const lds_cptr vp0=shm3+LDS_V+((lane>>4)&1)*32+(lane&3)*8+(4*hi+((lane&15)>>2))*64;
  const int NTr=(q0+QBLK+KVBLK-1)/KVBLK; const int NT=(NTr<4)?4:((NTr+1)&~1);
  const __attribute__((address_space(3))) unsigned*mrow=(const __attribute__((address_space(3))) unsigned*)((__attribute__((address_space(3))) const char*)maskb)+r32*66;
  DMA_K(0,0);DMA_V(0,0);DMA_K(1,SLOTB);
  bf16x8 qr[4];
  #pragma unroll
  for(int d0=0;d0<4;++d0)qr[d0]=*reinterpret_cast<const bf16x8*>(&Qw[(long)r32*QP+d0*16+hi*8]);
  float zz_=0.f; asm volatile("":"+v"(zz_)); float mhat=zz_,l_reg=zz_;f32x16 o[2];
  #pragma unroll
  for(int r=0;r<16;++r){o[0][r]=zz_;o[1][r]=zz_;}
  f32x16 negm;
  #pragma unroll
  for(int r=0;r<16;++r)negm[r]=zz_;
  asm volatile("":"+v"(negm));
  #define CMASK(P0,P1,t) do{ const unsigned ml_=mrow[2*(t)], mh_=mrow[2*(t)+1]; amask(P0,P1,ml_,mh_,hi); }while(0)
  bool resc=false;
  #define START(P0,P1) do{ const float rm=rowmax(P0,P1); resc=false; \
    { const float dl=(rm>-INFINITY)?rm:0.f; mhat=fadd_s(mhat,dl); \
      _Pragma("unroll") for(int r=0;r<16;++r){P0[r]=fsub_s(P0[r],dl);P1[r]=fsub_s(P1[r],dl);} \
      _Pragma("unroll") for(int r=0;r<16;++r)negm[r]=-mhat; asm volatile("":"+v"(negm)); } \
    _Pragma("unroll") for(int r=0;r<16;++r)P0[r]=__builtin_amdgcn_exp2f(P0[r]); }while(0)
  #define RESC() do{ if(resc){ asm volatile("s_waitcnt lgkmcnt(0)":::"memory"); \
      _Pragma("unroll") for(int d_=0;d_<2;++d_) _Pragma("unroll") for(int r=0;r<16;++r)o[d_][r]*=wsf[crow(r,hi)]; } }while(0)
  f32x16 pA0,pA1,pB0,pB1;
  int sl_prev=0,sl_cur=0,sl_next=SLOTB;
  #define ROT() do{sl_prev=sl_cur;sl_cur=sl_next;sl_next=(sl_next==(NSLOT-1)*SLOTB)?0:sl_next+SLOTB;}while(0)
  DMA_K(2,2*SLOTB);
  WAIT_BAR(3);
  qkt(pA0,pA1,Kbase,qr,negm,r32,hi);asm volatile("s_nop 15\n\ts_nop 7":"+v"(pA0),"+v"(pA1));CMASK(pA0,pA1,0);
  START(pA0,pA1);
  _Pragma("unroll") for(int r=0;r<16;++r)pA1[r]=__builtin_amdgcn_exp2f(pA1[r]);
  WAIT_BAR(0);
  DMA_K(3,0);DMA_V(1,SLOTB);
  ROT();
  kload8(kf,kp0+sl_cur);
  WAIT_BAR(2);
  s16x4 vlo[8],vhi[8]; u32x4 pw0,pw1,pw2,pw3;
  #define PKW(P,B) cvtpk_s(P[B],P[B+1])
  #define PAF(k) __builtin_bit_cast(bf16x8,pw##k)
  #define VFR(i) (bf16x8){vlo[i][0],vlo[i][1],vlo[i][2],vlo[i][3],vhi[i][0],vhi[i][1],vhi[i][2],vhi[i][3]}
  #define PIN(x) asm volatile("":"+v"(x))
  #define MX3(a,b,c) __builtin_fmaxf(__builtin_fmaxf((a),(b)),(c))
  #define GAPA(MF,A0,A1,A2,A3,W0,W1,PW) do{ MF; sacc+=A0; sacc+=A1; sacc+=A2; sacc+=A3; PIN(sacc); W0; W1; PIN(PW); SBAR(); }while(0)
  #define EX(v) __builtin_amdgcn_exp2f(v)
  #define GAPB(MF,X,B) do{ MF; X[B]=EX(X[B]); X[B+1]=EX(X[B+1]); X[B+2]=EX(X[B+2]); X[B+3]=EX(X[B+3]); PIN(X); SBAR(); }while(0)
  #define VRD(i) do{ vlo[i]=vtr(vp_+(((i)>>2)*4096+((i)&3)*1024)); vhi[i]=vtr(vp_+(((i)>>2)*4096+((i)&3)*1024+512)); }while(0)
  #define KRD(G,j) do{ if(G){ kload2(kf,kp0+sl_next,j); SBAR(); } }while(0)
  #define STEP(C0,C1,P0,P1,t,GK,GV,GL) do{ SBAR(); \
    const lds_cptr vp_=vp0+sl_prev; \
    VRD(0); SBAR(); float sacc=(P0[0]+P0[1]); \
    GAPA(C0=__builtin_amdgcn_mfma_f32_32x32x16_bf16(kf[0],qr[0],negm,0,0,0), P0[2],P0[3],P0[4],P0[5],     pw0[0]=PKW(P0,0), pw0[1]=PKW(P0,2), pw0); \
    VRD(4); SBAR(); GAPA(C1=__builtin_amdgcn_mfma_f32_32x32x16_bf16(kf[1],qr[0],negm,0,0,0), P0[6],P0[7],P0[8],P0[9],     pw0[2]=PKW(P0,4), pw0[3]=PKW(P0,6), pw0); \
    VRD(1); SBAR(); GAPA(C0=__builtin_amdgcn_mfma_f32_32x32x16_bf16(kf[2],qr[1],C0,0,0,0),   P0[10],P0[11],P0[12],P0[13], pw1[0]=PKW(P0,8), pw1[1]=PKW(P0,10), pw1); \
    VRD(5); SBAR(); GAPA(C1=__builtin_amdgcn_mfma_f32_32x32x16_bf16(kf[3],qr[1],C1,0,0,0),   P0[14],P0[15],P1[0],P1[1],   pw1[2]=PKW(P0,12),pw1[3]=PKW(P0,14), pw1); \
    VRD(2); SBAR(); GAPA(C0=__builtin_amdgcn_mfma_f32_32x32x16_bf16(kf[4],qr[2],C0,0,0,0),   P1[2],P1[3],P1[4],P1[5],     pw2[0]=PKW(P1,0), pw2[1]=PKW(P1,2), pw2); \
    VRD(6); SBAR(); GAPA(C1=__builtin_amdgcn_mfma_f32_32x32x16_bf16(kf[5],qr[2],C1,0,0,0),   P1[6],P1[7],P1[8],P1[9],     pw2[2]=PKW(P1,4), pw2[3]=PKW(P1,6), pw2); \
    VRD(3); SBAR(); GAPA(C0=__builtin_amdgcn_mfma_f32_32x32x16_bf16(kf[6],qr[3],C0,0,0,0),   P1[10],P1[11],P1[12],P1[13], pw3[0]=PKW(P1,8), pw3[1]=PKW(P1,10), pw3); \
    VRD(7); SBAR(); GAPA(C1=__builtin_amdgcn_mfma_f32_32x32x16_bf16(kf[7],qr[3],C1,0,0,0),   P1[14],P1[15],0.f,0.f,       pw3[2]=PKW(P1,12),pw3[3]=PKW(P1,14), pw3); \
    l_reg+=sacc; \
    if(GK){DMA_K((t)+3,sl_cur);} if(GV){DMA_V((t)+1,sl_next);} \
    CMASK(C0,C1,t); \
    { float a=MX3(C0[0],C0[1],C1[0]),b=MX3(C0[2],C0[3],C1[1]); a=MX3(a,C1[2],C1[3]); \
      _Pragma("unroll") for(int r=4;r<16;r+=4){a=MX3(a,C0[r],C0[r+1]);b=MX3(b,C0[r+2],C0[r+3]);a=MX3(a,C1[r],C1[r+1]);b=MX3(b,C1[r+2],C1[r+3]);} \
      float rm=__builtin_fmaxf(a,b); { auto rr=__builtin_amdgcn_permlane32_swap(__float_as_uint(rm),__float_as_uint(rm),false,false); rm=__builtin_fmaxf(__uint_as_float(rr[0]),__uint_as_float(rr[1])); } \
      resc=false; \
      if(__builtin_expect(__any(rm>(float)THRL),0)){ const float dl=__builtin_fmaxf(rm,0.f); mhat+=dl; \
        _Pragma("unroll") for(int r=0;r<16;++r){C0[r]-=dl;C1[r]-=dl;} \
        _Pragma("unroll") for(int r=0;r<16;++r)negm[r]=-mhat; asm volatile("":"+v"(negm)); \
        const float f=__builtin_amdgcn_exp2f(-dl); l_reg*=f; if(hi==0)wsf[r32]=f; resc=true; } } \
    SBAR(); \
    GAPB(o[0]=__builtin_amdgcn_mfma_f32_32x32x16_bf16(PAF(0),VFR(0),o[0],0,0,0), C0,0); \
    GAPB(o[1]=__builtin_amdgcn_mfma_f32_32x32x16_bf16(PAF(0),VFR(4),o[1],0,0,0), C0,4); \
    KRD(GL,0); GAPB(o[0]=__builtin_amdgcn_mfma_f32_32x32x16_bf16(PAF(1),VFR(1),o[0],0,0,0), C0,8); \
    KRD(GL,1); GAPB(o[1]=__builtin_amdgcn_mfma_f32_32x32x16_bf16(PAF(1),VFR(5),o[1],0,0,0), C0,12); \
    KRD(GL,2); GAPB(o[0]=__builtin_amdgcn_mfma_f32_32x32x16_bf16(PAF(2),VFR(2),o[0],0,0,0), C1,0); \
    KRD(GL,3); GAPB(o[1]=__builtin_amdgcn_mfma_f32_32x32x16_bf16(PAF(2),VFR(6),o[1],0,0,0), C1,4); \
    GAPB(o[0]=__builtin_amdgcn_mfma_f32_32x32x16_bf16(PAF(3),VFR(3),o[0],0,0,0), C1,8); \
    GAPB(o[1]=__builtin_amdgcn_mfma_f32_32x32x16_bf16(PAF(3),VFR(7),o[1],0,0,0), C1,12); \
    }while(0)
  int t=1;
  for(;t+5<NT;t+=2){
    STEP(pB0,pB1,pA0,pA1,t,true,true,true);     WAIT_BAR(2); RESC(); ROT();
    STEP(pA0,pA1,pB0,pB1,t+1,true,true,true);   WAIT_BAR(2); RESC(); ROT();
  }
  #define ENDW(tt) do{ if((tt)+3<NT){WAIT_BAR(2);} else if((tt)+2<NT){WAIT_BAR(1);} else {WAIT_BAR(0);} }while(0)
  for(;t+1<NT;t+=2){
    STEP(pB0,pB1,pA0,pA1,t,(t+3<NT),(t+1<NT),(t+1<NT));       ENDW(t);   RESC(); ROT();
    STEP(pA0,pA1,pB0,pB1,t+1,(t+4<NT),(t+2<NT),(t+2<NT));     ENDW(t+1); RESC(); ROT();
  }
  STEP(pB0,pB1,pA0,pA1,NT-1,false,false,false); RESC();
  { float sacc=pB0[0]+pB0[1]; _Pragma("unroll") for(int r=2;r<16;++r)sacc+=pB0[r]; _Pragma("unroll") for(int r=0;r<16;++r)sacc+=pB1[r]; l_reg+=sacc;
    pw0=(u32x4){PKW(pB0,0),PKW(pB0,2),PKW(pB0,4),PKW(pB0,6)};pw1=(u32x4){PKW(pB0,8),PKW(pB0,10),PKW(pB0,12),PKW(pB0,14)};pw2=(u32x4){PKW(pB1,0),PKW(pB1,2),PKW(pB1,4),PKW(pB1,6)};pw3=(u32x4){PKW(pB1,8),PKW(pB1,10),PKW(pB1,12),PKW(pB1,14)};
    SBAR(); pv(o,vb0+sl_cur,PAF(0),PAF(1),PAF(2),PAF(3)); }
  #undef PKW
  #undef PAF
  #undef VFR
  #undef PIN
  #undef MX3
  #undef GAPA
  #undef GAPB
  #undef EX
  #undef VRD
  #undef KRD
  #undef STEP
  #undef ENDW
  {auto rr=__builtin_amdgcn_permlane32_swap(__float_as_uint(l_reg),__float_as_uint(l_reg),false,false);l_reg=__uint_as_float(rr[0])+__uint_as_float(rr[1]);}
  if(hi==0)wsf[32+r32]=l_reg;asm volatile("s_waitcnt lgkmcnt(0)":::"memory");
  float rli[16];
  #pragma unroll
  for(int r=0;r<16;++r)rli[r]=__builtin_amdgcn_rcpf(wsf[32+crow(r,hi)]);
  bf16*Ow=O+(rowbase+q0)*OP+512+wid*D;
  { bf16*stg=(bf16*)(shm+LDS_OST)+wid*2048;
    #pragma unroll
    for(int r=0;r<16;++r){const int orow=crow(r,hi);
      #pragma unroll
      for(int d0=0;d0<2;++d0)stg[orow*64+d0*32+r32]=(bf16)(cvtpk_s(o[d0][r]*rli[r],0.f)&0xffffu);}
    asm volatile("s_waitcnt lgkmcnt(0)":::"memory");
    #pragma unroll
    for(int i=0;i<4;++i){const int row=i*8+(lane>>3),ch=lane&7; const u32x4 v=*(const u32x4*)(stg+row*64+ch*8); ATTN_STORE16(Ow+(long)row*OP+ch*8,v);} }
  asm volatile("s_waitcnt lgkmcnt(0)\n\ts_barrier":::"memory");
  #undef DMA_K
  #undef DMA_V
  #undef CMASK
  #undef START
  #undef RESC
  #undef ROT
}
constexpr int ATTN_LDS_BYTES=LDS_BYTES;
#undef SBAR
#undef WAIT_BAR
}

constexpr int DSA_MASK_OFF = 131072, DSA_MASK_STRIDE = 66;
typedef short bf16x8_t __attribute__((ext_vector_type(8)));
__device__ __forceinline__ int wave_sum_dpp_i(int x) {
    x += __builtin_amdgcn_update_dpp(0, x, 0xB1, 0xf, 0xf, true);
    x += __builtin_amdgcn_update_dpp(0, x, 0x4E, 0xf, 0xf, true);
    x += __builtin_amdgcn_update_dpp(0, x, 0x114, 0xf, 0xf, true);
    x += __builtin_amdgcn_update_dpp(0, x, 0x118, 0xf, 0xf, true);
    x += __builtin_amdgcn_update_dpp(0, x, 0x142, 0xa, 0xf, false);
    x += __builtin_amdgcn_update_dpp(0, x, 0x143, 0xc, 0xf, false);
    return __builtin_amdgcn_readlane(x, 63);
}
__device__ __forceinline__ int wave_incl_scan_dpp_i(int x) {
    int v = x;
    v += __builtin_amdgcn_update_dpp(0, x, 0x111, 0xf, 0xf, true);
    v += __builtin_amdgcn_update_dpp(0, x, 0x112, 0xf, 0xf, true);
    v += __builtin_amdgcn_update_dpp(0, x, 0x113, 0xf, 0xf, true);
    v += __builtin_amdgcn_update_dpp(0, v, 0x114, 0xf, 0xe, true);
    v += __builtin_amdgcn_update_dpp(0, v, 0x118, 0xf, 0xc, true);
    v += __builtin_amdgcn_update_dpp(0, v, 0x142, 0xa, 0xf, false);
    v += __builtin_amdgcn_update_dpp(0, v, 0x143, 0xc, 0xf, false);
    return v;
}
__device__ __forceinline__ int count_ge(const unsigned (&k)[32], unsigned cand, int nreg) {
    int cl = 0;
#pragma unroll
    for (int g4 = 0; g4 < 8; ++g4) if (4 * g4 < nreg) {
#pragma unroll
        for (int j = 0; j < 4; ++j) cl += (k[4 * g4 + j] >= cand) ? 1 : 0; }
    return wave_sum_dpp_i(cl);
}
template <int OPK> __device__ __forceinline__ float dpp_opf(float a, float b) { return OPK == 0 ? fmaxf(a, b) : fminf(a, b); }
template <int OPK> __device__ __forceinline__ float wave_reduce_f(float x) {
    const int id = OPK == 0 ? (int)0xff800000 : (int)0x7f800000;
    x = dpp_opf<OPK>(x, __int_as_float(__builtin_amdgcn_update_dpp(id, __float_as_int(x), 0xB1, 0xf, 0xf, false)));
    x = dpp_opf<OPK>(x, __int_as_float(__builtin_amdgcn_update_dpp(id, __float_as_int(x), 0x4E, 0xf, 0xf, false)));
    x = dpp_opf<OPK>(x, __int_as_float(__builtin_amdgcn_update_dpp(id, __float_as_int(x), 0x114, 0xf, 0xf, false)));
    x = dpp_opf<OPK>(x, __int_as_float(__builtin_amdgcn_update_dpp(id, __float_as_int(x), 0x118, 0xf, 0xf, false)));
    x = dpp_opf<OPK>(x, __int_as_float(__builtin_amdgcn_update_dpp(id, __float_as_int(x), 0x142, 0xa, 0xf, false)));
    x = dpp_opf<OPK>(x, __int_as_float(__builtin_amdgcn_update_dpp(id, __float_as_int(x), 0x143, 0xc, 0xf, false)));
    return __int_as_float(__builtin_amdgcn_readlane(__float_as_int(x), 63));
}
__device__ __forceinline__ unsigned binof(float v, float vmin, float scale) { const unsigned b = (unsigned)(int)__fmul_rn(__fsub_rn(v, vmin), scale); return b > 2047u ? 2047u : b; }
__device__ __forceinline__ unsigned long long select_topk(const float (&k)[32], int kk, int nvalid, int nreg, int lane, LAS unsigned* hist, unsigned* errw) {
    const float NINF = -INFINITY;
    int mlo = 0, mhi = 0;
#define SEL_PUT(i, m) do { if (lane == (i)) { mlo = (int)(unsigned)(m); mhi = (int)(unsigned)((m) >> 32); } } while (0)
#define SEL_MINE (((unsigned long long)(unsigned)mhi << 32) | (unsigned long long)(unsigned)mlo)
    if (nvalid <= kk) {
#pragma unroll
        for (int g4 = 0; g4 < 8; ++g4) if (4 * g4 < nreg) {
#pragma unroll
            for (int j = 0; j < 4; ++j) { const int i = 4 * g4 + j; const unsigned long long m = __ballot(k[i] > NINF); SEL_PUT(i, m); } }
        return SEL_MINE;
    }
    float T = 0.f; bool exact = false;
    float mx = NINF, mn = INFINITY;
#pragma unroll
    for (int g4 = 0; g4 < 8; ++g4) if (4 * g4 < nreg) {
#pragma unroll
        for (int j = 0; j < 4; ++j) { const float v = k[4 * g4 + j]; mx = fmaxf(mx, v); mn = fminf(mn, v > NINF ? v : INFINITY); } }
    const float vmax = wave_reduce_f<0>(mx), vmin = wave_reduce_f<1>(mn);
    if (vmax == vmin) { T = vmax; }
    else {
        const float scale = 2046.5f / (vmax - vmin);
        LAS u32x4* h4 = (LAS u32x4*)hist;
#pragma unroll
        for (int j = 0; j < 8; ++j) h4[lane + 64 * j] = (u32x4){0u, 0u, 0u, 0u};
#pragma unroll
        for (int g4 = 0; g4 < 8; ++g4) if (4 * g4 < nreg) {
#pragma unroll
            for (int j = 0; j < 4; ++j) __hip_atomic_fetch_add(hist + binof(k[4 * g4 + j], vmin, scale), 1u, __ATOMIC_RELAXED, __HIP_MEMORY_SCOPE_WORKGROUP); }
        u32x4 w[8];
#pragma unroll
        for (int j = 0; j < 8; ++j) w[j] = ((LAS u32x4*)(hist + 2016 - 32 * lane))[j];
        if (lane == 0) w[7][3] = 0u;
        int s = 0;
#pragma unroll
        for (int j = 0; j < 8; ++j) s += (int)((w[j][0] + w[j][1]) + (w[j][2] + w[j][3]));
        const int Pinc = wave_incl_scan_dpp_i(s);
        const unsigned long long geb = __ballot(Pinc >= kk);
        const int Lstar = __builtin_ctzll(geb);
        const int above_l = __builtin_amdgcn_readlane(Pinc - s, Lstar);
        const int binj = 2047 - 32 * Lstar - (lane & 31);
        const int cntj = (binj == 2047) ? 0 : (int)hist[binj];
        int P2 = wave_incl_scan_dpp_i(lane < 32 ? cntj : 0) + above_l;
        const int jst = __builtin_ctzll(__ballot(P2 >= kk));
        const int Bstar = 2047 - 32 * Lstar - jst, cnt_above = __builtin_amdgcn_readlane(P2 - cntj, jst), cB = __builtin_amdgcn_readlane(cntj, jst);
        const int r = kk - cnt_above;
        if (cB <= 64) {
            LAS unsigned* cand = hist; int base = 0;
#pragma unroll
            for (int g4 = 0; g4 < 8; ++g4) if (4 * g4 < nreg) {
#pragma unroll
                for (int j = 0; j < 4; ++j) { const float v = k[4 * g4 + j]; const bool c = binof(v, vmin, scale) == (unsigned)Bstar; const unsigned long long bal = __ballot(c);
                    if (bal) { if (c) cand[base + __builtin_amdgcn_mbcnt_hi((unsigned)(bal >> 32), __builtin_amdgcn_mbcnt_lo((unsigned)bal, 0u))] = __float_as_uint(v); base += __popcll(bal); } } }
            const float myc = (lane < cB) ? __uint_as_float(cand[lane]) : NINF;
            float prev = INFINITY; int cum = 0;
            for (int it = 0; it < 64; ++it) {
                const float m = wave_reduce_f<0>(myc < prev ? myc : NINF);
                cum += __popcll(__ballot(myc == m));
                if (cum >= r) { T = m; exact = (cum == r); break; }
                prev = m;
            }
        } else {
            float prev = INFINITY; int cum = 0;
            for (int it = 0; it < 2048; ++it) {
                float lm = NINF;
#pragma unroll
                for (int i = 0; i < 32; ++i) { const float v = k[i]; if (v < prev && binof(v, vmin, scale) == (unsigned)Bstar) lm = fmaxf(lm, v); }
                const float m = wave_reduce_f<0>(lm);
                int mult = 0;
#pragma unroll
                for (int i = 0; i < 32; ++i) mult += __popcll(__ballot(k[i] == m));
                cum += mult;
                if (cum >= r) { T = m; exact = (cum == r); break; }
                prev = m;
            }
        }
    }
    if (exact) {
#pragma unroll
        for (int g4 = 0; g4 < 8; ++g4) if (4 * g4 < nreg) {
#pragma unroll
            for (int j = 0; j < 4; ++j) { const int i = 4 * g4 + j; const unsigned long long m = __ballot(k[i] >= T); SEL_PUT(i, m); } }
    } else {
        int ngt = 0;
#pragma unroll
        for (int i = 0; i < 32; ++i) ngt += __popcll(__ballot(k[i] > T));
        int need = kk - ngt;
#pragma unroll
        for (int i = 0; i < 32; ++i) {
            const unsigned long long eqb = __ballot(k[i] == T);
            const int rank = __builtin_amdgcn_mbcnt_hi((unsigned)(eqb >> 32), __builtin_amdgcn_mbcnt_lo((unsigned)eqb, 0u));
            const bool sel = (k[i] > T) || ((k[i] == T) && (rank < need));
            const unsigned long long m = __ballot(sel);
            need -= __popcll(eqb); if (need < 0) need = 0;
            SEL_PUT(i, m);
        }
    }
    const unsigned long long mine = SEL_MINE;
    if (wave_sum_dpp_i(lane < 32 ? __popcll(mine) : 0) != kk && lane == 0) atomicOr(errw, 1u);
    return mine;
#undef SEL_PUT
#undef SEL_MINE
}
__device__ __forceinline__ void dsa_select(int b, int qb, const bf16* IQb, const bf16* IKb, const float* IW, unsigned char* lds, int lane, int wave, unsigned* errw) {
    lane = launder_i(lane_id());
    unsigned* keys = (unsigned*)lds; unsigned* maskw = (unsigned*)(lds + DSA_MASK_OFF);
    if (qb < TOPK / 32) {
#pragma unroll 1
        for (int j = 0; j < 4; ++j) { const int q = 4 * wave + j, t = qb * 32 + q;
            if (lane < 32) { const int lo = 64 * lane; unsigned long long m = 0ull; if (t >= lo + 63) m = ~0ull; else if (t >= lo) m = (2ull << (t - lo)) - 1ull;
                *(unsigned long long*)(maskw + q * DSA_MASK_STRIDE + 2 * lane) = m; } }
        __syncthreads();
        return;
    }
    const size_t rb = (size_t)b * SEQ; const int q0 = qb * 32; const int ntk16 = 4 * ((qb >> 1) + 1);
    const int l15 = lane & 15, l4 = lane >> 4;
    bf16x8_t a2[2][4][2]; f32x4 wq2[2][4];
#pragma unroll
    for (int rr = 0; rr < 2; ++rr)
#pragma unroll
        for (int mt = 0; mt < 4; ++mt) {
            const bf16* ar = IQb + (rb + q0 + 16 * rr + 4 * mt + (l15 >> 2)) * 256 + (l15 & 3) * 64 + 8 * l4;
            a2[rr][mt][0] = *(const bf16x8_t*)ar; a2[rr][mt][1] = *(const bf16x8_t*)(ar + 32);
            wq2[rr][mt] = *(const f32x4*)(IW + (rb + q0 + 16 * rr + 4 * mt + l4) * 4);
        }
#pragma unroll
    for (int rnd = 0; rnd < 2; ++rnd) {
        const int qb0 = q0 + 16 * rnd;
        bf16x8_t a[4][2]; f32x4 wq[4];
#pragma unroll
        for (int mt = 0; mt < 4; ++mt) { a[mt][0] = a2[rnd][mt][0]; a[mt][1] = a2[rnd][mt][1]; wq[mt] = wq2[rnd][mt]; }
        bf16x8_t bc[4][2], bn[4][2];
#define DSA_LOADG(dst, ntb) do { _Pragma("unroll") for (int u = 0; u < 4; ++u) { const int nt_ = (ntb) + 8 * u; \
            if (nt_ < ntk16) { const bf16* br = IKb + (rb + 16 * nt_ + l15) * 64 + 8 * l4; dst[u][0] = *(const bf16x8_t*)br; dst[u][1] = *(const bf16x8_t*)(br + 32); } \
            else { dst[u][0] = (bf16x8_t){0, 0, 0, 0, 0, 0, 0, 0}; dst[u][1] = dst[u][0]; } } } while (0)
        DSA_LOADG(bn, wave);
        for (int ntb = wave; ntb < ntk16; ntb += 32) {
#pragma unroll
            for (int u = 0; u < 4; ++u) { bc[u][0] = bn[u][0]; bc[u][1] = bn[u][1]; }
            if (ntb + 32 < ntk16) DSA_LOADG(bn, ntb + 32);
#pragma unroll
            for (int u = 0; u < 4; ++u) {
                const int nt = ntb + 8 * u;
                if (nt < ntk16) {
                    const int s = 16 * nt + l15;
#pragma unroll
                    for (int mt = 0; mt < 4; ++mt) {
                        f32x4 c = (f32x4){0.f, 0.f, 0.f, 0.f};
                        c = __builtin_amdgcn_mfma_f32_16x16x32_bf16(a[mt][0], bc[u][0], c, 0, 0, 0);
                        c = __builtin_amdgcn_mfma_f32_16x16x32_bf16(a[mt][1], bc[u][1], c, 0, 0, 0);
                        const float r0 = __int_as_float(max(__float_as_int(c[0]), 0)), r1 = __int_as_float(max(__float_as_int(c[1]), 0)), r2 = __int_as_float(max(__float_as_int(c[2]), 0)), r3 = __int_as_float(max(__float_as_int(c[3]), 0));
                        float sc = wq[mt][0] * r0; sc = fmaf(wq[mt][1], r1, sc); sc = fmaf(wq[mt][2], r2, sc); sc = fmaf(wq[mt][3], r3, sc);
                        const int ql = 4 * mt + l4, t = qb0 + ql;
                        keys[ql * 2048 + s] = (s <= t) ? __float_as_uint(sc) : 0xff800000u;
                    }
                }
            }
        }
#undef DSA_LOADG
        __syncthreads();
#pragma unroll 1
        for (int j = 0; j < 2; ++j) {
            const int ql = 2 * wave + j, t = qb0 + ql, kk = (t + 1 < TOPK) ? (t + 1) : TOPK, nreg = (t >> 6) + 1;
            float k[32];
#pragma unroll
            for (int i = 0; i < 32; ++i) k[i] = (i < nreg) ? __uint_as_float(keys[ql * 2048 + 64 * i + lane]) : -INFINITY;
            const unsigned long long mine = select_topk(k, kk, t + 1, nreg, lane, (LAS unsigned*)((LAS unsigned char*)lds) + ql * 2048, errw);
            if (lane < 32) *(unsigned long long*)(maskw + (16 * rnd + ql) * DSA_MASK_STRIDE + 2 * lane) = mine;
        }
        __syncthreads();
    }
}

constexpr int LD64 = 72, LD128 = 136;
constexpr int SSD_CM = 0, SSD_BM = 18432, SSD_XS = 36864, SSD_XDT = 55296, SSD_BDT = 72704, SSD_MT = 90112, SSD_HB = 124928, SSD_DTS = 134144, SSD_ACUM = 134656, SSD_CW = 135168;
__device__ __forceinline__ bf16x8_t ldfrag(const bf16* base, int row, int ld, int k0) { return *(const bf16x8_t*)(base + row * ld + k0); }
__device__ __forceinline__ void ssd_item(int b, int h, KPtr P, const bf16* XBC, const float* DT, const bf16* Zb, bf16* ASb, float* SSQP, unsigned char* lds, int tid) {
    tid = launder_i(tid);
    const int lane = tid & 63, w = __builtin_amdgcn_readfirstlane(tid >> 6), l15 = lane & 15, l4 = lane >> 4, g = h >> 2;
    bf16* Cm = (bf16*)(lds + SSD_CM); bf16* Bm = (bf16*)(lds + SSD_BM); bf16* xs = (bf16*)(lds + SSD_XS); bf16* XdtT = (bf16*)(lds + SSD_XDT);
    bf16* BdT = (bf16*)(lds + SSD_BDT); bf16* Mt = (bf16*)(lds + SSD_MT); bf16* Hb = (bf16*)(lds + SSD_HB);
    float* dts = (float*)(lds + SSD_DTS); float* acum = (float*)(lds + SSD_ACUM);
    const float A = -__expf(P->a_log[h]), dtb = P->dt_bias[h], Dh = P->d_skip[h];
    f32x4 Hacc[2]; Hacc[0] = (f32x4){0.f, 0.f, 0.f, 0.f}; Hacc[1] = Hacc[0];
    for (int e = tid; e < 64 * LD64 / 2; e += NT) ((unsigned*)Hb)[e] = 0u;
    float* cwl = (float*)(lds + SSD_CW);
    for (int e = tid; e < 960; e += NT) { const int T = (e < 768) ? (e >> 8) : ((e - 768) >> 6), ch = e & 63, cb = (T == 0) ? h * 64 : (T == 1 ? 512 + g * 64 : 640 + g * 64);
        cwl[e] = (e < 768) ? P->conv_w[((e >> 6) & 3) * 768 + cb + ch] : P->conv_b[cb + ch]; }
    const int pt = w >> 1, ntb = 2 * (w & 1);
    const int sl = tid >> 2, sc0 = (tid & 3) * 16;
    u32x4 raw[3][4][2]; float dtraw = 0.f; u32x2 zc[4], zn[4];
#define SSD_LOADRAW(cc) do { const size_t rb_ = (size_t)b * SEQ + (cc) * 128; const bf16* xr_ = XBC + (rb_ + sl) * 768; \
        _Pragma("unroll") for (int T_ = 0; T_ < 3; ++T_) { const int cb_ = (T_ == 0) ? h * 64 : (T_ == 1 ? 512 + g * 64 : 640 + g * 64); \
            _Pragma("unroll") for (int j_ = 0; j_ < 4; ++j_) { raw[T_][j_][0] = *(const u32x4*)(xr_ + (j_ - 3) * 768 + cb_ + sc0); raw[T_][j_][1] = *(const u32x4*)(xr_ + (j_ - 3) * 768 + cb_ + sc0 + 8); } } } while (0)
#define SSD_PREFETCH(cc, ZD) do { const size_t rb_ = (size_t)b * SEQ + (cc) * 128; \
        if (tid < 128) dtraw = DT[(rb_ + tid) * 8 + h]; \
        _Pragma("unroll") for (int jt_ = 0; jt_ < 4; ++jt_) ZD[jt_] = *(const u32x2*)(Zb + (rb_ + 16 * w + l15) * 512 + h * 64 + 16 * jt_ + 4 * l4); } while (0)
    SSD_PREFETCH(0, zc);
    for (int c = 0; c < SEQ / 128; ++c) {
        const size_t rbase = (size_t)b * SEQ + c * 128;
        SSD_LOADRAW(c);
        if (tid < 128) { const float v = dtraw + dtb; dts[tid] = (v > 20.f) ? v : log1pf(__expf(v)); }
        __syncthreads();
        if (w == 0) {
            const float a0 = dts[2 * lane] * A, a1 = dts[2 * lane + 1] * A; const float s = a0 + a1; float inc = s;
#pragma unroll
            for (int o = 1; o < 64; o <<= 1) { const float v = __shfl_up(inc, o); if (lane >= o) inc += v; }
            const float ex = inc - s; acum[2 * lane] = ex + a0; acum[2 * lane + 1] = ex + s;
        }
        __syncthreads();
        const float alast = acum[127];
        {
            const int l = sl, c0 = sc0;
            const float dtl = dts[l], dec = __expf(alast - acum[l]);
            const int tmin = 3 - (c * 128 + l);
#pragma unroll
            for (int T = 0; T < 3; ++T) {
                u32x4 u[4][2];
#pragma unroll
                for (int j = 0; j < 4; ++j) { u[j][0] = raw[T][j][0]; u[j][1] = raw[T][j][1]; }
                if (c == 0) {
#pragma unroll
                    for (int j = 0; j < 3; ++j) if (j < tmin) { u[j][0] = (u32x4){0u, 0u, 0u, 0u}; u[j][1] = u[j][0]; } }
                float v[16];
#pragma unroll
                for (int i = 0; i < 16; ++i) v[i] = cwl[768 + T * 64 + c0 + i];
#pragma unroll
                for (int j = 0; j < 4; ++j)
#pragma unroll
                    for (int i = 0; i < 16; ++i) { const unsigned wd = u[j][i >> 3][(i >> 1) & 3]; const float xv = (i & 1) ? __uint_as_float(wd & 0xffff0000u) : __uint_as_float(wd << 16);
                        v[i] = fmaf(cwl[(T * 4 + j) * 64 + c0 + i], xv, v[i]); }
#pragma unroll
                for (int i = 0; i < 16; ++i) v[i] = silu(v[i]);
                bf16* dstm = (T == 0) ? xs : (T == 1 ? Bm : Cm);
                u32x4 o0, o1; o0.x = pg8::cvt_pk_bf16(v[0], v[1]); o0.y = pg8::cvt_pk_bf16(v[2], v[3]); o0.z = pg8::cvt_pk_bf16(v[4], v[5]); o0.w = pg8::cvt_pk_bf16(v[6], v[7]);
                o1.x = pg8::cvt_pk_bf16(v[8], v[9]); o1.y = pg8::cvt_pk_bf16(v[10], v[11]); o1.z = pg8::cvt_pk_bf16(v[12], v[13]); o1.w = pg8::cvt_pk_bf16(v[14], v[15]);
                *(u32x4*)(dstm + l * LD64 + c0) = o0; *(u32x4*)(dstm + l * LD64 + c0 + 8) = o1;
                if (T == 0) {
#pragma unroll
                    for (int i = 0; i < 16; ++i) XdtT[(c0 + i) * LD128 + l] = f2bf(v[i] * dtl); }
                if (T == 1) {
#pragma unroll
                    for (int i = 0; i < 16; ++i) BdT[(c0 + i) * LD128 + l] = f2bf(v[i] * dec); }
            }
        }
        if (c + 1 < SEQ / 128) SSD_PREFETCH(c + 1, zn);
        __syncthreads();
        const int lrow = 16 * w + l15; const float al = acum[lrow];
        {
            const bf16x8_t c0f = ldfrag(Cm, lrow, LD64, 8 * l4), c1f = ldfrag(Cm, lrow, LD64, 32 + 8 * l4);
            for (int j = 0; j <= w; ++j) {
                const bf16x8_t bf0 = ldfrag(Bm, 16 * j + l15, LD64, 8 * l4), bf1 = ldfrag(Bm, 16 * j + l15, LD64, 32 + 8 * l4);
                f32x4 acc = (f32x4){0.f, 0.f, 0.f, 0.f};
                acc = __builtin_amdgcn_mfma_f32_16x16x32_bf16(bf0, c0f, acc, 0, 0, 0);
                acc = __builtin_amdgcn_mfma_f32_16x16x32_bf16(bf1, c1f, acc, 0, 0, 0);
                const int s0 = 16 * j + 4 * l4; float m[4];
#pragma unroll
                for (int r = 0; r < 4; ++r) { const int s = s0 + r; m[r] = (s <= lrow) ? acc[r] * __expf(al - acum[s]) : 0.f; }
                u32x2 o; o.x = pg8::cvt_pk_bf16(m[0], m[1]); o.y = pg8::cvt_pk_bf16(m[2], m[3]);
                *(u32x2*)(Mt + lrow * LD128 + s0) = o;
            }
            if ((w & 1) == 0) *(u32x2*)(Mt + lrow * LD128 + 16 * (w + 1) + 4 * l4) = (u32x2){0u, 0u};
        }
        {
            const bf16x8_t c0f = ldfrag(Cm, lrow, LD64, 8 * l4), c1f = ldfrag(Cm, lrow, LD64, 32 + 8 * l4);
            const float ea = __expf(al); const int nks = (w >> 1) + 1;
            float ssq = 0.f;
            bf16x8_t mf[4];
#pragma unroll
            for (int ks = 0; ks < 4; ++ks) mf[ks] = (ks < nks) ? ldfrag(Mt, lrow, LD128, 32 * ks + 8 * l4) : (bf16x8_t){0, 0, 0, 0, 0, 0, 0, 0};
#pragma unroll
            for (int jt = 0; jt < 4; ++jt) {
                bf16x8_t hb0 = ldfrag(Hb, 16 * jt + l15, LD64, 8 * l4), hb1 = ldfrag(Hb, 16 * jt + l15, LD64, 32 + 8 * l4), xd[4];
#pragma unroll
                for (int ks = 0; ks < 4; ++ks) if (ks < nks) xd[ks] = ldfrag(XdtT, 16 * jt + l15, LD128, 32 * ks + 8 * l4);
                f32x4 acc = (f32x4){0.f, 0.f, 0.f, 0.f};
                acc = __builtin_amdgcn_mfma_f32_16x16x32_bf16(hb0, c0f, acc, 0, 0, 0);
                acc = __builtin_amdgcn_mfma_f32_16x16x32_bf16(hb1, c1f, acc, 0, 0, 0);
                acc = acc * ea;
#pragma unroll
                for (int ks = 0; ks < 4; ++ks) if (ks < nks) acc = __builtin_amdgcn_mfma_f32_16x16x32_bf16(xd[ks], mf[ks], acc, 0, 0, 0);
                const int p0 = 16 * jt + 4 * l4;
                const u32x2 xb = *(const u32x2*)(xs + lrow * LD64 + p0);
                const u32x2 zb = zc[jt];
                const float x0 = __uint_as_float(xb.x << 16), x1 = __uint_as_float(xb.x & 0xffff0000u), x2 = __uint_as_float(xb.y << 16), x3 = __uint_as_float(xb.y & 0xffff0000u);
                const float z0 = __uint_as_float(zb.x << 16), z1 = __uint_as_float(zb.x & 0xffff0000u), z2 = __uint_as_float(zb.y << 16), z3 = __uint_as_float(zb.y & 0xffff0000u);
                f32x4 y; y[0] = (acc[0] + Dh * x0) * silu(z0); y[1] = (acc[1] + Dh * x1) * silu(z1); y[2] = (acc[2] + Dh * x2) * silu(z2); y[3] = (acc[3] + Dh * x3) * silu(z3);
                u32x2 yo; yo.x = pg8::cvt_pk_bf16(y[0], y[1]); yo.y = pg8::cvt_pk_bf16(y[2], y[3]);
                *(u32x2*)(ASb + (rbase + lrow) * 1024 + h * 64 + p0) = yo;
                ssq += (y[0] * y[0] + y[1] * y[1]) + (y[2] * y[2] + y[3] * y[3]);
            }
            ssq += __shfl_xor(ssq, 16); ssq += __shfl_xor(ssq, 32);
            if (l4 == 0) SSQP[(rbase + lrow) * 8 + h] = ssq;
        }
        __syncthreads();
        {
            const float el = __expf(alast);
            bf16x8_t xf[4];
#pragma unroll
            for (int ks = 0; ks < 4; ++ks) xf[ks] = ldfrag(XdtT, 16 * pt + l15, LD128, 32 * ks + 8 * l4);
#pragma unroll
            for (int i = 0; i < 2; ++i) {
                bf16x8_t bd[4];
#pragma unroll
                for (int ks = 0; ks < 4; ++ks) bd[ks] = ldfrag(BdT, 16 * (ntb + i) + l15, LD128, 32 * ks + 8 * l4);
                f32x4 acc = Hacc[i] * el;
#pragma unroll
                for (int ks = 0; ks < 4; ++ks) acc = __builtin_amdgcn_mfma_f32_16x16x32_bf16(xf[ks], bd[ks], acc, 0, 0, 0);
                Hacc[i] = acc;
#pragma unroll
                for (int r = 0; r < 4; ++r) Hb[(16 * pt + 4 * l4 + r) * LD64 + 16 * (ntb + i) + l15] = f2bf(acc[r]);
            }
        }
#pragma unroll
        for (int jt = 0; jt < 4; ++jt) zc[jt] = zn[jt];
    }
    __syncthreads();
#undef SSD_PREFETCH
#undef SSD_LOADRAW
}

struct MoeOrder {
    int n; const LAS int* ul;
    __device__ __forceinline__ bool next(int i, pg8::Unit& u) const { if (i >= n) return false; u.pm = ul[2 * i]; u.pn = ul[2 * i + 1]; return true; }
    __device__ __forceinline__ void a_ready(const pg8::Unit&) const {}
    __device__ __forceinline__ void done(const pg8::Unit&) const {}
};
struct EpiSwiGLU {
    static constexpr bool PERM = true, AFTER_DRAIN = false; static constexpr int MID_T = 0;
    bf16* Hid;
    __device__ __forceinline__ void operator()(const pg8::f32x4 (&acc)[2][2][4][2], const pg8::Unit& u, int wr, int wc, int fr, int fq) const {
        const int row0 = u.pm * 256 + wr * 64 + fr, pl = u.pn & 1, hc = 128 * pl + 16 * wc + 4 * fq;
#pragma unroll
        for (int ai = 0; ai < 2; ++ai)
#pragma unroll
            for (int m = 0; m < 4; ++m) { const int row = row0 + ai * 128 + m * 16;
#pragma unroll
                for (int bj = 0; bj < 2; ++bj) { const f32x4 g = acc[ai][bj][m][0], uu = acc[ai][bj][m][1]; f32x4 h;
#pragma unroll
                    for (int e = 0; e < 4; ++e) h[e] = silu(g[e]) * uu[e];
                    u32x2 w; w.x = pg8::cvt_pk_bf16(h[0], h[1]); w.y = pg8::cvt_pk_bf16(h[2], h[3]);
                    *(u32x2*)(Hid + (size_t)row * EFF + hc + 64 * bj) = w; } }
    }
};
struct EpiDown {
    static constexpr bool PERM = true, AFTER_DRAIN = false; static constexpr int MID_T = 0;
    const int* DSTI; const float* WGT; bf16* Y;
    __device__ __forceinline__ void operator()(const pg8::f32x4 (&acc)[2][2][4][2], const pg8::Unit& u, int wr, int wc, int fr, int fq) const {
        const int row0 = u.pm * 256 + wr * 64 + fr, col0 = (u.pn & 3) * 256 + 32 * wc + 8 * fq;
#pragma unroll
        for (int ai = 0; ai < 2; ++ai)
#pragma unroll
            for (int m = 0; m < 4; ++m) { const int row = row0 + ai * 128 + m * 16; const unsigned di = (unsigned)DSTI[row]; const float w = WGT[row];
                bf16* Yr = Y + (size_t)di * DM + col0;
#pragma unroll
                for (int bj = 0; bj < 2; ++bj) { const f32x4 a = acc[ai][bj][m][0] * w, b = acc[ai][bj][m][1] * w;
                    u32x4 o; o.x = pg8::cvt_pk_bf16(a[0], a[1]); o.y = pg8::cvt_pk_bf16(a[2], a[3]); o.z = pg8::cvt_pk_bf16(b[0], b[1]); o.w = pg8::cvt_pk_bf16(b[2], b[3]);
                    *(u32x4*)(Yr + 128 * bj) = o; }
                asm volatile("" ::: "memory"); }
    }
};


__device__ __forceinline__ unsigned wave_select(const unsigned (&keys)[32], int kk, int lane) {
    unsigned T = 0u;
    for (int bit = 31; bit >= 0; --bit) {
        const unsigned cand = T | (1u << bit);
        int c = 0;
#pragma unroll
        for (int i = 0; i < 32; ++i) c += (keys[i] >= cand) ? 1 : 0;
#pragma unroll
        for (int o = 1; o < 64; o <<= 1) c += __shfl_xor(c, o);
        if (c >= kk) T = cand;
    }
    unsigned mgt = 0u, meq = 0u;
#pragma unroll
    for (int i = 0; i < 32; ++i) { mgt |= (keys[i] > T) ? (1u << i) : 0u; meq |= (keys[i] == T) ? (1u << i) : 0u; }
    int ngt = __popc(mgt), neq = __popc(meq);
    int tgt = ngt, teq = neq;
#pragma unroll
    for (int o = 1; o < 64; o <<= 1) { tgt += __shfl_xor(tgt, o); teq += __shfl_xor(teq, o); }
    const int need = kk - tgt;
    if (teq == need) return mgt | meq;
    int pre = neq;
#pragma unroll
    for (int o = 1; o < 64; o <<= 1) { const int v = __shfl_up(pre, o); if (lane >= o) pre += v; }
    pre -= neq;
    unsigned sel = mgt; int taken = pre;
#pragma unroll
    for (int i = 0; i < 32; ++i) { if ((meq >> i) & 1u) { if (taken < need) sel |= (1u << i); ++taken; } }
    return sel;
}

#define XB_TMO      128
#define XB_XCNT(j)  (256  + 64 * (j))
#define XB_XSUB(j)  (1280 + 64 * (j))
#define XB_XGEN(j)  (2304 + 64 * (j))
#define XB_TOP      3328
#define XB_TOPGEN   3392
#define XCD_BAR_WORDS 3456
#define XB_SPIN_CAP (1u << 18)

__device__ __forceinline__ unsigned xb_ld(unsigned* p)              { return __hip_atomic_load(p, __ATOMIC_RELAXED, __HIP_MEMORY_SCOPE_AGENT); }
__device__ __forceinline__ unsigned xb_add(unsigned* p, unsigned v) { return __hip_atomic_fetch_add(p, v, __ATOMIC_RELAXED, __HIP_MEMORY_SCOPE_AGENT); }
__device__ __forceinline__ unsigned xb_xcc_id() { return (unsigned)__builtin_amdgcn_s_getreg((3 << 11) | 20) & 0xFu; }
#define XB_SPIN(cond, bar) do { unsigned _sp = 0; while (cond) { __builtin_amdgcn_s_sleep(1); \
    if ((++_sp & 255u) == 0u) { if (xb_ld(&(bar)[XB_TMO])) break; if (_sp > XB_SPIN_CAP) { atomicAdd(&(bar)[XB_TMO], 1u); break; } } } } while (0)

struct XcdBarrier {
    unsigned* bar; unsigned x;
    volatile LAS unsigned* st;
};

__device__ __forceinline__ XcdBarrier xcd_barrier_post(unsigned* bar, volatile LAS unsigned* st, const int wave_s) {
    XcdBarrier b; b.bar = bar; b.x = xb_xcc_id(); b.st = st;
    if (wave_s == 0 && lane_id() == 0) (void)xb_add(&bar[XB_XCNT(b.x)], 1u);
    return b;
}
__device__ __forceinline__ void xcd_barrier_complete(unsigned* bar, unsigned x, unsigned& nloc, unsigned& nx) {
    const unsigned G = gridDim.x * gridDim.y * gridDim.z;
    unsigned sum, cnt, mine, sp = 0u;
    for (;;) {
        sum = 0u; cnt = 0u; mine = 0u;
#pragma unroll
        for (unsigned j = 0; j < 16; ++j) { const unsigned c = xb_ld(&bar[XB_XCNT(j)]); sum += c; cnt += (c > 0u) ? 1u : 0u; mine = (j == x) ? c : mine; }
        if (sum == G) break;
        __builtin_amdgcn_s_sleep(1);
        if ((++sp & 255u) == 0u) { if (xb_ld(&bar[XB_TMO])) break; if (sp > XB_SPIN_CAP) { atomicAdd(&bar[XB_TMO], 1u); break; } }
    }
    nloc = mine > 0u ? mine : 1u; nx = cnt > 0u ? cnt : 1u;
}

__device__ __forceinline__ void xcd_barrier(const XcdBarrier& b, const int wave_s) {
    asm volatile("s_waitcnt vmcnt(0)" ::: "memory");
    __syncthreads();
    if (wave_s == 0 && lane_id() == 0) {
        unsigned* bar = b.bar;
        __builtin_amdgcn_s_waitcnt(0);
        unsigned nloc = b.st[0], nx = b.st[1];
        if (nloc == 0u) { xcd_barrier_complete(bar, b.x, nloc, nx); b.st[0] = nloc; b.st[1] = nx; }
        const unsigned old = xb_add(&bar[XB_XSUB(b.x)], 1u);
        const unsigned gen = old / nloc;
        if (old + 1u == (gen + 1u) * nloc) {
            __builtin_amdgcn_fence(__ATOMIC_RELEASE, "agent");
            asm volatile("s_waitcnt vmcnt(0)" ::: "memory");
            const unsigned og = xb_add(&bar[XB_TOP], 1u);
            const unsigned tg = og / nx;
            if (og + 1u == (tg + 1u) * nx) xb_add(&bar[XB_TOPGEN], 1u);
            else XB_SPIN(xb_ld(&bar[XB_TOPGEN]) == tg, bar);
            __builtin_amdgcn_fence(__ATOMIC_ACQUIRE, "agent");
            xb_add(&bar[XB_XGEN(b.x)], 1u);
            asm volatile("s_waitcnt vmcnt(0)" ::: "memory");
        } else {
            XB_SPIN(xb_ld(&bar[XB_XGEN(b.x)]) == gen, bar);
            __builtin_amdgcn_fence(__ATOMIC_ACQUIRE, "agent");
            asm volatile("s_waitcnt vmcnt(0)" ::: "memory");
        }
    }
    __syncthreads();
}


#define PHASE_VARS const KPtr P = launder_k(KP0); const int wave = wave_s, lane = launder_i(lane_id()), tid = wave * 64 + lane, gw = bid * 8 + wave; unsigned char* ws = P->ws; unsigned* ctl = (unsigned*)(ws + WS_CTL); float2* rope = (float2*)(ws + WS_ROPE); float* tokw = (float*)(ws + WS_TOKW); int* lists = (int*)(ws + WS_LISTS); bf16* Qb = (bf16*)(ws + WS_Q); bf16* Kb = (bf16*)(ws + WS_K); bf16* Vb = (bf16*)(ws + WS_V); bf16* IKb = (bf16*)(ws + WS_IK); float* IW = (float*)(ws + WS_IW); float* DT = (float*)(ws + WS_DT); bf16* IQb = (bf16*)(ws + WS_IQ); bf16* Zb = (bf16*)(ws + WS_Z); bf16* XBC = (bf16*)(ws + WS_XBC); bf16* ASb = (bf16*)(ws + WS_AS); float* X1 = (float*)(ws + WS_X1); bf16* X1b = (bf16*)(ws + WS_X1B); bf16* Y0 = (bf16*)(ws + WS_Y0); bf16* Y1 = (bf16*)(ws + WS_Y1); float* SSQP = (float*)(ws + WS_SSQP); bf16* H1b = (bf16*)(ws + WS_X1); float* WGG = (float*)(ws + WS_RCONST + 4096); bf16* WguT = (bf16*)(ws + WS_WGU_T); bf16* WdT = (bf16*)(ws + WS_WD_T); int* ENT = (int*)(ws + WS_ENT); float* WGT = (float*)(ws + WS_ENT + 512 * 1024); int* ROWT = (int*)(ws + WS_ENT + 1024 * 1024); bf16* Xs = (bf16*)(ws + WS_XS); bf16* Hid = (bf16*)(ws + WS_HID); bf16* XB = (bf16*)(ws + WS_XB); bf16* WinT = (bf16*)(ws + WS_WIN_T); bf16* WoutT = (bf16*)(ws + WS_WOUT_T);
#ifndef PROBE_MASK
#define PROBE_MASK 0
#endif
#define STAMP(k) do { if (PROBE_MASK && bid == 0 && wave_s == 0 && lane_id() == 0) { const unsigned long long now_ = __builtin_amdgcn_s_memrealtime(); if ((PROBE_MASK >> (k)) & 1) pst[1] += now_ - pst[0]; pst[0] = now_; } } while (0)
__global__ void __launch_bounds__(NT, 2) hybrid_fwd(Params p) {
    extern __shared__ __attribute__((aligned(16))) unsigned char lds[];
    cg::grid_group grid = cg::this_grid();
    const int wave_s = __builtin_amdgcn_readfirstlane((int)threadIdx.x >> 6);
    const int G = gridDim.x, bid = blockIdx.x, NGW = G * 8;
    const KPtr KP0 = (KPtr)__builtin_amdgcn_kernarg_segment_ptr();
    volatile LAS unsigned* xst = (volatile LAS unsigned*)((LAS unsigned char*)lds + LDS_BYTES - 32);
    if (wave_s == 0 && lane_id() < 4) xst[lane_id()] = 0u;
    __syncthreads();
    const XcdBarrier xbar = xcd_barrier_post((unsigned*)(KP0->ws + WS_CTL) + CW_BAR, xst, wave_s);
    if (KP0->ws == nullptr) grid.sync();
#define GRID_SYNC() xcd_barrier(xbar, wave_s)
    volatile LAS unsigned long long* pst = (volatile LAS unsigned long long*)((LAS unsigned char*)lds + LDS_BYTES - 96);
    if (PROBE_MASK && bid == 0 && wave_s == 0 && lane_id() == 0) { pst[0] = __builtin_amdgcn_s_memrealtime(); pst[1] = 0ull; }
    {   PHASE_VARS
    for (int e = bid * NT + tid; e < SEQ * 32; e += G * NT) {
        const int t = e >> 5, i = e & 31;
        const float inv = powf(10000.0f, -(float)(2 * i) / 64.0f);
        const float ang = (float)t * inv;
        float s, c; sincosf(ang, &s, &c);
        rope[e] = make_float2(c, s);
    }
    for (int e = bid * NT + tid; e < 52 * 128; e += G * NT) {
        const int r = e >> 7, c = e & 127; const int row = (r < 4) ? (512 + 196 + r) : (512 + 208 + (r - 4));
        *(u32x4*)(WinT + (size_t)row * DM + c * 8) = (u32x4){0u, 0u, 0u, 0u};
    }
    {
        LAS float* scr = (LAS float*)((LAS unsigned char*)lds + wave * 16384);
        constexpr int I_IN = (DM / 64) * ((INW + 31) / 32), I_OUT = (DM / 64) * (DM / 32), I_GU = NEXP * 2 * 128, I_D = NEXP * 128;
        for (int it = launder_i(gw); it < I_IN; it += NGW) {
            int r = it;
            if (r < I_IN) { transpose_item(P->w_in, DM, INW, WinT, scr, r, lane, [](int c) { return win_dest_row(c); }, [](int k, float&) { return k; }); continue; } r -= I_IN;
        }
    }
    for (int e = bid * NT + tid; e < DM * 20; e += G * NT) { const int k = e / 20, j = e - k * 20; WGG[e] = P->ln1_g[k] * ((j < 4) ? P->w_rg[k * 4 + j] : P->w_re[k * 16 + (j - 4)]); }
    if (wave == 0 && bid >= G - 20) {
        float* rc = (float*)(ws + WS_RCONST); const int j = G - 1 - bid;
        float wv[16], gv[16], bv[16];
#pragma unroll
        for (int i = 0; i < 16; ++i) { const int k = lane + 64 * i; wv[i] = (j < 4) ? P->w_rg[k * 4 + j] : P->w_re[k * 16 + (j - 4)]; gv[i] = P->ln1_g[k]; bv[i] = P->ln1_b[k]; }
        float gs = 0.f, bs = 0.f;
#pragma unroll
        for (int i = 0; i < 16; ++i) { gs = fmaf(gv[i], wv[i], gs); bs = fmaf(bv[i], wv[i], bs); }
        gs = wave_sum(gs); bs = wave_sum(bs);
        if (lane == 0) { rc[j] = gs; rc[20 + j] = bs + ((j < 4) ? P->b_rg[j] : P->b_re[j - 4]); }
    }
    {
        const size_t NP = (size_t)M * DM / 8, stride = (size_t)G * NT;
        for (size_t e0 = (size_t)bid * NT + tid; e0 < NP; e0 += 8 * stride) {
            f32x4 a[8], b[8];
#pragma unroll
            for (int u = 0; u < 8; ++u) { const size_t e = e0 + u * stride; if (e < NP) { a[u] = __builtin_nontemporal_load((const f32x4*)(P->x + e * 8)); b[u] = __builtin_nontemporal_load((const f32x4*)(P->x + e * 8 + 4)); } }
#pragma unroll
            for (int u = 0; u < 8; ++u) { const size_t e = e0 + u * stride; if (e < NP) {
                u32x4 w; w.x = pg8::cvt_pk_bf16(a[u][0], a[u][1]); w.y = pg8::cvt_pk_bf16(a[u][2], a[u][3]); w.z = pg8::cvt_pk_bf16(b[u][0], b[u][1]); w.w = pg8::cvt_pk_bf16(b[u][2], b[u][3]);
                *(u32x4*)(XB + e * 8) = w; } }
        }
    }
    }
    GRID_SYNC(); STAMP(0);
    {   PHASE_VARS
    {
        pg8::Gemm g{XB, WinT, M, NPAD, DM}; pg8::StaticOrder S; S.init(M, NPAD, G, bid);
        EpiInProj E{Qb, Kb, Vb, IKb, IQb, Zb, XBC, IW, DT, rope};
        pg8::gemm_phase<EpiInProj, pg8::StaticOrder, true, true>((PG8_LAS unsigned char*)lds, g, S, E, wave_s);
    }
    }
    GRID_SYNC(); STAMP(1);
    {   PHASE_VARS
    for (int item = bid; item < BATCH * 8; item += G) ssd_item(__builtin_amdgcn_readfirstlane(item >> 3), __builtin_amdgcn_readfirstlane(item & 7), P, XBC, DT, Zb, ASb, SSQP, lds, tid);
    {
        volatile int* qslot = (volatile int*)(lds + LDS_BYTES - 64);
        const unsigned xcc = (unsigned)__builtin_amdgcn_s_getreg((3 << 11) | 20) & 7u;
        for (;;) {
            __syncthreads();
            if (tid == 0) { int pi = -1;
                for (unsigned a = 0; a < 8 && pi < 0; ++a) { const unsigned q = (xcc + a) & 7u; const unsigned idx = atomicAdd(&ctl[CW_DSAQ + 16 * q], 1u); if (idx < 128u) pi = (int)(q * 128u + idx); }
                *qslot = pi; }
            __syncthreads();
            const int pi = __builtin_amdgcn_readfirstlane(*qslot); if (pi < 0) break;
            const int q = pi >> 7, idx = pi & 127, b = q + 8 * (idx & 1), qb = 63 - (idx >> 1);
            dsa_select(b, qb, IQb, IKb, IW, lds, lane, wave_s, &ctl[CW_ERR]);
            attn_body::attn_unit<8>(b, qb, Qb, Kb, Vb, ASb, (char*)lds, (const char*)lds + DSA_MASK_OFF, wave_s);
        }
    }
    __syncthreads();
    {
        LAS float* scr = (LAS float*)((LAS unsigned char*)lds + wave * 16384);
        constexpr int I_OUT = (DM / 64) * (DM / 32), I_GU = NEXP * 2 * 128, I_D = NEXP * 128, I_ALL = I_OUT + I_GU + I_D;
        for (;;) {
            int base = 0; if (lane == 0) base = (int)atomicAdd(&ctl[CW_WQ], 8u);
            base = __builtin_amdgcn_readfirstlane(base); if (base >= I_ALL) break;
            for (int it = base; it < base + 8 && it < I_ALL; ++it) {
                int r = it;
                if (r < I_OUT) { { const float* nw = P->ssd_norm_w; transpose_item(P->w_out, DM, DM, WoutT, scr, r, lane, [](int c) { return c; }, [nw](int k, float& sc) { if (k < 512) { sc = nw[k]; return k + 512; } return k - 512; }); } continue; } r -= I_OUT;
                if (r < I_GU) { const int e = r >> 8, up = (r >> 7) & 1, sub = r & 127; const float* W = (up ? P->w_up : P->w_gate) + (size_t)e * DM * EFF;
                transpose_item(W, DM, EFF, WguT + (size_t)e * 512 * DM, scr, sub, lane, [up](int c) { return 8 * (c >> 2) + 4 * up + (c & 3); }, [](int k, float&) { return k; }); continue; } r -= I_GU;
                { const int e = r >> 7, sub = r & 127; transpose_item(P->w_down + (size_t)e * EFF * DM, EFF, DM, WdT + (size_t)e * DM * EFF, scr, sub, lane, [](int c) { return c; }, [](int k, float&) { return k; }); }
            }
        }
    }
    }
    GRID_SYNC(); STAMP(2);
    {   PHASE_VARS
    {
        pg8::Gemm g{ASb, WoutT, M, DM, DM}; pg8::StaticOrder S; S.init(M, DM, G, bid);
        EpiH1 E{P->x, H1b, SSQP};
        pg8::gemm_phase<EpiH1, pg8::StaticOrder, true, true>((PG8_LAS unsigned char*)lds, g, S, E, wave_s);
    }
    }
    GRID_SYNC(); STAMP(4);
    {   PHASE_VARS
    {
        float* Wg = (float*)lds;
        int* lcnt = (int*)(lds + 81920); int* lbase = lcnt + 16; int* rec = lbase + 16;
        float* recw = (float*)(rec + 4 * 128);
        float* rlg = recw + 2 * 128;
        float* rstat = rlg + 20 * 128;
        { f32x4 t4[10];
#pragma unroll
          for (int i = 0; i < 10; ++i) t4[i] = ((const f32x4*)WGG)[tid + NT * i];
#pragma unroll
          for (int i = 0; i < 10; ++i) ((f32x4*)Wg)[tid + NT * i] = t4[i]; }
        if (tid < 16) lcnt[tid] = 0;
        __syncthreads();
        const int rows_per_wave = M / NGW;
        const int l15 = lane & 15, ph = lane >> 4;
        {
            const bf16* hr = H1b + (size_t)(gw + NGW * l15) * DM + 4 * ph;
            const float* wb0 = Wg + (4 * ph) * 20 + l15; const float* wb1 = Wg + (4 * ph) * 20 + 16 + (l15 < 4 ? l15 : 3);
            f32x4 c0 = (f32x4){0.f, 0.f, 0.f, 0.f}, c1 = c0; float s = 0.f, ss = 0.f;
            u32x2 an[8];
#pragma unroll
            for (int u = 0; u < 8; ++u) an[u] = *(const u32x2*)(hr + 16 * u);
#pragma unroll 1
            for (int i0 = 0; i0 < 64; i0 += 8) {
                f32x4 a[8];
#pragma unroll
                for (int u = 0; u < 8; ++u) { a[u][0] = __uint_as_float(an[u].x << 16); a[u][1] = __uint_as_float(an[u].x & 0xffff0000u); a[u][2] = __uint_as_float(an[u].y << 16); a[u][3] = __uint_as_float(an[u].y & 0xffff0000u); }
                if (i0 + 8 < 64) {
#pragma unroll
                    for (int u = 0; u < 8; ++u) an[u] = *(const u32x2*)(hr + 16 * (i0 + 8 + u)); }
#pragma unroll
                for (int u = 0; u < 8; ++u) {
                    s += (a[u][0] + a[u][1]) + (a[u][2] + a[u][3]); ss += (a[u][0] * a[u][0] + a[u][1] * a[u][1]) + (a[u][2] * a[u][2] + a[u][3] * a[u][3]);
#pragma unroll
                    for (int e = 0; e < 4; ++e) { const int ko = (16 * (i0 + u) + e) * 20;
                        c0 = __builtin_amdgcn_mfma_f32_16x16x4f32(a[u][e], wb0[ko], c0, 0, 0, 0);
                        c1 = __builtin_amdgcn_mfma_f32_16x16x4f32(a[u][e], wb1[ko], c1, 0, 0, 0); }
                }
            }
            { const int ln2 = launder_i(lane); const int i16 = (ln2 ^ 16) << 2, i32 = (ln2 ^ 32) << 2;
              s += __builtin_bit_cast(float, __builtin_amdgcn_ds_bpermute(i16, __builtin_bit_cast(int, s))); s += __builtin_bit_cast(float, __builtin_amdgcn_ds_bpermute(i32, __builtin_bit_cast(int, s)));
              ss += __builtin_bit_cast(float, __builtin_amdgcn_ds_bpermute(i16, __builtin_bit_cast(int, ss))); ss += __builtin_bit_cast(float, __builtin_amdgcn_ds_bpermute(i32, __builtin_bit_cast(int, ss))); }
            const float mean = s * (1.f / DM), var = ss * (1.f / DM) - mean * mean;
            if (ph == 0) { rstat[(wave * 16 + l15) * 2] = mean; rstat[(wave * 16 + l15) * 2 + 1] = rsqrtf(var + LN_EPS); }
#pragma unroll
            for (int r = 0; r < 4; ++r) { const int rl = wave * 16 + 4 * ph + r; rlg[rl * 20 + l15] = c0[r]; if (l15 < 4) rlg[rl * 20 + 16 + l15] = c1[r]; }
        }
        __syncthreads();
        {
            f32x4 gg[4], bb[4];
#pragma unroll
            for (int j = 0; j < 4; ++j) { gg[j] = *(const f32x4*)(P->ln1_g + lane * 4 + 256 * j); bb[j] = *(const f32x4*)(P->ln1_b + lane * 4 + 256 * j); }
            for (int it = 0; it < rows_per_wave; it += 4) {
                f32x4 v[4][4];
#pragma unroll
                for (int r = 0; r < 4; ++r)
#pragma unroll
                    for (int j = 0; j < 4; ++j) { const u32x2 hb = *(const u32x2*)(H1b + (size_t)(gw + NGW * (it + r)) * DM + lane * 4 + 256 * j);
                        v[r][j][0] = __uint_as_float(hb.x << 16); v[r][j][1] = __uint_as_float(hb.x & 0xffff0000u); v[r][j][2] = __uint_as_float(hb.y << 16); v[r][j][3] = __uint_as_float(hb.y & 0xffff0000u); }
#pragma unroll
                for (int r = 0; r < 4; ++r) { const float mean = rstat[(wave * 16 + it + r) * 2], rstd = rstat[(wave * 16 + it + r) * 2 + 1];
#pragma unroll
                    for (int j = 0; j < 4; ++j) { const f32x4 o = (v[r][j] - mean) * rstd * gg[j] + bb[j]; u32x2 w; w.x = pg8::cvt_pk_bf16(o[0], o[1]); w.y = pg8::cvt_pk_bf16(o[2], o[3]);
                        *(u32x2*)(X1b + (size_t)(gw + NGW * (it + r)) * DM + lane * 4 + 256 * j) = w; } }
            }
        }
        const float* rc = (const float*)(ws + WS_RCONST);
        for (int rl = tid; rl < 8 * rows_per_wave; rl += NT) {
            const float mean = rstat[rl * 2], rstd = rstat[rl * 2 + 1];
            float lg[20];
#pragma unroll
            for (int j = 0; j < 20; ++j) lg[j] = rstd * (rlg[rl * 20 + j] - mean * rc[j]) + rc[20 + j];
            int gi = 0; float gm = lg[0];
#pragma unroll
            for (int i = 1; i < 4; ++i) if (lg[i] > gm) { gm = lg[i]; gi = i; }
            float gs = 0.f;
#pragma unroll
            for (int i = 0; i < 4; ++i) gs += __expf(lg[i] - gm);
            const float gprob = 1.f / gs;
            float el[4];
#pragma unroll
            for (int i = 0; i < 4; ++i) { float v0 = 0.f;
#pragma unroll
                for (int g2 = 0; g2 < 4; ++g2) if (g2 == gi) v0 = lg[4 + g2 * 4 + i];
                el[i] = v0; }
            int i0 = 0; float m0 = el[0];
#pragma unroll
            for (int i = 1; i < 4; ++i) if (el[i] > m0) { m0 = el[i]; i0 = i; }
            int i1 = -1; float m1 = -INFINITY;
#pragma unroll
            for (int i = 0; i < 4; ++i) if (i != i0 && el[i] > m1) { m1 = el[i]; i1 = i; }
            const float e1 = __expf(m1 - m0), inv = 1.f / (1.f + e1);
            const int ex0 = gi * 4 + i0, ex1 = gi * 4 + i1;
            rec[rl * 4 + 0] = ex0; rec[rl * 4 + 1] = atomicAdd(&lcnt[ex0], 1); rec[rl * 4 + 2] = ex1; rec[rl * 4 + 3] = atomicAdd(&lcnt[ex1], 1);
            recw[rl * 2] = inv * gprob; recw[rl * 2 + 1] = e1 * inv * gprob;
        }
        __syncthreads();
        if (tid < 16) lbase[tid] = (int)atomicAdd(&ctl[CW_CNT + 64 * tid], (unsigned)lcnt[tid]);
        __syncthreads();
        for (int rl = tid; rl < 8 * rows_per_wave; rl += NT) {
            const int row = (bid * 8 + rl / rows_per_wave) + NGW * (rl % rows_per_wave);
            const int e0 = rec[rl * 4], e1x = rec[rl * 4 + 2];
            lists[(size_t)e0 * M + lbase[e0] + rec[rl * 4 + 1]] = row * 2; lists[(size_t)e1x * M + lbase[e1x] + rec[rl * 4 + 3]] = row * 2 + 1;
            tokw[row * 2] = recw[rl * 2]; tokw[row * 2 + 1] = recw[rl * 2 + 1];
        }
    }
    }
    GRID_SYNC(); STAMP(5);
    {   PHASE_VARS
    int* tb = (int*)(lds + 135168);
    if (tid < NEXP) tb[32 + tid] = (int)((__hip_atomic_load(&ctl[CW_CNT + 64 * tid], __ATOMIC_RELAXED, __HIP_MEMORY_SCOPE_AGENT) + 255u) >> 8);
    __syncthreads();
    if (tid == 0) { int a = 0; for (int e = 0; e < NEXP; ++e) { tb[e] = a; a += tb[32 + e]; } tb[NEXP] = a; }
    __syncthreads();
    const int ntiles = tb[NEXP];
    for (int sr = bid * NT + tid; sr < ntiles * 256; sr += G * NT) {
        const int rt = sr >> 8; int e = 0;
#pragma unroll
        for (int j = 1; j < NEXP; ++j) if (rt >= tb[j]) e = j;
        const int slot = sr - tb[e] * 256; const int cnt_e = (int)__hip_atomic_load(&ctl[CW_CNT + 64 * e], __ATOMIC_RELAXED, __HIP_MEMORY_SCOPE_AGENT);
        const int en = (slot < cnt_e) ? lists[(size_t)e * M + slot] : -1;
        ENT[sr] = (en >= 0) ? ((en & 1) * M + (en >> 1)) : 2 * M; WGT[sr] = (en >= 0) ? tokw[en] : 0.f;
    }
    {
        LAS int* ul = (LAS int*)((LAS unsigned char*)lds + 135168 + 128); int n = 0;
        if (tid == 0) { for (int L = bid; L < ntiles * 2; L += G) { const int rt = L >> 1; int e = 0; for (int j = 1; j < NEXP; ++j) if (rt >= tb[j]) e = j; ul[2 * n] = rt; ul[2 * n + 1] = e * 2 + (L & 1); ++n; } ul[62] = n; }
        __syncthreads(); n = ul[62];
        LAS int* rtl = (LAS int*)((LAS unsigned char*)lds + 135168 + 512);
        for (int e = tid; e < n * 256; e += NT) { const int rt = ul[2 * (e >> 8)], ex = ul[2 * (e >> 8) + 1] >> 1, slot = (rt - tb[ex]) * 256 + (e & 255);
            const int cnt_e = (int)__hip_atomic_load(&ctl[CW_CNT + 64 * ex], __ATOMIC_RELAXED, __HIP_MEMORY_SCOPE_AGENT); rtl[e] = (slot < cnt_e) ? (lists[(size_t)ex * M + slot] >> 1) : 0; }
        __syncthreads();
        pg8::Gemm g{X1b, WguT, MAXROWS, 512, DM}; MoeOrder S{n, ul};
        EpiSwiGLU E{Hid};
        pg8::gemm_phase<EpiSwiGLU, MoeOrder, true, true, true>((PG8_LAS unsigned char*)lds, g, S, E, wave_s, rtl);
    }
    }
    GRID_SYNC(); STAMP(7);
    {   PHASE_VARS
    const LAS int* tb = (const LAS int*)((LAS unsigned char*)lds + 135168); const int ntiles = tb[NEXP];
    {
        LAS int* ul = (LAS int*)((LAS unsigned char*)lds + 135168 + 128); int n = 0;
        __syncthreads();
        if (tid == 0) { for (int L = bid; L < ntiles * 4; L += G) { const int rt = L >> 2; int e = 0; for (int j = 1; j < NEXP; ++j) if (rt >= tb[j]) e = j; ul[2 * n] = rt; ul[2 * n + 1] = e * 4 + (L & 3); ++n; } ul[62] = n; }
        __syncthreads(); n = ul[62];
        pg8::Gemm g{Hid, WdT, MAXROWS, DM, EFF}; MoeOrder S{n, ul};
        EpiDown E{ENT, WGT, Y0};
        pg8::gemm_phase<EpiDown, MoeOrder, true, true>((PG8_LAS unsigned char*)lds, g, S, E, wave_s);
    }
    }
    GRID_SYNC(); STAMP(8);
    {   PHASE_VARS
    const bool poison = __hip_atomic_load(&ctl[CW_ERR], __ATOMIC_RELAXED, __HIP_MEMORY_SCOPE_AGENT) != 0u; const float qnan = __builtin_nanf("");
    for (int row = launder_i(gw); row < M; row += NGW) {
        f32x4 v[4]; float s = 0.f;
#pragma unroll
        for (int j = 0; j < 4; ++j) { const int c0 = lane * 4 + 256 * j; const u32x2 xb = *(const u32x2*)(X1b + (size_t)row * DM + c0);
            v[j][0] = __uint_as_float(xb.x << 16) * ALPHA; v[j][1] = __uint_as_float(xb.x & 0xffff0000u) * ALPHA; v[j][2] = __uint_as_float(xb.y << 16) * ALPHA; v[j][3] = __uint_as_float(xb.y & 0xffff0000u) * ALPHA;
            const u32x2 a = *(const u32x2*)(Y0 + (size_t)row * DM + c0), b = *(const u32x2*)(Y1 + (size_t)row * DM + c0);
            v[j][0] += __uint_as_float(a.x << 16) + __uint_as_float(b.x << 16); v[j][1] += __uint_as_float(a.x & 0xffff0000u) + __uint_as_float(b.x & 0xffff0000u);
            v[j][2] += __uint_as_float(a.y << 16) + __uint_as_float(b.y << 16); v[j][3] += __uint_as_float(a.y & 0xffff0000u) + __uint_as_float(b.y & 0xffff0000u);
            s += (v[j][0] + v[j][1]) + (v[j][2] + v[j][3]); }
        const float mean = wave_sum(s) * (1.f / DM); float s2 = 0.f;
#pragma unroll
        for (int j = 0; j < 4; ++j) { v[j] = v[j] - mean; s2 += (v[j][0] * v[j][0] + v[j][1] * v[j][1]) + (v[j][2] * v[j][2] + v[j][3] * v[j][3]); }
        const float rstd = rsqrtf(wave_sum(s2) * (1.f / DM) + LN_EPS);
#pragma unroll
        for (int j = 0; j < 4; ++j) { const int c0 = lane * 4 + 256 * j;
            const f32x4 gg = *(const f32x4*)(P->ln2_g + c0), bb = *(const f32x4*)(P->ln2_b + c0);
            f32x4 o = v[j] * rstd * gg + bb; if (poison) o = (f32x4){qnan, qnan, qnan, qnan};
            *(f32x4*)(P->out + (size_t)row * DM + c0) = o; }
    }
    }
    STAMP(9);
    if (PROBE_MASK && bid == 0 && wave_s == 0 && lane_id() == 0) { const unsigned long long t0 = __builtin_amdgcn_s_memrealtime(), d = 8ull * pst[1]; while (__builtin_amdgcn_s_memrealtime() - t0 < d) __builtin_amdgcn_s_sleep(8); }
}

extern "C" void kernel_launch(void* const* d_in, const int* in_sizes, int n_in, void* d_out, int out_size, void* d_ws, size_t ws_size, hipStream_t stream) {
    static int grid = 0;
    if (grid == 0) {
        if (n_in != 20 || in_sizes[0] != M * DM || out_size != M * DM || ws_size < WS_END) { fprintf(stderr, "kernel_launch: unexpected shapes (n_in %d, in0 %d, out %d, ws %zu)\n", n_in, n_in > 0 ? in_sizes[0] : -1, out_size, ws_size); grid = -1; return; }
        int dev = 0, cus = 0, per_cu = 0;
        (void)hipGetDevice(&dev);
        (void)hipDeviceGetAttribute(&cus, hipDeviceAttributeMultiprocessorCount, dev);
        (void)hipFuncSetAttribute((const void*)hybrid_fwd, hipFuncAttributeMaxDynamicSharedMemorySize, LDS_BYTES);
        (void)hipOccupancyMaxActiveBlocksPerMultiprocessor(&per_cu, (const void*)hybrid_fwd, NT, LDS_BYTES);
        if (per_cu < 1) { fprintf(stderr, "kernel_launch: occupancy query says %d blocks/CU\n", per_cu); grid = -1; return; }
        grid = cus;
    }
    if (grid < 0) return;
    (void)hipMemsetAsync((char*)d_ws + WS_CTL, 0, CTL_BYTES, stream);
    Params p{};
    const float** f = (const float**)&p;
    for (int i = 0; i < 20; ++i) f[i] = (const float*)d_in[i];
    p.out = (float*)d_out; p.ws = (unsigned char*)d_ws;
    void* args[] = {&p};
    hipError_t e = hipLaunchCooperativeKernel((const void*)hybrid_fwd, dim3(grid), dim3(NT), args, LDS_BYTES, stream);
    if (e != hipSuccess) fprintf(stderr, "cooperative launch failed: %s (grid %d)\n", hipGetErrorString(e), grid);
}
```

```cpp
#include <hip/hip_runtime.h>
#include <hip/hip_cooperative_groups.h>
#include <cstdio>
#include <cstdint>
namespace cg = cooperative_groups;

constexpr int BATCH = 16, SEQ = 2048, DM = 1024, M = BATCH * SEQ;
constexpr int INW = 2252;
constexpr int C_Q = 0, C_K = 512, C_V = 576, C_IQ = 640, C_IK = 896, C_IW = 960, C_Z = 964, C_XBC = 1476, C_DT = 2244;
constexpr int NEXP = 16, EFF = 256;
constexpr float LN_EPS = 1e-5f;
constexpr float ALPHA = 1.189207115002721f;
constexpr float INDEXER_SCALE = 0.0625f;
constexpr float QSCALE = 0.125f * 1.4426950408889634f;
constexpr int TOPK = 256;
constexpr int NT = 512;
constexpr int LDS_BYTES = 147456;

constexpr size_t MiB = 1u << 20;
constexpr size_t WS_CTL = 0, CTL_BYTES = 1 * MiB;
constexpr size_t WS_ROPE = 1 * MiB;
constexpr size_t WS_TOKW = 2 * MiB;
constexpr size_t WS_LISTS = 3 * MiB;
constexpr size_t WS_WIN_T = 8 * MiB;
constexpr size_t WS_WOUT_T = 16 * MiB;
constexpr size_t WS_WGU_T = 18 * MiB;
constexpr size_t WS_WD_T = 34 * MiB;
constexpr size_t WS_RCONST = 7 * MiB;
constexpr size_t WS_ENT = 5 * MiB;
constexpr size_t WS_XS = 48 * MiB;
constexpr size_t WS_HID = 192 * MiB;
constexpr int MAXTILES = 272, MAXROWS = MAXTILES * 256;
constexpr size_t WS_XB = 256 * MiB;
constexpr int NPAD = 2304;
constexpr size_t WS_Q = 48 * MiB;
constexpr size_t WS_K = 80 * MiB, WS_V = 84 * MiB, WS_IK = 88 * MiB;
constexpr size_t WS_IW = 92 * MiB;
constexpr size_t WS_DT = 93 * MiB;
constexpr size_t WS_IQ = 96 * MiB;
constexpr size_t WS_Z = 112 * MiB;
constexpr size_t WS_XBC = 144 * MiB;
constexpr size_t WS_AS = 192 * MiB;
constexpr size_t WS_X1 = 256 * MiB;
constexpr size_t WS_X1B = 384 * MiB;
constexpr size_t WS_Y0 = 48 * MiB, WS_Y1 = 112 * MiB;
constexpr size_t WS_P32 = 224 * MiB;
constexpr size_t WS_XC = 256 * MiB;
constexpr size_t WS_BCC = 320 * MiB;
constexpr size_t WS_SSQP = 42 * MiB;
constexpr size_t WS_END = 512 * MiB;
constexpr int CW_CNT = 8192;
constexpr int CW_BAR = 4096;
constexpr int CW_ERR = 32;
constexpr int CW_WQ = 48;
constexpr int CW_DSAQ = 128;

typedef unsigned short bf16;
typedef float f32x4 __attribute__((ext_vector_type(4)));
typedef unsigned u32x4 __attribute__((ext_vector_type(4)));
typedef unsigned u32x2 __attribute__((ext_vector_type(2)));

struct Params {
    const float* x; const float* w_in; const float* conv_w; const float* conv_b; const float* dt_bias; const float* a_log; const float* d_skip;
    const float* ssd_norm_w; const float* w_out; const float* ln1_g; const float* ln1_b; const float* w_rg; const float* b_rg; const float* w_re; const float* b_re;
    const float* w_gate; const float* w_up; const float* w_down; const float* ln2_g; const float* ln2_b;
    float* out; unsigned char* ws;
};

__device__ __forceinline__ int launder_i(int v);
__device__ __forceinline__ int lane_id() { unsigned m = ~0u; asm volatile("" : "+s"(m)); return (int)__builtin_amdgcn_mbcnt_hi(m, __builtin_amdgcn_mbcnt_lo(m, 0u)); }
typedef const __attribute__((address_space(4))) Params* KPtr;
__device__ __forceinline__ KPtr launder_k(KPtr k) { asm volatile("" : "+s"(k)); return k; }
__device__ __forceinline__ float bf2f(bf16 v) { return __uint_as_float((unsigned)v << 16); }
__device__ __forceinline__ bf16 f2bf(float f) { unsigned u = __float_as_uint(f); return (bf16)((u + 0x7fffu + ((u >> 16) & 1u)) >> 16); }
__device__ __forceinline__ float silu(float v) { return v * __builtin_amdgcn_rcpf(1.f + __expf(-v)); }
__device__ __forceinline__ float wave_sum(float v) {
#define WS_DPP(ctrl, rm, bc) v += __int_as_float(__builtin_amdgcn_update_dpp(0, __float_as_int(v), ctrl, rm, 0xf, bc))
    WS_DPP(0xB1, 0xf, true); WS_DPP(0x4E, 0xf, true); WS_DPP(0x114, 0xf, true); WS_DPP(0x118, 0xf, true); WS_DPP(0x142, 0xa, false); WS_DPP(0x143, 0xc, false);
#undef WS_DPP
    return __int_as_float(__builtin_amdgcn_readlane(__float_as_int(v), 63));
}
__device__ __forceinline__ float wave_max(float v) {
#pragma unroll
    for (int o = 1; o < 64; o <<= 1) v = fmaxf(v, __shfl_xor(v, o));
    return v;
}
__device__ __forceinline__ int launder_i(int v) { asm volatile("" : "+v"(v)); return v; }
__device__ __forceinline__ unsigned sortkey(float f) { unsigned u = __float_as_uint(f); return (u & 0x80000000u) ? ~u : (u | 0x80000000u); }

namespace pg8 {
#define PG8_LAS __attribute__((address_space(3)))
typedef unsigned short bf16_t;
typedef short bf16x8 __attribute__((ext_vector_type(8)));
typedef float f32x4 __attribute__((ext_vector_type(4)));
typedef unsigned u32x4 __attribute__((ext_vector_type(4)));
constexpr int BM = 256, BK = 64, HALF = 128, HTB = HALF * BK * 2  , STAGE_BYTES = 8 * HTB, NXCD = 8, WGM = 8;

__host__ __device__ __forceinline__ int lds_byte(int r, int c) { const int st = (r >> 4) * 2 + (c >> 5), rr = r & 15, cc = c & 31, ob = rr * 64 + cc * 2; return st * 1024 + (ob ^ (((ob >> 9) & 1) << 5)); }
__host__ __device__ __forceinline__ void stage_rc(int b, int& R, int& C) { const int st = b / 1024, sb = b % 1024, swz = sb ^ (((sb >> 9) & 1) << 5); R = (st >> 1) * 16 + swz / 64; C = (st & 1) * 32 + (swz % 64) / 2; }
__host__ __device__ __forceinline__ int perm32(int rho) { const int n = rho >> 4, i = rho & 15; return 8 * (i >> 2) + 4 * n + (i & 3); }

struct Unit { int pm, pn; };
struct Gemm { const bf16_t* A; const bf16_t* Bt; int M, N, K; };

struct StaticOrder {
    int nM, nN, nwg, G, c;
    __host__ __device__ void init(int M, int N, int G_, int c_) { nM = M / BM; nN = N / BM; nwg = nM * nN; G = G_; c = c_; }
    __host__ __device__ bool next(int i, Unit& u) const {
        const long L = (long)i * G + c; if (L >= nwg) return false;
        int wgid = (int)L; { const int q = nwg / NXCD, r = nwg % NXCD, xcd = wgid % NXCD, off = wgid / NXCD; wgid = (xcd < r ? xcd * (q + 1) : r * (q + 1) + (xcd - r) * q) + off; }
        const int nig = WGM * nN, gid = wgid / nig, fm = gid * WGM, gsz = (nM - fm) < WGM ? (nM - fm) : WGM;
        u.pm = fm + ((wgid % nig) % gsz); u.pn = (wgid % nig) / gsz; return true;
    }
    __device__ __forceinline__ void a_ready(const Unit&) const {}
    __device__ __forceinline__ void done(const Unit&) const {}
};

__device__ __forceinline__ unsigned cvt_pk_bf16(float lo, float hi) { unsigned r; asm volatile("v_cvt_pk_bf16_f32 %0, %1, %2" : "=v"(r) : "v"(lo), "v"(hi)); return r; }
template <class Epi, class Sched, bool ALIGN_EPI = false, bool SP2 = false, bool GATHER = false>
__device__ __forceinline__ void gemm_phase(PG8_LAS unsigned char* lds, const Gemm g, const Sched& S, const Epi& E, const int wave_s, const PG8_LAS int* rtl = nullptr) {
    int tid_l = wave_s * 64 + lane_id(); asm volatile("" : "+v"(tid_l));
    const int tid = tid_l, wid = wave_s, lane = tid & 63, wr = wid >> 2, wc = wid & 3, fr = lane & 15, fq = lane >> 4;
    const int K = g.K, nt = K / BK;
    unsigned voffA[2], voffB[2];
#pragma unroll
    for (int i = 0; i < 2; ++i) { int R, C; stage_rc(tid * 16 + i * 8192, R, C); const int Rb = Epi::PERM ? ((R & ~31) + perm32(R & 31)) : R;
        voffA[i] = (unsigned)(R * K + C) * 2u; voffB[i] = (unsigned)(Rb * K + C) * 2u; }
    const size_t kstep = (size_t)(BK * 2);
    const size_t hstepB = (size_t)HALF * K * 2;
    const size_t tstep = 2 * hstepB;
    const size_t hstep = GATHER ? 0 : hstepB, tstepA = GATHER ? 0 : tstep;
    int rowA[2]; { int R, C; stage_rc(tid * 16, R, C); rowA[0] = R; stage_rc(tid * 16 + 8192, R, C); rowA[1] = R; }
    unsigned voffGc[2][2], voffGn[2][2];
#define PG8_GVOFF(dst, uidx) do { _Pragma("unroll") for (int _h = 0; _h < 2; ++_h) _Pragma("unroll") for (int _i = 0; _i < 2; ++_i) { int R_, C_; stage_rc(tid * 16 + _i * 8192, R_, C_); \
        dst[_h][_i] = (unsigned)rtl[(uidx) * 256 + _h * 128 + R_] * (unsigned)(K * 2) + (unsigned)(C_ * 2); } } while (0)
    const unsigned ldsw = (unsigned)wid * 1024u;
    const int aoff = lds_byte(wr * 64 + fr, fq * 8), boff = lds_byte(wc * 32 + fr, fq * 8);
#define PG8_SA(b, h) (((b) * 2 + (h)) * HTB)
#define PG8_SB(b, h) ((4 + (b) * 2 + (h)) * HTB)
#define PG8_STAGE(bufoff, gbase, voff) do { _Pragma("unroll") for (int _i = 0; _i < 2; ++_i) \
        __builtin_amdgcn_global_load_lds((const unsigned*)((const char*)(gbase) + (voff)[_i]), (PG8_LAS unsigned*)(lds + (bufoff) + ldsw + _i * 8192), 16, 0, 0); } while (0)
#define PG8_STAGE_A(bufoff, gbase, h, nx) do { if constexpr (GATHER) { if (nx) PG8_STAGE(bufoff, gbase, voffGn[h]); else PG8_STAGE(bufoff, gbase, voffGc[h]); } else PG8_STAGE(bufoff, gbase, voffA); } while (0)
#define PG8_LDA(dst, b, h) do { _Pragma("unroll") for (int m = 0; m < 4; ++m) _Pragma("unroll") for (int k = 0; k < 2; ++k) dst[m][k] = *(const PG8_LAS bf16x8*)(lds + PG8_SA(b, h) + aoff + m * 2048 + k * 1024); } while (0)
#define PG8_LDB(dst, b, h) do { _Pragma("unroll") for (int n = 0; n < 2; ++n) _Pragma("unroll") for (int k = 0; k < 2; ++k) dst[n][k] = *(const PG8_LAS bf16x8*)(lds + PG8_SB(b, h) + boff + n * 2048 + k * 1024); } while (0)
#define PG8_MMA(ai, bj, At, Bt) do { __builtin_amdgcn_s_setprio(1); _Pragma("unroll") for (int m = 0; m < 4; ++m) _Pragma("unroll") for (int n = 0; n < 2; ++n) _Pragma("unroll") for (int k = 0; k < 2; ++k) \
        acc[ai][bj][m][n] = __builtin_amdgcn_mfma_f32_16x16x32_bf16(Bt[n][k], At[m][k], acc[ai][bj][m][n], 0, 0, 0); __builtin_amdgcn_s_setprio(0); } while (0)
#define PG8_WAIT_V(n) asm volatile("s_waitcnt vmcnt(" #n ")" ::: "memory")
#define PG8_WAIT_L(n) asm volatile("s_waitcnt lgkmcnt(" #n ")" ::: "memory")
#define PG8_BAR __builtin_amdgcn_s_barrier()
#define PG8_SCHED __builtin_amdgcn_sched_barrier(0)
    Unit cur, nxt; int ui = 0;
    if (!S.next(0, cur)) return;
    f32x4 acc[2][2][4][2];
#pragma unroll
    for (int a = 0; a < 2; ++a)
#pragma unroll
        for (int b = 0; b < 2; ++b)
#pragma unroll
            for (int m = 0; m < 4; ++m)
#pragma unroll
                for (int n = 0; n < 2; ++n) acc[a][b][m][n] = (f32x4){0.f, 0.f, 0.f, 0.f};
    bf16x8 At[4][2], B0[2][2], B1[2][2];
    const char* cA = (const char*)g.A + (size_t)cur.pm * tstepA; const char* cB = (const char*)g.Bt + (size_t)cur.pn * tstep;
    if constexpr (GATHER) { PG8_GVOFF(voffGc, 0); _Pragma("unroll") for (int _h = 0; _h < 2; ++_h) _Pragma("unroll") for (int _i = 0; _i < 2; ++_i) voffGn[_h][_i] = voffGc[_h][_i]; }
    S.a_ready(cur);
    if constexpr (SP2) {
        PG8_STAGE(PG8_SB(0, 0), cB, voffB); PG8_STAGE(PG8_SB(0, 1), cB + hstepB, voffB); PG8_STAGE_A(PG8_SA(0, 0), cA, 0, false); PG8_STAGE_A(PG8_SA(0, 1), cA + hstep, 1, false);
        if (wr == 1) PG8_BAR;
        PG8_WAIT_V(2); PG8_BAR;
        PG8_STAGE(PG8_SB(1, 0), cB + kstep, voffB); PG8_STAGE_A(PG8_SA(1, 0), cA + kstep, 0, false); PG8_STAGE(PG8_SB(1, 1), cB + hstepB + kstep, voffB);
        PG8_WAIT_V(6); PG8_BAR;
    } else {
        PG8_STAGE(PG8_SB(0, 0), cB, voffB); PG8_STAGE_A(PG8_SA(0, 0), cA, 0, false); PG8_STAGE(PG8_SB(0, 1), cB + hstepB, voffB); PG8_STAGE_A(PG8_SA(0, 1), cA + hstep, 1, false);
        if (wr == 1) PG8_BAR;
        PG8_WAIT_V(4); PG8_BAR;
        PG8_STAGE(PG8_SB(1, 0), cB + kstep, voffB); PG8_STAGE_A(PG8_SA(1, 0), cA + kstep, 0, false); PG8_STAGE(PG8_SB(1, 1), cB + hstepB + kstep, voffB);
        PG8_WAIT_V(6); PG8_BAR;
    }
    for (;;) {
        const bool has_next = S.next(ui + 1, nxt);
        const char* nA = has_next ? (const char*)g.A + (size_t)nxt.pm * tstepA : cA; const char* nB = has_next ? (const char*)g.Bt + (size_t)nxt.pn * tstep : cB;
        for (int t = 0; t < nt; t += 2) {
            if constexpr (Epi::MID_T > 0) { if (t == Epi::MID_T) E.mid(acc, cur, wr, wc, fr, fq); }
            const bool last = (t == nt - 2);
            const char* a1 = cA + (size_t)(t + 1) * kstep;
            const char* a2 = last ? nA : cA + (size_t)(t + 2) * kstep; const char* b2 = last ? nB : cB + (size_t)(t + 2) * kstep;
            const char* a3 = a2 + kstep; const char* b3 = b2 + kstep;
            if (last && has_next) { S.a_ready(nxt); if constexpr (GATHER) PG8_GVOFF(voffGn, ui + 1); }
            if constexpr (SP2) {
            PG8_LDB(B0, 0, 0); PG8_LDB(B1, 0, 1); PG8_SCHED; PG8_LDA(At, 0, 0); PG8_STAGE_A(PG8_SA(1, 1), a1 + hstep, 1, false);
            PG8_WAIT_V(8); PG8_WAIT_L(0); PG8_BAR; PG8_MMA(0, 0, At, B0); PG8_MMA(0, 1, At, B1); PG8_BAR; PG8_SCHED;
            PG8_LDA(At, 0, 1); PG8_STAGE(PG8_SB(0, 0), b2, voffB); PG8_STAGE(PG8_SB(0, 1), b2 + hstepB, voffB); PG8_STAGE_A(PG8_SA(0, 0), a2, 0, last);
            PG8_WAIT_V(8); PG8_WAIT_L(0); PG8_BAR; PG8_MMA(1, 0, At, B0); PG8_MMA(1, 1, At, B1); PG8_BAR; PG8_SCHED;
            PG8_LDB(B0, 1, 0); PG8_LDB(B1, 1, 1); PG8_SCHED; PG8_LDA(At, 1, 0); PG8_STAGE_A(PG8_SA(0, 1), a2 + hstep, 1, last);
            PG8_WAIT_V(8); PG8_WAIT_L(0); PG8_BAR; PG8_MMA(0, 0, At, B0); PG8_MMA(0, 1, At, B1); PG8_BAR; PG8_SCHED;
            PG8_LDA(At, 1, 1); PG8_STAGE(PG8_SB(1, 0), b3, voffB); PG8_STAGE(PG8_SB(1, 1), b3 + hstepB, voffB); PG8_STAGE_A(PG8_SA(1, 0), a3, 0, last);
            PG8_WAIT_V(8); PG8_WAIT_L(0); PG8_BAR; PG8_MMA(1, 0, At, B0); PG8_MMA(1, 1, At, B1); PG8_BAR; PG8_SCHED;
            } else {
            PG8_LDB(B0, 0, 0); PG8_SCHED; PG8_LDA(At, 0, 0); PG8_STAGE_A(PG8_SA(1, 1), a1 + hstep, 1, false);
            PG8_WAIT_L(8); PG8_BAR; PG8_WAIT_L(0); PG8_MMA(0, 0, At, B0); PG8_BAR; PG8_SCHED;
            PG8_LDB(B1, 0, 1); PG8_STAGE(PG8_SB(0, 0), b2, voffB);
            PG8_BAR; PG8_WAIT_L(0); PG8_MMA(0, 1, At, B1); PG8_BAR;
            PG8_LDA(At, 0, 1); PG8_STAGE_A(PG8_SA(0, 0), a2, 0, last);
            PG8_BAR; PG8_WAIT_L(0); PG8_MMA(1, 0, At, B0); PG8_BAR; PG8_SCHED;
            PG8_STAGE(PG8_SB(0, 1), b2 + hstepB, voffB);
            PG8_WAIT_V(6); PG8_BAR; PG8_MMA(1, 1, At, B1); PG8_BAR;
            PG8_LDB(B0, 1, 0); PG8_SCHED; PG8_LDA(At, 1, 0); PG8_STAGE_A(PG8_SA(0, 1), a2 + hstep, 1, last);
            PG8_WAIT_L(8); PG8_BAR; PG8_WAIT_L(0); PG8_MMA(0, 0, At, B0); PG8_BAR; PG8_SCHED;
            PG8_LDB(B1, 1, 1); PG8_STAGE(PG8_SB(1, 0), b3, voffB);
            PG8_BAR; PG8_WAIT_L(0); PG8_MMA(0, 1, At, B1); PG8_BAR;
            PG8_LDA(At, 1, 1); PG8_STAGE_A(PG8_SA(1, 0), a3, 0, last);
            PG8_BAR; PG8_WAIT_L(0); PG8_MMA(1, 0, At, B0); PG8_BAR; PG8_SCHED;
            PG8_STAGE(PG8_SB(1, 1), b3 + hstepB, voffB);
            PG8_WAIT_V(6); PG8_BAR; PG8_MMA(1, 1, At, B1); PG8_BAR;
            }
        }
        if constexpr (ALIGN_EPI) { if (wr == 0) PG8_BAR; }
        if constexpr (!Epi::AFTER_DRAIN) { E(acc, cur, wr, wc, fr, fq); S.done(cur); }
        if (!has_next) break;
#pragma unroll
        for (int a = 0; a < 2; ++a)
#pragma unroll
            for (int b = 0; b < 2; ++b)
#pragma unroll
                for (int m = 0; m < 4; ++m)
#pragma unroll
                    for (int n = 0; n < 2; ++n) acc[a][b][m][n] = (f32x4){0.f, 0.f, 0.f, 0.f};
        cur = nxt; cA = nA; cB = nB; ++ui;
        if constexpr (GATHER) { _Pragma("unroll") for (int _h = 0; _h < 2; ++_h) _Pragma("unroll") for (int _i = 0; _i < 2; ++_i) voffGc[_h][_i] = voffGn[_h][_i]; }
        if constexpr (ALIGN_EPI) { if (wr == 1) PG8_BAR; }
    }
    PG8_WAIT_V(0);
    if constexpr (!ALIGN_EPI) { if (wr == 0) PG8_BAR; }
    PG8_BAR;
    if constexpr (Epi::AFTER_DRAIN) { E.fused(acc, cur, wr, wc, fr, fq, lds, wid, lane); S.done(cur); }
#undef PG8_SA
#undef PG8_SB
#undef PG8_STAGE
#undef PG8_STAGE_A
#undef PG8_GVOFF
#undef PG8_LDA
#undef PG8_LDB
#undef PG8_MMA
#undef PG8_WAIT_V
#undef PG8_WAIT_L
#undef PG8_BAR
#undef PG8_SCHED
}
}

#define LAS __attribute__((address_space(3)))
__host__ __device__ __forceinline__ int rope_pos(int j) { return 2 * (j & 31) + (j >> 5); }
__host__ __device__ __forceinline__ int win_dest_row(int c) {
    if (c < C_K) return (c & ~63) + rope_pos(c & 63);
    if (c < C_V) return 512 + rope_pos(c - C_K);
    if (c < C_IQ) return 512 + 64 + (c - C_V);
    if (c < C_IK) return 768 + ((c - C_IQ) & ~63) + rope_pos((c - C_IQ) & 63);
    if (c < C_IW) return 512 + 128 + rope_pos(c - C_IK);
    if (c < C_Z) return 512 + 192 + (c - C_IW);
    if (c < C_XBC) return 1024 + (c - C_Z);
    if (c < C_DT) return 1536 + (c - C_XBC);
    return 512 + 200 + (c - C_DT);
}
struct EpiInProj {
    static constexpr bool PERM = true, AFTER_DRAIN = false; static constexpr int MID_T = 0;
    bf16 *Q, *K, *V, *IK, *IQ, *Z, *XBC; float *IW, *DT; const float2* rope;
    __device__ __forceinline__ u32x4 pack8(const f32x4 a, const f32x4 b) const { u32x4 w; w.x = pg8::cvt_pk_bf16(a[0], a[1]); w.y = pg8::cvt_pk_bf16(a[2], a[3]); w.z = pg8::cvt_pk_bf16(b[0], b[1]); w.w = pg8::cvt_pk_bf16(b[2], b[3]); return w; }
    __device__ __forceinline__ u32x4 rope8(const f32x4 v0, const f32x4 v1, const f32x4 r0, const f32x4 r1, float sc) const {
        f32x4 a, b;
        a[0] = (v0[0] * r0[0] - v0[1] * r0[1]) * sc; a[1] = (v0[0] * r0[1] + v0[1] * r0[0]) * sc;
        a[2] = (v0[2] * r0[2] - v0[3] * r0[3]) * sc; a[3] = (v0[2] * r0[3] + v0[3] * r0[2]) * sc;
        b[0] = (v1[0] * r1[0] - v1[1] * r1[1]) * sc; b[1] = (v1[0] * r1[1] + v1[1] * r1[0]) * sc;
        b[2] = (v1[2] * r1[2] - v1[3] * r1[3]) * sc; b[3] = (v1[2] * r1[3] + v1[3] * r1[2]) * sc;
        return pack8(a, b);
    }
    __device__ __forceinline__ void operator()(const pg8::f32x4 (&acc)[2][2][4][2], const pg8::Unit& u, int wr, int wc, int fr, int fq) const {
        const int pn = u.pn, row0 = u.pm * 256 + wr * 64 + fr, cw = 32 * wc + 8 * fq;
        if (pn <= 1 || pn == 3) {
            bf16* dst = (pn == 3) ? IQ : Q; const int ld = (pn == 3) ? 256 : 512; const float sc = (pn == 3) ? 1.f : QSCALE; const int hb = (pn == 3) ? 0 : pn * 4;
#pragma unroll
            for (int ai = 0; ai < 2; ++ai)
#pragma unroll
                for (int m = 0; m < 4; ++m) { const int row = row0 + ai * 128 + m * 16, t = row & (SEQ - 1);
                    const f32x4* rp = (const f32x4*)(rope + t * 32 + 16 * (wc & 1) + 4 * fq); const f32x4 r0 = rp[0], r1 = rp[1];
#pragma unroll
                    for (int bj = 0; bj < 2; ++bj) { const int head = hb + 2 * bj + (wc >> 1);
                        *(u32x4*)(dst + (size_t)row * ld + head * 64 + 32 * (wc & 1) + 8 * fq) = rope8(acc[ai][bj][m][0], acc[ai][bj][m][1], r0, r1, sc); } }
        } else if (pn == 2) {
#pragma unroll
            for (int ai = 0; ai < 2; ++ai)
#pragma unroll
                for (int m = 0; m < 4; ++m) { const int row = row0 + ai * 128 + m * 16, t = row & (SEQ - 1);
                    if (wc < 2) { const f32x4* rp = (const f32x4*)(rope + t * 32 + 16 * wc + 4 * fq); const f32x4 r0 = rp[0], r1 = rp[1];
                        *(u32x4*)(K + (size_t)row * 64 + cw) = rope8(acc[ai][0][m][0], acc[ai][0][m][1], r0, r1, 1.f);
                        *(u32x4*)(IK + (size_t)row * 64 + cw) = rope8(acc[ai][1][m][0], acc[ai][1][m][1], r0, r1, 1.f);
                    } else {
                        *(u32x4*)(V + (size_t)row * 64 + (cw - 64)) = pack8(acc[ai][0][m][0], acc[ai][0][m][1]);
                        if (wc == 2 && fq == 0) *(f32x4*)(IW + (size_t)row * 4) = acc[ai][1][m][0] * INDEXER_SCALE;
                        if (wc == 2 && fq == 1) { *(f32x4*)(DT + (size_t)row * 8) = acc[ai][1][m][0]; *(f32x4*)(DT + (size_t)row * 8 + 4) = acc[ai][1][m][1]; }
                    } }
        } else {
            bf16* dst = (pn < 6) ? Z : XBC; const int ld = (pn < 6) ? 512 : 768; const int cb = (pn < 6) ? (pn - 4) * 256 : (pn - 6) * 256;
#pragma unroll
            for (int ai = 0; ai < 2; ++ai)
#pragma unroll
                for (int m = 0; m < 4; ++m) { const int row = row0 + ai * 128 + m * 16;
#pragma unroll
                    for (int bj = 0; bj < 2; ++bj) *(u32x4*)(dst + (size_t)row * ld + cb + 128 * bj + cw) = pack8(acc[ai][bj][m][0], acc[ai][bj][m][1]); }
        }
    }
};
struct EpiH1 {
    static constexpr bool PERM = true, AFTER_DRAIN = false; static constexpr int MID_T = 8;
    const float* x; bf16* out; const float* ssqp;
    __device__ __forceinline__ void mid(pg8::f32x4 (&acc)[2][2][4][2], const pg8::Unit& u, int wr, int wc, int fr, int fq) const {
        asm volatile("" : "+v"(fr));
        const int row0 = u.pm * 256 + wr * 64 + fr;
#pragma unroll
        for (int ai = 0; ai < 2; ++ai)
#pragma unroll
            for (int m = 0; m < 4; ++m) { const f32x4* sp = (const f32x4*)(ssqp + (size_t)(row0 + ai * 128 + m * 16) * 8); const f32x4 s0 = sp[0], s1 = sp[1];
                const float r = rsqrtf(((s0[0] + s0[1]) + (s0[2] + s0[3]) + (s1[0] + s1[1]) + (s1[2] + s1[3])) * (1.f / 512.f) + LN_EPS);
#pragma unroll
                for (int bj = 0; bj < 2; ++bj)
#pragma unroll
                    for (int n = 0; n < 2; ++n) acc[ai][bj][m][n] = acc[ai][bj][m][n] * r; }
    }
    __device__ __forceinline__ void operator()(const pg8::f32x4 (&acc)[2][2][4][2], const pg8::Unit& u, int wr, int wc, int fr, int fq) const {
        const int row0 = u.pm * 256 + wr * 64 + fr, col0 = u.pn * 256 + wc * 32 + 8 * fq;
#pragma unroll
        for (int ai = 0; ai < 2; ++ai)
#pragma unroll
            for (int m = 0; m < 4; ++m) { const size_t off = (size_t)(row0 + ai * 128 + m * 16) * DM + col0;
#pragma unroll
                for (int bj = 0; bj < 2; ++bj) { const u32x4 xb = *(const u32x4*)(out + off + bj * 128);
                    f32x4 h0, h1v;
                    h0[0] = __uint_as_float(xb.x << 16); h0[1] = __uint_as_float(xb.x & 0xffff0000u); h0[2] = __uint_as_float(xb.y << 16); h0[3] = __uint_as_float(xb.y & 0xffff0000u);
                    h1v[0] = __uint_as_float(xb.z << 16); h1v[1] = __uint_as_float(xb.z & 0xffff0000u); h1v[2] = __uint_as_float(xb.w << 16); h1v[3] = __uint_as_float(xb.w & 0xffff0000u);
                    h0 = h0 * ALPHA + acc[ai][bj][m][0]; h1v = h1v * ALPHA + acc[ai][bj][m][1];
                    u32x4 w; w.x = pg8::cvt_pk_bf16(h0[0], h0[1]); w.y = pg8::cvt_pk_bf16(h0[2], h0[3]); w.z = pg8::cvt_pk_bf16(h1v[0], h1v[1]); w.w = pg8::cvt_pk_bf16(h1v[2], h1v[3]);
                    *(u32x4*)(out + off + bj * 128) = w; } }
    }
};
template <class DR, class KM>
__device__ __forceinline__ void transpose_item(const float* W, int K, int N, bf16* WT, LAS float* scr, int item, int lane, DR drow, KM kmap) {
    const int nblk = (N + 31) / 32, kb = item / nblk, nb = item % nblk, k0 = 64 * kb, n0 = 32 * nb;
    float tv[32];
#pragma unroll
    for (int i = 0; i < 32; ++i) { const int kk = 2 * i + (lane >> 5), col = n0 + (lane & 31); float sc = 1.f; const int ks = kmap(k0 + kk, sc); tv[i] = (col < N) ? W[(size_t)ks * N + col] * sc : 0.f; }
#pragma unroll
    for (int i = 0; i < 32; ++i) scr[(2 * i + (lane >> 5)) * 33 + (lane & 31)] = tv[i];
    asm volatile("s_waitcnt lgkmcnt(0)" ::: "memory");
    const int c = lane & 7;
#pragma unroll
    for (int j = 0; j < 4; ++j) { const int n = (lane >> 3) + 8 * j, col = n0 + n; const LAS float* s = scr + (8 * c) * 33 + n;
        u32x4 o; o.x = pg8::cvt_pk_bf16(s[0 * 33], s[1 * 33]); o.y = pg8::cvt_pk_bf16(s[2 * 33], s[3 * 33]); o.z = pg8::cvt_pk_bf16(s[4 * 33], s[5 * 33]); o.w = pg8::cvt_pk_bf16(s[6 * 33], s[7 * 33]);
        if (col < N) *(u32x4*)(WT + (size_t)drow(col) * K + k0 + 8 * c) = o; }
    asm volatile("s_waitcnt lgkmcnt(0)" ::: "memory");
}
namespace attn_body {
using bf16=unsigned short;
using bf16x8=__attribute__((ext_vector_type(8)))short;
using s16x4=__attribute__((ext_vector_type(4)))short;
using f32x16=__attribute__((ext_vector_type(16)))float;
using u32x4=__attribute__((ext_vector_type(4)))unsigned;
constexpr int SEQ=2048,D=64,QP=512,KP=64,OP=1024;
constexpr int NW=8,QBLK=32,KVBLK=64;
__device__ __forceinline__ int crow(int r,int hi){return (r&3)+8*(r>>2)+4*hi;}
#define SBAR() __builtin_amdgcn_sched_barrier(0)
__device__ __forceinline__ void amask(f32x16&p0,f32x16&p1,unsigned mlo,unsigned mhi,int hi){
  const unsigned NEGB=0xff800000u; const unsigned a=mlo>>(4*hi), b=mhi>>(4*hi);
  #pragma unroll
  for(int r=0;r<16;++r){ const int pos=(r&3)+8*(r>>2);
    const unsigned s0=(unsigned)__builtin_amdgcn_sbfe((int)a,pos,1), s1=(unsigned)__builtin_amdgcn_sbfe((int)b,pos,1);
    const float v0=p0[r], v1=p1[r];
    p0[r]=__uint_as_float((s0&__float_as_uint(v0))|(~s0&NEGB));
    p1[r]=__uint_as_float((s1&__float_as_uint(v1))|(~s1&NEGB)); }
}

constexpr int NSLOT=3, SLOTB=8192;
constexpr int LDS_K=0, LDS_V=NSLOT*SLOTB, LDS_WS=2*NSLOT*SLOTB, LDS_OST=LDS_WS+NW*64*4, LDS_BYTES=LDS_OST+NW*4096;
constexpr float C2=0.125f*1.4426950408889634f;
__device__ __forceinline__ void glds16(const void*gsrc,unsigned lds_dst){unsigned keep;
  asm volatile("s_mov_b32 %0, m0\n\ts_mov_b32 m0, %2\n\ts_nop 0\n\tglobal_load_lds_dwordx4 %1, off\n\ts_mov_b32 m0, %0":"=&s"(keep):"v"(gsrc),"s"(lds_dst):"memory");}
__device__ __forceinline__ float max3f(float a,float b,float c){float r;asm("v_max3_f32 %0, %1, %2, %3":"=v"(r):"v"(a),"v"(b),"v"(c));return r;}
__device__ __forceinline__ float max2f(float a,float b){float r;asm("v_max_f32_e32 %0, %1, %2":"=v"(r):"v"(a),"v"(b));return r;}
__device__ __forceinline__ float fadd_s(float a,float b){float r;asm("v_add_f32_e32 %0, %1, %2":"=v"(r):"v"(a),"v"(b));return r;}
__device__ __forceinline__ float fsub_s(float a,float b){float r;asm("v_sub_f32_e32 %0, %1, %2":"=v"(r):"v"(a),"v"(b));return r;}
typedef float f32x2_t __attribute__((ext_vector_type(2))); typedef __bf16 bf16x2_t __attribute__((ext_vector_type(2)));
__device__ __forceinline__ unsigned cvtpk_s(float lo,float hi){f32x2_t v={lo,hi};bf16x2_t b=__builtin_convertvector(v,bf16x2_t);return __builtin_bit_cast(unsigned,b);}
#define WAIT_BAR(N) asm volatile("s_waitcnt vmcnt(" #N ") lgkmcnt(0)\n\ts_barrier":::"memory")

__device__ __forceinline__ void qkt(f32x16&p0,f32x16&p1,const char*Kslot,const bf16x8*qr,const f32x16&negm,int r32,int hi){
  const char*kb=Kslot+hi*1024+r32*16;
  #pragma unroll
  for(int d0=0;d0<4;++d0){
    const bf16x8 b0=*reinterpret_cast<const bf16x8*>(kb+d0*2048);
    const bf16x8 b1=*reinterpret_cast<const bf16x8*>(kb+d0*2048+512);
    if(d0==0){p0=__builtin_amdgcn_mfma_f32_32x32x16_bf16(b0,qr[0],negm,0,0,0);p1=__builtin_amdgcn_mfma_f32_32x32x16_bf16(b1,qr[0],negm,0,0,0);}
    else{p0=__builtin_amdgcn_mfma_f32_32x32x16_bf16(b0,qr[d0],p0,0,0,0);p1=__builtin_amdgcn_mfma_f32_32x32x16_bf16(b1,qr[d0],p1,0,0,0);}}
}
typedef __attribute__((address_space(3))) const char* lds_cptr;
typedef short v4i16_t __attribute__((ext_vector_type(4)));
__device__ __forceinline__ void kload8(bf16x8*kf,lds_cptr kp){
  kf[0]=*(const __attribute__((address_space(3))) bf16x8*)(kp);      kf[1]=*(const __attribute__((address_space(3))) bf16x8*)(kp+512);
  kf[2]=*(const __attribute__((address_space(3))) bf16x8*)(kp+2048); kf[3]=*(const __attribute__((address_space(3))) bf16x8*)(kp+2560);
  kf[4]=*(const __attribute__((address_space(3))) bf16x8*)(kp+4096); kf[5]=*(const __attribute__((address_space(3))) bf16x8*)(kp+4608);
  kf[6]=*(const __attribute__((address_space(3))) bf16x8*)(kp+6144); kf[7]=*(const __attribute__((address_space(3))) bf16x8*)(kp+6656);
}
__device__ __forceinline__ void kload2(bf16x8*kf,lds_cptr kp,int j){ kf[2*j]=*(const __attribute__((address_space(3))) bf16x8*)(kp+j*2048); kf[2*j+1]=*(const __attribute__((address_space(3))) bf16x8*)(kp+j*2048+512); }
__device__ __forceinline__ s16x4 vtr(lds_cptr p){ return __builtin_bit_cast(s16x4,__builtin_amdgcn_ds_read_tr16_b64_v4i16((__attribute__((address_space(3))) v4i16_t*)p)); }
__device__ __forceinline__ float rowmax(const f32x16&p0,const f32x16&p1){
  float a=max3f(p0[0],p0[1],p1[0]),b=max3f(p0[2],p0[3],p1[1]);a=max3f(a,p1[2],p1[3]);
  #pragma unroll
  for(int r=4;r<16;r+=4){a=max3f(a,p0[r],p0[r+1]);b=max3f(b,p0[r+2],p0[r+3]);a=max3f(a,p1[r],p1[r+1]);b=max3f(b,p1[r+2],p1[r+3]);}
  const float m=max2f(a,b);
  auto rr=__builtin_amdgcn_permlane32_swap(__float_as_uint(m),__float_as_uint(m),false,false);
  return max2f(__uint_as_float(rr[0]),__uint_as_float(rr[1]));
}
__device__ __forceinline__ void pv(f32x16*o,int vb,bf16x8 pa0,bf16x8 pa1,bf16x8 pa2,bf16x8 pa3){
  #pragma unroll
  for(int d0=0;d0<2;++d0){s16x4 lo[4],hi[4];
    #pragma unroll
    for(int ks=0;ks<4;++ks){
      asm volatile("ds_read_b64_tr_b16 %0,%1 offset:%c2":"=&v"(lo[ks]):"v"(vb),"i"(d0*4096+ks*1024):"memory");
      asm volatile("ds_read_b64_tr_b16 %0,%1 offset:%c2":"=&v"(hi[ks]):"v"(vb),"i"(d0*4096+ks*1024+512):"memory");}
    asm volatile("s_waitcnt lgkmcnt(0)":::"memory");SBAR();
    #define PK(k) (bf16x8){lo[k][0],lo[k][1],lo[k][2],lo[k][3],hi[k][0],hi[k][1],hi[k][2],hi[k][3]}
    o[d0]=__builtin_amdgcn_mfma_f32_32x32x16_bf16(pa0,PK(0),o[d0],0,0,0);
    o[d0]=__builtin_amdgcn_mfma_f32_32x32x16_bf16(pa1,PK(1),o[d0],0,0,0);
    o[d0]=__builtin_amdgcn_mfma_f32_32x32x16_bf16(pa2,PK(2),o[d0],0,0,0);
    o[d0]=__builtin_amdgcn_mfma_f32_32x32x16_bf16(pa3,PK(3),o[d0],0,0,0);
    #undef PK
  }
}

#ifndef ATTN_STORE16
#define ATTN_STORE16(p,v) (*(u32x4*)(p)=(v))
#endif
template<int THRL> __device__ __forceinline__ void attn_unit(int b,int qb,const bf16*Q,const bf16*__restrict__ K,const bf16*__restrict__ V,bf16*O,char*shm,const char*maskb,const int wave_s){
  int lane_l=lane_id(); asm volatile("":"+v"(lane_l)); const int lane=lane_l,tid=wave_s*64+lane,r32=lane&31,hi=lane>>5; const int wid=wave_s;
  const long rowbase=(long)b*SEQ; const int q0=qb*QBLK;
  const bf16*Qw=Q+(rowbase+q0)*QP+wid*D;
  const bf16*Kh=K+rowbase*KP,*Vh=V+rowbase*KP;
  const unsigned lds0=(unsigned)(uintptr_t)shm;
  float*wsf=(float*)(shm+LDS_WS)+wid*64;
  const bf16*ksrc=Kh+(long)lane*KP+wid*8;
  const bf16*vsrc=Vh+(long)(16*(wid&3)+(lane>>2))*KP+(wid>>2)*32+(lane&3)*8;
  const unsigned kdst=lds0+LDS_K+wid*1024, vdst=lds0+LDS_V+wid*1024;
  #define DMA_K(t,slot) glds16(ksrc+(long)(t)*KVBLK*KP,(unsigned)__builtin_amdgcn_readfirstlane(kdst+(slot)))
  #define DMA_V(t,slot) glds16(vsrc+(long)(t)*KVBLK*KP,(unsigned)__builtin_amdgcn_readfirstlane(vdst+(slot)))
  const int vb0=(int)(lds0+LDS_V)+((lane>>4)&1)*32+(lane&3)*8+(4*hi+((lane&15)>>2))*64;
  const char*Kbase=shm+LDS_K; bf16x8 kf[8];
  const lds_cptr shm3=(lds_cptr)shm; const lds_cptr kp0=shm3+LDS_K+hi*1024+r32*16; const lds_cptr vp0=shm3+LDS_V+((lane>>4)&1)*32+(lane&3)*8+(4*hi+((lane&15)>>2))*64;
  const int NTr=(q0+QBLK+KVBLK-1)/KVBLK; const int NT=(NTr<4)?4:((NTr+1)&~1);
  const __attribute__((address_space(3))) unsigned*mrow=(const __attribute__((address_space(3))) unsigned*)((__attribute__((address_space(3))) const char*)maskb)+r32*66;
  DMA_K(0,0);DMA_V(0,0);DMA_K(1,SLOTB);
  bf16x8 qr[4];
  #pragma unroll
  for(int d0=0;d0<4;++d0)qr[d0]=*reinterpret_cast<const bf16x8*>(&Qw[(long)r32*QP+d0*16+hi*8]);
  float zz_=0.f; asm volatile("":"+v"(zz_)); float mhat=zz_,l_reg=zz_;f32x16 o[2];
  #pragma unroll
  for(int r=0;r<16;++r){o[0][r]=zz_;o[1][r]=zz_;}
  f32x16 negm;
  #pragma unroll
  for(int r=0;r<16;++r)negm[r]=zz_;
  asm volatile("":"+v"(negm));
  #define CMASK(P0,P1,t) do{ const unsigned ml_=mrow[2*(t)], mh_=mrow[2*(t)+1]; amask(P0,P1,ml_,mh_,hi); }while(0)
  bool resc=false;
  #define START(P0,P1) do{ const float rm=rowmax(P0,P1); resc=false; \
    { const float dl=(rm>-INFINITY)?rm:0.f; mhat=fadd_s(mhat,dl); \
      _Pragma("unroll") for(int r=0;r<16;++r){P0[r]=fsub_s(P0[r],dl);P1[r]=fsub_s(P1[r],dl);} \
      _Pragma("unroll") for(int r=0;r<16;++r)negm[r]=-mhat; asm volatile("":"+v"(negm)); } \
    _Pragma("unroll") for(int r=0;r<16;++r)P0[r]=__builtin_amdgcn_exp2f(P0[r]); }while(0)
  #define RESC() do{ if(resc){ asm volatile("s_waitcnt lgkmcnt(0)":::"memory"); \
      _Pragma("unroll") for(int d_=0;d_<2;++d_) _Pragma("unroll") for(int r=0;r<16;++r)o[d_][r]*=wsf[crow(r,hi)]; } }while(0)
  f32x16 pA0,pA1,pB0,pB1;
  int sl_prev=0,sl_cur=0,sl_next=SLOTB;
  #define ROT() do{sl_prev=sl_cur;sl_cur=sl_next;sl_next=(sl_next==(NSLOT-1)*SLOTB)?0:sl_next+SLOTB;}while(0)
  DMA_K(2,2*SLOTB);
  WAIT_BAR(3);
  qkt(pA0,pA1,Kbase,qr,negm,r32,hi);asm volatile("s_nop 15\n\ts_nop 7":"+v"(pA0),"+v"(pA1));CMASK(pA0,pA1,0);
  START(pA0,pA1);
  _Pragma("unroll") for(int r=0;r<16;++r)pA1[r]=__builtin_amdgcn_exp2f(pA1[r]);
  WAIT_BAR(0);
  DMA_K(3,0);DMA_V(1,SLOTB);
  ROT();
  kload8(kf,kp0+sl_cur);
  WAIT_BAR(2);
  s16x4 vlo[8],vhi[8]; u32x4 pw0,pw1,pw2,pw3;
  #define PKW(P,B) cvtpk_s(P[B],P[B+1])
  #define PAF(k) __builtin_bit_cast(bf16x8,pw##k)
  #define VFR(i) (bf16x8){vlo[i][0],vlo[i][1],vlo[i][2],vlo[i][3],vhi[i][0],vhi[i][1],vhi[i][2],vhi[i][3]}
  #define PIN(x) asm volatile("":"+v"(x))
  #define MX3(a,b,c) __builtin_fmaxf(__builtin_fmaxf((a),(b)),(c))
  #define GAPA(MF,A0,A1,A2,A3,W0,W1,PW) do{ MF; sacc+=A0; sacc+=A1; sacc+=A2; sacc+=A3; PIN(sacc); W0; W1; PIN(PW); SBAR(); }while(0)
  #define EX(v) __builtin_amdgcn_exp2f(v)
  #define GAPB(MF,X,B) do{ MF; X[B]=EX(X[B]); X[B+1]=EX(X[B+1]); X[B+2]=EX(X[B+2]); X[B+3]=EX(X[B+3]); PIN(X); SBAR(); }while(0)
  #define VRD(i) do{ vlo[i]=vtr(vp_+(((i)>>2)*4096+((i)&3)*1024)); vhi[i]=vtr(vp_+(((i)>>2)*4096+((i)&3)*1024+512)); }while(0)
  #define KRD(G,j) do{ if(G){ kload2(kf,kp0+sl_next,j); SBAR(); } }while(0)
  #define STEP(C0,C1,P0,P1,t,GK,GV,GL) do{ SBAR(); \
    const lds_cptr vp_=vp0+sl_prev; \
    VRD(0); SBAR(); float sacc=(P0[0]+P0[1]); \
    GAPA(C0=__builtin_amdgcn_mfma_f32_32x32x16_bf16(kf[0],qr[0],negm,0,0,0), P0[2],P0[3],P0[4],P0[5],     pw0[0]=PKW(P0,0), pw0[1]=PKW(P0,2), pw0); \
    VRD(4); SBAR(); GAPA(C1=__builtin_amdgcn_mfma_f32_32x32x16_bf16(kf[1],qr[0],negm,0,0,0), P0[6],P0[7],P0[8],P0[9],     pw0[2]=PKW(P0,4), pw0[3]=PKW(P0,6), pw0); \
    VRD(1); SBAR(); GAPA(C0=__builtin_amdgcn_mfma_f32_32x32x16_bf16(kf[2],qr[1],C0,0,0,0),   P0[10],P0[11],P0[12],P0[13], pw1[0]=PKW(P0,8), pw1[1]=PKW(P0,10), pw1); \
    VRD(5); SBAR(); GAPA(C1=__builtin_amdgcn_mfma_f32_32x32x16_bf16(kf[3],qr[1],C1,0,0,0),   P0[14],P0[15],P1[0],P1[1],   pw1[2]=PKW(P0,12),pw1[3]=PKW(P0,14), pw1); \
    VRD(2); SBAR(); GAPA(C0=__builtin_amdgcn_mfma_f32_32x32x16_bf16(kf[4],qr[2],C0,0,0,0),   P1[2],P1[3],P1[4],P1[5],     pw2[0]=PKW(P1,0), pw2[1]=PKW(P1,2), pw2); \
    VRD(6); SBAR(); GAPA(C1=__builtin_amdgcn_mfma_f32_32x32x16_bf16(kf[5],qr[2],C1,0,0,0),   P1[6],P1[7],P1[8],P1[9],     pw2[2]=PKW(P1,4), pw2[3]=PKW(P1,6), pw2); \
    VRD(3); SBAR(); GAPA(C0=__builtin_amdgcn_mfma_f32_32x32x16_bf16(kf[6],qr[3],C0,0,0,0),   P1[10],P1[11],P1[12],P1[13], pw3[0]=PKW(P1,8), pw3[1]=PKW(P1,10), pw3); \
    VRD(7); SBAR(); GAPA(C1=__builtin_amdgcn_mfma_f32_32x32x16_bf16(kf[7],qr[3],C1,0,0,0),   P1[14],P1[15],0.f,0.f,       pw3[2]=PKW(P1,12),pw3[3]=PKW(P1,14), pw3); \
    l_reg+=sacc; \
    if(GK){DMA_K((t)+3,sl_cur);} if(GV){DMA_V((t)+1,sl_next);} \
    CMASK(C0,C1,t); \
    { float a=MX3(C0[0],C0[1],C1[0]),b=MX3(C0[2],C0[3],C1[1]); a=MX3(a,C1[2],C1[3]); \
      _Pragma("unroll") for(int r=4;r<16;r+=4){a=MX3(a,C0[r],C0[r+1]);b=MX3(b,C0[r+2],C0[r+3]);a=MX3(a,C1[r],C1[r+1]);b=MX3(b,C1[r+2],C1[r+3]);} \
      float rm=__builtin_fmaxf(a,b); { auto rr=__builtin_amdgcn_permlane32_swap(__float_as_uint(rm),__float_as_uint(rm),false,false); rm=__builtin_fmaxf(__uint_as_float(rr[0]),__uint_as_float(rr[1])); } \
      resc=false; \
      if(__builtin_expect(__any(rm>(float)THRL),0)){ const float dl=__builtin_fmaxf(rm,0.f); mhat+=dl; \
        _Pragma("unroll") for(int r=0;r<16;++r){C0[r]-=dl;C1[r]-=dl;} \
        _Pragma("unroll") for(int r=0;r<16;++r)negm[r]=-mhat; asm volatile("":"+v"(negm)); \
        const float f=__builtin_amdgcn_exp2f(-dl); l_reg*=f; if(hi==0)wsf[r32]=f; resc=true; } } \
    SBAR(); \
    GAPB(o[0]=__builtin_amdgcn_mfma_f32_32x32x16_bf16(PAF(0),VFR(0),o[0],0,0,0), C0,0); \
    GAPB(o[1]=__builtin_amdgcn_mfma_f32_32x32x16_bf16(PAF(0),VFR(4),o[1],0,0,0), C0,4); \
    KRD(GL,0); GAPB(o[0]=__builtin_amdgcn_mfma_f32_32x32x16_bf16(PAF(1),VFR(1),o[0],0,0,0), C0,8); \
    KRD(GL,1); GAPB(o[1]=__builtin_amdgcn_mfma_f32_32x32x16_bf16(PAF(1),VFR(5),o[1],0,0,0), C0,12); \
    KRD(GL,2); GAPB(o[0]=__builtin_amdgcn_mfma_f32_32x32x16_bf16(PAF(2),VFR(2),o[0],0,0,0), C1,0); \
    KRD(GL,3); GAPB(o[1]=__builtin_amdgcn_mfma_f32_32x32x16_bf16(PAF(2),VFR(6),o[1],0,0,0), C1,4); \
    GAPB(o[0]=__builtin_amdgcn_mfma_f32_32x32x16_bf16(PAF(3),VFR(3),o[0],0,0,0), C1,8); \
    GAPB(o[1]=__builtin_amdgcn_mfma_f32_32x32x16_bf16(PAF(3),VFR(7),o[1],0,0,0), C1,12); \
    }while(0)
  int t=1;
  for(;t+5<NT;t+=2){
    STEP(pB0,pB1,pA0,pA1,t,true,true,true);     WAIT_BAR(2); RESC(); ROT();
    STEP(pA0,pA1,pB0,pB1,t+1,true,true,true);   WAIT_BAR(2); RESC(); ROT();
  }
  #define ENDW(tt) do{ if((tt)+3<NT){WAIT_BAR(2);} else if((tt)+2<NT){WAIT_BAR(1);} else {WAIT_BAR(0);} }while(0)
  for(;t+1<NT;t+=2){
    STEP(pB0,pB1,pA0,pA1,t,(t+3<NT),(t+1<NT),(t+1<NT));       ENDW(t);   RESC(); ROT();
    STEP(pA0,pA1,pB0,pB1,t+1,(t+4<NT),(t+2<NT),(t+2<NT));     ENDW(t+1); RESC(); ROT();
  }
  STEP(pB0,pB1,pA0,pA1,NT-1,false,false,false); RESC();
  { float sacc=pB0[0]+pB0[1]; _Pragma("unroll") for(int r=2;r<16;++r)sacc+=pB0[r]; _Pragma("unroll") for(int r=0;r<16;++r)sacc+=pB1[r]; l_reg+=sacc;
    pw0=(u32x4){PKW(pB0,0),PKW(pB0,2),PKW(pB0,4),PKW(pB0,6)};pw1=(u32x4){PKW(pB0,8),PKW(pB0,10),PKW(pB0,12),PKW(pB0,14)};pw2=(u32x4){PKW(pB1,0),PKW(pB1,2),PKW(pB1,4),PKW(pB1,6)};pw3=(u32x4){PKW(pB1,8),PKW(pB1,10),PKW(pB1,12),PKW(pB1,14)};
    SBAR(); pv(o,vb0+sl_cur,PAF(0),PAF(1),PAF(2),PAF(3)); }
  #undef PKW
  #undef PAF
  #undef VFR
  #undef PIN
  #undef MX3
  #undef GAPA
  #undef GAPB
  #undef EX
  #undef VRD
  #undef KRD
  #undef STEP
  #undef ENDW
  {auto rr=__builtin_amdgcn_permlane32_swap(__float_as_uint(l_reg),__float_as_uint(l_reg),false,false);l_reg=__uint_as_float(rr[0])+__uint_as_float(rr[1]);}
  if(hi==0)wsf[32+r32]=l_reg;asm volatile("s_waitcnt lgkmcnt(0)":::"memory");
  float rli[16];
  #pragma unroll
  for(int r=0;r<16;++r)rli[r]=__builtin_amdgcn_rcpf(wsf[32+crow(r,hi)]);
  bf16*Ow=O+(rowbase+q0)*OP+512+wid*D;
  { bf16*stg=(bf16*)(shm+LDS_OST)+wid*2048;
    #pragma unroll
    for(int r=0;r<16;++r){const int orow=crow(r,hi);
      #pragma unroll
      for(int d0=0;d0<2;++d0)stg[orow*64+d0*32+r32]=(bf16)(cvtpk_s(o[d0][r]*rli[r],0.f)&0xffffu);}
    asm volatile("s_waitcnt lgkmcnt(0)":::"memory");
    #pragma unroll
    for(int i=0;i<4;++i){const int row=i*8+(lane>>3),ch=lane&7; const u32x4 v=*(const u32x4*)(stg+row*64+ch*8); ATTN_STORE16(Ow+(long)row*OP+ch*8,v);} }
  asm volatile("s_waitcnt lgkmcnt(0)\n\ts_barrier":::"memory");
  #undef DMA_K
  #undef DMA_V
  #undef CMASK
  #undef START
  #undef RESC
  #undef ROT
}
constexpr int ATTN_LDS_BYTES=LDS_BYTES;
#undef SBAR
#undef WAIT_BAR
}

constexpr int DSA_MASK_OFF = 131072, DSA_MASK_STRIDE = 66;
typedef short bf16x8_t __attribute__((ext_vector_type(8)));
__device__ __forceinline__ int wave_sum_dpp_i(int x) {
    x += __builtin_amdgcn_update_dpp(0, x, 0xB1, 0xf, 0xf, true);
    x += __builtin_amdgcn_update_dpp(0, x, 0x4E, 0xf, 0xf, true);
    x += __builtin_amdgcn_update_dpp(0, x, 0x114, 0xf, 0xf, true);
    x += __builtin_amdgcn_update_dpp(0, x, 0x118, 0xf, 0xf, true);
    x += __builtin_amdgcn_update_dpp(0, x, 0x142, 0xa, 0xf, false);
    x += __builtin_amdgcn_update_dpp(0, x, 0x143, 0xc, 0xf, false);
    return __builtin_amdgcn_readlane(x, 63);
}
__device__ __forceinline__ int wave_incl_scan_dpp_i(int x) {
    int v = x;
    v += __builtin_amdgcn_update_dpp(0, x, 0x111, 0xf, 0xf, true);
    v += __builtin_amdgcn_update_dpp(0, x, 0x112, 0xf, 0xf, true);
    v += __builtin_amdgcn_update_dpp(0, x, 0x113, 0xf, 0xf, true);
    v += __builtin_amdgcn_update_dpp(0, v, 0x114, 0xf, 0xe, true);
    v += __builtin_amdgcn_update_dpp(0, v, 0x118, 0xf, 0xc, true);
    v += __builtin_amdgcn_update_dpp(0, v, 0x142, 0xa, 0xf, false);
    v += __builtin_amdgcn_update_dpp(0, v, 0x143, 0xc, 0xf, false);
    return v;
}
__device__ __forceinline__ int count_ge(const unsigned (&k)[32], unsigned cand, int nreg) {
    int cl = 0;
#pragma unroll
    for (int g4 = 0; g4 < 8; ++g4) if (4 * g4 < nreg) {
#pragma unroll
        for (int j = 0; j < 4; ++j) cl += (k[4 * g4 + j] >= cand) ? 1 : 0; }
    return wave_sum_dpp_i(cl);
}
template <int OPK> __device__ __forceinline__ float dpp_opf(float a, float b) { return OPK == 0 ? fmaxf(a, b) : fminf(a, b); }
template <int OPK> __device__ __forceinline__ float wave_reduce_f(float x) {
    const int id = OPK == 0 ? (int)0xff800000 : (int)0x7f800000;
    x = dpp_opf<OPK>(x, __int_as_float(__builtin_amdgcn_update_dpp(id, __float_as_int(x), 0xB1, 0xf, 0xf, false)));
    x = dpp_opf<OPK>(x, __int_as_float(__builtin_amdgcn_update_dpp(id, __float_as_int(x), 0x4E, 0xf, 0xf, false)));
    x = dpp_opf<OPK>(x, __int_as_float(__builtin_amdgcn_update_dpp(id, __float_as_int(x), 0x114, 0xf, 0xf, false)));
    x = dpp_opf<OPK>(x, __int_as_float(__builtin_amdgcn_update_dpp(id, __float_as_int(x), 0x118, 0xf, 0xf, false)));
    x = dpp_opf<OPK>(x, __int_as_float(__builtin_amdgcn_update_dpp(id, __float_as_int(x), 0x142, 0xa, 0xf, false)));
    x = dpp_opf<OPK>(x, __int_as_float(__builtin_amdgcn_update_dpp(id, __float_as_int(x), 0x143, 0xc, 0xf, false)));
    return __int_as_float(__builtin_amdgcn_readlane(__float_as_int(x), 63));
}
__device__ __forceinline__ unsigned binof(float v, float vmin, float scale) { const unsigned b = (unsigned)(int)__fmul_rn(__fsub_rn(v, vmin), scale); return b > 2047u ? 2047u : b; }
__device__ __forceinline__ unsigned long long select_topk(const float (&k)[32], int kk, int nvalid, int nreg, int lane, LAS unsigned* hist, unsigned* errw) {
    const float NINF = -INFINITY;
    int mlo = 0, mhi = 0;
#define SEL_PUT(i, m) do { if (lane == (i)) { mlo = (int)(unsigned)(m); mhi = (int)(unsigned)((m) >> 32); } } while (0)
#define SEL_MINE (((unsigned long long)(unsigned)mhi << 32) | (unsigned long long)(unsigned)mlo)
    if (nvalid <= kk) {
#pragma unroll
        for (int g4 = 0; g4 < 8; ++g4) if (4 * g4 < nreg) {
#pragma unroll
            for (int j = 0; j < 4; ++j) { const int i = 4 * g4 + j; const unsigned long long m = __ballot(k[i] > NINF); SEL_PUT(i, m); } }
        return SEL_MINE;
    }
    float T = 0.f; bool exact = false;
    float mx = NINF, mn = INFINITY;
#pragma unroll
    for (int g4 = 0; g4 < 8; ++g4) if (4 * g4 < nreg) {
#pragma unroll
        for (int j = 0; j < 4; ++j) { const float v = k[4 * g4 + j]; mx = fmaxf(mx, v); mn = fminf(mn, v > NINF ? v : INFINITY); } }
    const float vmax = wave_reduce_f<0>(mx), vmin = wave_reduce_f<1>(mn);
    if (vmax == vmin) { T = vmax; }
    else {
        const float scale = 2046.5f / (vmax - vmin);
        LAS u32x4* h4 = (LAS u32x4*)hist;
#pragma unroll
        for (int j = 0; j < 8; ++j) h4[lane + 64 * j] = (u32x4){0u, 0u, 0u, 0u};
#pragma unroll
        for (int g4 = 0; g4 < 8; ++g4) if (4 * g4 < nreg) {
#pragma unroll
            for (int j = 0; j < 4; ++j) __hip_atomic_fetch_add(hist + binof(k[4 * g4 + j], vmin, scale), 1u, __ATOMIC_RELAXED, __HIP_MEMORY_SCOPE_WORKGROUP); }
        u32x4 w[8];
#pragma unroll
        for (int j = 0; j < 8; ++j) w[j] = ((LAS u32x4*)(hist + 2016 - 32 * lane))[j];
        if (lane == 0) w[7][3] = 0u;
        int s = 0;
#pragma unroll
        for (int j = 0; j < 8; ++j) s += (int)((w[j][0] + w[j][1]) + (w[j][2] + w[j][3]));
        const int Pinc = wave_incl_scan_dpp_i(s);
        const unsigned long long geb = __ballot(Pinc >= kk);
        const int Lstar = __builtin_ctzll(geb);
        const int above_l = __builtin_amdgcn_readlane(Pinc - s, Lstar);
        const int binj = 2047 - 32 * Lstar - (lane & 31);
        const int cntj = (binj == 2047) ? 0 : (int)hist[binj];
        int P2 = wave_incl_scan_dpp_i(lane < 32 ? cntj : 0) + above_l;
        const int jst = __builtin_ctzll(__ballot(P2 >= kk));
        const int Bstar = 2047 - 32 * Lstar - jst, cnt_above = __builtin_amdgcn_readlane(P2 - cntj, jst), cB = __builtin_amdgcn_readlane(cntj, jst);
        const int r = kk - cnt_above;
        if (cB <= 64) {
            LAS unsigned* cand = hist; int base = 0;
#pragma unroll
            for (int g4 = 0; g4 < 8; ++g4) if (4 * g4 < nreg) {
#pragma unroll
                for (int j = 0; j < 4; ++j) { const float v = k[4 * g4 + j]; const bool c = binof(v, vmin, scale) == (unsigned)Bstar; const unsigned long long bal = __ballot(c);
                    if (bal) { if (c) cand[base + __builtin_amdgcn_mbcnt_hi((unsigned)(bal >> 32), __builtin_amdgcn_mbcnt_lo((unsigned)bal, 0u))] = __float_as_uint(v); base += __popcll(bal); } } }
            const float myc = (lane < cB) ? __uint_as_float(cand[lane]) : NINF;
            float prev = INFINITY; int cum = 0;
            for (int it = 0; it < 64; ++it) {
                const float m = wave_reduce_f<0>(myc < prev ? myc : NINF);
                cum += __popcll(__ballot(myc == m));
                if (cum >= r) { T = m; exact = (cum == r); break; }
                prev = m;
            }
        } else {
            float prev = INFINITY; int cum = 0;
            for (int it = 0; it < 2048; ++it) {
                float lm = NINF;
#pragma unroll
                for (int i = 0; i < 32; ++i) { const float v = k[i]; if (v < prev && binof(v, vmin, scale) == (unsigned)Bstar) lm = fmaxf(lm, v); }
                const float m = wave_reduce_f<0>(lm);
                int mult = 0;
#pragma unroll
                for (int i = 0; i < 32; ++i) mult += __popcll(__ballot(k[i] == m));
                cum += mult;
                if (cum >= r) { T = m; exact = (cum == r); break; }
                prev = m;
            }
        }
    }
    if (exact) {
#pragma unroll
        for (int g4 = 0; g4 < 8; ++g4) if (4 * g4 < nreg) {
#pragma unroll
            for (int j = 0; j < 4; ++j) { const int i = 4 * g4 + j; const unsigned long long m = __ballot(k[i] >= T); SEL_PUT(i, m); } }
    } else {
        int ngt = 0;
#pragma unroll
        for (int i = 0; i < 32; ++i) ngt += __popcll(__ballot(k[i] > T));
        int need = kk - ngt;
#pragma unroll
        for (int i = 0; i < 32; ++i) {
            const unsigned long long eqb = __ballot(k[i] == T);
            const int rank = __builtin_amdgcn_mbcnt_hi((unsigned)(eqb >> 32), __builtin_amdgcn_mbcnt_lo((unsigned)eqb, 0u));
            const bool sel = (k[i] > T) || ((k[i] == T) && (rank < need));
            const unsigned long long m = __ballot(sel);
            need -= __popcll(eqb); if (need < 0) need = 0;
            SEL_PUT(i, m);
        }
    }
    const unsigned long long mine = SEL_MINE;
    if (wave_sum_dpp_i(lane < 32 ? __popcll(mine) : 0) != kk && lane == 0) atomicOr(errw, 1u);
    return mine;
#undef SEL_PUT
#undef SEL_MINE
}
__device__ __forceinline__ void dsa_select(int b, int qb, const bf16* IQb, const bf16* IKb, const float* IW, unsigned char* lds, int lane, int wave, unsigned* errw) {
    lane = launder_i(lane_id());
    unsigned* keys = (unsigned*)lds; unsigned* maskw = (unsigned*)(lds + DSA_MASK_OFF);
    if (qb < TOPK / 32) {
#pragma unroll 1
        for (int j = 0; j < 4; ++j) { const int q = 4 * wave + j, t = qb * 32 + q;
            if (lane < 32) { const int lo = 64 * lane; unsigned long long m = 0ull; if (t >= lo + 63) m = ~0ull; else if (t >= lo) m = (2ull << (t - lo)) - 1ull;
                *(unsigned long long*)(maskw + q * DSA_MASK_STRIDE + 2 * lane) = m; } }
        __syncthreads();
        return;
    }
    const size_t rb = (size_t)b * SEQ; const int q0 = qb * 32; const int ntk16 = 4 * ((qb >> 1) + 1);
    const int l15 = lane & 15, l4 = lane >> 4;
    bf16x8_t a2[2][4][2]; f32x4 wq2[2][4];
#pragma unroll
    for (int rr = 0; rr < 2; ++rr)
#pragma unroll
        for (int mt = 0; mt < 4; ++mt) {
            const bf16* ar = IQb + (rb + q0 + 16 * rr + 4 * mt + (l15 >> 2)) * 256 + (l15 & 3) * 64 + 8 * l4;
            a2[rr][mt][0] = *(const bf16x8_t*)ar; a2[rr][mt][1] = *(const bf16x8_t*)(ar + 32);
            wq2[rr][mt] = *(const f32x4*)(IW + (rb + q0 + 16 * rr + 4 * mt + l4) * 4);
        }
    bf16x8_t bn[4][2];
#pragma unroll
    for (int rnd = 0; rnd < 2; ++rnd) {
        const int qb0 = q0 + 16 * rnd;
        bf16x8_t a[4][2]; f32x4 wq[4];
#pragma unroll
        for (int mt = 0; mt < 4; ++mt) { a[mt][0] = a2[rnd][mt][0]; a[mt][1] = a2[rnd][mt][1]; wq[mt] = wq2[rnd][mt]; }
        bf16x8_t bc[4][2];
#define DSA_LOADG(dst, ntb) do { _Pragma("unroll") for (int u = 0; u < 4; ++u) { const int nt_ = (ntb) + 8 * u; \
            if (nt_ < ntk16) { const bf16* br = IKb + (rb + 16 * nt_ + l15) * 64 + 8 * l4; dst[u][0] = *(const bf16x8_t*)br; dst[u][1] = *(const bf16x8_t*)(br + 32); } \
            else { dst[u][0] = (bf16x8_t){0, 0, 0, 0, 0, 0, 0, 0}; dst[u][1] = dst[u][0]; } } } while (0)
        if (rnd == 0) DSA_LOADG(bn, wave);
        for (int ntb = wave; ntb < ntk16; ntb += 32) {
#pragma unroll
            for (int u = 0; u < 4; ++u) { bc[u][0] = bn[u][0]; bc[u][1] = bn[u][1]; }
            if (ntb + 32 < ntk16) DSA_LOADG(bn, ntb + 32);
#pragma unroll
            for (int u = 0; u < 4; ++u) {
                const int nt = ntb + 8 * u;
                if (nt < ntk16) {
                    const int s = 16 * nt + l15;
                    f32x4 cc[4];
#pragma unroll
                    for (int mt = 0; mt < 4; ++mt) cc[mt] = __builtin_amdgcn_mfma_f32_16x16x32_bf16(a[mt][0], bc[u][0], (f32x4){0.f, 0.f, 0.f, 0.f}, 0, 0, 0);
#pragma unroll
                    for (int mt = 0; mt < 4; ++mt) cc[mt] = __builtin_amdgcn_mfma_f32_16x16x32_bf16(a[mt][1], bc[u][1], cc[mt], 0, 0, 0);
                    __builtin_amdgcn_sched_barrier(0);
#pragma unroll
                    for (int mt = 0; mt < 4; ++mt) {
                        const f32x4 c = cc[mt];
                        const float r0 = __int_as_float(max(__float_as_int(c[0]), 0)), r1 = __int_as_float(max(__float_as_int(c[1]), 0)), r2 = __int_as_float(max(__float_as_int(c[2]), 0)), r3 = __int_as_float(max(__float_as_int(c[3]), 0));
                        float sc = wq[mt][0] * r0; sc = fmaf(wq[mt][1], r1, sc); sc = fmaf(wq[mt][2], r2, sc); sc = fmaf(wq[mt][3], r3, sc);
                        const int ql = 4 * mt + l4, t = qb0 + ql;
                        keys[ql * 2048 + s] = (s <= t) ? __float_as_uint(sc) : 0xff800000u;
                    }
                }
            }
        }
        if (rnd == 0) DSA_LOADG(bn, wave);
#undef DSA_LOADG
        __syncthreads();
#pragma unroll 1
        for (int j = 0; j < 2; ++j) {
            const int ql = 2 * wave + j, t = qb0 + ql, kk = (t + 1 < TOPK) ? (t + 1) : TOPK, nreg = (t >> 6) + 1;
            float k[32];
#pragma unroll
            for (int i = 0; i < 32; ++i) k[i] = (i < nreg) ? __uint_as_float(keys[ql * 2048 + 64 * i + lane]) : -INFINITY;
            const unsigned long long mine = select_topk(k, kk, t + 1, nreg, lane, (LAS unsigned*)((LAS unsigned char*)lds) + ql * 2048, errw);
            if (lane < 32) *(unsigned long long*)(maskw + (16 * rnd + ql) * DSA_MASK_STRIDE + 2 * lane) = mine;
        }
        __syncthreads();
    }
}

constexpr int LD64 = 72, LD128 = 136;
constexpr int SSD_CM = 0, SSD_BM = 18432, SSD_XS = 36864, SSD_XDT = 55296, SSD_BDT = 72704, SSD_MT = 90112, SSD_HB = 124928, SSD_DTS = 134144, SSD_ACUM = 134656, SSD_CW = 135168;
__device__ __forceinline__ bf16x8_t ldfrag(const bf16* base, int row, int ld, int k0) { return *(const bf16x8_t*)(base + row * ld + k0); }
__device__ __forceinline__ void ssd_item(int b, int h, KPtr P, const bf16* XBC, const bf16* BCc, const float* DT, const bf16* Zb, bf16* ASb, float* SSQP, unsigned char* lds, int tid) {
    tid = launder_i(tid);
    const int lane = tid & 63, w = __builtin_amdgcn_readfirstlane(tid >> 6), l15 = lane & 15, l4 = lane >> 4, g = h >> 2;
    bf16* Cm = (bf16*)(lds + SSD_CM); bf16* Bm = (bf16*)(lds + SSD_BM); bf16* xs = (bf16*)(lds + SSD_XS); bf16* XdtT = (bf16*)(lds + SSD_XDT);
    bf16* BdT = (bf16*)(lds + SSD_BDT); bf16* Mt = (bf16*)(lds + SSD_MT); bf16* Hb = (bf16*)(lds + SSD_HB);
    float* dts = (float*)(lds + SSD_DTS); float* acum = (float*)(lds + SSD_ACUM);
    const float A = -__expf(P->a_log[h]), dtb = P->dt_bias[h], Dh = P->d_skip[h];
    f32x4 Hacc[2]; Hacc[0] = (f32x4){0.f, 0.f, 0.f, 0.f}; Hacc[1] = Hacc[0];
    for (int e = tid; e < 64 * LD64 / 2; e += NT) ((unsigned*)Hb)[e] = 0u;
    float* cwl = (float*)(lds + SSD_CW);
    for (int e = tid; e < 960; e += NT) { const int T = (e < 768) ? (e >> 8) : ((e - 768) >> 6), ch = e & 63, cb = (T == 0) ? h * 64 : (T == 1 ? 512 + g * 64 : 640 + g * 64);
        cwl[e] = (e < 768) ? P->conv_w[((e >> 6) & 3) * 768 + cb + ch] : P->conv_b[cb + ch]; }
    const int pt = w >> 1, ntb = 2 * (w & 1);
    const int sl = tid >> 2, sc0 = (tid & 3) * 16;
    u32x4 raw[4][2], bcv[2][2]; float dtraw = 0.f; u32x2 zc[4], zn[4];
#define SSD_LOADRAW(cc) do { const size_t rb_ = (size_t)b * SEQ + (cc) * 128; const bf16* xr_ = XBC + (rb_ + sl) * 768 + h * 64 + sc0; \
        _Pragma("unroll") for (int j_ = 0; j_ < 4; ++j_) { raw[j_][0] = *(const u32x4*)(xr_ + (j_ - 3) * 768); raw[j_][1] = *(const u32x4*)(xr_ + (j_ - 3) * 768 + 8); } \
        const bf16* bc_ = BCc + (rb_ + sl) * 256 + g * 64 + sc0; \
        bcv[0][0] = *(const u32x4*)bc_; bcv[0][1] = *(const u32x4*)(bc_ + 8); bcv[1][0] = *(const u32x4*)(bc_ + 128); bcv[1][1] = *(const u32x4*)(bc_ + 136); } while (0)
#define SSD_PREFETCH(cc, ZD) do { const size_t rb_ = (size_t)b * SEQ + (cc) * 128; \
        if (tid < 128) dtraw = DT[(rb_ + tid) * 8 + h]; \
        _Pragma("unroll") for (int jt_ = 0; jt_ < 4; ++jt_) ZD[jt_] = *(const u32x2*)(Zb + (rb_ + 16 * w + l15) * 512 + h * 64 + 16 * jt_ + 4 * l4); } while (0)
    SSD_PREFETCH(0, zc);
    for (int c = 0; c < SEQ / 128; ++c) {
        const size_t rbase = (size_t)b * SEQ + c * 128;
        SSD_LOADRAW(c);
        if (tid < 128) { const float v = dtraw + dtb; dts[tid] = (v > 20.f) ? v : log1pf(__expf(v)); }
        __syncthreads();
        if (w == 0) {
            const float a0 = dts[2 * lane] * A, a1 = dts[2 * lane + 1] * A; const float s = a0 + a1; float inc = s;
#pragma unroll
            for (int o = 1; o < 64; o <<= 1) { const float v = __shfl_up(inc, o); if (lane >= o) inc += v; }
            const float ex = inc - s; acum[2 * lane] = ex + a0; acum[2 * lane + 1] = ex + s;
        }
        __syncthreads();
        const float alast = acum[127];
        {
            const int l = sl, c0 = sc0;
            const float dtl = dts[l], dec = __expf(alast - acum[l]);
            const int tmin = 3 - (c * 128 + l);
#pragma unroll
            for (int T = 0; T < 3; ++T) {
                float v[16];
                if (T == 0) {
                    u32x4 u[4][2];
#pragma unroll
                    for (int j = 0; j < 4; ++j) { u[j][0] = raw[j][0]; u[j][1] = raw[j][1]; }
                    if (c == 0) {
#pragma unroll
                        for (int j = 0; j < 3; ++j) if (j < tmin) { u[j][0] = (u32x4){0u, 0u, 0u, 0u}; u[j][1] = u[j][0]; } }
#pragma unroll
                    for (int i = 0; i < 16; ++i) v[i] = cwl[768 + c0 + i];
#pragma unroll
                    for (int j = 0; j < 4; ++j)
#pragma unroll
                        for (int i = 0; i < 16; ++i) { const unsigned wd = u[j][i >> 3][(i >> 1) & 3]; const float xv = (i & 1) ? __uint_as_float(wd & 0xffff0000u) : __uint_as_float(wd << 16);
                            v[i] = fmaf(cwl[j * 64 + c0 + i], xv, v[i]); }
#pragma unroll
                    for (int i = 0; i < 16; ++i) v[i] = silu(v[i]);
                } else {
#pragma unroll
                    for (int i = 0; i < 16; ++i) { const unsigned wd = bcv[T - 1][i >> 3][(i >> 1) & 3]; v[i] = (i & 1) ? __uint_as_float(wd & 0xffff0000u) : __uint_as_float(wd << 16); }
                }
                bf16* dstm = (T == 0) ? xs : (T == 1 ? Bm : Cm);
                if (T == 0) {
                    u32x4 o0, o1; o0.x = pg8::cvt_pk_bf16(v[0], v[1]); o0.y = pg8::cvt_pk_bf16(v[2], v[3]); o0.z = pg8::cvt_pk_bf16(v[4], v[5]); o0.w = pg8::cvt_pk_bf16(v[6], v[7]);
                    o1.x = pg8::cvt_pk_bf16(v[8], v[9]); o1.y = pg8::cvt_pk_bf16(v[10], v[11]); o1.z = pg8::cvt_pk_bf16(v[12], v[13]); o1.w = pg8::cvt_pk_bf16(v[14], v[15]);
                    *(u32x4*)(dstm + l * LD64 + c0) = o0; *(u32x4*)(dstm + l * LD64 + c0 + 8) = o1;
                } else { *(u32x4*)(dstm + l * LD64 + c0) = bcv[T - 1][0]; *(u32x4*)(dstm + l * LD64 + c0 + 8) = bcv[T - 1][1]; }
                if (T == 0) {
#pragma unroll
                    for (int i = 0; i < 16; ++i) XdtT[(c0 + i) * LD128 + l] = f2bf(v[i] * dtl); }
                if (T == 1) {
#pragma unroll
                    for (int i = 0; i < 16; ++i) BdT[(c0 + i) * LD128 + l] = f2bf(v[i] * dec); }
            }
        }
        if (c + 1 < SEQ / 128) SSD_PREFETCH(c + 1, zn);
        __syncthreads();
        const int lrow = 16 * w + l15; const float al = acum[lrow];
        {
            const bf16x8_t c0f = ldfrag(Cm, lrow, LD64, 8 * l4), c1f = ldfrag(Cm, lrow, LD64, 32 + 8 * l4);
            for (int j = 0; j <= w; ++j) {
                const bf16x8_t bf0 = ldfrag(Bm, 16 * j + l15, LD64, 8 * l4), bf1 = ldfrag(Bm, 16 * j + l15, LD64, 32 + 8 * l4);
                f32x4 acc = (f32x4){0.f, 0.f, 0.f, 0.f};
                acc = __builtin_amdgcn_mfma_f32_16x16x32_bf16(bf0, c0f, acc, 0, 0, 0);
                acc = __builtin_amdgcn_mfma_f32_16x16x32_bf16(bf1, c1f, acc, 0, 0, 0);
                const int s0 = 16 * j + 4 * l4; float m[4];
#pragma unroll
                for (int r = 0; r < 4; ++r) { const int s = s0 + r; m[r] = (s <= lrow) ? acc[r] * __expf(al - acum[s]) : 0.f; }
                u32x2 o; o.x = pg8::cvt_pk_bf16(m[0], m[1]); o.y = pg8::cvt_pk_bf16(m[2], m[3]);
                *(u32x2*)(Mt + lrow * LD128 + s0) = o;
            }
            if ((w & 1) == 0) *(u32x2*)(Mt + lrow * LD128 + 16 * (w + 1) + 4 * l4) = (u32x2){0u, 0u};
        }
        {
            const bf16x8_t c0f = ldfrag(Cm, lrow, LD64, 8 * l4), c1f = ldfrag(Cm, lrow, LD64, 32 + 8 * l4);
            const float ea = __expf(al); const int nks = (w >> 1) + 1;
            float ssq = 0.f;
            bf16x8_t mf[4];
#pragma unroll
            for (int ks = 0; ks < 4; ++ks) mf[ks] = (ks < nks) ? ldfrag(Mt, lrow, LD128, 32 * ks + 8 * l4) : (bf16x8_t){0, 0, 0, 0, 0, 0, 0, 0};
#pragma unroll
            for (int jt = 0; jt < 4; ++jt) {
                bf16x8_t hb0 = ldfrag(Hb, 16 * jt + l15, LD64, 8 * l4), hb1 = ldfrag(Hb, 16 * jt + l15, LD64, 32 + 8 * l4), xd[4];
#pragma unroll
                for (int ks = 0; ks < 4; ++ks) if (ks < nks) xd[ks] = ldfrag(XdtT, 16 * jt + l15, LD128, 32 * ks + 8 * l4);
                f32x4 acc = (f32x4){0.f, 0.f, 0.f, 0.f};
                acc = __builtin_amdgcn_mfma_f32_16x16x32_bf16(hb0, c0f, acc, 0, 0, 0);
                acc = __builtin_amdgcn_mfma_f32_16x16x32_bf16(hb1, c1f, acc, 0, 0, 0);
                acc = acc * ea;
#pragma unroll
                for (int ks = 0; ks < 4; ++ks) if (ks < nks) acc = __builtin_amdgcn_mfma_f32_16x16x32_bf16(xd[ks], mf[ks], acc, 0, 0, 0);
                const int p0 = 16 * jt + 4 * l4;
                const u32x2 xb = *(const u32x2*)(xs + lrow * LD64 + p0);
                const u32x2 zb = zc[jt];
                const float x0 = __uint_as_float(xb.x << 16), x1 = __uint_as_float(xb.x & 0xffff0000u), x2 = __uint_as_float(xb.y << 16), x3 = __uint_as_float(xb.y & 0xffff0000u);
                const float z0 = __uint_as_float(zb.x << 16), z1 = __uint_as_float(zb.x & 0xffff0000u), z2 = __uint_as_float(zb.y << 16), z3 = __uint_as_float(zb.y & 0xffff0000u);
                f32x4 y; y[0] = (acc[0] + Dh * x0) * silu(z0); y[1] = (acc[1] + Dh * x1) * silu(z1); y[2] = (acc[2] + Dh * x2) * silu(z2); y[3] = (acc[3] + Dh * x3) * silu(z3);
                u32x2 yo; yo.x = pg8::cvt_pk_bf16(y[0], y[1]); yo.y = pg8::cvt_pk_bf16(y[2], y[3]);
                *(u32x2*)(ASb + (rbase + lrow) * 1024 + h * 64 + p0) = yo;
                ssq += (y[0] * y[0] + y[1] * y[1]) + (y[2] * y[2] + y[3] * y[3]);
            }
            ssq += __shfl_xor(ssq, 16); ssq += __shfl_xor(ssq, 32);
            if (l4 == 0) SSQP[(rbase + lrow) * 8 + h] = ssq;
        }
        __syncthreads();
        {
            const float el = __expf(alast);
            bf16x8_t xf[4];
#pragma unroll
            for (int ks = 0; ks < 4; ++ks) xf[ks] = ldfrag(XdtT, 16 * pt + l15, LD128, 32 * ks + 8 * l4);
#pragma unroll
            for (int i = 0; i < 2; ++i) {
                bf16x8_t bd[4];
#pragma unroll
                for (int ks = 0; ks < 4; ++ks) bd[ks] = ldfrag(BdT, 16 * (ntb + i) + l15, LD128, 32 * ks + 8 * l4);
                f32x4 acc = Hacc[i] * el;
#pragma unroll
                for (int ks = 0; ks < 4; ++ks) acc = __builtin_amdgcn_mfma_f32_16x16x32_bf16(xf[ks], bd[ks], acc, 0, 0, 0);
                Hacc[i] = acc;
#pragma unroll
                for (int r = 0; r < 4; ++r) Hb[(16 * pt + 4 * l4 + r) * LD64 + 16 * (ntb + i) + l15] = f2bf(acc[r]);
            }
        }
#pragma unroll
        for (int jt = 0; jt < 4; ++jt) zc[jt] = zn[jt];
    }
    __syncthreads();
#undef SSD_PREFETCH
#undef SSD_LOADRAW
}

struct MoeOrder {
    int n; const LAS int* ul;
    __device__ __forceinline__ bool next(int i, pg8::Unit& u) const { if (i >= n) return false; u.pm = ul[2 * i]; u.pn = ul[2 * i + 1]; return true; }
    __device__ __forceinline__ void a_ready(const pg8::Unit&) const {}
    __device__ __forceinline__ void done(const pg8::Unit&) const {}
};
struct EpiSwiGLU {
    static constexpr bool PERM = true, AFTER_DRAIN = false; static constexpr int MID_T = 0;
    bf16* Hid;
    __device__ __forceinline__ void operator()(const pg8::f32x4 (&acc)[2][2][4][2], const pg8::Unit& u, int wr, int wc, int fr, int fq) const {
        const int row0 = u.pm * 256 + wr * 64 + fr, pl = u.pn & 1, hc = 128 * pl + 16 * wc + 4 * fq;
#pragma unroll
        for (int ai = 0; ai < 2; ++ai)
#pragma unroll
            for (int m = 0; m < 4; ++m) { const int row = row0 + ai * 128 + m * 16;
#pragma unroll
                for (int bj = 0; bj < 2; ++bj) { const f32x4 g = acc[ai][bj][m][0], uu = acc[ai][bj][m][1]; f32x4 h;
#pragma unroll
                    for (int e = 0; e < 4; ++e) h[e] = silu(g[e]) * uu[e];
                    u32x2 w; w.x = pg8::cvt_pk_bf16(h[0], h[1]); w.y = pg8::cvt_pk_bf16(h[2], h[3]);
                    *(u32x2*)(Hid + (size_t)row * EFF + hc + 64 * bj) = w; } }
    }
};
struct EpiDown {
    static constexpr bool PERM = true, AFTER_DRAIN = false; static constexpr int MID_T = 0;
    const int* DSTI; const float* WGT; bf16* Y;
    __device__ __forceinline__ void operator()(const pg8::f32x4 (&acc)[2][2][4][2], const pg8::Unit& u, int wr, int wc, int fr, int fq) const {
        const int row0 = u.pm * 256 + wr * 64 + fr, col0 = (u.pn & 3) * 256 + 32 * wc + 8 * fq;
#pragma unroll
        for (int ai = 0; ai < 2; ++ai)
#pragma unroll
            for (int m = 0; m < 4; ++m) { const int row = row0 + ai * 128 + m * 16; const unsigned di = (unsigned)DSTI[row]; const float w = WGT[row];
                bf16* Yr = Y + (size_t)di * DM + col0;
#pragma unroll
                for (int bj = 0; bj < 2; ++bj) { const f32x4 a = acc[ai][bj][m][0] * w, b = acc[ai][bj][m][1] * w;
                    u32x4 o; o.x = pg8::cvt_pk_bf16(a[0], a[1]); o.y = pg8::cvt_pk_bf16(a[2], a[3]); o.z = pg8::cvt_pk_bf16(b[0], b[1]); o.w = pg8::cvt_pk_bf16(b[2], b[3]);
                    *(u32x4*)(Yr + 128 * bj) = o; }
                asm volatile("" ::: "memory"); }
    }
};


__device__ __forceinline__ unsigned wave_select(const unsigned (&keys)[32], int kk, int lane) {
    unsigned T = 0u;
    for (int bit = 31; bit >= 0; --bit) {
        const unsigned cand = T | (1u << bit);
        int c = 0;
#pragma unroll
        for (int i = 0; i < 32; ++i) c += (keys[i] >= cand) ? 1 : 0;
#pragma unroll
        for (int o = 1; o < 64; o <<= 1) c += __shfl_xor(c, o);
        if (c >= kk) T = cand;
    }
    unsigned mgt = 0u, meq = 0u;
#pragma unroll
    for (int i = 0; i < 32; ++i) { mgt |= (keys[i] > T) ? (1u << i) : 0u; meq |= (keys[i] == T) ? (1u << i) : 0u; }
    int ngt = __popc(mgt), neq = __popc(meq);
    int tgt = ngt, teq = neq;
#pragma unroll
    for (int o = 1; o < 64; o <<= 1) { tgt += __shfl_xor(tgt, o); teq += __shfl_xor(teq, o); }
    const int need = kk - tgt;
    if (teq == need) return mgt | meq;
    int pre = neq;
#pragma unroll
    for (int o = 1; o < 64; o <<= 1) { const int v = __shfl_up(pre, o); if (lane >= o) pre += v; }
    pre -= neq;
    unsigned sel = mgt; int taken = pre;
#pragma unroll
    for (int i = 0; i < 32; ++i) { if ((meq >> i) & 1u) { if (taken < need) sel |= (1u << i); ++taken; } }
    return sel;
}

#define XB_TMO      128
#define XB_XCNT(j)  (256  + 64 * (j))
#define XB_XSUB(j)  (1280 + 64 * (j))
#define XB_XGEN(j)  (2304 + 64 * (j))
#define XB_TOP      3328
#define XB_TOPGEN   3392
#define XCD_BAR_WORDS 3456
#define XB_SPIN_CAP (1u << 18)

__device__ __forceinline__ unsigned xb_ld(unsigned* p)              { return __hip_atomic_load(p, __ATOMIC_RELAXED, __HIP_MEMORY_SCOPE_AGENT); }
__device__ __forceinline__ unsigned xb_add(unsigned* p, unsigned v) { return __hip_atomic_fetch_add(p, v, __ATOMIC_RELAXED, __HIP_MEMORY_SCOPE_AGENT); }
__device__ __forceinline__ unsigned xb_xcc_id() { return (unsigned)__builtin_amdgcn_s_getreg((3 << 11) | 20) & 0xFu; }
#define XB_SPIN(cond, bar) do { unsigned _sp = 0; while (cond) { __builtin_amdgcn_s_sleep(1); \
    if ((++_sp & 255u) == 0u) { if (xb_ld(&(bar)[XB_TMO])) break; if (_sp > XB_SPIN_CAP) { atomicAdd(&(bar)[XB_TMO], 1u); break; } } } } while (0)

struct XcdBarrier {
    unsigned* bar; unsigned x;
    volatile LAS unsigned* st;
};

__device__ __forceinline__ XcdBarrier xcd_barrier_post(unsigned* bar, volatile LAS unsigned* st, const int wave_s) {
    XcdBarrier b; b.bar = bar; b.x = xb_xcc_id(); b.st = st;
    if (wave_s == 0 && lane_id() == 0) (void)xb_add(&bar[XB_XCNT(b.x)], 1u);
    return b;
}
__device__ __forceinline__ void xcd_barrier_complete(unsigned* bar, unsigned x, unsigned& nloc, unsigned& nx) {
    const unsigned G = gridDim.x * gridDim.y * gridDim.z;
    unsigned sum, cnt, mine, sp = 0u;
    for (;;) {
        sum = 0u; cnt = 0u; mine = 0u;
#pragma unroll
        for (unsigned j = 0; j < 16; ++j) { const unsigned c = xb_ld(&bar[XB_XCNT(j)]); sum += c; cnt += (c > 0u) ? 1u : 0u; mine = (j == x) ? c : mine; }
        if (sum == G) break;
        __builtin_amdgcn_s_sleep(1);
        if ((++sp & 255u) == 0u) { if (xb_ld(&bar[XB_TMO])) break; if (sp > XB_SPIN_CAP) { atomicAdd(&bar[XB_TMO], 1u); break; } }
    }
    nloc = mine > 0u ? mine : 1u; nx = cnt > 0u ? cnt : 1u;
}

__device__ __forceinline__ void xcd_barrier(const XcdBarrier& b, const int wave_s) {
    asm volatile("s_waitcnt vmcnt(0)" ::: "memory");
    __syncthreads();
    if (wave_s == 0 && lane_id() == 0) {
        unsigned* bar = b.bar;
        __builtin_amdgcn_s_waitcnt(0);
        unsigned nloc = b.st[0], nx = b.st[1];
        if (nloc == 0u) { xcd_barrier_complete(bar, b.x, nloc, nx); b.st[0] = nloc; b.st[1] = nx; }
        const unsigned old = xb_add(&bar[XB_XSUB(b.x)], 1u);
        const unsigned gen = old / nloc;
        if (old + 1u == (gen + 1u) * nloc) {
            __builtin_amdgcn_fence(__ATOMIC_RELEASE, "agent");
            asm volatile("s_waitcnt vmcnt(0)" ::: "memory");
            const unsigned og = xb_add(&bar[XB_TOP], 1u);
            const unsigned tg = og / nx;
            if (og + 1u == (tg + 1u) * nx) xb_add(&bar[XB_TOPGEN], 1u);
            else XB_SPIN(xb_ld(&bar[XB_TOPGEN]) == tg, bar);
            __builtin_amdgcn_fence(__ATOMIC_ACQUIRE, "agent");
            xb_add(&bar[XB_XGEN(b.x)], 1u);
            asm volatile("s_waitcnt vmcnt(0)" ::: "memory");
        } else {
            XB_SPIN(xb_ld(&bar[XB_XGEN(b.x)]) == gen, bar);
            __builtin_amdgcn_fence(__ATOMIC_ACQUIRE, "agent");
            asm volatile("s_waitcnt vmcnt(0)" ::: "memory");
        }
    }
    __syncthreads();
}


#define PHASE_VARS const KPtr P = launder_k(KP0); const int wave = wave_s, lane = launder_i(lane_id()), tid = wave * 64 + lane, gw = bid * 8 + wave; unsigned char* ws = P->ws; unsigned* ctl = (unsigned*)(ws + WS_CTL); float2* rope = (float2*)(ws + WS_ROPE); float* tokw = (float*)(ws + WS_TOKW); int* lists = (int*)(ws + WS_LISTS); bf16* Qb = (bf16*)(ws + WS_Q); bf16* Kb = (bf16*)(ws + WS_K); bf16* Vb = (bf16*)(ws + WS_V); bf16* IKb = (bf16*)(ws + WS_IK); float* IW = (float*)(ws + WS_IW); float* DT = (float*)(ws + WS_DT); bf16* IQb = (bf16*)(ws + WS_IQ); bf16* Zb = (bf16*)(ws + WS_Z); bf16* XBC = (bf16*)(ws + WS_XBC); bf16* ASb = (bf16*)(ws + WS_AS); float* X1 = (float*)(ws + WS_X1); bf16* X1b = (bf16*)(ws + WS_X1B); bf16* Y0 = (bf16*)(ws + WS_Y0); bf16* Y1 = (bf16*)(ws + WS_Y1); float* SSQP = (float*)(ws + WS_SSQP); bf16* BCc = (bf16*)(ws + WS_BCC); bf16* H1b = (bf16*)(ws + WS_X1); float* WGG = (float*)(ws + WS_RCONST + 4096); bf16* WguT = (bf16*)(ws + WS_WGU_T); bf16* WdT = (bf16*)(ws + WS_WD_T); int* ENT = (int*)(ws + WS_ENT); float* WGT = (float*)(ws + WS_ENT + 512 * 1024); int* ROWT = (int*)(ws + WS_ENT + 1024 * 1024); bf16* Xs = (bf16*)(ws + WS_XS); bf16* Hid = (bf16*)(ws + WS_HID); bf16* XB = (bf16*)(ws + WS_XB); bf16* WinT = (bf16*)(ws + WS_WIN_T); bf16* WoutT = (bf16*)(ws + WS_WOUT_T);
#ifndef PROBE_MASK
#define PROBE_MASK 0
#endif
#define STAMP(k) do { if (PROBE_MASK && bid == 0 && wave_s == 0 && lane_id() == 0) { const unsigned long long now_ = __builtin_amdgcn_s_memrealtime(); if ((PROBE_MASK >> (k)) & 1) pst[1] += now_ - pst[0]; pst[0] = now_; } } while (0)
__global__ void __launch_bounds__(NT, 2) hybrid_fwd(Params p) {
    extern __shared__ __attribute__((aligned(16))) unsigned char lds[];
    cg::grid_group grid = cg::this_grid();
    const int wave_s = __builtin_amdgcn_readfirstlane((int)threadIdx.x >> 6);
    const int G = gridDim.x, bid = blockIdx.x, NGW = G * 8;
    const KPtr KP0 = (KPtr)__builtin_amdgcn_kernarg_segment_ptr();
    volatile LAS unsigned* xst = (volatile LAS unsigned*)((LAS unsigned char*)lds + LDS_BYTES - 32);
    if (wave_s == 0 && lane_id() < 4) xst[lane_id()] = 0u;
    __syncthreads();
    const XcdBarrier xbar = xcd_barrier_post((unsigned*)(KP0->ws + WS_CTL) + CW_BAR, xst, wave_s);
    if (KP0->ws == nullptr) grid.sync();
#define GRID_SYNC() xcd_barrier(xbar, wave_s)
    volatile LAS unsigned long long* pst = (volatile LAS unsigned long long*)((LAS unsigned char*)lds + LDS_BYTES - 96);
    if (PROBE_MASK && bid == 0 && wave_s == 0 && lane_id() == 0) { pst[0] = __builtin_amdgcn_s_memrealtime(); pst[1] = 0ull; }
    {   PHASE_VARS
    for (int e = bid * NT + tid; e < SEQ * 32; e += G * NT) {
        const int t = e >> 5, i = e & 31;
        const float inv = powf(10000.0f, -(float)(2 * i) / 64.0f);
        const float ang = (float)t * inv;
        float s, c; sincosf(ang, &s, &c);
        rope[e] = make_float2(c, s);
    }
    for (int e = bid * NT + tid; e < 52 * 128; e += G * NT) {
        const int r = e >> 7, c = e & 127; const int row = (r < 4) ? (512 + 196 + r) : (512 + 208 + (r - 4));
        *(u32x4*)(WinT + (size_t)row * DM + c * 8) = (u32x4){0u, 0u, 0u, 0u};
    }
    {
        LAS float* scr = (LAS float*)((LAS unsigned char*)lds + wave * 16384);
        constexpr int I_IN = (DM / 64) * ((INW + 31) / 32), I_OUT = (DM / 64) * (DM / 32), I_GU = NEXP * 2 * 128, I_D = NEXP * 128;
        for (int it = launder_i(gw); it < I_IN; it += NGW) {
            int r = it;
            if (r < I_IN) { transpose_item(P->w_in, DM, INW, WinT, scr, r, lane, [](int c) { return win_dest_row(c); }, [](int k, float&) { return k; }); continue; } r -= I_IN;
        }
    }
    for (int e = bid * NT + tid; e < DM * 20; e += G * NT) { const int k = e / 20, j = e - k * 20; WGG[e] = P->ln1_g[k] * ((j < 4) ? P->w_rg[k * 4 + j] : P->w_re[k * 16 + (j - 4)]); }
    if (wave == 0 && bid >= G - 20) {
        float* rc = (float*)(ws + WS_RCONST); const int j = G - 1 - bid;
        float wv[16], gv[16], bv[16];
#pragma unroll
        for (int i = 0; i < 16; ++i) { const int k = lane + 64 * i; wv[i] = (j < 4) ? P->w_rg[k * 4 + j] : P->w_re[k * 16 + (j - 4)]; gv[i] = P->ln1_g[k]; bv[i] = P->ln1_b[k]; }
        float gs = 0.f, bs = 0.f;
#pragma unroll
        for (int i = 0; i < 16; ++i) { gs = fmaf(gv[i], wv[i], gs); bs = fmaf(bv[i], wv[i], bs); }
        gs = wave_sum(gs); bs = wave_sum(bs);
        if (lane == 0) { rc[j] = gs; rc[20 + j] = bs + ((j < 4) ? P->b_rg[j] : P->b_re[j - 4]); }
    }
    {
        const size_t NP = (size_t)M * DM / 8, stride = (size_t)G * NT;
        for (size_t e0 = (size_t)bid * NT + tid; e0 < NP; e0 += 8 * stride) {
            f32x4 a[8], b[8];
#pragma unroll
            for (int u = 0; u < 8; ++u) { const size_t e = e0 + u * stride; if (e < NP) { a[u] = __builtin_nontemporal_load((const f32x4*)(P->x + e * 8)); b[u] = __builtin_nontemporal_load((const f32x4*)(P->x + e * 8 + 4)); } }
#pragma unroll
            for (int u = 0; u < 8; ++u) { const size_t e = e0 + u * stride; if (e < NP) {
                u32x4 w; w.x = pg8::cvt_pk_bf16(a[u][0], a[u][1]); w.y = pg8::cvt_pk_bf16(a[u][2], a[u][3]); w.z = pg8::cvt_pk_bf16(b[u][0], b[u][1]); w.w = pg8::cvt_pk_bf16(b[u][2], b[u][3]);
                *(u32x4*)(XB + e * 8) = w; } }
        }
    }
    }
    GRID_SYNC(); STAMP(0);
    {   PHASE_VARS
    {
        pg8::Gemm g{XB, WinT, M, NPAD, DM}; pg8::StaticOrder S; S.init(M, NPAD, G, bid);
        EpiInProj E{Qb, Kb, Vb, IKb, IQb, Zb, XBC, IW, DT, rope};
        pg8::gemm_phase<EpiInProj, pg8::StaticOrder, true, true>((PG8_LAS unsigned char*)lds, g, S, E, wave_s);
    }
    }
    GRID_SYNC(); STAMP(1);
    {   PHASE_VARS
    {
        const int cgp = tid & 15;
        float cwr[4][16], cbr[16];
#pragma unroll
        for (int i = 0; i < 16; ++i) { cbr[i] = P->conv_b[512 + 16 * cgp + i];
#pragma unroll
            for (int j = 0; j < 4; ++j) cwr[j][i] = P->conv_w[j * 768 + 512 + 16 * cgp + i]; }
        const int NI = M * 16, stride = G * NT;
        for (int it0 = bid * NT + tid; it0 < NI; it0 += 4 * stride) {
            u32x4 u[4][4][2];
#pragma unroll
            for (int q = 0; q < 4; ++q) { const int it = it0 + q * stride; if (it < NI) { const int row = it >> 4; const bf16* xr = XBC + (size_t)row * 768 + 512 + 16 * cgp;
#pragma unroll
                for (int j = 0; j < 4; ++j) { u[q][j][0] = *(const u32x4*)(xr + (j - 3) * 768); u[q][j][1] = *(const u32x4*)(xr + (j - 3) * 768 + 8); } } }
#pragma unroll
            for (int q = 0; q < 4; ++q) { const int it = it0 + q * stride; if (it < NI) { const int row = it >> 4, t = row & (SEQ - 1);
                float v[16];
#pragma unroll
                for (int i = 0; i < 16; ++i) v[i] = cbr[i];
#pragma unroll
                for (int j = 0; j < 4; ++j) if (t - 3 + j >= 0) {
#pragma unroll
                    for (int i = 0; i < 16; ++i) { const unsigned wd = u[q][j][i >> 3][(i >> 1) & 3]; const float xv = (i & 1) ? __uint_as_float(wd & 0xffff0000u) : __uint_as_float(wd << 16); v[i] = fmaf(cwr[j][i], xv, v[i]); } }
#pragma unroll
                for (int i = 0; i < 16; ++i) v[i] = silu(v[i]);
                u32x4 o0, o1; o0.x = pg8::cvt_pk_bf16(v[0], v[1]); o0.y = pg8::cvt_pk_bf16(v[2], v[3]); o0.z = pg8::cvt_pk_bf16(v[4], v[5]); o0.w = pg8::cvt_pk_bf16(v[6], v[7]);
                o1.x = pg8::cvt_pk_bf16(v[8], v[9]); o1.y = pg8::cvt_pk_bf16(v[10], v[11]); o1.z = pg8::cvt_pk_bf16(v[12], v[13]); o1.w = pg8::cvt_pk_bf16(v[14], v[15]);
                *(u32x4*)(BCc + (size_t)row * 256 + 16 * cgp) = o0; *(u32x4*)(BCc + (size_t)row * 256 + 16 * cgp + 8) = o1; } }
        }
    }
    }
    GRID_SYNC(); STAMP(22);
    {   PHASE_VARS
    for (int item = bid; item < BATCH * 8; item += G) ssd_item(__builtin_amdgcn_readfirstlane(item >> 3), __builtin_amdgcn_readfirstlane(item & 7), P, XBC, BCc, DT, Zb, ASb, SSQP, lds, tid);
    {
        volatile int* qslot = (volatile int*)(lds + LDS_BYTES - 64);
        const unsigned xcc = (unsigned)__builtin_amdgcn_s_getreg((3 << 11) | 20) & 7u;
        for (;;) {
            __syncthreads();
            if (tid == 0) { int pi = -1;
                for (unsigned a = 0; a < 8 && pi < 0; ++a) { const unsigned q = (xcc + a) & 7u; const unsigned idx = atomicAdd(&ctl[CW_DSAQ + 16 * q], 1u); if (idx < 128u) pi = (int)(q * 128u + idx); }
                *qslot = pi; }
            __syncthreads();
            const int pi = __builtin_amdgcn_readfirstlane(*qslot); if (pi < 0) break;
            const int q = pi >> 7, idx = pi & 127, b = q + 8 * (idx & 1), qb = 63 - (idx >> 1);
            dsa_select(b, qb, IQb, IKb, IW, lds, lane, wave_s, &ctl[CW_ERR]);
            attn_body::attn_unit<8>(b, qb, Qb, Kb, Vb, ASb, (char*)lds, (const char*)lds + DSA_MASK_OFF, wave_s);
        }
    }
    __syncthreads();
    {
        LAS float* scr = (LAS float*)((LAS unsigned char*)lds + wave * 16384);
        constexpr int I_OUT = (DM / 64) * (DM / 32), I_GU = NEXP * 2 * 128, I_D = NEXP * 128, I_ALL = I_OUT + I_GU + I_D;
        for (;;) {
            int base = 0; if (lane == 0) base = (int)atomicAdd(&ctl[CW_WQ], 8u);
            base = __builtin_amdgcn_readfirstlane(base); if (base >= I_ALL) break;
            for (int it = base; it < base + 8 && it < I_ALL; ++it) {
                int r = it;
                if (r < I_OUT) { { const float* nw = P->ssd_norm_w; transpose_item(P->w_out, DM, DM, WoutT, scr, r, lane, [](int c) { return c; }, [nw](int k, float& sc) { if (k < 512) { sc = nw[k]; return k + 512; } return k - 512; }); } continue; } r -= I_OUT;
                if (r < I_GU) { const int e = r >> 8, up = (r >> 7) & 1, sub = r & 127; const float* W = (up ? P->w_up : P->w_gate) + (size_t)e * DM * EFF;
                transpose_item(W, DM, EFF, WguT + (size_t)e * 512 * DM, scr, sub, lane, [up](int c) { return 8 * (c >> 2) + 4 * up + (c & 3); }, [](int k, float&) { return k; }); continue; } r -= I_GU;
                { const int e = r >> 7, sub = r & 127; transpose_item(P->w_down + (size_t)e * EFF * DM, EFF, DM, WdT + (size_t)e * DM * EFF, scr, sub, lane, [](int c) { return c; }, [](int k, float&) { return k; }); }
            }
        }
    }
    }
    GRID_SYNC(); STAMP(2);
    {   PHASE_VARS
    {
        pg8::Gemm g{ASb, WoutT, M, DM, DM}; pg8::StaticOrder S; S.init(M, DM, G, bid);
        EpiH1 E{P->x, H1b, SSQP};
        pg8::gemm_phase<EpiH1, pg8::StaticOrder, true, true>((PG8_LAS unsigned char*)lds, g, S, E, wave_s);
    }
    }
    GRID_SYNC(); STAMP(4);
    {   PHASE_VARS
    {
        float* Wg = (float*)lds;
        int* lcnt = (int*)(lds + 81920); int* lbase = lcnt + 16; int* rec = lbase + 16;
        float* recw = (float*)(rec + 4 * 128);
        float* rlg = recw + 2 * 128;
        float* rstat = rlg + 20 * 128;
        { f32x4 t4[10];
#pragma unroll
          for (int i = 0; i < 10; ++i) t4[i] = ((const f32x4*)WGG)[tid + NT * i];
#pragma unroll
          for (int i = 0; i < 10; ++i) ((f32x4*)Wg)[tid + NT * i] = t4[i]; }
        if (tid < 16) lcnt[tid] = 0;
        __syncthreads();
        const int rows_per_wave = M / NGW;
        const int l15 = lane & 15, ph = lane >> 4;
        {
            const bf16* hr = H1b + (size_t)(gw + NGW * l15) * DM + 4 * ph;
            const float* wb0 = Wg + (4 * ph) * 20 + l15; const float* wb1 = Wg + (4 * ph) * 20 + 16 + (l15 < 4 ? l15 : 3);
            f32x4 c0 = (f32x4){0.f, 0.f, 0.f, 0.f}, c1 = c0; float s = 0.f, ss = 0.f;
            u32x2 an[8];
#pragma unroll
            for (int u = 0; u < 8; ++u) an[u] = *(const u32x2*)(hr + 16 * u);
#pragma unroll 1
            for (int i0 = 0; i0 < 64; i0 += 8) {
                f32x4 a[8];
#pragma unroll
                for (int u = 0; u < 8; ++u) { a[u][0] = __uint_as_float(an[u].x << 16); a[u][1] = __uint_as_float(an[u].x & 0xffff0000u); a[u][2] = __uint_as_float(an[u].y << 16); a[u][3] = __uint_as_float(an[u].y & 0xffff0000u); }
                if (i0 + 8 < 64) {
#pragma unroll
                    for (int u = 0; u < 8; ++u) an[u] = *(const u32x2*)(hr + 16 * (i0 + 8 + u)); }
#pragma unroll
                for (int u = 0; u < 8; ++u) {
                    s += (a[u][0] + a[u][1]) + (a[u][2] + a[u][3]); ss += (a[u][0] * a[u][0] + a[u][1] * a[u][1]) + (a[u][2] * a[u][2] + a[u][3] * a[u][3]);
#pragma unroll
                    for (int e = 0; e < 4; ++e) { const int ko = (16 * (i0 + u) + e) * 20;
                        c0 = __builtin_amdgcn_mfma_f32_16x16x4f32(a[u][e], wb0[ko], c0, 0, 0, 0);
                        c1 = __builtin_amdgcn_mfma_f32_16x16x4f32(a[u][e], wb1[ko], c1, 0, 0, 0); }
                }
            }
            { const int ln2 = launder_i(lane); const int i16 = (ln2 ^ 16) << 2, i32 = (ln2 ^ 32) << 2;
              s += __builtin_bit_cast(float, __builtin_amdgcn_ds_bpermute(i16, __builtin_bit_cast(int, s))); s += __builtin_bit_cast(float, __builtin_amdgcn_ds_bpermute(i32, __builtin_bit_cast(int, s)));
              ss += __builtin_bit_cast(float, __builtin_amdgcn_ds_bpermute(i16, __builtin_bit_cast(int, ss))); ss += __builtin_bit_cast(float, __builtin_amdgcn_ds_bpermute(i32, __builtin_bit_cast(int, ss))); }
            const float mean = s * (1.f / DM), var = ss * (1.f / DM) - mean * mean;
            if (ph == 0) { rstat[(wave * 16 + l15) * 2] = mean; rstat[(wave * 16 + l15) * 2 + 1] = rsqrtf(var + LN_EPS); }
#pragma unroll
            for (int r = 0; r < 4; ++r) { const int rl = wave * 16 + 4 * ph + r; rlg[rl * 20 + l15] = c0[r]; if (l15 < 4) rlg[rl * 20 + 16 + l15] = c1[r]; }
        }
        __syncthreads();
        {
            f32x4 gg[4], bb[4];
#pragma unroll
            for (int j = 0; j < 4; ++j) { gg[j] = *(const f32x4*)(P->ln1_g + lane * 4 + 256 * j); bb[j] = *(const f32x4*)(P->ln1_b + lane * 4 + 256 * j); }
            for (int it = 0; it < rows_per_wave; it += 4) {
                f32x4 v[4][4];
#pragma unroll
                for (int r = 0; r < 4; ++r)
#pragma unroll
                    for (int j = 0; j < 4; ++j) { const u32x2 hb = *(const u32x2*)(H1b + (size_t)(gw + NGW * (it + r)) * DM + lane * 4 + 256 * j);
                        v[r][j][0] = __uint_as_float(hb.x << 16); v[r][j][1] = __uint_as_float(hb.x & 0xffff0000u); v[r][j][2] = __uint_as_float(hb.y << 16); v[r][j][3] = __uint_as_float(hb.y & 0xffff0000u); }
#pragma unroll
                for (int r = 0; r < 4; ++r) { const float mean = rstat[(wave * 16 + it + r) * 2], rstd = rstat[(wave * 16 + it + r) * 2 + 1];
#pragma unroll
                    for (int j = 0; j < 4; ++j) { const f32x4 o = (v[r][j] - mean) * rstd * gg[j] + bb[j]; u32x2 w; w.x = pg8::cvt_pk_bf16(o[0], o[1]); w.y = pg8::cvt_pk_bf16(o[2], o[3]);
                        *(u32x2*)(X1b + (size_t)(gw + NGW * (it + r)) * DM + lane * 4 + 256 * j) = w; } }
            }
        }
        const float* rc = (const float*)(ws + WS_RCONST);
        for (int rl = tid; rl < 8 * rows_per_wave; rl += NT) {
            const float mean = rstat[rl * 2], rstd = rstat[rl * 2 + 1];
            float lg[20];
#pragma unroll
            for (int j = 0; j < 20; ++j) lg[j] = rstd * (rlg[rl * 20 + j] - mean * rc[j]) + rc[20 + j];
            int gi = 0; float gm = lg[0];
#pragma unroll
            for (int i = 1; i < 4; ++i) if (lg[i] > gm) { gm = lg[i]; gi = i; }
            float gs = 0.f;
#pragma unroll
            for (int i = 0; i < 4; ++i) gs += __expf(lg[i] - gm);
            const float gprob = 1.f / gs;
            float el[4];
#pragma unroll
            for (int i = 0; i < 4; ++i) { float v0 = 0.f;
#pragma unroll
                for (int g2 = 0; g2 < 4; ++g2) if (g2 == gi) v0 = lg[4 + g2 * 4 + i];
                el[i] = v0; }
            int i0 = 0; float m0 = el[0];
#pragma unroll
            for (int i = 1; i < 4; ++i) if (el[i] > m0) { m0 = el[i]; i0 = i; }
            int i1 = -1; float m1 = -INFINITY;
#pragma unroll
            for (int i = 0; i < 4; ++i) if (i != i0 && el[i] > m1) { m1 = el[i]; i1 = i; }
            const float e1 = __expf(m1 - m0), inv = 1.f / (1.f + e1);
            const int ex0 = gi * 4 + i0, ex1 = gi * 4 + i1;
            rec[rl * 4 + 0] = ex0; rec[rl * 4 + 1] = atomicAdd(&lcnt[ex0], 1); rec[rl * 4 + 2] = ex1; rec[rl * 4 + 3] = atomicAdd(&lcnt[ex1], 1);
            recw[rl * 2] = inv * gprob; recw[rl * 2 + 1] = e1 * inv * gprob;
        }
        __syncthreads();
        if (tid < 16) lbase[tid] = (int)atomicAdd(&ctl[CW_CNT + 64 * tid], (unsigned)lcnt[tid]);
        __syncthreads();
        for (int rl = tid; rl < 8 * rows_per_wave; rl += NT) {
            const int row = (bid * 8 + rl / rows_per_wave) + NGW * (rl % rows_per_wave);
            const int e0 = rec[rl * 4], e1x = rec[rl * 4 + 2];
            lists[(size_t)e0 * M + lbase[e0] + rec[rl * 4 + 1]] = row * 2; lists[(size_t)e1x * M + lbase[e1x] + rec[rl * 4 + 3]] = row * 2 + 1;
            tokw[row * 2] = recw[rl * 2]; tokw[row * 2 + 1] = recw[rl * 2 + 1];
        }
    }
    }
    GRID_SYNC(); STAMP(5);
    {   PHASE_VARS
    int* tb = (int*)(lds + 135168);
    if (tid < NEXP) tb[32 + tid] = (int)((__hip_atomic_load(&ctl[CW_CNT + 64 * tid], __ATOMIC_RELAXED, __HIP_MEMORY_SCOPE_AGENT) + 255u) >> 8);
    __syncthreads();
    if (tid == 0) { int a = 0; for (int e = 0; e < NEXP; ++e) { tb[e] = a; a += tb[32 + e]; } tb[NEXP] = a; }
    __syncthreads();
    const int ntiles = tb[NEXP];
    for (int sr = bid * NT + tid; sr < ntiles * 256; sr += G * NT) {
        const int rt = sr >> 8; int e = 0;
#pragma unroll
        for (int j = 1; j < NEXP; ++j) if (rt >= tb[j]) e = j;
        const int slot = sr - tb[e] * 256; const int cnt_e = (int)__hip_atomic_load(&ctl[CW_CNT + 64 * e], __ATOMIC_RELAXED, __HIP_MEMORY_SCOPE_AGENT);
        const int en = (slot < cnt_e) ? lists[(size_t)e * M + slot] : -1;
        ENT[sr] = (en >= 0) ? ((en & 1) * M + (en >> 1)) : 2 * M; WGT[sr] = (en >= 0) ? tokw[en] : 0.f;
    }
    {
        LAS int* ul = (LAS int*)((LAS unsigned char*)lds + 135168 + 128); int n = 0;
        if (tid == 0) { for (int L = bid; L < ntiles * 2; L += G) { const int rt = L >> 1; int e = 0; for (int j = 1; j < NEXP; ++j) if (rt >= tb[j]) e = j; ul[2 * n] = rt; ul[2 * n + 1] = e * 2 + (L & 1); ++n; } ul[62] = n; }
        __syncthreads(); n = ul[62];
        LAS int* rtl = (LAS int*)((LAS unsigned char*)lds + 135168 + 512);
        for (int e = tid; e < n * 256; e += NT) { const int rt = ul[2 * (e >> 8)], ex = ul[2 * (e >> 8) + 1] >> 1, slot = (rt - tb[ex]) * 256 + (e & 255);
            const int cnt_e = (int)__hip_atomic_load(&ctl[CW_CNT + 64 * ex], __ATOMIC_RELAXED, __HIP_MEMORY_SCOPE_AGENT); rtl[e] = (slot < cnt_e) ? (lists[(size_t)ex * M + slot] >> 1) : 0; }
        __syncthreads();
        pg8::Gemm g{X1b, WguT, MAXROWS, 512, DM}; MoeOrder S{n, ul};
        EpiSwiGLU E{Hid};
        pg8::gemm_phase<EpiSwiGLU, MoeOrder, true, true, true>((PG8_LAS unsigned char*)lds, g, S, E, wave_s, rtl);
    }
    }
    GRID_SYNC(); STAMP(7);
    {   PHASE_VARS
    const LAS int* tb = (const LAS int*)((LAS unsigned char*)lds + 135168); const int ntiles = tb[NEXP];
    {
        LAS int* ul = (LAS int*)((LAS unsigned char*)lds + 135168 + 128); int n = 0;
        __syncthreads();
        if (tid == 0) { for (int L = bid; L < ntiles * 4; L += G) { const int rt = L >> 2; int e = 0; for (int j = 1; j < NEXP; ++j) if (rt >= tb[j]) e = j; ul[2 * n] = rt; ul[2 * n + 1] = e * 4 + (L & 3); ++n; } ul[62] = n; }
        __syncthreads(); n = ul[62];
        pg8::Gemm g{Hid, WdT, MAXROWS, DM, EFF}; MoeOrder S{n, ul};
        EpiDown E{ENT, WGT, Y0};
        pg8::gemm_phase<EpiDown, MoeOrder, true, true>((PG8_LAS unsigned char*)lds, g, S, E, wave_s);
    }
    }
    GRID_SYNC(); STAMP(8);
    {   PHASE_VARS
    const bool poison = __hip_atomic_load(&ctl[CW_ERR], __ATOMIC_RELAXED, __HIP_MEMORY_SCOPE_AGENT) != 0u; const float qnan = __builtin_nanf("");
    for (int row = launder_i(gw); row < M; row += NGW) {
        f32x4 v[4]; float s = 0.f;
#pragma unroll
        for (int j = 0; j < 4; ++j) { const int c0 = lane * 4 + 256 * j; const u32x2 xb = *(const u32x2*)(X1b + (size_t)row * DM + c0);
            v[j][0] = __uint_as_float(xb.x << 16) * ALPHA; v[j][1] = __uint_as_float(xb.x & 0xffff0000u) * ALPHA; v[j][2] = __uint_as_float(xb.y << 16) * ALPHA; v[j][3] = __uint_as_float(xb.y & 0xffff0000u) * ALPHA;
            const u32x2 a = *(const u32x2*)(Y0 + (size_t)row * DM + c0), b = *(const u32x2*)(Y1 + (size_t)row * DM + c0);
            v[j][0] += __uint_as_float(a.x << 16) + __uint_as_float(b.x << 16); v[j][1] += __uint_as_float(a.x & 0xffff0000u) + __uint_as_float(b.x & 0xffff0000u);
            v[j][2] += __uint_as_float(a.y << 16) + __uint_as_float(b.y << 16); v[j][3] += __uint_as_float(a.y & 0xffff0000u) + __uint_as_float(b.y & 0xffff0000u);
            s += (v[j][0] + v[j][1]) + (v[j][2] + v[j][3]); }
        const float mean = wave_sum(s) * (1.f / DM); float s2 = 0.f;
#pragma unroll
        for (int j = 0; j < 4; ++j) { v[j] = v[j] - mean; s2 += (v[j][0] * v[j][0] + v[j][1] * v[j][1]) + (v[j][2] * v[j][2] + v[j][3] * v[j][3]); }
        const float rstd = rsqrtf(wave_sum(s2) * (1.f / DM) + LN_EPS);
#pragma unroll
        for (int j = 0; j < 4; ++j) { const int c0 = lane * 4 + 256 * j;
            const f32x4 gg = *(const f32x4*)(P->ln2_g + c0), bb = *(const f32x4*)(P->ln2_b + c0);
            f32x4 o = v[j] * rstd * gg + bb; if (poison) o = (f32x4){qnan, qnan, qnan, qnan};
            *(f32x4*)(P->out + (size_t)row * DM + c0) = o; }
    }
    }
    STAMP(9);
    if (PROBE_MASK && bid == 0 && wave_s == 0 && lane_id() == 0) { const unsigned long long t0 = __builtin_amdgcn_s_memrealtime(), d = 8ull * pst[1]; while (__builtin_amdgcn_s_memrealtime() - t0 < d) __builtin_amdgcn_s_sleep(8); }
}

extern "C" void kernel_launch(void* const* d_in, const int* in_sizes, int n_in, void* d_out, int out_size, void* d_ws, size_t ws_size, hipStream_t stream) {
    static int grid = 0;
    if (grid == 0) {
        if (n_in != 20 || in_sizes[0] != M * DM || out_size != M * DM || ws_size < WS_END) { fprintf(stderr, "kernel_launch: unexpected shapes (n_in %d, in0 %d, out %d, ws %zu)\n", n_in, n_in > 0 ? in_sizes[0] : -1, out_size, ws_size); grid = -1; return; }
        int dev = 0, cus = 0, per_cu = 0;
        (void)hipGetDevice(&dev);
        (void)hipDeviceGetAttribute(&cus, hipDeviceAttributeMultiprocessorCount, dev);
        (void)hipFuncSetAttribute((const void*)hybrid_fwd, hipFuncAttributeMaxDynamicSharedMemorySize, LDS_BYTES);
        (void)hipOccupancyMaxActiveBlocksPerMultiprocessor(&per_cu, (const void*)hybrid_fwd, NT, LDS_BYTES);
        if (per_cu < 1) { fprintf(stderr, "kernel_launch: occupancy query says %d blocks/CU\n", per_cu); grid = -1; return; }
        grid = cus;
    }
    if (grid < 0) return;
    (void)hipMemsetAsync((char*)d_ws + WS_CTL, 0, CTL_BYTES, stream);
    Params p{};
    const float** f = (const float**)&p;
    for (int i = 0; i < 20; ++i) f[i] = (const float*)d_in[i];
    p.out = (float*)d_out; p.ws = (unsigned char*)d_ws;
    void* args[] = {&p};
    hipError_t e = hipLaunchCooperativeKernel((const void*)hybrid_fwd, dim3(grid), dim3(NT), args, LDS_BYTES, stream);
    if (e != hipSuccess) fprintf(stderr, "cooperative launch failed: %s (grid %d)\n", hipGetErrorString(e), grid);
}
```

```cpp
#include <hip/hip_runtime.h>
#include <hip/hip_cooperative_groups.h>
#include <cstdio>
#include <cstdint>
namespace cg = cooperative_groups;

constexpr int BATCH = 16, SEQ = 2048, DM = 1024, M = BATCH * SEQ;
constexpr int INW = 2252;
constexpr int C_Q = 0, C_K = 512, C_V = 576, C_IQ = 640, C_IK = 896, C_IW = 960, C_Z = 964, C_XBC = 1476, C_DT = 2244;
constexpr int NEXP = 16, EFF = 256;
constexpr float LN_EPS = 1e-5f;
constexpr float ALPHA = 1.189207115002721f;
constexpr float INDEXER_SCALE = 0.0625f;
constexpr float QSCALE = 0.125f * 1.4426950408889634f;
constexpr int TOPK = 256;
constexpr int NT = 512;
constexpr int LDS_BYTES = 163840;

constexpr size_t MiB = 1u << 20;
constexpr size_t WS_CTL = 0, CTL_BYTES = 1 * MiB;
constexpr size_t WS_ROPE = 1 * MiB;
constexpr size_t WS_TOKW = 2 * MiB;
constexpr size_t WS_LISTS = 3 * MiB;
constexpr size_t WS_WIN_T = 8 * MiB;
constexpr size_t WS_WOUT_T = 16 * MiB;
constexpr size_t WS_WGU_T = 18 * MiB;
constexpr size_t WS_WD_T = 34 * MiB;
constexpr size_t WS_RCONST = 7 * MiB;
constexpr size_t WS_ENT = 5 * MiB;
constexpr size_t WS_XS = 48 * MiB;
constexpr size_t WS_HID = 192 * MiB;
constexpr int MAXTILES = 272, MAXROWS = MAXTILES * 256;
constexpr size_t WS_XB = 256 * MiB;
constexpr int NPAD = 2304;
constexpr size_t WS_Q = 48 * MiB;
constexpr size_t WS_K = 80 * MiB, WS_V = 84 * MiB, WS_IK = 88 * MiB;
constexpr size_t WS_IW = 92 * MiB;
constexpr size_t WS_DT = 93 * MiB;
constexpr size_t WS_IQ = 96 * MiB;
constexpr size_t WS_Z = 112 * MiB;
constexpr size_t WS_XBC = 144 * MiB;
constexpr size_t WS_AS = 192 * MiB;
constexpr size_t WS_X1 = 256 * MiB;
constexpr size_t WS_X1B = 384 * MiB;
constexpr size_t WS_Y0 = 48 * MiB, WS_Y1 = 112 * MiB;
constexpr size_t WS_P32 = 224 * MiB;
constexpr size_t WS_XC = 256 * MiB;
constexpr size_t WS_BCC = 320 * MiB;
constexpr size_t WS_SSQP = 42 * MiB;
constexpr size_t WS_END = 512 * MiB;
constexpr int CW_CNT = 8192;
constexpr int CW_BAR = 4096;
constexpr int CW_ERR = 32;
constexpr int CW_WQ = 48;
constexpr int CW_DSAQ = 128;

typedef unsigned short bf16;
typedef float f32x4 __attribute__((ext_vector_type(4)));
typedef unsigned u32x4 __attribute__((ext_vector_type(4)));
typedef unsigned u32x2 __attribute__((ext_vector_type(2)));

struct Params {
    const float* x; const float* w_in; const float* conv_w; const float* conv_b; const float* dt_bias; const float* a_log; const float* d_skip;
    const float* ssd_norm_w; const float* w_out; const float* ln1_g; const float* ln1_b; const float* w_rg; const float* b_rg; const float* w_re; const float* b_re;
    const float* w_gate; const float* w_up; const float* w_down; const float* ln2_g; const float* ln2_b;
    float* out; unsigned char* ws;
};

__device__ __forceinline__ int launder_i(int v);
__device__ __forceinline__ int lane_id() { unsigned m = ~0u; asm volatile("" : "+s"(m)); return (int)__builtin_amdgcn_mbcnt_hi(m, __builtin_amdgcn_mbcnt_lo(m, 0u)); }
typedef const __attribute__((address_space(4))) Params* KPtr;
__device__ __forceinline__ KPtr launder_k(KPtr k) { asm volatile("" : "+s"(k)); return k; }
__device__ __forceinline__ float bf2f(bf16 v) { return __uint_as_float((unsigned)v << 16); }
__device__ __forceinline__ bf16 f2bf(float f) { unsigned u = __float_as_uint(f); return (bf16)((u + 0x7fffu + ((u >> 16) & 1u)) >> 16); }
__device__ __forceinline__ float silu(float v) { return v * __builtin_amdgcn_rcpf(1.f + __expf(-v)); }
__device__ __forceinline__ float wave_sum(float v) {
#define WS_DPP(ctrl, rm, bc) v += __int_as_float(__builtin_amdgcn_update_dpp(0, __float_as_int(v), ctrl, rm, 0xf, bc))
    WS_DPP(0xB1, 0xf, true); WS_DPP(0x4E, 0xf, true); WS_DPP(0x114, 0xf, true); WS_DPP(0x118, 0xf, true); WS_DPP(0x142, 0xa, false); WS_DPP(0x143, 0xc, false);
#undef WS_DPP
    return __int_as_float(__builtin_amdgcn_readlane(__float_as_int(v), 63));
}
__device__ __forceinline__ float wave_max(float v) {
#pragma unroll
    for (int o = 1; o < 64; o <<= 1) v = fmaxf(v, __shfl_xor(v, o));
    return v;
}
__device__ __forceinline__ int launder_i(int v) { asm volatile("" : "+v"(v)); return v; }
__device__ __forceinline__ unsigned sortkey(float f) { unsigned u = __float_as_uint(f); return (u & 0x80000000u) ? ~u : (u | 0x80000000u); }

namespace pg8 {
#define PG8_LAS __attribute__((address_space(3)))
typedef unsigned short bf16_t;
typedef short bf16x8 __attribute__((ext_vector_type(8)));
typedef float f32x4 __attribute__((ext_vector_type(4)));
typedef unsigned u32x4 __attribute__((ext_vector_type(4)));
constexpr int BM = 256, BK = 64, HALF = 128, HTB = HALF * BK * 2  , STAGE_BYTES = 8 * HTB, NXCD = 8, WGM = 8;

__host__ __device__ __forceinline__ int lds_byte(int r, int c) { const int st = (r >> 4) * 2 + (c >> 5), rr = r & 15, cc = c & 31, ob = rr * 64 + cc * 2; return st * 1024 + (ob ^ (((ob >> 9) & 1) << 5)); }
__host__ __device__ __forceinline__ void stage_rc(int b, int& R, int& C) { const int st = b / 1024, sb = b % 1024, swz = sb ^ (((sb >> 9) & 1) << 5); R = (st >> 1) * 16 + swz / 64; C = (st & 1) * 32 + (swz % 64) / 2; }
__host__ __device__ __forceinline__ int perm32(int rho) { const int n = rho >> 4, i = rho & 15; return 8 * (i >> 2) + 4 * n + (i & 3); }

struct Unit { int pm, pn; };
struct Gemm { const bf16_t* A; const bf16_t* Bt; int M, N, K; };

struct StaticOrder {
    int nM, nN, nwg, G, c;
    __host__ __device__ void init(int M, int N, int G_, int c_) { nM = M / BM; nN = N / BM; nwg = nM * nN; G = G_; c = c_; }
    __host__ __device__ bool next(int i, Unit& u) const {
        const long L = (long)i * G + c; if (L >= nwg) return false;
        int wgid = (int)L; { const int q = nwg / NXCD, r = nwg % NXCD, xcd = wgid % NXCD, off = wgid / NXCD; wgid = (xcd < r ? xcd * (q + 1) : r * (q + 1) + (xcd - r) * q) + off; }
        const int nig = WGM * nN, gid = wgid / nig, fm = gid * WGM, gsz = (nM - fm) < WGM ? (nM - fm) : WGM;
        u.pm = fm + ((wgid % nig) % gsz); u.pn = (wgid % nig) / gsz; return true;
    }
    __device__ __forceinline__ void a_ready(const Unit&) const {}
    __device__ __forceinline__ void done(const Unit&) const {}
};

__device__ __forceinline__ unsigned cvt_pk_bf16(float lo, float hi) { unsigned r; asm volatile("v_cvt_pk_bf16_f32 %0, %1, %2" : "=v"(r) : "v"(lo), "v"(hi)); return r; }
template <class Epi, class Sched, bool ALIGN_EPI = false, bool SP2 = false, bool GATHER = false>
__device__ __forceinline__ void gemm_phase(PG8_LAS unsigned char* lds, const Gemm g, const Sched& S, const Epi& E, const int wave_s, const PG8_LAS int* rtl = nullptr) {
    int tid_l = wave_s * 64 + lane_id(); asm volatile("" : "+v"(tid_l));
    const int tid = tid_l, wid = wave_s, lane = tid & 63, wr = wid >> 2, wc = wid & 3, fr = lane & 15, fq = lane >> 4;
    const int K = g.K, nt = K / BK;
    unsigned voffA[2], voffB[2];
#pragma unroll
    for (int i = 0; i < 2; ++i) { int R, C; stage_rc(tid * 16 + i * 8192, R, C); const int Rb = Epi::PERM ? ((R & ~31) + perm32(R & 31)) : R;
        voffA[i] = (unsigned)(R * K + C) * 2u; voffB[i] = (unsigned)(Rb * K + C) * 2u; }
    const size_t kstep = (size_t)(BK * 2);
    const size_t hstepB = (size_t)HALF * K * 2;
    const size_t tstep = 2 * hstepB;
    const size_t hstep = GATHER ? 0 : hstepB, tstepA = GATHER ? 0 : tstep;
    int rowA[2]; { int R, C; stage_rc(tid * 16, R, C); rowA[0] = R; stage_rc(tid * 16 + 8192, R, C); rowA[1] = R; }
    unsigned voffGc[2][2], voffGn[2][2];
#define PG8_GVOFF(dst, uidx) do { _Pragma("unroll") for (int _h = 0; _h < 2; ++_h) _Pragma("unroll") for (int _i = 0; _i < 2; ++_i) { int R_, C_; stage_rc(tid * 16 + _i * 8192, R_, C_); \
        dst[_h][_i] = (unsigned)rtl[(uidx) * 256 + _h * 128 + R_] * (unsigned)(K * 2) + (unsigned)(C_ * 2); } } while (0)
    const unsigned ldsw = (unsigned)wid * 1024u;
    const int aoff = lds_byte(wr * 64 + fr, fq * 8), boff = lds_byte(wc * 32 + fr, fq * 8);
#define PG8_SA(b, h) (((b) * 2 + (h)) * HTB)
#define PG8_SB(b, h) ((4 + (b) * 2 + (h)) * HTB)
#define PG8_STAGE(bufoff, gbase, voff) do { _Pragma("unroll") for (int _i = 0; _i < 2; ++_i) \
        __builtin_amdgcn_global_load_lds((const unsigned*)((const char*)(gbase) + (voff)[_i]), (PG8_LAS unsigned*)(lds + (bufoff) + ldsw + _i * 8192), 16, 0, 0); } while (0)
#define PG8_STAGE_A(bufoff, gbase, h, nx) do { if constexpr (GATHER) { if (nx) PG8_STAGE(bufoff, gbase, voffGn[h]); else PG8_STAGE(bufoff, gbase, voffGc[h]); } else PG8_STAGE(bufoff, gbase, voffA); } while (0)
#define PG8_LDA(dst, b, h) do { _Pragma("unroll") for (int m = 0; m < 4; ++m) _Pragma("unroll") for (int k = 0; k < 2; ++k) dst[m][k] = *(const PG8_LAS bf16x8*)(lds + PG8_SA(b, h) + aoff + m * 2048 + k * 1024); } while (0)
#define PG8_LDB(dst, b, h) do { _Pragma("unroll") for (int n = 0; n < 2; ++n) _Pragma("unroll") for (int k = 0; k < 2; ++k) dst[n][k] = *(const PG8_LAS bf16x8*)(lds + PG8_SB(b, h) + boff + n * 2048 + k * 1024); } while (0)
#define PG8_MMA(ai, bj, At, Bt) do { __builtin_amdgcn_s_setprio(1); _Pragma("unroll") for (int m = 0; m < 4; ++m) _Pragma("unroll") for (int n = 0; n < 2; ++n) _Pragma("unroll") for (int k = 0; k < 2; ++k) \
        acc[ai][bj][m][n] = __builtin_amdgcn_mfma_f32_16x16x32_bf16(Bt[n][k], At[m][k], acc[ai][bj][m][n], 0, 0, 0); __builtin_amdgcn_s_setprio(0); } while (0)
#define PG8_WAIT_V(n) asm volatile("s_waitcnt vmcnt(" #n ")" ::: "memory")
#define PG8_WAIT_L(n) asm volatile("s_waitcnt lgkmcnt(" #n ")" ::: "memory")
#define PG8_BAR __builtin_amdgcn_s_barrier()
#define PG8_SCHED __builtin_amdgcn_sched_barrier(0)
    Unit cur, nxt; int ui = 0;
    if (!S.next(0, cur)) return;
    f32x4 acc[2][2][4][2];
#pragma unroll
    for (int a = 0; a < 2; ++a)
#pragma unroll
        for (int b = 0; b < 2; ++b)
#pragma unroll
            for (int m = 0; m < 4; ++m)
#pragma unroll
                for (int n = 0; n < 2; ++n) acc[a][b][m][n] = (f32x4){0.f, 0.f, 0.f, 0.f};
    bf16x8 At[4][2], B0[2][2], B1[2][2];
    const char* cA = (const char*)g.A + (size_t)cur.pm * tstepA; const char* cB = (const char*)g.Bt + (size_t)cur.pn * tstep;
    if constexpr (GATHER) { PG8_GVOFF(voffGc, 0); _Pragma("unroll") for (int _h = 0; _h < 2; ++_h) _Pragma("unroll") for (int _i = 0; _i < 2; ++_i) voffGn[_h][_i] = voffGc[_h][_i]; }
    S.a_ready(cur);
    if constexpr (SP2) {
        PG8_STAGE(PG8_SB(0, 0), cB, voffB); PG8_STAGE(PG8_SB(0, 1), cB + hstepB, voffB); PG8_STAGE_A(PG8_SA(0, 0), cA, 0, false); PG8_STAGE_A(PG8_SA(0, 1), cA + hstep, 1, false);
        if (wr == 1) PG8_BAR;
        PG8_WAIT_V(2); PG8_BAR;
        PG8_STAGE(PG8_SB(1, 0), cB + kstep, voffB); PG8_STAGE_A(PG8_SA(1, 0), cA + kstep, 0, false); PG8_STAGE(PG8_SB(1, 1), cB + hstepB + kstep, voffB);
        PG8_WAIT_V(6); PG8_BAR;
    } else {
        PG8_STAGE(PG8_SB(0, 0), cB, voffB); PG8_STAGE_A(PG8_SA(0, 0), cA, 0, false); PG8_STAGE(PG8_SB(0, 1), cB + hstepB, voffB); PG8_STAGE_A(PG8_SA(0, 1), cA + hstep, 1, false);
        if (wr == 1) PG8_BAR;
        PG8_WAIT_V(4); PG8_BAR;
        PG8_STAGE(PG8_SB(1, 0), cB + kstep, voffB); PG8_STAGE_A(PG8_SA(1, 0), cA + kstep, 0, false); PG8_STAGE(PG8_SB(1, 1), cB + hstepB + kstep, voffB);
        PG8_WAIT_V(6); PG8_BAR;
    }
    for (;;) {
        const bool has_next = S.next(ui + 1, nxt);
        const char* nA = has_next ? (const char*)g.A + (size_t)nxt.pm * tstepA : cA; const char* nB = has_next ? (const char*)g.Bt + (size_t)nxt.pn * tstep : cB;
        for (int t = 0; t < nt; t += 2) {
            if constexpr (Epi::MID_T > 0) { if (t == Epi::MID_T) E.mid(acc, cur, wr, wc, fr, fq); }
            const bool last = (t == nt - 2);
            const char* a1 = cA + (size_t)(t + 1) * kstep;
            const char* a2 = last ? nA : cA + (size_t)(t + 2) * kstep; const char* b2 = last ? nB : cB + (size_t)(t + 2) * kstep;
            const char* a3 = a2 + kstep; const char* b3 = b2 + kstep;
            if (last && has_next) { S.a_ready(nxt); if constexpr (GATHER) PG8_GVOFF(voffGn, ui + 1); }
            if constexpr (SP2) {
            PG8_LDB(B0, 0, 0); PG8_LDB(B1, 0, 1); PG8_SCHED; PG8_LDA(At, 0, 0); PG8_STAGE_A(PG8_SA(1, 1), a1 + hstep, 1, false);
            PG8_WAIT_V(8); PG8_WAIT_L(0); PG8_BAR; PG8_MMA(0, 0, At, B0); PG8_MMA(0, 1, At, B1); PG8_BAR; PG8_SCHED;
            PG8_LDA(At, 0, 1); PG8_STAGE(PG8_SB(0, 0), b2, voffB); PG8_STAGE(PG8_SB(0, 1), b2 + hstepB, voffB); PG8_STAGE_A(PG8_SA(0, 0), a2, 0, last);
            PG8_WAIT_V(8); PG8_WAIT_L(0); PG8_BAR; PG8_MMA(1, 0, At, B0); PG8_MMA(1, 1, At, B1); PG8_BAR; PG8_SCHED;
            PG8_LDB(B0, 1, 0); PG8_LDB(B1, 1, 1); PG8_SCHED; PG8_LDA(At, 1, 0); PG8_STAGE_A(PG8_SA(0, 1), a2 + hstep, 1, last);
            PG8_WAIT_V(8); PG8_WAIT_L(0); PG8_BAR; PG8_MMA(0, 0, At, B0); PG8_MMA(0, 1, At, B1); PG8_BAR; PG8_SCHED;
            PG8_LDA(At, 1, 1); PG8_STAGE(PG8_SB(1, 0), b3, voffB); PG8_STAGE(PG8_SB(1, 1), b3 + hstepB, voffB); PG8_STAGE_A(PG8_SA(1, 0), a3, 0, last);
            PG8_WAIT_V(8); PG8_WAIT_L(0); PG8_BAR; PG8_MMA(1, 0, At, B0); PG8_MMA(1, 1, At, B1); PG8_BAR; PG8_SCHED;
            } else {
            PG8_LDB(B0, 0, 0); PG8_SCHED; PG8_LDA(At, 0, 0); PG8_STAGE_A(PG8_SA(1, 1), a1 + hstep, 1, false);
            PG8_WAIT_L(8); PG8_BAR; PG8_WAIT_L(0); PG8_MMA(0, 0, At, B0); PG8_BAR; PG8_SCHED;
            PG8_LDB(B1, 0, 1); PG8_STAGE(PG8_SB(0, 0), b2, voffB);
            PG8_BAR; PG8_WAIT_L(0); PG8_MMA(0, 1, At, B1); PG8_BAR;
            PG8_LDA(At, 0, 1); PG8_STAGE_A(PG8_SA(0, 0), a2, 0, last);
            PG8_BAR; PG8_WAIT_L(0); PG8_MMA(1, 0, At, B0); PG8_BAR; PG8_SCHED;
            PG8_STAGE(PG8_SB(0, 1), b2 + hstepB, voffB);
            PG8_WAIT_V(6); PG8_BAR; PG8_MMA(1, 1, At, B1); PG8_BAR;
            PG8_LDB(B0, 1, 0); PG8_SCHED; PG8_LDA(At, 1, 0); PG8_STAGE_A(PG8_SA(0, 1), a2 + hstep, 1, last);
            PG8_WAIT_L(8); PG8_BAR; PG8_WAIT_L(0); PG8_MMA(0, 0, At, B0); PG8_BAR; PG8_SCHED;
            PG8_LDB(B1, 1, 1); PG8_STAGE(PG8_SB(1, 0), b3, voffB);
            PG8_BAR; PG8_WAIT_L(0); PG8_MMA(0, 1, At, B1); PG8_BAR;
            PG8_LDA(At, 1, 1); PG8_STAGE_A(PG8_SA(1, 0), a3, 0, last);
            PG8_BAR; PG8_WAIT_L(0); PG8_MMA(1, 0, At, B0); PG8_BAR; PG8_SCHED;
            PG8_STAGE(PG8_SB(1, 1), b3 + hstepB, voffB);
            PG8_WAIT_V(6); PG8_BAR; PG8_MMA(1, 1, At, B1); PG8_BAR;
            }
        }
        if constexpr (ALIGN_EPI) { if (wr == 0) PG8_BAR; }
        if constexpr (!Epi::AFTER_DRAIN) { E(acc, cur, wr, wc, fr, fq); S.done(cur); }
        if (!has_next) break;
#pragma unroll
        for (int a = 0; a < 2; ++a)
#pragma unroll
            for (int b = 0; b < 2; ++b)
#pragma unroll
                for (int m = 0; m < 4; ++m)
#pragma unroll
                    for (int n = 0; n < 2; ++n) acc[a][b][m][n] = (f32x4){0.f, 0.f, 0.f, 0.f};
        cur = nxt; cA = nA; cB = nB; ++ui;
        if constexpr (GATHER) { _Pragma("unroll") for (int _h = 0; _h < 2; ++_h) _Pragma("unroll") for (int _i = 0; _i < 2; ++_i) voffGc[_h][_i] = voffGn[_h][_i]; }
        if constexpr (ALIGN_EPI) { if (wr == 1) PG8_BAR; }
    }
    PG8_WAIT_V(0);
    if constexpr (!ALIGN_EPI) { if (wr == 0) PG8_BAR; }
    PG8_BAR;
    if constexpr (Epi::AFTER_DRAIN) { E.fused(acc, cur, wr, wc, fr, fq, lds, wid, lane); S.done(cur); }
#undef PG8_SA
#undef PG8_SB
#undef PG8_STAGE
#undef PG8_STAGE_A
#undef PG8_GVOFF
#undef PG8_LDA
#undef PG8_LDB
#undef PG8_MMA
#undef PG8_WAIT_V
#undef PG8_WAIT_L
#undef PG8_BAR
#undef PG8_SCHED
}
}

#define LAS __attribute__((address_space(3)))
__host__ __device__ __forceinline__ int rope_pos(int j) { return 2 * (j & 31) + (j >> 5); }
__host__ __device__ __forceinline__ int win_dest_row(int c) {
    if (c < C_K) return (c & ~63) + rope_pos(c & 63);
    if (c < C_V) return 512 + rope_pos(c - C_K);
    if (c < C_IQ) return 512 + 64 + (c - C_V);
    if (c < C_IK) return 768 + ((c - C_IQ) & ~63) + rope_pos((c - C_IQ) & 63);
    if (c < C_IW) return 512 + 128 + rope_pos(c - C_IK);
    if (c < C_Z) return 512 + 192 + (c - C_IW);
    if (c < C_XBC) return 1024 + (c - C_Z);
    if (c < C_DT) return 1536 + (c - C_XBC);
    return 512 + 200 + (c - C_DT);
}
struct EpiInProj {
    static constexpr bool PERM = true, AFTER_DRAIN = false; static constexpr int MID_T = 0;
    bf16 *Q, *K, *V, *IK, *IQ, *Z, *XBC; float *IW, *DT; const float2* rope;
    __device__ __forceinline__ u32x4 pack8(const f32x4 a, const f32x4 b) const { u32x4 w; w.x = pg8::cvt_pk_bf16(a[0], a[1]); w.y = pg8::cvt_pk_bf16(a[2], a[3]); w.z = pg8::cvt_pk_bf16(b[0], b[1]); w.w = pg8::cvt_pk_bf16(b[2], b[3]); return w; }
    __device__ __forceinline__ u32x4 rope8(const f32x4 v0, const f32x4 v1, const f32x4 r0, const f32x4 r1, float sc) const {
        f32x4 a, b;
        a[0] = (v0[0] * r0[0] - v0[1] * r0[1]) * sc; a[1] = (v0[0] * r0[1] + v0[1] * r0[0]) * sc;
        a[2] = (v0[2] * r0[2] - v0[3] * r0[3]) * sc; a[3] = (v0[2] * r0[3] + v0[3] * r0[2]) * sc;
        b[0] = (v1[0] * r1[0] - v1[1] * r1[1]) * sc; b[1] = (v1[0] * r1[1] + v1[1] * r1[0]) * sc;
        b[2] = (v1[2] * r1[2] - v1[3] * r1[3]) * sc; b[3] = (v1[2] * r1[3] + v1[3] * r1[2]) * sc;
        return pack8(a, b);
    }
    __device__ __forceinline__ void operator()(const pg8::f32x4 (&acc)[2][2][4][2], const pg8::Unit& u, int wr, int wc, int fr, int fq) const {
        const int pn = u.pn, row0 = u.pm * 256 + wr * 64 + fr, cw = 32 * wc + 8 * fq;
        if (pn <= 1 || pn == 3) {
            bf16* dst = (pn == 3) ? IQ : Q; const int ld = (pn == 3) ? 256 : 512; const float sc = (pn == 3) ? 1.f : QSCALE; const int hb = (pn == 3) ? 0 : pn * 4;
#pragma unroll
            for (int ai = 0; ai < 2; ++ai)
#pragma unroll
                for (int m = 0; m < 4; ++m) { const int row = row0 + ai * 128 + m * 16, t = row & (SEQ - 1);
                    const f32x4* rp = (const f32x4*)(rope + t * 32 + 16 * (wc & 1) + 4 * fq); const f32x4 r0 = rp[0], r1 = rp[1];
#pragma unroll
                    for (int bj = 0; bj < 2; ++bj) { const int head = hb + 2 * bj + (wc >> 1);
                        *(u32x4*)(dst + (size_t)row * ld + head * 64 + 32 * (wc & 1) + 8 * fq) = rope8(acc[ai][bj][m][0], acc[ai][bj][m][1], r0, r1, sc); } }
        } else if (pn == 2) {
#pragma unroll
            for (int ai = 0; ai < 2; ++ai)
#pragma unroll
                for (int m = 0; m < 4; ++m) { const int row = row0 + ai * 128 + m * 16, t = row & (SEQ - 1);
                    if (wc < 2) { const f32x4* rp = (const f32x4*)(rope + t * 32 + 16 * wc + 4 * fq); const f32x4 r0 = rp[0], r1 = rp[1];
                        *(u32x4*)(K + (size_t)row * 64 + cw) = rope8(acc[ai][0][m][0], acc[ai][0][m][1], r0, r1, 1.f);
                        *(u32x4*)(IK + (size_t)row * 64 + cw) = rope8(acc[ai][1][m][0], acc[ai][1][m][1], r0, r1, 1.f);
                    } else {
                        *(u32x4*)(V + (size_t)row * 64 + (cw - 64)) = pack8(acc[ai][0][m][0], acc[ai][0][m][1]);
                        if (wc == 2 && fq == 0) *(f32x4*)(IW + (size_t)row * 4) = acc[ai][1][m][0] * INDEXER_SCALE;
                        if (wc == 2 && fq == 1) { *(f32x4*)(DT + (size_t)row * 8) = acc[ai][1][m][0]; *(f32x4*)(DT + (size_t)row * 8 + 4) = acc[ai][1][m][1]; }
                    } }
        } else {
            bf16* dst = (pn < 6) ? Z : XBC; const int ld = (pn < 6) ? 512 : 768; const int cb = (pn < 6) ? (pn - 4) * 256 : (pn - 6) * 256;
#pragma unroll
            for (int ai = 0; ai < 2; ++ai)
#pragma unroll
                for (int m = 0; m < 4; ++m) { const int row = row0 + ai * 128 + m * 16;
#pragma unroll
                    for (int bj = 0; bj < 2; ++bj) *(u32x4*)(dst + (size_t)row * ld + cb + 128 * bj + cw) = pack8(acc[ai][bj][m][0], acc[ai][bj][m][1]); }
        }
    }
};
struct EpiH1 {
    static constexpr bool PERM = true, AFTER_DRAIN = false; static constexpr int MID_T = 8;
    const float* x; bf16* out; const float* ssqp;
    __device__ __forceinline__ void mid(pg8::f32x4 (&acc)[2][2][4][2], const pg8::Unit& u, int wr, int wc, int fr, int fq) const {
        asm volatile("" : "+v"(fr));
        const int row0 = u.pm * 256 + wr * 64 + fr;
#pragma unroll
        for (int ai = 0; ai < 2; ++ai)
#pragma unroll
            for (int m = 0; m < 4; ++m) { const f32x4* sp = (const f32x4*)(ssqp + (size_t)(row0 + ai * 128 + m * 16) * 8); const f32x4 s0 = sp[0], s1 = sp[1];
                const float r = rsqrtf(((s0[0] + s0[1]) + (s0[2] + s0[3]) + (s1[0] + s1[1]) + (s1[2] + s1[3])) * (1.f / 512.f) + LN_EPS);
#pragma unroll
                for (int bj = 0; bj < 2; ++bj)
#pragma unroll
                    for (int n = 0; n < 2; ++n) acc[ai][bj][m][n] = acc[ai][bj][m][n] * r; }
    }
    __device__ __forceinline__ void operator()(const pg8::f32x4 (&acc)[2][2][4][2], const pg8::Unit& u, int wr, int wc, int fr, int fq) const {
        const int row0 = u.pm * 256 + wr * 64 + fr, col0 = u.pn * 256 + wc * 32 + 8 * fq;
#pragma unroll
        for (int ai = 0; ai < 2; ++ai)
#pragma unroll
            for (int m = 0; m < 4; ++m) { const size_t off = (size_t)(row0 + ai * 128 + m * 16) * DM + col0;
#pragma unroll
                for (int bj = 0; bj < 2; ++bj) { const u32x4 xb = *(const u32x4*)(out + off + bj * 128);
                    f32x4 h0, h1v;
                    h0[0] = __uint_as_float(xb.x << 16); h0[1] = __uint_as_float(xb.x & 0xffff0000u); h0[2] = __uint_as_float(xb.y << 16); h0[3] = __uint_as_float(xb.y & 0xffff0000u);
                    h1v[0] = __uint_as_float(xb.z << 16); h1v[1] = __uint_as_float(xb.z & 0xffff0000u); h1v[2] = __uint_as_float(xb.w << 16); h1v[3] = __uint_as_float(xb.w & 0xffff0000u);
                    h0 = h0 * ALPHA + acc[ai][bj][m][0]; h1v = h1v * ALPHA + acc[ai][bj][m][1];
                    u32x4 w; w.x = pg8::cvt_pk_bf16(h0[0], h0[1]); w.y = pg8::cvt_pk_bf16(h0[2], h0[3]); w.z = pg8::cvt_pk_bf16(h1v[0], h1v[1]); w.w = pg8::cvt_pk_bf16(h1v[2], h1v[3]);
                    *(u32x4*)(out + off + bj * 128) = w; } }
    }
};
template <class DR, class KM>
__device__ __forceinline__ void transpose_item(const float* W, int K, int N, bf16* WT, LAS float* scr, int item, int lane, DR drow, KM kmap) {
    const int nblk = (N + 31) / 32, kb = item / nblk, nb = item % nblk, k0 = 64 * kb, n0 = 32 * nb;
    float tv[32];
#pragma unroll
    for (int i = 0; i < 32; ++i) { const int kk = 2 * i + (lane >> 5), col = n0 + (lane & 31); float sc = 1.f; const int ks = kmap(k0 + kk, sc); tv[i] = (col < N) ? W[(size_t)ks * N + col] * sc : 0.f; }
#pragma unroll
    for (int i = 0; i < 32; ++i) scr[(2 * i + (lane >> 5)) * 33 + (lane & 31)] = tv[i];
    asm volatile("s_waitcnt lgkmcnt(0)" ::: "memory");
    const int c = lane & 7;
#pragma unroll
    for (int j = 0; j < 4; ++j) { const int n = (lane >> 3) + 8 * j, col = n0 + n; const LAS float* s = scr + (8 * c) * 33 + n;
        u32x4 o; o.x = pg8::cvt_pk_bf16(s[0 * 33], s[1 * 33]); o.y = pg8::cvt_pk_bf16(s[2 * 33], s[3 * 33]); o.z = pg8::cvt_pk_bf16(s[4 * 33], s[5 * 33]); o.w = pg8::cvt_pk_bf16(s[6 * 33], s[7 * 33]);
        if (col < N) *(u32x4*)(WT + (size_t)drow(col) * K + k0 + 8 * c) = o; }
    asm volatile("s_waitcnt lgkmcnt(0)" ::: "memory");
}
namespace attn_body {
using bf16=unsigned short;
using bf16x8=__attribute__((ext_vector_type(8)))short;
using s16x4=__attribute__((ext_vector_type(4)))short;
using f32x16=__attribute__((ext_vector_type(16)))float;
using u32x4=__attribute__((ext_vector_type(4)))unsigned;
constexpr int SEQ=2048,D=64,QP=512,KP=64,OP=1024;
constexpr int NW=8,QBLK=32,KVBLK=64;
__device__ __forceinline__ int crow(int r,int hi){return (r&3)+8*(r>>2)+4*hi;}
#define SBAR() __builtin_amdgcn_sched_barrier(0)
#define ATT_ANDB(X,I,M,K) do{ float t_=X[I]; asm volatile("v_and_b32_sdwa %0, sext(%1), %0 dst_sel:DWORD dst_unused:UNUSED_PAD src0_sel:BYTE_" #K " src1_sel:DWORD":"+v"(t_):"v"(M)); X[I]=t_; }while(0)
#define ATT_AND4(X,B,M) do{ ATT_ANDB(X,(B),M,0); ATT_ANDB(X,(B)+1,M,1); ATT_ANDB(X,(B)+2,M,2); ATT_ANDB(X,(B)+3,M,3); }while(0)

constexpr int NSLOT=3, SLOTB=8192;
constexpr int LDS_K=0, LDS_V=NSLOT*SLOTB, LDS_WS=2*NSLOT*SLOTB, LDS_OST=LDS_WS+NW*64*4, LDS_BYTES=LDS_OST+NW*4096;
constexpr float C2=0.125f*1.4426950408889634f;
__device__ __forceinline__ void glds16(const void*gsrc,unsigned lds_dst){unsigned keep;
  asm volatile("s_mov_b32 %0, m0\n\ts_mov_b32 m0, %2\n\ts_nop 0\n\tglobal_load_lds_dwordx4 %1, off\n\ts_mov_b32 m0, %0":"=&s"(keep):"v"(gsrc),"s"(lds_dst):"memory");}
__device__ __forceinline__ float max3f(float a,float b,float c){float r;asm("v_max3_f32 %0, %1, %2, %3":"=v"(r):"v"(a),"v"(b),"v"(c));return r;}
__device__ __forceinline__ float max2f(float a,float b){float r;asm("v_max_f32_e32 %0, %1, %2":"=v"(r):"v"(a),"v"(b));return r;}
__device__ __forceinline__ float fadd_s(float a,float b){float r;asm("v_add_f32_e32 %0, %1, %2":"=v"(r):"v"(a),"v"(b));return r;}
__device__ __forceinline__ float fsub_s(float a,float b){float r;asm("v_sub_f32_e32 %0, %1, %2":"=v"(r):"v"(a),"v"(b));return r;}
typedef float f32x2_t __attribute__((ext_vector_type(2))); typedef __bf16 bf16x2_t __attribute__((ext_vector_type(2)));
__device__ __forceinline__ unsigned cvtpk_s(float lo,float hi){f32x2_t v={lo,hi};bf16x2_t b=__builtin_convertvector(v,bf16x2_t);return __builtin_bit_cast(unsigned,b);}
#define WAIT_BAR(N) asm volatile("s_waitcnt vmcnt(" #N ") lgkmcnt(0)\n\ts_barrier":::"memory")

__device__ __forceinline__ void qkt(f32x16&p0,f32x16&p1,const char*Kslot,const bf16x8*qr,const f32x16&negm,int r32,int hi){
  const char*kb=Kslot+hi*1024+r32*16;
  #pragma unroll
  for(int d0=0;d0<4;++d0){
    const bf16x8 b0=*reinterpret_cast<const bf16x8*>(kb+d0*2048);
    const bf16x8 b1=*reinterpret_cast<const bf16x8*>(kb+d0*2048+512);
    if(d0==0){p0=__builtin_amdgcn_mfma_f32_32x32x16_bf16(b0,qr[0],negm,0,0,0);p1=__builtin_amdgcn_mfma_f32_32x32x16_bf16(b1,qr[0],negm,0,0,0);}
    else{p0=__builtin_amdgcn_mfma_f32_32x32x16_bf16(b0,qr[d0],p0,0,0,0);p1=__builtin_amdgcn_mfma_f32_32x32x16_bf16(b1,qr[d0],p1,0,0,0);}}
}
typedef __attribute__((address_space(3))) const char* lds_cptr;
typedef short v4i16_t __attribute__((ext_vector_type(4)));
__device__ __forceinline__ void kload8(bf16x8*kf,lds_cptr kp){
  kf[0]=*(const __attribute__((address_space(3))) bf16x8*)(kp);      kf[1]=*(const __attribute__((address_space(3))) bf16x8*)(kp+512);
  kf[2]=*(const __attribute__((address_space(3))) bf16x8*)(kp+2048); kf[3]=*(const __attribute__((address_space(3))) bf16x8*)(kp+2560);
  kf[4]=*(const __attribute__((address_space(3))) bf16x8*)(kp+4096); kf[5]=*(const __attribute__((address_space(3))) bf16x8*)(kp+4608);
  kf[6]=*(const __attribute__((address_space(3))) bf16x8*)(kp+6144); kf[7]=*(const __attribute__((address_space(3))) bf16x8*)(kp+6656);
}
__device__ __forceinline__ void kload2(bf16x8*kf,lds_cptr kp,int j){ kf[2*j]=*(const __attribute__((address_space(3))) bf16x8*)(kp+j*2048); kf[2*j+1]=*(const __attribute__((address_space(3))) bf16x8*)(kp+j*2048+512); }
__device__ __forceinline__ s16x4 vtr(lds_cptr p){ return __builtin_bit_cast(s16x4,__builtin_amdgcn_ds_read_tr16_b64_v4i16((__attribute__((address_space(3))) v4i16_t*)p)); }
__device__ __forceinline__ float rowmax(const f32x16&p0,const f32x16&p1){
  float a=max3f(p0[0],p0[1],p1[0]),b=max3f(p0[2],p0[3],p1[1]);a=max3f(a,p1[2],p1[3]);
  #pragma unroll
  for(int r=4;r<16;r+=4){a=max3f(a,p0[r],p0[r+1]);b=max3f(b,p0[r+2],p0[r+3]);a=max3f(a,p1[r],p1[r+1]);b=max3f(b,p1[r+2],p1[r+3]);}
  const float m=max2f(a,b);
  auto rr=__builtin_amdgcn_permlane32_swap(__float_as_uint(m),__float_as_uint(m),false,false);
  return max2f(__uint_as_float(rr[0]),__uint_as_float(rr[1]));
}
__device__ __forceinline__ void pv(f32x16*o,int vb,bf16x8 pa0,bf16x8 pa1,bf16x8 pa2,bf16x8 pa3){
  #pragma unroll
  for(int d0=0;d0<2;++d0){s16x4 lo[4],hi[4];
    #pragma unroll
    for(int ks=0;ks<4;++ks){
      asm volatile("ds_read_b64_tr_b16 %0,%1 offset:%c2":"=&v"(lo[ks]):"v"(vb),"i"(d0*4096+ks*1024):"memory");
      asm volatile("ds_read_b64_tr_b16 %0,%1 offset:%c2":"=&v"(hi[ks]):"v"(vb),"i"(d0*4096+ks*1024+512):"memory");}
    asm volatile("s_waitcnt lgkmcnt(0)":::"memory");SBAR();
    #define PK(k) (bf16x8){lo[k][0],lo[k][1],lo[k][2],lo[k][3],hi[k][0],hi[k][1],hi[k][2],hi[k][3]}
    o[d0]=__builtin_amdgcn_mfma_f32_32x32x16_bf16(pa0,PK(0),o[d0],0,0,0);
    o[d0]=__builtin_amdgcn_mfma_f32_32x32x16_bf16(pa1,PK(1),o[d0],0,0,0);
    o[d0]=__builtin_amdgcn_mfma_f32_32x32x16_bf16(pa2,PK(2),o[d0],0,0,0);
    o[d0]=__builtin_amdgcn_mfma_f32_32x32x16_bf16(pa3,PK(3),o[d0],0,0,0);
    #undef PK
  }
}

#ifndef ATTN_STORE16
#define ATTN_STORE16(p,v) (*(u32x4*)(p)=(v))
#endif
template<int THRL> __device__ __forceinline__ void attn_unit(int b,int qb,const bf16*Q,const bf16*__restrict__ K,const bf16*__restrict__ V,bf16*O,char*shm,const char*maskb,const int wave_s){
  int lane_l=lane_id(); asm volatile("":"+v"(lane_l)); const int lane=lane_l,tid=wave_s*64+lane,r32=lane&31,hi=lane>>5; const int wid=wave_s;
  const long rowbase=(long)b*SEQ; const int q0=qb*QBLK;
  const bf16*Qw=Q+(rowbase+q0)*QP+wid*D;
  const bf16*Kh=K+rowbase*KP,*Vh=V+rowbase*KP;
  const unsigned lds0=(unsigned)(uintptr_t)shm;
  float*wsf=(float*)(shm+LDS_WS)+wid*64;
  const bf16*ksrc=Kh+(long)lane*KP+wid*8;
  const bf16*vsrc=Vh+(long)(16*(wid&3)+(lane>>2))*KP+(wid>>2)*32+(lane&3)*8;
  const unsigned kdst=lds0+LDS_K+wid*1024, vdst=lds0+LDS_V+wid*1024;
  #define DMA_K(t,slot) glds16(ksrc+(long)(t)*KVBLK*KP,(unsigned)__builtin_amdgcn_readfirstlane(kdst+(slot)))
  #define DMA_V(t,slot) glds16(vsrc+(long)(t)*KVBLK*KP,(unsigned)__builtin_amdgcn_readfirstlane(vdst+(slot)))
  const int vb0=(int)(lds0+LDS_V)+((lane>>4)&1)*32+(lane&3)*8+(4*hi+((lane&15)>>2))*64;
  const char*Kbase=shm+LDS_K; bf16x8 kf[8];
  const lds_cptr shm3=(lds_cptr)shm; const lds_cptr kp0=shm3+LDS_K+hi*1024+r32*16; const lds_cptr vp0=shm3+LDS_V+((lane>>4)&1)*32+(lane&3)*8+(4*hi+((lane&15)>>2))*64;
  const int NTr=(q0+QBLK+KVBLK-1)/KVBLK; const int NT=(NTr<4)?4:((NTr+1)&~1);
  const __attribute__((address_space(3))) char*bm0=(const __attribute__((address_space(3))) char*)((__attribute__((address_space(3))) const char*)maskb)+r32*64;
  const int offA_=(((2*hi)+(r32>>2))&3)*16, offB_=(((2*hi+1)+(r32>>2))&3)*16; u32x4 mbA,mbB;
  #define LDMASK(t) do{ mbA=*(const __attribute__((address_space(3))) u32x4*)(bm0+(t)*2048+offA_); mbB=*(const __attribute__((address_space(3))) u32x4*)(bm0+(t)*2048+offB_); }while(0)
  DMA_K(0,0);DMA_V(0,0);DMA_K(1,SLOTB);
  bf16x8 qr[4];
  #pragma unroll
  for(int d0=0;d0<4;++d0)qr[d0]=*reinterpret_cast<const bf16x8*>(&Qw[(long)r32*QP+d0*16+hi*8]);
  float zz_=0.f; asm volatile("":"+v"(zz_)); float mhat=zz_,l_reg=zz_;f32x16 o[2];
  #pragma unroll
  for(int r=0;r<16;++r){o[0][r]=zz_;o[1][r]=zz_;}
  f32x16 negm;
  #pragma unroll
  for(int r=0;r<16;++r)negm[r]=zz_;
  asm volatile("":"+v"(negm));
  bool resc=false;
  #define START(P0,P1) do{ const float rm=rowmax(P0,P1); resc=false; \
    { const float dl=(rm>-INFINITY)?rm:0.f; mhat=fadd_s(mhat,dl); \
      _Pragma("unroll") for(int r=0;r<16;++r){P0[r]=fsub_s(P0[r],dl);P1[r]=fsub_s(P1[r],dl);} \
      _Pragma("unroll") for(int r=0;r<16;++r)negm[r]=-mhat; asm volatile("":"+v"(negm)); } \
    _Pragma("unroll") for(int r=0;r<16;++r)P0[r]=__builtin_amdgcn_exp2f(P0[r]); \
    ATT_AND4(P0,0,mbA[0]); ATT_AND4(P0,4,mbA[1]); ATT_AND4(P0,8,mbA[2]); ATT_AND4(P0,12,mbA[3]); }while(0)
  #define RESC() do{ if(resc){ asm volatile("s_waitcnt lgkmcnt(0)":::"memory"); \
      _Pragma("unroll") for(int d_=0;d_<2;++d_) _Pragma("unroll") for(int r=0;r<16;++r)o[d_][r]*=wsf[crow(r,hi)]; } }while(0)
  f32x16 pA0,pA1,pB0,pB1;
  int sl_prev=0,sl_cur=0,sl_next=SLOTB;
  #define ROT() do{sl_prev=sl_cur;sl_cur=sl_next;sl_next=(sl_next==(NSLOT-1)*SLOTB)?0:sl_next+SLOTB;}while(0)
  DMA_K(2,2*SLOTB);
  WAIT_BAR(3);
  LDMASK(0);
  qkt(pA0,pA1,Kbase,qr,negm,r32,hi);asm volatile("s_nop 15\n\ts_nop 7":"+v"(pA0),"+v"(pA1));
  START(pA0,pA1);
  _Pragma("unroll") for(int r=0;r<16;++r)pA1[r]=__builtin_amdgcn_exp2f(pA1[r]);
  ATT_AND4(pA1,0,mbB[0]); ATT_AND4(pA1,4,mbB[1]); ATT_AND4(pA1,8,mbB[2]); ATT_AND4(pA1,12,mbB[3]);
  WAIT_BAR(0);
  DMA_K(3,0);DMA_V(1,SLOTB);
  ROT();
  kload8(kf,kp0+sl_cur);
  WAIT_BAR(2);
  s16x4 vlo[8],vhi[8]; u32x4 pw0,pw1,pw2,pw3;
  #define PKW(P,B) cvtpk_s(P[B],P[B+1])
  #define PAF(k) __builtin_bit_cast(bf16x8,pw##k)
  #define VFR(i) (bf16x8){vlo[i][0],vlo[i][1],vlo[i][2],vlo[i][3],vhi[i][0],vhi[i][1],vhi[i][2],vhi[i][3]}
  #define PIN(x) asm volatile("":"+v"(x))
  #define MX3(a,b,c) __builtin_fmaxf(__builtin_fmaxf((a),(b)),(c))
  #define GAPA(MF,A0,A1,A2,A3,W0,W1,PW) do{ MF; sacc+=A0; sacc+=A1; sacc+=A2; sacc+=A3; PIN(sacc); W0; W1; PIN(PW); SBAR(); }while(0)
  #define EX(v) __builtin_amdgcn_exp2f(v)
  #define GAPB(MF,X,B,MR) do{ MF; X[B]=EX(X[B]); X[B+1]=EX(X[B+1]); X[B+2]=EX(X[B+2]); X[B+3]=EX(X[B+3]); ATT_AND4(X,B,MR); PIN(X); SBAR(); }while(0)
  #define VRD(i) do{ vlo[i]=vtr(vp_+(((i)>>2)*4096+((i)&3)*1024)); vhi[i]=vtr(vp_+(((i)>>2)*4096+((i)&3)*1024+512)); }while(0)
  #define KRD(G,j) do{ if(G){ kload2(kf,kp0+sl_next,j); SBAR(); } }while(0)
  #define STEP(C0,C1,P0,P1,t,GK,GV,GL) do{ SBAR(); \
    const lds_cptr vp_=vp0+sl_prev; \
    VRD(0); SBAR(); float sacc=(P0[0]+P0[1]); \
    GAPA(C0=__builtin_amdgcn_mfma_f32_32x32x16_bf16(kf[0],qr[0],negm,0,0,0), P0[2],P0[3],P0[4],P0[5],     pw0[0]=PKW(P0,0), pw0[1]=PKW(P0,2), pw0); \
    VRD(4); SBAR(); GAPA(C1=__builtin_amdgcn_mfma_f32_32x32x16_bf16(kf[1],qr[0],negm,0,0,0), P0[6],P0[7],P0[8],P0[9],     pw0[2]=PKW(P0,4), pw0[3]=PKW(P0,6), pw0); \
    VRD(1); SBAR(); GAPA(C0=__builtin_amdgcn_mfma_f32_32x32x16_bf16(kf[2],qr[1],C0,0,0,0),   P0[10],P0[11],P0[12],P0[13], pw1[0]=PKW(P0,8), pw1[1]=PKW(P0,10), pw1); \
    VRD(5); SBAR(); GAPA(C1=__builtin_amdgcn_mfma_f32_32x32x16_bf16(kf[3],qr[1],C1,0,0,0),   P0[14],P0[15],P1[0],P1[1],   pw1[2]=PKW(P0,12),pw1[3]=PKW(P0,14), pw1); \
    VRD(2); SBAR(); GAPA(C0=__builtin_amdgcn_mfma_f32_32x32x16_bf16(kf[4],qr[2],C0,0,0,0),   P1[2],P1[3],P1[4],P1[5],     pw2[0]=PKW(P1,0), pw2[1]=PKW(P1,2), pw2); \
    VRD(6); SBAR(); GAPA(C1=__builtin_amdgcn_mfma_f32_32x32x16_bf16(kf[5],qr[2],C1,0,0,0),   P1[6],P1[7],P1[8],P1[9],     pw2[2]=PKW(P1,4), pw2[3]=PKW(P1,6), pw2); \
    VRD(3); SBAR(); GAPA(C0=__builtin_amdgcn_mfma_f32_32x32x16_bf16(kf[6],qr[3],C0,0,0,0),   P1[10],P1[11],P1[12],P1[13], pw3[0]=PKW(P1,8), pw3[1]=PKW(P1,10), pw3); \
    VRD(7); SBAR(); GAPA(C1=__builtin_amdgcn_mfma_f32_32x32x16_bf16(kf[7],qr[3],C1,0,0,0),   P1[14],P1[15],0.f,0.f,       pw3[2]=PKW(P1,12),pw3[3]=PKW(P1,14), pw3); \
    l_reg+=sacc; \
    if(GK){DMA_K((t)+3,sl_cur);} if(GV){DMA_V((t)+1,sl_next);} \
    LDMASK(t); \
    { float a=MX3(C0[0],C0[1],C1[0]),b=MX3(C0[2],C0[3],C1[1]); a=MX3(a,C1[2],C1[3]); \
      _Pragma("unroll") for(int r=4;r<16;r+=4){a=MX3(a,C0[r],C0[r+1]);b=MX3(b,C0[r+2],C0[r+3]);a=MX3(a,C1[r],C1[r+1]);b=MX3(b,C1[r+2],C1[r+3]);} \
      float rm=__builtin_fmaxf(a,b); { auto rr=__builtin_amdgcn_permlane32_swap(__float_as_uint(rm),__float_as_uint(rm),false,false); rm=__builtin_fmaxf(__uint_as_float(rr[0]),__uint_as_float(rr[1])); } \
      resc=false; \
      if(__builtin_expect(__any(rm>(float)THRL),0)){ const float dl=__builtin_fmaxf(rm,0.f); mhat+=dl; \
        _Pragma("unroll") for(int r=0;r<16;++r){C0[r]-=dl;C1[r]-=dl;} \
        _Pragma("unroll") for(int r=0;r<16;++r)negm[r]=-mhat; asm volatile("":"+v"(negm)); \
        const float f=__builtin_amdgcn_exp2f(-dl); l_reg*=f; if(hi==0)wsf[r32]=f; resc=true; } } \
    SBAR(); \
    GAPB(o[0]=__builtin_amdgcn_mfma_f32_32x32x16_bf16(PAF(0),VFR(0),o[0],0,0,0), C0,0,mbA[0]); \
    GAPB(o[1]=__builtin_amdgcn_mfma_f32_32x32x16_bf16(PAF(0),VFR(4),o[1],0,0,0), C0,4,mbA[1]); \
    KRD(GL,0); GAPB(o[0]=__builtin_amdgcn_mfma_f32_32x32x16_bf16(PAF(1),VFR(1),o[0],0,0,0), C0,8,mbA[2]); \
    KRD(GL,1); GAPB(o[1]=__builtin_amdgcn_mfma_f32_32x32x16_bf16(PAF(1),VFR(5),o[1],0,0,0), C0,12,mbA[3]); \
    KRD(GL,2); GAPB(o[0]=__builtin_amdgcn_mfma_f32_32x32x16_bf16(PAF(2),VFR(2),o[0],0,0,0), C1,0,mbB[0]); \
    KRD(GL,3); GAPB(o[1]=__builtin_amdgcn_mfma_f32_32x32x16_bf16(PAF(2),VFR(6),o[1],0,0,0), C1,4,mbB[1]); \
    GAPB(o[0]=__builtin_amdgcn_mfma_f32_32x32x16_bf16(PAF(3),VFR(3),o[0],0,0,0), C1,8,mbB[2]); \
    GAPB(o[1]=__builtin_amdgcn_mfma_f32_32x32x16_bf16(PAF(3),VFR(7),o[1],0,0,0), C1,12,mbB[3]); \
    }while(0)
  int t=1;
  for(;t+5<NT;t+=2){
    STEP(pB0,pB1,pA0,pA1,t,true,true,true);     WAIT_BAR(2); RESC(); ROT();
    STEP(pA0,pA1,pB0,pB1,t+1,true,true,true);   WAIT_BAR(2); RESC(); ROT();
  }
  #define ENDW(tt) do{ if((tt)+3<NT){WAIT_BAR(2);} else if((tt)+2<NT){WAIT_BAR(1);} else {WAIT_BAR(0);} }while(0)
  for(;t+1<NT;t+=2){
    STEP(pB0,pB1,pA0,pA1,t,(t+3<NT),(t+1<NT),(t+1<NT));       ENDW(t);   RESC(); ROT();
    STEP(pA0,pA1,pB0,pB1,t+1,(t+4<NT),(t+2<NT),(t+2<NT));     ENDW(t+1); RESC(); ROT();
  }
  STEP(pB0,pB1,pA0,pA1,NT-1,false,false,false); RESC();
  { float sacc=pB0[0]+pB0[1]; _Pragma("unroll") for(int r=2;r<16;++r)sacc+=pB0[r]; _Pragma("unroll") for(int r=0;r<16;++r)sacc+=pB1[r]; l_reg+=sacc;
    pw0=(u32x4){PKW(pB0,0),PKW(pB0,2),PKW(pB0,4),PKW(pB0,6)};pw1=(u32x4){PKW(pB0,8),PKW(pB0,10),PKW(pB0,12),PKW(pB0,14)};pw2=(u32x4){PKW(pB1,0),PKW(pB1,2),PKW(pB1,4),PKW(pB1,6)};pw3=(u32x4){PKW(pB1,8),PKW(pB1,10),PKW(pB1,12),PKW(pB1,14)};
    SBAR(); pv(o,vb0+sl_cur,PAF(0),PAF(1),PAF(2),PAF(3)); }
  #undef PKW
  #undef PAF
  #undef VFR
  #undef PIN
  #undef MX3
  #undef GAPA
  #undef GAPB
  #undef EX
  #undef VRD
  #undef KRD
  #undef STEP
  #undef ENDW
  {auto rr=__builtin_amdgcn_permlane32_swap(__float_as_uint(l_reg),__float_as_uint(l_reg),false,false);l_reg=__uint_as_float(rr[0])+__uint_as_float(rr[1]);}
  if(hi==0)wsf[32+r32]=l_reg;asm volatile("s_waitcnt lgkmcnt(0)":::"memory");
  float rli[16];
  #pragma unroll
  for(int r=0;r<16;++r)rli[r]=__builtin_amdgcn_rcpf(wsf[32+crow(r,hi)]);
  bf16*Ow=O+(rowbase+q0)*OP+512+wid*D;
  { bf16*stg=(bf16*)(shm+LDS_OST)+wid*2048;
    #pragma unroll
    for(int r=0;r<16;++r){const int orow=crow(r,hi);
      #pragma unroll
      for(int d0=0;d0<2;++d0)stg[orow*64+d0*32+r32]=(bf16)(cvtpk_s(o[d0][r]*rli[r],0.f)&0xffffu);}
    asm volatile("s_waitcnt lgkmcnt(0)":::"memory");
    #pragma unroll
    for(int i=0;i<4;++i){const int row=i*8+(lane>>3),ch=lane&7; const u32x4 v=*(const u32x4*)(stg+row*64+ch*8); ATTN_STORE16(Ow+(long)row*OP+ch*8,v);} }
  asm volatile("s_waitcnt lgkmcnt(0)\n\ts_barrier":::"memory");
  #undef DMA_K
  #undef DMA_V
  #undef LDMASK
  #undef START
  #undef RESC
  #undef ROT
}
constexpr int ATTN_LDS_BYTES=LDS_BYTES;
#undef SBAR
#undef WAIT_BAR
}

constexpr int DSA_MASK_OFF = 149504, DSA_MASK_STRIDE = 66;
constexpr int DSA_BMASK_OFF = 83968;
typedef short bf16x8_t __attribute__((ext_vector_type(8)));
__device__ __forceinline__ int wave_sum_dpp_i(int x) {
    x += __builtin_amdgcn_update_dpp(0, x, 0xB1, 0xf, 0xf, true);
    x += __builtin_amdgcn_update_dpp(0, x, 0x4E, 0xf, 0xf, true);
    x += __builtin_amdgcn_update_dpp(0, x, 0x114, 0xf, 0xf, true);
    x += __builtin_amdgcn_update_dpp(0, x, 0x118, 0xf, 0xf, true);
    x += __builtin_amdgcn_update_dpp(0, x, 0x142, 0xa, 0xf, false);
    x += __builtin_amdgcn_update_dpp(0, x, 0x143, 0xc, 0xf, false);
    return __builtin_amdgcn_readlane(x, 63);
}
__device__ __forceinline__ int wave_incl_scan_dpp_i(int x) {
    int v = x;
    v += __builtin_amdgcn_update_dpp(0, x, 0x111, 0xf, 0xf, true);
    v += __builtin_amdgcn_update_dpp(0, x, 0x112, 0xf, 0xf, true);
    v += __builtin_amdgcn_update_dpp(0, x, 0x113, 0xf, 0xf, true);
    v += __builtin_amdgcn_update_dpp(0, v, 0x114, 0xf, 0xe, true);
    v += __builtin_amdgcn_update_dpp(0, v, 0x118, 0xf, 0xc, true);
    v += __builtin_amdgcn_update_dpp(0, v, 0x142, 0xa, 0xf, false);
    v += __builtin_amdgcn_update_dpp(0, v, 0x143, 0xc, 0xf, false);
    return v;
}
__device__ __forceinline__ int count_ge(const unsigned (&k)[32], unsigned cand, int nreg) {
    int cl = 0;
#pragma unroll
    for (int g4 = 0; g4 < 8; ++g4) if (4 * g4 < nreg) {
#pragma unroll
        for (int j = 0; j < 4; ++j) cl += (k[4 * g4 + j] >= cand) ? 1 : 0; }
    return wave_sum_dpp_i(cl);
}
template <int OPK> __device__ __forceinline__ float dpp_opf(float a, float b) { return OPK == 0 ? fmaxf(a, b) : fminf(a, b); }
template <int OPK> __device__ __forceinline__ float wave_reduce_f(float x) {
    const int id = OPK == 0 ? (int)0xff800000 : (int)0x7f800000;
    x = dpp_opf<OPK>(x, __int_as_float(__builtin_amdgcn_update_dpp(id, __float_as_int(x), 0xB1, 0xf, 0xf, false)));
    x = dpp_opf<OPK>(x, __int_as_float(__builtin_amdgcn_update_dpp(id, __float_as_int(x), 0x4E, 0xf, 0xf, false)));
    x = dpp_opf<OPK>(x, __int_as_float(__builtin_amdgcn_update_dpp(id, __float_as_int(x), 0x114, 0xf, 0xf, false)));
    x = dpp_opf<OPK>(x, __int_as_float(__builtin_amdgcn_update_dpp(id, __float_as_int(x), 0x118, 0xf, 0xf, false)));
    x = dpp_opf<OPK>(x, __int_as_float(__builtin_amdgcn_update_dpp(id, __float_as_int(x), 0x142, 0xa, 0xf, false)));
    x = dpp_opf<OPK>(x, __int_as_float(__builtin_amdgcn_update_dpp(id, __float_as_int(x), 0x143, 0xc, 0xf, false)));
    return __int_as_float(__builtin_amdgcn_readlane(__float_as_int(x), 63));
}
__device__ __forceinline__ unsigned binof(float v, float vmin, float scale) { const unsigned b = (unsigned)(int)__fmul_rn(__fsub_rn(v, vmin), scale); return b > 2047u ? 2047u : b; }
__device__ __forceinline__ unsigned long long select_topk(const float (&k)[32], int kk, int nvalid, int nreg, int lane, LAS unsigned* hist, unsigned* errw) {
    const float NINF = -INFINITY;
    int mlo = 0, mhi = 0;
#define SEL_PUT(i, m) do { if (lane == (i)) { mlo = (int)(unsigned)(m); mhi = (int)(unsigned)((m) >> 32); } } while (0)
#define SEL_MINE (((unsigned long long)(unsigned)mhi << 32) | (unsigned long long)(unsigned)mlo)
    if (nvalid <= kk) {
#pragma unroll
        for (int g4 = 0; g4 < 8; ++g4) if (4 * g4 < nreg) {
#pragma unroll
            for (int j = 0; j < 4; ++j) { const int i = 4 * g4 + j; const unsigned long long m = __ballot(k[i] > NINF); SEL_PUT(i, m); } }
        return SEL_MINE;
    }
    float T = 0.f; bool exact = false;
    float mx = NINF, mn = INFINITY;
#pragma unroll
    for (int g4 = 0; g4 < 8; ++g4) if (4 * g4 < nreg) {
#pragma unroll
        for (int j = 0; j < 4; ++j) { const float v = k[4 * g4 + j]; mx = fmaxf(mx, v); mn = fminf(mn, v > NINF ? v : INFINITY); } }
    const float vmax = wave_reduce_f<0>(mx), vmin = wave_reduce_f<1>(mn);
    if (vmax == vmin) { T = vmax; }
    else {
        const float scale = 2046.5f / (vmax - vmin);
        LAS u32x4* h4 = (LAS u32x4*)hist;
#pragma unroll
        for (int j = 0; j < 8; ++j) h4[lane + 64 * j] = (u32x4){0u, 0u, 0u, 0u};
#pragma unroll
        for (int g4 = 0; g4 < 8; ++g4) if (4 * g4 < nreg) {
#pragma unroll
            for (int j = 0; j < 4; ++j) __hip_atomic_fetch_add(hist + binof(k[4 * g4 + j], vmin, scale), 1u, __ATOMIC_RELAXED, __HIP_MEMORY_SCOPE_WORKGROUP); }
        u32x4 w[8];
#pragma unroll
        for (int j = 0; j < 8; ++j) w[j] = ((LAS u32x4*)(hist + 2016 - 32 * lane))[j];
        if (lane == 0) w[7][3] = 0u;
        int s = 0;
#pragma unroll
        for (int j = 0; j < 8; ++j) s += (int)((w[j][0] + w[j][1]) + (w[j][2] + w[j][3]));
        const int Pinc = wave_incl_scan_dpp_i(s);
        const unsigned long long geb = __ballot(Pinc >= kk);
        const int Lstar = __builtin_ctzll(geb);
        const int above_l = __builtin_amdgcn_readlane(Pinc - s, Lstar);
        const int binj = 2047 - 32 * Lstar - (lane & 31);
        const int cntj = (binj == 2047) ? 0 : (int)hist[binj];
        int P2 = wave_incl_scan_dpp_i(lane < 32 ? cntj : 0) + above_l;
        const int jst = __builtin_ctzll(__ballot(P2 >= kk));
        const int Bstar = 2047 - 32 * Lstar - jst, cnt_above = __builtin_amdgcn_readlane(P2 - cntj, jst), cB = __builtin_amdgcn_readlane(cntj, jst);
        const int r = kk - cnt_above;
        if (cB <= 64) {
            LAS unsigned* cand = hist; int base = 0;
#pragma unroll
            for (int g4 = 0; g4 < 8; ++g4) if (4 * g4 < nreg) {
#pragma unroll
                for (int j = 0; j < 4; ++j) { const float v = k[4 * g4 + j]; const bool c = binof(v, vmin, scale) == (unsigned)Bstar; const unsigned long long bal = __ballot(c);
                    if (bal) { if (c) cand[base + __builtin_amdgcn_mbcnt_hi((unsigned)(bal >> 32), __builtin_amdgcn_mbcnt_lo((unsigned)bal, 0u))] = __float_as_uint(v); base += __popcll(bal); } } }
            const float myc = (lane < cB) ? __uint_as_float(cand[lane]) : NINF;
            float prev = INFINITY; int cum = 0;
            for (int it = 0; it < 64; ++it) {
                const float m = wave_reduce_f<0>(myc < prev ? myc : NINF);
                cum += __popcll(__ballot(myc == m));
                if (cum >= r) { T = m; exact = (cum == r); break; }
                prev = m;
            }
        } else {
            float prev = INFINITY; int cum = 0;
            for (int it = 0; it < 2048; ++it) {
                float lm = NINF;
#pragma unroll
                for (int i = 0; i < 32; ++i) { const float v = k[i]; if (v < prev && binof(v, vmin, scale) == (unsigned)Bstar) lm = fmaxf(lm, v); }
                const float m = wave_reduce_f<0>(lm);
                int mult = 0;
#pragma unroll
                for (int i = 0; i < 32; ++i) mult += __popcll(__ballot(k[i] == m));
                cum += mult;
                if (cum >= r) { T = m; exact = (cum == r); break; }
                prev = m;
            }
        }
    }
    if (exact) {
#pragma unroll
        for (int g4 = 0; g4 < 8; ++g4) if (4 * g4 < nreg) {
#pragma unroll
            for (int j = 0; j < 4; ++j) { const int i = 4 * g4 + j; const unsigned long long m = __ballot(k[i] >= T); SEL_PUT(i, m); } }
    } else {
        int ngt = 0;
#pragma unroll
        for (int i = 0; i < 32; ++i) ngt += __popcll(__ballot(k[i] > T));
        int need = kk - ngt;
#pragma unroll
        for (int i = 0; i < 32; ++i) {
            const unsigned long long eqb = __ballot(k[i] == T);
            const int rank = __builtin_amdgcn_mbcnt_hi((unsigned)(eqb >> 32), __builtin_amdgcn_mbcnt_lo((unsigned)eqb, 0u));
            const bool sel = (k[i] > T) || ((k[i] == T) && (rank < need));
            const unsigned long long m = __ballot(sel);
            need -= __popcll(eqb); if (need < 0) need = 0;
            SEL_PUT(i, m);
        }
    }
    const unsigned long long mine = SEL_MINE;
    if (wave_sum_dpp_i(lane < 32 ? __popcll(mine) : 0) != kk && lane == 0) atomicOr(errw, 1u);
    return mine;
#undef SEL_PUT
#undef SEL_MINE
}
__device__ __forceinline__ void dsa_select(int b, int qb, const bf16* IQb, const bf16* IKb, const float* IW, unsigned char* lds, int lane, int wave, unsigned* errw) {
    lane = launder_i(lane_id());
    unsigned* keys = (unsigned*)lds; unsigned* maskw = (unsigned*)(lds + DSA_MASK_OFF);
    if (qb < TOPK / 32) {
#pragma unroll 1
        for (int j = 0; j < 4; ++j) { const int q = 4 * wave + j, t = qb * 32 + q;
            if (lane < 32) { const int lo = 64 * lane; unsigned long long m = 0ull; if (t >= lo + 63) m = ~0ull; else if (t >= lo) m = (2ull << (t - lo)) - 1ull;
                *(unsigned long long*)(maskw + q * DSA_MASK_STRIDE + 2 * lane) = m; } }
        __syncthreads();
        return;
    }
    const size_t rb = (size_t)b * SEQ; const int q0 = qb * 32; const int ntk16 = 4 * ((qb >> 1) + 1);
    const int l15 = lane & 15, l4 = lane >> 4;
    bf16x8_t a2[2][4][2]; f32x4 wq2[2][4];
#pragma unroll
    for (int rr = 0; rr < 2; ++rr)
#pragma unroll
        for (int mt = 0; mt < 4; ++mt) {
            const bf16* ar = IQb + (rb + q0 + 16 * rr + 4 * mt + (l15 >> 2)) * 256 + (l15 & 3) * 64 + 8 * l4;
            a2[rr][mt][0] = *(const bf16x8_t*)ar; a2[rr][mt][1] = *(const bf16x8_t*)(ar + 32);
            wq2[rr][mt] = *(const f32x4*)(IW + (rb + q0 + 16 * rr + 4 * mt + l4) * 4);
        }
    bf16x8_t bn[4][2];
#pragma unroll
    for (int rnd = 0; rnd < 2; ++rnd) {
        const int qb0 = q0 + 16 * rnd;
        bf16x8_t a[4][2]; f32x4 wq[4];
#pragma unroll
        for (int mt = 0; mt < 4; ++mt) { a[mt][0] = a2[rnd][mt][0]; a[mt][1] = a2[rnd][mt][1]; wq[mt] = wq2[rnd][mt]; }
        bf16x8_t bc[4][2];
#define DSA_LOADG(dst, ntb) do { _Pragma("unroll") for (int u = 0; u < 4; ++u) { const int nt_ = (ntb) + 8 * u; \
            if (nt_ < ntk16) { const bf16* br = IKb + (rb + 16 * nt_ + l15) * 64 + 8 * l4; dst[u][0] = *(const bf16x8_t*)br; dst[u][1] = *(const bf16x8_t*)(br + 32); } \
            else { dst[u][0] = (bf16x8_t){0, 0, 0, 0, 0, 0, 0, 0}; dst[u][1] = dst[u][0]; } } } while (0)
        if (rnd == 0) DSA_LOADG(bn, wave);
        for (int ntb = wave; ntb < ntk16; ntb += 32) {
#pragma unroll
            for (int u = 0; u < 4; ++u) { bc[u][0] = bn[u][0]; bc[u][1] = bn[u][1]; }
            if (ntb + 32 < ntk16) DSA_LOADG(bn, ntb + 32);
#pragma unroll
            for (int u = 0; u < 4; ++u) {
                const int nt = ntb + 8 * u;
                if (nt < ntk16) {
                    const int s = 16 * nt + l15;
                    f32x4 cc[4];
#pragma unroll
                    for (int mt = 0; mt < 4; ++mt) cc[mt] = __builtin_amdgcn_mfma_f32_16x16x32_bf16(a[mt][0], bc[u][0], (f32x4){0.f, 0.f, 0.f, 0.f}, 0, 0, 0);
#pragma unroll
                    for (int mt = 0; mt < 4; ++mt) cc[mt] = __builtin_amdgcn_mfma_f32_16x16x32_bf16(a[mt][1], bc[u][1], cc[mt], 0, 0, 0);
                    __builtin_amdgcn_sched_barrier(0);
#pragma unroll
                    for (int mt = 0; mt < 4; ++mt) {
                        const f32x4 c = cc[mt];
                        const float r0 = __int_as_float(max(__float_as_int(c[0]), 0)), r1 = __int_as_float(max(__float_as_int(c[1]), 0)), r2 = __int_as_float(max(__float_as_int(c[2]), 0)), r3 = __int_as_float(max(__float_as_int(c[3]), 0));
                        float sc = wq[mt][0] * r0; sc = fmaf(wq[mt][1], r1, sc); sc = fmaf(wq[mt][2], r2, sc); sc = fmaf(wq[mt][3], r3, sc);
                        const int ql = 4 * mt + l4, t = qb0 + ql;
                        keys[ql * 2048 + s] = (s <= t) ? __float_as_uint(sc) : 0xff800000u;
                    }
                }
            }
        }
        if (rnd == 0) DSA_LOADG(bn, wave);
#undef DSA_LOADG
        __syncthreads();
#pragma unroll 1
        for (int j = 0; j < 2; ++j) {
            const int ql = 2 * wave + j, t = qb0 + ql, kk = (t + 1 < TOPK) ? (t + 1) : TOPK, nreg = (t >> 6) + 1;
            float k[32];
#pragma unroll
            for (int i = 0; i < 32; ++i) k[i] = (i < nreg) ? __uint_as_float(keys[ql * 2048 + 64 * i + lane]) : -INFINITY;
            const unsigned long long mine = select_topk(k, kk, t + 1, nreg, lane, (LAS unsigned*)((LAS unsigned char*)lds) + ql * 2048, errw);
            if (lane < 32) *(unsigned long long*)(maskw + (16 * rnd + ql) * DSA_MASK_STRIDE + 2 * lane) = mine;
        }
        __syncthreads();
    }
}

constexpr int LD64 = 72, LD128 = 136;
constexpr int SSD_CM = 0, SSD_BM = 18432, SSD_XS = 36864, SSD_XDT = 55296, SSD_BDT = 72704, SSD_MT = 90112, SSD_HB = 124928, SSD_DTS = 134144, SSD_ACUM = 134656, SSD_CW = 135168;
__device__ __forceinline__ bf16x8_t ldfrag(const bf16* base, int row, int ld, int k0) { return *(const bf16x8_t*)(base + row * ld + k0); }
__device__ __forceinline__ void ssd_item(int b, int h, KPtr P, const bf16* XBC, const bf16* BCc, const float* DT, const bf16* Zb, bf16* ASb, float* SSQP, unsigned char* lds, int tid) {
    tid = launder_i(tid);
    const int lane = tid & 63, w = __builtin_amdgcn_readfirstlane(tid >> 6), l15 = lane & 15, l4 = lane >> 4, g = h >> 2;
    bf16* Cm = (bf16*)(lds + SSD_CM); bf16* Bm = (bf16*)(lds + SSD_BM); bf16* xs = (bf16*)(lds + SSD_XS); bf16* XdtT = (bf16*)(lds + SSD_XDT);
    bf16* BdT = (bf16*)(lds + SSD_BDT); bf16* Mt = (bf16*)(lds + SSD_MT); bf16* Hb = (bf16*)(lds + SSD_HB);
    float* dts = (float*)(lds + SSD_DTS); float* acum = (float*)(lds + SSD_ACUM);
    const float A = -__expf(P->a_log[h]), dtb = P->dt_bias[h], Dh = P->d_skip[h];
    f32x4 Hacc[2]; Hacc[0] = (f32x4){0.f, 0.f, 0.f, 0.f}; Hacc[1] = Hacc[0];
    for (int e = tid; e < 64 * LD64 / 2; e += NT) ((unsigned*)Hb)[e] = 0u;
    float* cwl = (float*)(lds + SSD_CW);
    for (int e = tid; e < 960; e += NT) { const int T = (e < 768) ? (e >> 8) : ((e - 768) >> 6), ch = e & 63, cb = (T == 0) ? h * 64 : (T == 1 ? 512 + g * 64 : 640 + g * 64);
        cwl[e] = (e < 768) ? P->conv_w[((e >> 6) & 3) * 768 + cb + ch] : P->conv_b[cb + ch]; }
    const int pt = w >> 1, ntb = 2 * (w & 1);
    const int sl = tid >> 2, sc0 = (tid & 3) * 16;
    u32x4 raw[4][2], bcv[2][2]; float dtraw = 0.f; u32x2 zc[4], zn[4];
#define SSD_LOADRAW(cc) do { const size_t rb_ = (size_t)b * SEQ + (cc) * 128; const bf16* xr_ = XBC + (rb_ + sl) * 768 + h * 64 + sc0; \
        _Pragma("unroll") for (int j_ = 0; j_ < 4; ++j_) { raw[j_][0] = *(const u32x4*)(xr_ + (j_ - 3) * 768); raw[j_][1] = *(const u32x4*)(xr_ + (j_ - 3) * 768 + 8); } \
        const bf16* bc_ = BCc + (rb_ + sl) * 256 + g * 64 + sc0; \
        bcv[0][0] = *(const u32x4*)bc_; bcv[0][1] = *(const u32x4*)(bc_ + 8); bcv[1][0] = *(const u32x4*)(bc_ + 128); bcv[1][1] = *(const u32x4*)(bc_ + 136); } while (0)
#define SSD_PREFETCH(cc, ZD) do { const size_t rb_ = (size_t)b * SEQ + (cc) * 128; \
        if (tid < 128) dtraw = DT[(rb_ + tid) * 8 + h]; \
        _Pragma("unroll") for (int jt_ = 0; jt_ < 4; ++jt_) ZD[jt_] = *(const u32x2*)(Zb + (rb_ + 16 * w + l15) * 512 + h * 64 + 16 * jt_ + 4 * l4); } while (0)
    SSD_PREFETCH(0, zc);
    for (int c = 0; c < SEQ / 128; ++c) {
        const size_t rbase = (size_t)b * SEQ + c * 128;
        SSD_LOADRAW(c);
        if (tid < 128) { const float v = dtraw + dtb; dts[tid] = (v > 20.f) ? v : log1pf(__expf(v)); }
        __syncthreads();
        if (w == 0) {
            const float a0 = dts[2 * lane] * A, a1 = dts[2 * lane + 1] * A; const float s = a0 + a1; float inc = s;
#pragma unroll
            for (int o = 1; o < 64; o <<= 1) { const float v = __shfl_up(inc, o); if (lane >= o) inc += v; }
            const float ex = inc - s; acum[2 * lane] = ex + a0; acum[2 * lane + 1] = ex + s;
        }
        __syncthreads();
        const float alast = acum[127];
        {
            const int l = sl, c0 = sc0;
            const float dtl = dts[l], dec = __expf(alast - acum[l]);
            const int tmin = 3 - (c * 128 + l);
#pragma unroll
            for (int T = 0; T < 3; ++T) {
                float v[16];
                if (T == 0) {
                    u32x4 u[4][2];
#pragma unroll
                    for (int j = 0; j < 4; ++j) { u[j][0] = raw[j][0]; u[j][1] = raw[j][1]; }
                    if (c == 0) {
#pragma unroll
                        for (int j = 0; j < 3; ++j) if (j < tmin) { u[j][0] = (u32x4){0u, 0u, 0u, 0u}; u[j][1] = u[j][0]; } }
#pragma unroll
                    for (int i = 0; i < 16; ++i) v[i] = cwl[768 + c0 + i];
#pragma unroll
                    for (int j = 0; j < 4; ++j)
#pragma unroll
                        for (int i = 0; i < 16; ++i) { const unsigned wd = u[j][i >> 3][(i >> 1) & 3]; const float xv = (i & 1) ? __uint_as_float(wd & 0xffff0000u) : __uint_as_float(wd << 16);
                            v[i] = fmaf(cwl[j * 64 + c0 + i], xv, v[i]); }
#pragma unroll
                    for (int i = 0; i < 16; ++i) v[i] = silu(v[i]);
                } else {
#pragma unroll
                    for (int i = 0; i < 16; ++i) { const unsigned wd = bcv[T - 1][i >> 3][(i >> 1) & 3]; v[i] = (i & 1) ? __uint_as_float(wd & 0xffff0000u) : __uint_as_float(wd << 16); }
                }
                bf16* dstm = (T == 0) ? xs : (T == 1 ? Bm : Cm);
                if (T == 0) {
                    u32x4 o0, o1; o0.x = pg8::cvt_pk_bf16(v[0], v[1]); o0.y = pg8::cvt_pk_bf16(v[2], v[3]); o0.z = pg8::cvt_pk_bf16(v[4], v[5]); o0.w = pg8::cvt_pk_bf16(v[6], v[7]);
                    o1.x = pg8::cvt_pk_bf16(v[8], v[9]); o1.y = pg8::cvt_pk_bf16(v[10], v[11]); o1.z = pg8::cvt_pk_bf16(v[12], v[13]); o1.w = pg8::cvt_pk_bf16(v[14], v[15]);
                    *(u32x4*)(dstm + l * LD64 + c0) = o0; *(u32x4*)(dstm + l * LD64 + c0 + 8) = o1;
                } else { *(u32x4*)(dstm + l * LD64 + c0) = bcv[T - 1][0]; *(u32x4*)(dstm + l * LD64 + c0 + 8) = bcv[T - 1][1]; }
                if (T == 0) {
#pragma unroll
                    for (int i = 0; i < 16; ++i) XdtT[(c0 + i) * LD128 + l] = f2bf(v[i] * dtl); }
                if (T == 1) {
#pragma unroll
                    for (int i = 0; i < 16; ++i) BdT[(c0 + i) * LD128 + l] = f2bf(v[i] * dec); }
            }
        }
        if (c + 1 < SEQ / 128) SSD_PREFETCH(c + 1, zn);
        __syncthreads();
        const int lrow = 16 * w + l15; const float al = acum[lrow];
        {
            const bf16x8_t c0f = ldfrag(Cm, lrow, LD64, 8 * l4), c1f = ldfrag(Cm, lrow, LD64, 32 + 8 * l4);
            for (int j = 0; j <= w; ++j) {
                const bf16x8_t bf0 = ldfrag(Bm, 16 * j + l15, LD64, 8 * l4), bf1 = ldfrag(Bm, 16 * j + l15, LD64, 32 + 8 * l4);
                f32x4 acc = (f32x4){0.f, 0.f, 0.f, 0.f};
                acc = __builtin_amdgcn_mfma_f32_16x16x32_bf16(bf0, c0f, acc, 0, 0, 0);
                acc = __builtin_amdgcn_mfma_f32_16x16x32_bf16(bf1, c1f, acc, 0, 0, 0);
                const int s0 = 16 * j + 4 * l4; float m[4];
#pragma unroll
                for (int r = 0; r < 4; ++r) { const int s = s0 + r; m[r] = (s <= lrow) ? acc[r] * __expf(al - acum[s]) : 0.f; }
                u32x2 o; o.x = pg8::cvt_pk_bf16(m[0], m[1]); o.y = pg8::cvt_pk_bf16(m[2], m[3]);
                *(u32x2*)(Mt + lrow * LD128 + s0) = o;
            }
            if ((w & 1) == 0) *(u32x2*)(Mt + lrow * LD128 + 16 * (w + 1) + 4 * l4) = (u32x2){0u, 0u};
        }
        {
            const bf16x8_t c0f = ldfrag(Cm, lrow, LD64, 8 * l4), c1f = ldfrag(Cm, lrow, LD64, 32 + 8 * l4);
            const float ea = __expf(al); const int nks = (w >> 1) + 1;
            float ssq = 0.f;
            bf16x8_t mf[4];
#pragma unroll
            for (int ks = 0; ks < 4; ++ks) mf[ks] = (ks < nks) ? ldfrag(Mt, lrow, LD128, 32 * ks + 8 * l4) : (bf16x8_t){0, 0, 0, 0, 0, 0, 0, 0};
#pragma unroll
            for (int jt = 0; jt < 4; ++jt) {
                bf16x8_t hb0 = ldfrag(Hb, 16 * jt + l15, LD64, 8 * l4), hb1 = ldfrag(Hb, 16 * jt + l15, LD64, 32 + 8 * l4), xd[4];
#pragma unroll
                for (int ks = 0; ks < 4; ++ks) if (ks < nks) xd[ks] = ldfrag(XdtT, 16 * jt + l15, LD128, 32 * ks + 8 * l4);
                f32x4 acc = (f32x4){0.f, 0.f, 0.f, 0.f};
                acc = __builtin_amdgcn_mfma_f32_16x16x32_bf16(hb0, c0f, acc, 0, 0, 0);
                acc = __builtin_amdgcn_mfma_f32_16x16x32_bf16(hb1, c1f, acc, 0, 0, 0);
                acc = acc * ea;
#pragma unroll
                for (int ks = 0; ks < 4; ++ks) if (ks < nks) acc = __builtin_amdgcn_mfma_f32_16x16x32_bf16(xd[ks], mf[ks], acc, 0, 0, 0);
                const int p0 = 16 * jt + 4 * l4;
                const u32x2 xb = *(const u32x2*)(xs + lrow * LD64 + p0);
                const u32x2 zb = zc[jt];
                const float x0 = __uint_as_float(xb.x << 16), x1 = __uint_as_float(xb.x & 0xffff0000u), x2 = __uint_as_float(xb.y << 16), x3 = __uint_as_float(xb.y & 0xffff0000u);
                const float z0 = __uint_as_float(zb.x << 16), z1 = __uint_as_float(zb.x & 0xffff0000u), z2 = __uint_as_float(zb.y << 16), z3 = __uint_as_float(zb.y & 0xffff0000u);
                f32x4 y; y[0] = (acc[0] + Dh * x0) * silu(z0); y[1] = (acc[1] + Dh * x1) * silu(z1); y[2] = (acc[2] + Dh * x2) * silu(z2); y[3] = (acc[3] + Dh * x3) * silu(z3);
                u32x2 yo; yo.x = pg8::cvt_pk_bf16(y[0], y[1]); yo.y = pg8::cvt_pk_bf16(y[2], y[3]);
                *(u32x2*)(ASb + (rbase + lrow) * 1024 + h * 64 + p0) = yo;
                ssq += (y[0] * y[0] + y[1] * y[1]) + (y[2] * y[2] + y[3] * y[3]);
            }
            ssq += __shfl_xor(ssq, 16); ssq += __shfl_xor(ssq, 32);
            if (l4 == 0) SSQP[(rbase + lrow) * 8 + h] = ssq;
        }
        __syncthreads();
        {
            const float el = __expf(alast);
            bf16x8_t xf[4];
#pragma unroll
            for (int ks = 0; ks < 4; ++ks) xf[ks] = ldfrag(XdtT, 16 * pt + l15, LD128, 32 * ks + 8 * l4);
#pragma unroll
            for (int i = 0; i < 2; ++i) {
                bf16x8_t bd[4];
#pragma unroll
                for (int ks = 0; ks < 4; ++ks) bd[ks] = ldfrag(BdT, 16 * (ntb + i) + l15, LD128, 32 * ks + 8 * l4);
                f32x4 acc = Hacc[i] * el;
#pragma unroll
                for (int ks = 0; ks < 4; ++ks) acc = __builtin_amdgcn_mfma_f32_16x16x32_bf16(xf[ks], bd[ks], acc, 0, 0, 0);
                Hacc[i] = acc;
#pragma unroll
                for (int r = 0; r < 4; ++r) Hb[(16 * pt + 4 * l4 + r) * LD64 + 16 * (ntb + i) + l15] = f2bf(acc[r]);
            }
        }
#pragma unroll
        for (int jt = 0; jt < 4; ++jt) zc[jt] = zn[jt];
    }
    __syncthreads();
#undef SSD_PREFETCH
#undef SSD_LOADRAW
}

__device__ __forceinline__ void dsa_expand_masks(int qb, unsigned char* lds, int tid) {
    const int NTr = (qb * 32 + 32 + 63) / 64, NTt = (NTr < 4) ? 4 : ((NTr + 1) & ~1);
    const unsigned* maskw = (const unsigned*)(lds + DSA_MASK_OFF);
    for (int it = tid; it < NTt * 128; it += NT) {
        const int t = it >> 7, q = (it >> 2) & 31, c = it & 3, hi = c >> 1, half = c & 1;
        const unsigned w = maskw[q * DSA_MASK_STRIDE + 2 * t + half] >> (4 * hi);
        u32x4 o;
#pragma unroll
        for (int g2 = 0; g2 < 4; ++g2) { const unsigned n = (w >> (8 * g2)) & 0xfu; o[g2] = ((n * 0x00204081u) & 0x01010101u) * 0xffu; }
        *(u32x4*)(lds + DSA_BMASK_OFF + (t * 32 + q) * 64 + ((c + (q >> 2)) & 3) * 16) = o;
    }
    __syncthreads();
}

struct MoeOrder {
    int n; const LAS int* ul;
    __device__ __forceinline__ bool next(int i, pg8::Unit& u) const { if (i >= n) return false; u.pm = ul[2 * i]; u.pn = ul[2 * i + 1]; return true; }
    __device__ __forceinline__ void a_ready(const pg8::Unit&) const {}
    __device__ __forceinline__ void done(const pg8::Unit&) const {}
};
struct EpiSwiGLU {
    static constexpr bool PERM = true, AFTER_DRAIN = false; static constexpr int MID_T = 0;
    bf16* Hid;
    __device__ __forceinline__ void operator()(const pg8::f32x4 (&acc)[2][2][4][2], const pg8::Unit& u, int wr, int wc, int fr, int fq) const {
        const int row0 = u.pm * 256 + wr * 64 + fr, pl = u.pn & 1, hc = 128 * pl + 16 * wc + 4 * fq;
#pragma unroll
        for (int ai = 0; ai < 2; ++ai)
#pragma unroll
            for (int m = 0; m < 4; ++m) { const int row = row0 + ai * 128 + m * 16;
#pragma unroll
                for (int bj = 0; bj < 2; ++bj) { const f32x4 g = acc[ai][bj][m][0], uu = acc[ai][bj][m][1]; f32x4 h;
#pragma unroll
                    for (int e = 0; e < 4; ++e) h[e] = silu(g[e]) * uu[e];
                    u32x2 w; w.x = pg8::cvt_pk_bf16(h[0], h[1]); w.y = pg8::cvt_pk_bf16(h[2], h[3]);
                    *(u32x2*)(Hid + (size_t)row * EFF + hc + 64 * bj) = w; } }
    }
};
struct EpiDown {
    static constexpr bool PERM = true, AFTER_DRAIN = false; static constexpr int MID_T = 0;
    const int* DSTI; const float* WGT; bf16* Y;
    __device__ __forceinline__ void operator()(const pg8::f32x4 (&acc)[2][2][4][2], const pg8::Unit& u, int wr, int wc, int fr, int fq) const {
        const int row0 = u.pm * 256 + wr * 64 + fr, col0 = (u.pn & 3) * 256 + 32 * wc + 8 * fq;
#pragma unroll
        for (int ai = 0; ai < 2; ++ai)
#pragma unroll
            for (int m = 0; m < 4; ++m) { const int row = row0 + ai * 128 + m * 16; const unsigned di = (unsigned)DSTI[row]; const float w = WGT[row];
                bf16* Yr = Y + (size_t)di * DM + col0;
#pragma unroll
                for (int bj = 0; bj < 2; ++bj) { const f32x4 a = acc[ai][bj][m][0] * w, b = acc[ai][bj][m][1] * w;
                    u32x4 o; o.x = pg8::cvt_pk_bf16(a[0], a[1]); o.y = pg8::cvt_pk_bf16(a[2], a[3]); o.z = pg8::cvt_pk_bf16(b[0], b[1]); o.w = pg8::cvt_pk_bf16(b[2], b[3]);
                    *(u32x4*)(Yr + 128 * bj) = o; }
                asm volatile("" ::: "memory"); }
    }
};


__device__ __forceinline__ unsigned wave_select(const unsigned (&keys)[32], int kk, int lane) {
    unsigned T = 0u;
    for (int bit = 31; bit >= 0; --bit) {
        const unsigned cand = T | (1u << bit);
        int c = 0;
#pragma unroll
        for (int i = 0; i < 32; ++i) c += (keys[i] >= cand) ? 1 : 0;
#pragma unroll
        for (int o = 1; o < 64; o <<= 1) c += __shfl_xor(c, o);
        if (c >= kk) T = cand;
    }
    unsigned mgt = 0u, meq = 0u;
#pragma unroll
    for (int i = 0; i < 32; ++i) { mgt |= (keys[i] > T) ? (1u << i) : 0u; meq |= (keys[i] == T) ? (1u << i) : 0u; }
    int ngt = __popc(mgt), neq = __popc(meq);
    int tgt = ngt, teq = neq;
#pragma unroll
    for (int o = 1; o < 64; o <<= 1) { tgt += __shfl_xor(tgt, o); teq += __shfl_xor(teq, o); }
    const int need = kk - tgt;
    if (teq == need) return mgt | meq;
    int pre = neq;
#pragma unroll
    for (int o = 1; o < 64; o <<= 1) { const int v = __shfl_up(pre, o); if (lane >= o) pre += v; }
    pre -= neq;
    unsigned sel = mgt; int taken = pre;
#pragma unroll
    for (int i = 0; i < 32; ++i) { if ((meq >> i) & 1u) { if (taken < need) sel |= (1u << i); ++taken; } }
    return sel;
}

#define XB_TMO      128
#define XB_XCNT(j)  (256  + 64 * (j))
#define XB_XSUB(j)  (1280 + 64 * (j))
#define XB_XGEN(j)  (2304 + 64 * (j))
#define XB_TOP      3328
#define XB_TOPGEN   3392
#define XCD_BAR_WORDS 3456
#define XB_SPIN_CAP (1u << 18)

__device__ __forceinline__ unsigned xb_ld(unsigned* p)              { return __hip_atomic_load(p, __ATOMIC_RELAXED, __HIP_MEMORY_SCOPE_AGENT); }
__device__ __forceinline__ unsigned xb_add(unsigned* p, unsigned v) { return __hip_atomic_fetch_add(p, v, __ATOMIC_RELAXED, __HIP_MEMORY_SCOPE_AGENT); }
__device__ __forceinline__ unsigned xb_xcc_id() { return (unsigned)__builtin_amdgcn_s_getreg((3 << 11) | 20) & 0xFu; }
#define XB_SPIN(cond, bar) do { unsigned _sp = 0; while (cond) { __builtin_amdgcn_s_sleep(1); \
    if ((++_sp & 255u) == 0u) { if (xb_ld(&(bar)[XB_TMO])) break; if (_sp > XB_SPIN_CAP) { atomicAdd(&(bar)[XB_TMO], 1u); break; } } } } while (0)

struct XcdBarrier {
    unsigned* bar; unsigned x;
    volatile LAS unsigned* st;
};

__device__ __forceinline__ XcdBarrier xcd_barrier_post(unsigned* bar, volatile LAS unsigned* st, const int wave_s) {
    XcdBarrier b; b.bar = bar; b.x = xb_xcc_id(); b.st = st;
    if (wave_s == 0 && lane_id() == 0) (void)xb_add(&bar[XB_XCNT(b.x)], 1u);
    return b;
}
__device__ __forceinline__ void xcd_barrier_complete(unsigned* bar, unsigned x, unsigned& nloc, unsigned& nx) {
    const unsigned G = gridDim.x * gridDim.y * gridDim.z;
    unsigned sum, cnt, mine, sp = 0u;
    for (;;) {
        sum = 0u; cnt = 0u; mine = 0u;
#pragma unroll
        for (unsigned j = 0; j < 16; ++j) { const unsigned c = xb_ld(&bar[XB_XCNT(j)]); sum += c; cnt += (c > 0u) ? 1u : 0u; mine = (j == x) ? c : mine; }
        if (sum == G) break;
        __builtin_amdgcn_s_sleep(1);
        if ((++sp & 255u) == 0u) { if (xb_ld(&bar[XB_TMO])) break; if (sp > XB_SPIN_CAP) { atomicAdd(&bar[XB_TMO], 1u); break; } }
    }
    nloc = mine > 0u ? mine : 1u; nx = cnt > 0u ? cnt : 1u;
}

__device__ __forceinline__ void xcd_barrier(const XcdBarrier& b, const int wave_s) {
    asm volatile("s_waitcnt vmcnt(0)" ::: "memory");
    __syncthreads();
    if (wave_s == 0 && lane_id() == 0) {
        unsigned* bar = b.bar;
        __builtin_amdgcn_s_waitcnt(0);
        unsigned nloc = b.st[0], nx = b.st[1];
        if (nloc == 0u) { xcd_barrier_complete(bar, b.x, nloc, nx); b.st[0] = nloc; b.st[1] = nx; }
        const unsigned old = xb_add(&bar[XB_XSUB(b.x)], 1u);
        const unsigned gen = old / nloc;
        if (old + 1u == (gen + 1u) * nloc) {
            __builtin_amdgcn_fence(__ATOMIC_RELEASE, "agent");
            asm volatile("s_waitcnt vmcnt(0)" ::: "memory");
            const unsigned og = xb_add(&bar[XB_TOP], 1u);
            const unsigned tg = og / nx;
            if (og + 1u == (tg + 1u) * nx) xb_add(&bar[XB_TOPGEN], 1u);
            else XB_SPIN(xb_ld(&bar[XB_TOPGEN]) == tg, bar);
            __builtin_amdgcn_fence(__ATOMIC_ACQUIRE, "agent");
            xb_add(&bar[XB_XGEN(b.x)], 1u);
            asm volatile("s_waitcnt vmcnt(0)" ::: "memory");
        } else {
            XB_SPIN(xb_ld(&bar[XB_XGEN(b.x)]) == gen, bar);
            __builtin_amdgcn_fence(__ATOMIC_ACQUIRE, "agent");
            asm volatile("s_waitcnt vmcnt(0)" ::: "memory");
        }
    }
    __syncthreads();
}


#define PHASE_VARS const KPtr P = launder_k(KP0); const int wave = wave_s, lane = launder_i(lane_id()), tid = wave * 64 + lane, gw = bid * 8 + wave; unsigned char* ws = P->ws; unsigned* ctl = (unsigned*)(ws + WS_CTL); float2* rope = (float2*)(ws + WS_ROPE); float* tokw = (float*)(ws + WS_TOKW); int* lists = (int*)(ws + WS_LISTS); bf16* Qb = (bf16*)(ws + WS_Q); bf16* Kb = (bf16*)(ws + WS_K); bf16* Vb = (bf16*)(ws + WS_V); bf16* IKb = (bf16*)(ws + WS_IK); float* IW = (float*)(ws + WS_IW); float* DT = (float*)(ws + WS_DT); bf16* IQb = (bf16*)(ws + WS_IQ); bf16* Zb = (bf16*)(ws + WS_Z); bf16* XBC = (bf16*)(ws + WS_XBC); bf16* ASb = (bf16*)(ws + WS_AS); float* X1 = (float*)(ws + WS_X1); bf16* X1b = (bf16*)(ws + WS_X1B); bf16* Y0 = (bf16*)(ws + WS_Y0); bf16* Y1 = (bf16*)(ws + WS_Y1); float* SSQP = (float*)(ws + WS_SSQP); bf16* BCc = (bf16*)(ws + WS_BCC); bf16* H1b = (bf16*)(ws + WS_X1); float* WGG = (float*)(ws + WS_RCONST + 4096); bf16* WguT = (bf16*)(ws + WS_WGU_T); bf16* WdT = (bf16*)(ws + WS_WD_T); int* ENT = (int*)(ws + WS_ENT); float* WGT = (float*)(ws + WS_ENT + 512 * 1024); int* ROWT = (int*)(ws + WS_ENT + 1024 * 1024); bf16* Xs = (bf16*)(ws + WS_XS); bf16* Hid = (bf16*)(ws + WS_HID); bf16* XB = (bf16*)(ws + WS_XB); bf16* WinT = (bf16*)(ws + WS_WIN_T); bf16* WoutT = (bf16*)(ws + WS_WOUT_T);
#ifndef PROBE_MASK
#define PROBE_MASK 0
#endif
#define STAMP(k) do { if (PROBE_MASK && bid == 0 && wave_s == 0 && lane_id() == 0) { const unsigned long long now_ = __builtin_amdgcn_s_memrealtime(); if ((PROBE_MASK >> (k)) & 1) pst[1] += now_ - pst[0]; pst[0] = now_; } } while (0)
__global__ void __launch_bounds__(NT, 2) hybrid_fwd(Params p) {
    extern __shared__ __attribute__((aligned(16))) unsigned char lds[];
    cg::grid_group grid = cg::this_grid();
    const int wave_s = __builtin_amdgcn_readfirstlane((int)threadIdx.x >> 6);
    const int G = gridDim.x, bid = blockIdx.x, NGW = G * 8;
    const KPtr KP0 = (KPtr)__builtin_amdgcn_kernarg_segment_ptr();
    volatile LAS unsigned* xst = (volatile LAS unsigned*)((LAS unsigned char*)lds + LDS_BYTES - 32);
    if (wave_s == 0 && lane_id() < 4) xst[lane_id()] = 0u;
    __syncthreads();
    const XcdBarrier xbar = xcd_barrier_post((unsigned*)(KP0->ws + WS_CTL) + CW_BAR, xst, wave_s);
    if (KP0->ws == nullptr) grid.sync();
#define GRID_SYNC() xcd_barrier(xbar, wave_s)
    volatile LAS unsigned long long* pst = (volatile LAS unsigned long long*)((LAS unsigned char*)lds + LDS_BYTES - 96);
    if (PROBE_MASK && bid == 0 && wave_s == 0 && lane_id() == 0) { pst[0] = __builtin_amdgcn_s_memrealtime(); pst[1] = 0ull; }
    {   PHASE_VARS
    for (int e = bid * NT + tid; e < SEQ * 32; e += G * NT) {
        const int t = e >> 5, i = e & 31;
        const float inv = powf(10000.0f, -(float)(2 * i) / 64.0f);
        const float ang = (float)t * inv;
        float s, c; sincosf(ang, &s, &c);
        rope[e] = make_float2(c, s);
    }
    for (int e = bid * NT + tid; e < 52 * 128; e += G * NT) {
        const int r = e >> 7, c = e & 127; const int row = (r < 4) ? (512 + 196 + r) : (512 + 208 + (r - 4));
        *(u32x4*)(WinT + (size_t)row * DM + c * 8) = (u32x4){0u, 0u, 0u, 0u};
    }
    {
        LAS float* scr = (LAS float*)((LAS unsigned char*)lds + wave * 16384);
        constexpr int I_IN = (DM / 64) * ((INW + 31) / 32), I_OUT = (DM / 64) * (DM / 32), I_GU = NEXP * 2 * 128, I_D = NEXP * 128;
        for (int it = launder_i(gw); it < I_IN; it += NGW) {
            int r = it;
            if (r < I_IN) { transpose_item(P->w_in, DM, INW, WinT, scr, r, lane, [](int c) { return win_dest_row(c); }, [](int k, float&) { return k; }); continue; } r -= I_IN;
        }
    }
    for (int e = bid * NT + tid; e < DM * 20; e += G * NT) { const int k = e / 20, j = e - k * 20; WGG[e] = P->ln1_g[k] * ((j < 4) ? P->w_rg[k * 4 + j] : P->w_re[k * 16 + (j - 4)]); }
    if (wave == 0 && bid >= G - 20) {
        float* rc = (float*)(ws + WS_RCONST); const int j = G - 1 - bid;
        float wv[16], gv[16], bv[16];
#pragma unroll
        for (int i = 0; i < 16; ++i) { const int k = lane + 64 * i; wv[i] = (j < 4) ? P->w_rg[k * 4 + j] : P->w_re[k * 16 + (j - 4)]; gv[i] = P->ln1_g[k]; bv[i] = P->ln1_b[k]; }
        float gs = 0.f, bs = 0.f;
#pragma unroll
        for (int i = 0; i < 16; ++i) { gs = fmaf(gv[i], wv[i], gs); bs = fmaf(bv[i], wv[i], bs); }
        gs = wave_sum(gs); bs = wave_sum(bs);
        if (lane == 0) { rc[j] = gs; rc[20 + j] = bs + ((j < 4) ? P->b_rg[j] : P->b_re[j - 4]); }
    }
    {
        const size_t NP = (size_t)M * DM / 8, stride = (size_t)G * NT;
        for (size_t e0 = (size_t)bid * NT + tid; e0 < NP; e0 += 8 * stride) {
            f32x4 a[8], b[8];
#pragma unroll
            for (int u = 0; u < 8; ++u) { const size_t e = e0 + u * stride; if (e < NP) { a[u] = __builtin_nontemporal_load((const f32x4*)(P->x + e * 8)); b[u] = __builtin_nontemporal_load((const f32x4*)(P->x + e * 8 + 4)); } }
#pragma unroll
            for (int u = 0; u < 8; ++u) { const size_t e = e0 + u * stride; if (e < NP) {
                u32x4 w; w.x = pg8::cvt_pk_bf16(a[u][0], a[u][1]); w.y = pg8::cvt_pk_bf16(a[u][2], a[u][3]); w.z = pg8::cvt_pk_bf16(b[u][0], b[u][1]); w.w = pg8::cvt_pk_bf16(b[u][2], b[u][3]);
                *(u32x4*)(XB + e * 8) = w; } }
        }
    }
    }
    GRID_SYNC(); STAMP(0);
    {   PHASE_VARS
    {
        pg8::Gemm g{XB, WinT, M, NPAD, DM}; pg8::StaticOrder S; S.init(M, NPAD, G, bid);
        EpiInProj E{Qb, Kb, Vb, IKb, IQb, Zb, XBC, IW, DT, rope};
        pg8::gemm_phase<EpiInProj, pg8::StaticOrder, true, true>((PG8_LAS unsigned char*)lds, g, S, E, wave_s);
    }
    }
    GRID_SYNC(); STAMP(1);
    {   PHASE_VARS
    {
        const int cgp = tid & 15;
        float cwr[4][16], cbr[16];
#pragma unroll
        for (int i = 0; i < 16; ++i) { cbr[i] = P->conv_b[512 + 16 * cgp + i];
#pragma unroll
            for (int j = 0; j < 4; ++j) cwr[j][i] = P->conv_w[j * 768 + 512 + 16 * cgp + i]; }
        const int NI = M * 16, stride = G * NT;
        for (int it0 = bid * NT + tid; it0 < NI; it0 += 4 * stride) {
            u32x4 u[4][4][2];
#pragma unroll
            for (int q = 0; q < 4; ++q) { const int it = it0 + q * stride; if (it < NI) { const int row = it >> 4; const bf16* xr = XBC + (size_t)row * 768 + 512 + 16 * cgp;
#pragma unroll
                for (int j = 0; j < 4; ++j) { u[q][j][0] = *(const u32x4*)(xr + (j - 3) * 768); u[q][j][1] = *(const u32x4*)(xr + (j - 3) * 768 + 8); } } }
#pragma unroll
            for (int q = 0; q < 4; ++q) { const int it = it0 + q * stride; if (it < NI) { const int row = it >> 4, t = row & (SEQ - 1);
                float v[16];
#pragma unroll
                for (int i = 0; i < 16; ++i) v[i] = cbr[i];
#pragma unroll
                for (int j = 0; j < 4; ++j) if (t - 3 + j >= 0) {
#pragma unroll
                    for (int i = 0; i < 16; ++i) { const unsigned wd = u[q][j][i >> 3][(i >> 1) & 3]; const float xv = (i & 1) ? __uint_as_float(wd & 0xffff0000u) : __uint_as_float(wd << 16); v[i] = fmaf(cwr[j][i], xv, v[i]); } }
#pragma unroll
                for (int i = 0; i < 16; ++i) v[i] = silu(v[i]);
                u32x4 o0, o1; o0.x = pg8::cvt_pk_bf16(v[0], v[1]); o0.y = pg8::cvt_pk_bf16(v[2], v[3]); o0.z = pg8::cvt_pk_bf16(v[4], v[5]); o0.w = pg8::cvt_pk_bf16(v[6], v[7]);
                o1.x = pg8::cvt_pk_bf16(v[8], v[9]); o1.y = pg8::cvt_pk_bf16(v[10], v[11]); o1.z = pg8::cvt_pk_bf16(v[12], v[13]); o1.w = pg8::cvt_pk_bf16(v[14], v[15]);
                *(u32x4*)(BCc + (size_t)row * 256 + 16 * cgp) = o0; *(u32x4*)(BCc + (size_t)row * 256 + 16 * cgp + 8) = o1; } }
        }
    }
    }
    GRID_SYNC(); STAMP(22);
    {   PHASE_VARS
    for (int item = bid; item < BATCH * 8; item += G) ssd_item(__builtin_amdgcn_readfirstlane(item >> 3), __builtin_amdgcn_readfirstlane(item & 7), P, XBC, BCc, DT, Zb, ASb, SSQP, lds, tid);
    {
        volatile int* qslot = (volatile int*)(lds + LDS_BYTES - 64);
        const unsigned xcc = (unsigned)__builtin_amdgcn_s_getreg((3 << 11) | 20) & 7u;
        for (;;) {
            __syncthreads();
            if (tid == 0) { int pi = -1;
                for (unsigned a = 0; a < 8 && pi < 0; ++a) { const unsigned q = (xcc + a) & 7u; const unsigned idx = atomicAdd(&ctl[CW_DSAQ + 16 * q], 1u); if (idx < 128u) pi = (int)(q * 128u + idx); }
                *qslot = pi; }
            __syncthreads();
            const int pi = __builtin_amdgcn_readfirstlane(*qslot); if (pi < 0) break;
            const int q = pi >> 7, idx = pi & 127, b = q + 8 * (idx & 1), qb = 63 - (idx >> 1);
            dsa_select(b, qb, IQb, IKb, IW, lds, lane, wave_s, &ctl[CW_ERR]);
            dsa_expand_masks(qb, lds, wave_s * 64 + launder_i(lane_id()));
            attn_body::attn_unit<8>(b, qb, Qb, Kb, Vb, ASb, (char*)lds, (const char*)lds + DSA_BMASK_OFF, wave_s);
        }
    }
    __syncthreads();
    {
        LAS float* scr = (LAS float*)((LAS unsigned char*)lds + wave * 16384);
        constexpr int I_OUT = (DM / 64) * (DM / 32), I_GU = NEXP * 2 * 128, I_D = NEXP * 128, I_ALL = I_OUT + I_GU + I_D;
        for (;;) {
            int base = 0; if (lane == 0) base = (int)atomicAdd(&ctl[CW_WQ], 8u);
            base = __builtin_amdgcn_readfirstlane(base); if (base >= I_ALL) break;
            for (int it = base; it < base + 8 && it < I_ALL; ++it) {
                int r = it;
                if (r < I_OUT) { { const float* nw = P->ssd_norm_w; transpose_item(P->w_out, DM, DM, WoutT, scr, r, lane, [](int c) { return c; }, [nw](int k, float& sc) { if (k < 512) { sc = nw[k]; return k + 512; } return k - 512; }); } continue; } r -= I_OUT;
                if (r < I_GU) { const int e = r >> 8, up = (r >> 7) & 1, sub = r & 127; const float* W = (up ? P->w_up : P->w_gate) + (size_t)e * DM * EFF;
                transpose_item(W, DM, EFF, WguT + (size_t)e * 512 * DM, scr, sub, lane, [up](int c) { return 8 * (c >> 2) + 4 * up + (c & 3); }, [](int k, float&) { return k; }); continue; } r -= I_GU;
                { const int e = r >> 7, sub = r & 127; transpose_item(P->w_down + (size_t)e * EFF * DM, EFF, DM, WdT + (size_t)e * DM * EFF, scr, sub, lane, [](int c) { return c; }, [](int k, float&) { return k; }); }
            }
        }
    }
    }
    GRID_SYNC(); STAMP(2);
    {   PHASE_VARS
    {
        pg8::Gemm g{ASb, WoutT, M, DM, DM}; pg8::StaticOrder S; S.init(M, DM, G, bid);
        EpiH1 E{P->x, H1b, SSQP};
        pg8::gemm_phase<EpiH1, pg8::StaticOrder, true, true>((PG8_LAS unsigned char*)lds, g, S, E, wave_s);
    }
    }
    GRID_SYNC(); STAMP(4);
    {   PHASE_VARS
    {
        float* Wg = (float*)lds;
        int* lcnt = (int*)(lds + 81920); int* lbase = lcnt + 16; int* rec = lbase + 16;
        float* recw = (float*)(rec + 4 * 128);
        float* rlg = recw + 2 * 128;
        float* rstat = rlg + 20 * 128;
        { f32x4 t4[10];
#pragma unroll
          for (int i = 0; i < 10; ++i) t4[i] = ((const f32x4*)WGG)[tid + NT * i];
#pragma unroll
          for (int i = 0; i < 10; ++i) ((f32x4*)Wg)[tid + NT * i] = t4[i]; }
        if (tid < 16) lcnt[tid] = 0;
        __syncthreads();
        const int rows_per_wave = M / NGW;
        const int l15 = lane & 15, ph = lane >> 4;
        {
            const bf16* hr = H1b + (size_t)(gw + NGW * l15) * DM + 4 * ph;
            const float* wb0 = Wg + (4 * ph) * 20 + l15; const float* wb1 = Wg + (4 * ph) * 20 + 16 + (l15 < 4 ? l15 : 3);
            f32x4 c0 = (f32x4){0.f, 0.f, 0.f, 0.f}, c1 = c0; float s = 0.f, ss = 0.f;
            u32x2 an[8];
#pragma unroll
            for (int u = 0; u < 8; ++u) an[u] = *(const u32x2*)(hr + 16 * u);
#pragma unroll 1
            for (int i0 = 0; i0 < 64; i0 += 8) {
                f32x4 a[8];
#pragma unroll
                for (int u = 0; u < 8; ++u) { a[u][0] = __uint_as_float(an[u].x << 16); a[u][1] = __uint_as_float(an[u].x & 0xffff0000u); a[u][2] = __uint_as_float(an[u].y << 16); a[u][3] = __uint_as_float(an[u].y & 0xffff0000u); }
                if (i0 + 8 < 64) {
#pragma unroll
                    for (int u = 0; u < 8; ++u) an[u] = *(const u32x2*)(hr + 16 * (i0 + 8 + u)); }
#pragma unroll
                for (int u = 0; u < 8; ++u) {
                    s += (a[u][0] + a[u][1]) + (a[u][2] + a[u][3]); ss += (a[u][0] * a[u][0] + a[u][1] * a[u][1]) + (a[u][2] * a[u][2] + a[u][3] * a[u][3]);
#pragma unroll
                    for (int e = 0; e < 4; ++e) { const int ko = (16 * (i0 + u) + e) * 20;
                        c0 = __builtin_amdgcn_mfma_f32_16x16x4f32(a[u][e], wb0[ko], c0, 0, 0, 0);
                        c1 = __builtin_amdgcn_mfma_f32_16x16x4f32(a[u][e], wb1[ko], c1, 0, 0, 0); }
                }
            }
            { const int ln2 = launder_i(lane); const int i16 = (ln2 ^ 16) << 2, i32 = (ln2 ^ 32) << 2;
              s += __builtin_bit_cast(float, __builtin_amdgcn_ds_bpermute(i16, __builtin_bit_cast(int, s))); s += __builtin_bit_cast(float, __builtin_amdgcn_ds_bpermute(i32, __builtin_bit_cast(int, s)));
              ss += __builtin_bit_cast(float, __builtin_amdgcn_ds_bpermute(i16, __builtin_bit_cast(int, ss))); ss += __builtin_bit_cast(float, __builtin_amdgcn_ds_bpermute(i32, __builtin_bit_cast(int, ss))); }
            const float mean = s * (1.f / DM), var = ss * (1.f / DM) - mean * mean;
            if (ph == 0) { rstat[(wave * 16 + l15) * 2] = mean; rstat[(wave * 16 + l15) * 2 + 1] = rsqrtf(var + LN_EPS); }
#pragma unroll
            for (int r = 0; r < 4; ++r) { const int rl = wave * 16 + 4 * ph + r; rlg[rl * 20 + l15] = c0[r]; if (l15 < 4) rlg[rl * 20 + 16 + l15] = c1[r]; }
        }
        __syncthreads();
        {
            f32x4 gg[4], bb[4];
#pragma unroll
            for (int j = 0; j < 4; ++j) { gg[j] = *(const f32x4*)(P->ln1_g + lane * 4 + 256 * j); bb[j] = *(const f32x4*)(P->ln1_b + lane * 4 + 256 * j); }
            for (int it = 0; it < rows_per_wave; it += 4) {
                f32x4 v[4][4];
#pragma unroll
                for (int r = 0; r < 4; ++r)
#pragma unroll
                    for (int j = 0; j < 4; ++j) { const u32x2 hb = *(const u32x2*)(H1b + (size_t)(gw + NGW * (it + r)) * DM + lane * 4 + 256 * j);
                        v[r][j][0] = __uint_as_float(hb.x << 16); v[r][j][1] = __uint_as_float(hb.x & 0xffff0000u); v[r][j][2] = __uint_as_float(hb.y << 16); v[r][j][3] = __uint_as_float(hb.y & 0xffff0000u); }
#pragma unroll
                for (int r = 0; r < 4; ++r) { const float mean = rstat[(wave * 16 + it + r) * 2], rstd = rstat[(wave * 16 + it + r) * 2 + 1];
#pragma unroll
                    for (int j = 0; j < 4; ++j) { const f32x4 o = (v[r][j] - mean) * rstd * gg[j] + bb[j]; u32x2 w; w.x = pg8::cvt_pk_bf16(o[0], o[1]); w.y = pg8::cvt_pk_bf16(o[2], o[3]);
                        *(u32x2*)(X1b + (size_t)(gw + NGW * (it + r)) * DM + lane * 4 + 256 * j) = w; } }
            }
        }
        const float* rc = (const float*)(ws + WS_RCONST);
        for (int rl = tid; rl < 8 * rows_per_wave; rl += NT) {
            const float mean = rstat[rl * 2], rstd = rstat[rl * 2 + 1];
            float lg[20];
#pragma unroll
            for (int j = 0; j < 20; ++j) lg[j] = rstd * (rlg[rl * 20 + j] - mean * rc[j]) + rc[20 + j];
            int gi = 0; float gm = lg[0];
#pragma unroll
            for (int i = 1; i < 4; ++i) if (lg[i] > gm) { gm = lg[i]; gi = i; }
            float gs = 0.f;
#pragma unroll
            for (int i = 0; i < 4; ++i) gs += __expf(lg[i] - gm);
            const float gprob = 1.f / gs;
            float el[4];
#pragma unroll
            for (int i = 0; i < 4; ++i) { float v0 = 0.f;
#pragma unroll
                for (int g2 = 0; g2 < 4; ++g2) if (g2 == gi) v0 = lg[4 + g2 * 4 + i];
                el[i] = v0; }
            int i0 = 0; float m0 = el[0];
#pragma unroll
            for (int i = 1; i < 4; ++i) if (el[i] > m0) { m0 = el[i]; i0 = i; }
            int i1 = -1; float m1 = -INFINITY;
#pragma unroll
            for (int i = 0; i < 4; ++i) if (i != i0 && el[i] > m1) { m1 = el[i]; i1 = i; }
            const float e1 = __expf(m1 - m0), inv = 1.f / (1.f + e1);
            const int ex0 = gi * 4 + i0, ex1 = gi * 4 + i1;
            rec[rl * 4 + 0] = ex0; rec[rl * 4 + 1] = atomicAdd(&lcnt[ex0], 1); rec[rl * 4 + 2] = ex1; rec[rl * 4 + 3] = atomicAdd(&lcnt[ex1], 1);
            recw[rl * 2] = inv * gprob; recw[rl * 2 + 1] = e1 * inv * gprob;
        }
        __syncthreads();
        if (tid < 16) lbase[tid] = (int)atomicAdd(&ctl[CW_CNT + 64 * tid], (unsigned)lcnt[tid]);
        __syncthreads();
        for (int rl = tid; rl < 8 * rows_per_wave; rl += NT) {
            const int row = (bid * 8 + rl / rows_per_wave) + NGW * (rl % rows_per_wave);
            const int e0 = rec[rl * 4], e1x = rec[rl * 4 + 2];
            lists[(size_t)e0 * M + lbase[e0] + rec[rl * 4 + 1]] = row * 2; lists[(size_t)e1x * M + lbase[e1x] + rec[rl * 4 + 3]] = row * 2 + 1;
            tokw[row * 2] = recw[rl * 2]; tokw[row * 2 + 1] = recw[rl * 2 + 1];
        }
    }
    }
    GRID_SYNC(); STAMP(5);
    {   PHASE_VARS
    int* tb = (int*)(lds + 135168);
    if (tid < NEXP) tb[32 + tid] = (int)((__hip_atomic_load(&ctl[CW_CNT + 64 * tid], __ATOMIC_RELAXED, __HIP_MEMORY_SCOPE_AGENT) + 255u) >> 8);
    __syncthreads();
    if (tid == 0) { int a = 0; for (int e = 0; e < NEXP; ++e) { tb[e] = a; a += tb[32 + e]; } tb[NEXP] = a; }
    __syncthreads();
    const int ntiles = tb[NEXP];
    for (int sr = bid * NT + tid; sr < ntiles * 256; sr += G * NT) {
        const int rt = sr >> 8; int e = 0;
#pragma unroll
        for (int j = 1; j < NEXP; ++j) if (rt >= tb[j]) e = j;
        const int slot = sr - tb[e] * 256; const int cnt_e = (int)__hip_atomic_load(&ctl[CW_CNT + 64 * e], __ATOMIC_RELAXED, __HIP_MEMORY_SCOPE_AGENT);
        const int en = (slot < cnt_e) ? lists[(size_t)e * M + slot] : -1;
        ENT[sr] = (en >= 0) ? ((en & 1) * M + (en >> 1)) : 2 * M; WGT[sr] = (en >= 0) ? tokw[en] : 0.f;
    }
    {
        LAS int* ul = (LAS int*)((LAS unsigned char*)lds + 135168 + 128); int n = 0;
        if (tid == 0) { for (int L = bid; L < ntiles * 2; L += G) { const int rt = L >> 1; int e = 0; for (int j = 1; j < NEXP; ++j) if (rt >= tb[j]) e = j; ul[2 * n] = rt; ul[2 * n + 1] = e * 2 + (L & 1); ++n; } ul[62] = n; }
        __syncthreads(); n = ul[62];
        LAS int* rtl = (LAS int*)((LAS unsigned char*)lds + 135168 + 512);
        for (int e = tid; e < n * 256; e += NT) { const int rt = ul[2 * (e >> 8)], ex = ul[2 * (e >> 8) + 1] >> 1, slot = (rt - tb[ex]) * 256 + (e & 255);
            const int cnt_e = (int)__hip_atomic_load(&ctl[CW_CNT + 64 * ex], __ATOMIC_RELAXED, __HIP_MEMORY_SCOPE_AGENT); rtl[e] = (slot < cnt_e) ? (lists[(size_t)ex * M + slot] >> 1) : 0; }
        __syncthreads();
        pg8::Gemm g{X1b, WguT, MAXROWS, 512, DM}; MoeOrder S{n, ul};
        EpiSwiGLU E{Hid};
        pg8::gemm_phase<EpiSwiGLU, MoeOrder, true, true, true>((PG8_LAS unsigned char*)lds, g, S, E, wave_s, rtl);
    }
    }
    GRID_SYNC(); STAMP(7);
    {   PHASE_VARS
    const LAS int* tb = (const LAS int*)((LAS unsigned char*)lds + 135168); const int ntiles = tb[NEXP];
    {
        LAS int* ul = (LAS int*)((LAS unsigned char*)lds + 135168 + 128); int n = 0;
        __syncthreads();
        if (tid == 0) { for (int L = bid; L < ntiles * 4; L += G) { const int rt = L >> 2; int e = 0; for (int j = 1; j < NEXP; ++j) if (rt >= tb[j]) e = j; ul[2 * n] = rt; ul[2 * n + 1] = e * 4 + (L & 3); ++n; } ul[62] = n; }
        __syncthreads(); n = ul[62];
        pg8::Gemm g{Hid, WdT, MAXROWS, DM, EFF}; MoeOrder S{n, ul};
        EpiDown E{ENT, WGT, Y0};
        pg8::gemm_phase<EpiDown, MoeOrder, true, true>((PG8_LAS unsigned char*)lds, g, S, E, wave_s);
    }
    }
    GRID_SYNC(); STAMP(8);
    {   PHASE_VARS
    const bool poison = __hip_atomic_load(&ctl[CW_ERR], __ATOMIC_RELAXED, __HIP_MEMORY_SCOPE_AGENT) != 0u; const float qnan = __builtin_nanf("");
    for (int row = launder_i(gw); row < M; row += NGW) {
        f32x4 v[4]; float s = 0.f;
#pragma unroll
        for (int j = 0; j < 4; ++j) { const int c0 = lane * 4 + 256 * j; const u32x2 xb = *(const u32x2*)(X1b + (size_t)row * DM + c0);
            v[j][0] = __uint_as_float(xb.x << 16) * ALPHA; v[j][1] = __uint_as_float(xb.x & 0xffff0000u) * ALPHA; v[j][2] = __uint_as_float(xb.y << 16) * ALPHA; v[j][3] = __uint_as_float(xb.y & 0xffff0000u) * ALPHA;
            const u32x2 a = *(const u32x2*)(Y0 + (size_t)row * DM + c0), b = *(const u32x2*)(Y1 + (size_t)row * DM + c0);
            v[j][0] += __uint_as_float(a.x << 16) + __uint_as_float(b.x << 16); v[j][1] += __uint_as_float(a.x & 0xffff0000u) + __uint_as_float(b.x & 0xffff0000u);
            v[j][2] += __uint_as_float(a.y << 16) + __uint_as_float(b.y << 16); v[j][3] += __uint_as_float(a.y & 0xffff0000u) + __uint_as_float(b.y & 0xffff0000u);
            s += (v[j][0] + v[j][1]) + (v[j][2] + v[j][3]); }
        const float mean = wave_sum(s) * (1.f / DM); float s2 = 0.f;
#pragma unroll
        for (int j = 0; j < 4; ++j) { v[j] = v[j] - mean; s2 += (v[j][0] * v[j][0] + v[j][1] * v[j][1]) + (v[j][2] * v[j][2] + v[j][3] * v[j][3]); }
        const float rstd = rsqrtf(wave_sum(s2) * (1.f / DM) + LN_EPS);
#pragma unroll
        for (int j = 0; j < 4; ++j) { const int c0 = lane * 4 + 256 * j;
            const f32x4 gg = *(const f32x4*)(P->ln2_g + c0), bb = *(const f32x4*)(P->ln2_b + c0);
            f32x4 o = v[j] * rstd * gg + bb; if (poison) o = (f32x4){qnan, qnan, qnan, qnan};
            *(f32x4*)(P->out + (size_t)row * DM + c0) = o; }
    }
    }
    STAMP(9);
    if (PROBE_MASK && bid == 0 && wave_s == 0 && lane_id() == 0) { const unsigned long long t0 = __builtin_amdgcn_s_memrealtime(), d = 8ull * pst[1]; while (__builtin_amdgcn_s_memrealtime() - t0 < d) __builtin_amdgcn_s_sleep(8); }
}

extern "C" void kernel_launch(void* const* d_in, const int* in_sizes, int n_in, void* d_out, int out_size, void* d_ws, size_t ws_size, hipStream_t stream) {
    static int grid = 0;
    if (grid == 0) {
        if (n_in != 20 || in_sizes[0] != M * DM || out_size != M * DM || ws_size < WS_END) { fprintf(stderr, "kernel_launch: unexpected shapes (n_in %d, in0 %d, out %d, ws %zu)\n", n_in, n_in > 0 ? in_sizes[0] : -1, out_size, ws_size); grid = -1; return; }
        int dev = 0, cus = 0, per_cu = 0;
        (void)hipGetDevice(&dev);
        (void)hipDeviceGetAttribute(&cus, hipDeviceAttributeMultiprocessorCount, dev);
        (void)hipFuncSetAttribute((const void*)hybrid_fwd, hipFuncAttributeMaxDynamicSharedMemorySize, LDS_BYTES);
        (void)hipOccupancyMaxActiveBlocksPerMultiprocessor(&per_cu, (const void*)hybrid_fwd, NT, LDS_BYTES);
        if (per_cu < 1) { fprintf(stderr, "kernel_launch: occupancy query says %d blocks/CU\n", per_cu); grid = -1; return; }
        grid = cus;
    }
    if (grid < 0) return;
    (void)hipMemsetAsync((char*)d_ws + WS_CTL, 0, CTL_BYTES, stream);
    Params p{};
    const float** f = (const float**)&p;
    for (int i = 0; i < 20; ++i) f[i] = (const float*)d_in[i];
    p.out = (float*)d_out; p.ws = (unsigned char*)d_ws;
    void* args[] = {&p};
    hipError_t e = hipLaunchCooperativeKernel((const void*)hybrid_fwd, dim3(grid), dim3(NT), args, LDS_BYTES, stream);
    if (e != hipSuccess) fprintf(stderr, "cooperative launch failed: %s (grid %d)\n", hipGetErrorString(e), grid);
}
```

```cpp
#include <hip/hip_runtime.h>
#include <hip/hip_cooperative_groups.h>
#include <cstdio>
#include <cstdint>
namespace cg = cooperative_groups;

constexpr int BATCH = 16, SEQ = 2048, DM = 1024, M = BATCH * SEQ;
constexpr int INW = 2252;
constexpr int C_Q = 0, C_K = 512, C_V = 576, C_IQ = 640, C_IK = 896, C_IW = 960, C_Z = 964, C_XBC = 1476, C_DT = 2244;
constexpr int NEXP = 16, EFF = 256;
constexpr float LN_EPS = 1e-5f;
constexpr float ALPHA = 1.189207115002721f;
constexpr float INDEXER_SCALE = 0.0625f;
constexpr float QSCALE = 0.125f * 1.4426950408889634f;
constexpr int TOPK = 256;
constexpr int NT = 512;
constexpr int LDS_BYTES = 163840;

constexpr size_t MiB = 1u << 20;
constexpr size_t WS_CTL = 0, CTL_BYTES = 1 * MiB;
constexpr size_t WS_ROPE = 1 * MiB;
constexpr size_t WS_TOKW = 2 * MiB;
constexpr size_t WS_LISTS = 3 * MiB;
constexpr size_t WS_WIN_T = 8 * MiB;
constexpr size_t WS_WOUT_T = 16 * MiB;
constexpr size_t WS_WGU_T = 18 * MiB;
constexpr size_t WS_WD_T = 34 * MiB;
constexpr size_t WS_RCONST = 7 * MiB;
constexpr size_t WS_ENT = 5 * MiB;
constexpr size_t WS_XS = 48 * MiB;
constexpr size_t WS_HID = 192 * MiB;
constexpr int MAXTILES = 272, MAXROWS = MAXTILES * 256;
constexpr size_t WS_XB = 256 * MiB;
constexpr int NPAD = 2304;
constexpr size_t WS_Q = 48 * MiB;
constexpr size_t WS_K = 80 * MiB, WS_V = 84 * MiB, WS_IK = 88 * MiB;
constexpr size_t WS_IW = 92 * MiB;
constexpr size_t WS_DT = 93 * MiB;
constexpr size_t WS_IQ = 96 * MiB;
constexpr size_t WS_Z = 112 * MiB;
constexpr size_t WS_XBC = 144 * MiB;
constexpr size_t WS_AS = 192 * MiB;
constexpr size_t WS_X1 = 256 * MiB;
constexpr size_t WS_X1B = 384 * MiB;
constexpr size_t WS_Y0 = 48 * MiB, WS_Y1 = 112 * MiB;
constexpr size_t WS_P32 = 224 * MiB;
constexpr size_t WS_XC = 256 * MiB;
constexpr size_t WS_BCC = 320 * MiB;
constexpr size_t WS_SSQP = 42 * MiB;
constexpr size_t WS_END = 512 * MiB;
constexpr int CW_CNT = 8192;
constexpr int CW_BAR = 4096;
constexpr int CW_ERR = 32;
constexpr int CW_WQ = 48;
constexpr int CW_DSAQ = 128;

typedef unsigned short bf16;
typedef float f32x4 __attribute__((ext_vector_type(4)));
typedef unsigned u32x4 __attribute__((ext_vector_type(4)));
typedef unsigned u32x2 __attribute__((ext_vector_type(2)));

struct Params {
    const float* x; const float* w_in; const float* conv_w; const float* conv_b; const float* dt_bias; const float* a_log; const float* d_skip;
    const float* ssd_norm_w; const float* w_out; const float* ln1_g; const float* ln1_b; const float* w_rg; const float* b_rg; const float* w_re; const float* b_re;
    const float* w_gate; const float* w_up; const float* w_down; const float* ln2_g; const float* ln2_b;
    float* out; unsigned char* ws;
};

__device__ __forceinline__ int launder_i(int v);
__device__ __forceinline__ int lane_id() { unsigned m = ~0u; asm volatile("" : "+s"(m)); return (int)__builtin_amdgcn_mbcnt_hi(m, __builtin_amdgcn_mbcnt_lo(m, 0u)); }
typedef const __attribute__((address_space(4))) Params* KPtr;
__device__ __forceinline__ KPtr launder_k(KPtr k) { asm volatile("" : "+s"(k)); return k; }
__device__ __forceinline__ float bf2f(bf16 v) { return __uint_as_float((unsigned)v << 16); }
__device__ __forceinline__ bf16 f2bf(float f) { unsigned u = __float_as_uint(f); return (bf16)((u + 0x7fffu + ((u >> 16) & 1u)) >> 16); }
__device__ __forceinline__ float silu(float v) { return v * __builtin_amdgcn_rcpf(1.f + __expf(-v)); }
__device__ __forceinline__ float wave_sum(float v) {
#define WS_DPP(ctrl, rm, bc) v += __int_as_float(__builtin_amdgcn_update_dpp(0, __float_as_int(v), ctrl, rm, 0xf, bc))
    WS_DPP(0xB1, 0xf, true); WS_DPP(0x4E, 0xf, true); WS_DPP(0x114, 0xf, true); WS_DPP(0x118, 0xf, true); WS_DPP(0x142, 0xa, false); WS_DPP(0x143, 0xc, false);
#undef WS_DPP
    return __int_as_float(__builtin_amdgcn_readlane(__float_as_int(v), 63));
}
__device__ __forceinline__ float wave_max(float v) {
#pragma unroll
    for (int o = 1; o < 64; o <<= 1) v = fmaxf(v, __shfl_xor(v, o));
    return v;
}
__device__ __forceinline__ int launder_i(int v) { asm volatile("" : "+v"(v)); return v; }
__device__ __forceinline__ unsigned sortkey(float f) { unsigned u = __float_as_uint(f); return (u & 0x80000000u) ? ~u : (u | 0x80000000u); }

namespace pg8 {
#define PG8_LAS __attribute__((address_space(3)))
typedef unsigned short bf16_t;
typedef short bf16x8 __attribute__((ext_vector_type(8)));
typedef float f32x4 __attribute__((ext_vector_type(4)));
typedef unsigned u32x4 __attribute__((ext_vector_type(4)));
constexpr int BM = 256, BK = 64, HALF = 128, HTB = HALF * BK * 2  , STAGE_BYTES = 8 * HTB, NXCD = 8, WGM = 8;

__host__ __device__ __forceinline__ int lds_byte(int r, int c) { const int st = (r >> 4) * 2 + (c >> 5), rr = r & 15, cc = c & 31, ob = rr * 64 + cc * 2; return st * 1024 + (ob ^ (((ob >> 9) & 1) << 5)); }
__host__ __device__ __forceinline__ void stage_rc(int b, int& R, int& C) { const int st = b / 1024, sb = b % 1024, swz = sb ^ (((sb >> 9) & 1) << 5); R = (st >> 1) * 16 + swz / 64; C = (st & 1) * 32 + (swz % 64) / 2; }
__host__ __device__ __forceinline__ int perm32(int rho) { const int n = rho >> 4, i = rho & 15; return 8 * (i >> 2) + 4 * n + (i & 3); }

struct Unit { int pm, pn; };
struct Gemm { const bf16_t* A; const bf16_t* Bt; int M, N, K; };

struct StaticOrder {
    int nM, nN, nwg, G, c;
    __host__ __device__ void init(int M, int N, int G_, int c_) { nM = M / BM; nN = N / BM; nwg = nM * nN; G = G_; c = c_; }
    __host__ __device__ bool next(int i, Unit& u) const {
        const long L = (long)i * G + c; if (L >= nwg) return false;
        int wgid = (int)L; { const int q = nwg / NXCD, r = nwg % NXCD, xcd = wgid % NXCD, off = wgid / NXCD; wgid = (xcd < r ? xcd * (q + 1) : r * (q + 1) + (xcd - r) * q) + off; }
        const int nig = WGM * nN, gid = wgid / nig, fm = gid * WGM, gsz = (nM - fm) < WGM ? (nM - fm) : WGM;
        u.pm = fm + ((wgid % nig) % gsz); u.pn = (wgid % nig) / gsz; return true;
    }
    __device__ __forceinline__ void a_ready(const Unit&) const {}
    __device__ __forceinline__ void done(const Unit&) const {}
};

__device__ __forceinline__ unsigned cvt_pk_bf16(float lo, float hi) { unsigned r; asm volatile("v_cvt_pk_bf16_f32 %0, %1, %2" : "=v"(r) : "v"(lo), "v"(hi)); return r; }
template <class Epi, class Sched, bool ALIGN_EPI = false, bool SP2 = false, bool GATHER = false>
__device__ __forceinline__ void gemm_phase(PG8_LAS unsigned char* lds, const Gemm g, const Sched& S, const Epi& E, const int wave_s, const PG8_LAS int* rtl = nullptr) {
    int tid_l = wave_s * 64 + lane_id(); asm volatile("" : "+v"(tid_l));
    const int tid = tid_l, wid = wave_s, lane = tid & 63, wr = wid >> 2, wc = wid & 3, fr = lane & 15, fq = lane >> 4;
    const int K = g.K, nt = K / BK;
    unsigned voffA[2], voffB[2];
#pragma unroll
    for (int i = 0; i < 2; ++i) { int R, C; stage_rc(tid * 16 + i * 8192, R, C); const int Rb = Epi::PERM ? ((R & ~31) + perm32(R & 31)) : R;
        voffA[i] = (unsigned)(R * K + C) * 2u; voffB[i] = (unsigned)(Rb * K + C) * 2u; }
    const size_t kstep = (size_t)(BK * 2);
    const size_t hstepB = (size_t)HALF * K * 2;
    const size_t tstep = 2 * hstepB;
    const size_t hstep = GATHER ? 0 : hstepB, tstepA = GATHER ? 0 : tstep;
    int rowA[2]; { int R, C; stage_rc(tid * 16, R, C); rowA[0] = R; stage_rc(tid * 16 + 8192, R, C); rowA[1] = R; }
    unsigned voffGc[2][2], voffGn[2][2];
#define PG8_GVOFF(dst, uidx) do { _Pragma("unroll") for (int _h = 0; _h < 2; ++_h) _Pragma("unroll") for (int _i = 0; _i < 2; ++_i) { int R_, C_; stage_rc(tid * 16 + _i * 8192, R_, C_); \
        dst[_h][_i] = (unsigned)rtl[(uidx) * 256 + _h * 128 + R_] * (unsigned)(K * 2) + (unsigned)(C_ * 2); } } while (0)
    const unsigned ldsw = (unsigned)wid * 1024u;
    const int aoff = lds_byte(wr * 64 + fr, fq * 8), boff = lds_byte(wc * 32 + fr, fq * 8);
#define PG8_SA(b, h) (((b) * 2 + (h)) * HTB)
#define PG8_SB(b, h) ((4 + (b) * 2 + (h)) * HTB)
#define PG8_STAGE(bufoff, gbase, voff) do { _Pragma("unroll") for (int _i = 0; _i < 2; ++_i) \
        __builtin_amdgcn_global_load_lds((const unsigned*)((const char*)(gbase) + (voff)[_i]), (PG8_LAS unsigned*)(lds + (bufoff) + ldsw + _i * 8192), 16, 0, 0); } while (0)
#define PG8_STAGE_A(bufoff, gbase, h, nx) do { if constexpr (GATHER) { if (nx) PG8_STAGE(bufoff, gbase, voffGn[h]); else PG8_STAGE(bufoff, gbase, voffGc[h]); } else PG8_STAGE(bufoff, gbase, voffA); } while (0)
#define PG8_LDA(dst, b, h) do { _Pragma("unroll") for (int m = 0; m < 4; ++m) _Pragma("unroll") for (int k = 0; k < 2; ++k) dst[m][k] = *(const PG8_LAS bf16x8*)(lds + PG8_SA(b, h) + aoff + m * 2048 + k * 1024); } while (0)
#define PG8_LDB(dst, b, h) do { _Pragma("unroll") for (int n = 0; n < 2; ++n) _Pragma("unroll") for (int k = 0; k < 2; ++k) dst[n][k] = *(const PG8_LAS bf16x8*)(lds + PG8_SB(b, h) + boff + n * 2048 + k * 1024); } while (0)
#define PG8_MMA(ai, bj, At, Bt) do { __builtin_amdgcn_s_setprio(1); _Pragma("unroll") for (int m = 0; m < 4; ++m) _Pragma("unroll") for (int n = 0; n < 2; ++n) _Pragma("unroll") for (int k = 0; k < 2; ++k) \
        acc[ai][bj][m][n] = __builtin_amdgcn_mfma_f32_16x16x32_bf16(Bt[n][k], At[m][k], acc[ai][bj][m][n], 0, 0, 0); __builtin_amdgcn_s_setprio(0); } while (0)
#define PG8_WAIT_V(n) asm volatile("s_waitcnt vmcnt(" #n ")" ::: "memory")
#define PG8_WAIT_L(n) asm volatile("s_waitcnt lgkmcnt(" #n ")" ::: "memory")
#define PG8_BAR __builtin_amdgcn_s_barrier()
#define PG8_SCHED __builtin_amdgcn_sched_barrier(0)
    Unit cur, nxt; int ui = 0;
    if (!S.next(0, cur)) return;
    f32x4 acc[2][2][4][2];
#pragma unroll
    for (int a = 0; a < 2; ++a)
#pragma unroll
        for (int b = 0; b < 2; ++b)
#pragma unroll
            for (int m = 0; m < 4; ++m)
#pragma unroll
                for (int n = 0; n < 2; ++n) acc[a][b][m][n] = (f32x4){0.f, 0.f, 0.f, 0.f};
    bf16x8 At[4][2], B0[2][2], B1[2][2];
    const char* cA = (const char*)g.A + (size_t)cur.pm * tstepA; const char* cB = (const char*)g.Bt + (size_t)cur.pn * tstep;
    if constexpr (GATHER) { PG8_GVOFF(voffGc, 0); _Pragma("unroll") for (int _h = 0; _h < 2; ++_h) _Pragma("unroll") for (int _i = 0; _i < 2; ++_i) voffGn[_h][_i] = voffGc[_h][_i]; }
    S.a_ready(cur);
    if constexpr (SP2) {
        PG8_STAGE(PG8_SB(0, 0), cB, voffB); PG8_STAGE(PG8_SB(0, 1), cB + hstepB, voffB); PG8_STAGE_A(PG8_SA(0, 0), cA, 0, false); PG8_STAGE_A(PG8_SA(0, 1), cA + hstep, 1, false);
        if (wr == 1) PG8_BAR;
        PG8_WAIT_V(2); PG8_BAR;
        PG8_STAGE(PG8_SB(1, 0), cB + kstep, voffB); PG8_STAGE_A(PG8_SA(1, 0), cA + kstep, 0, false); PG8_STAGE(PG8_SB(1, 1), cB + hstepB + kstep, voffB);
        PG8_WAIT_V(6); PG8_BAR;
    } else {
        PG8_STAGE(PG8_SB(0, 0), cB, voffB); PG8_STAGE_A(PG8_SA(0, 0), cA, 0, false); PG8_STAGE(PG8_SB(0, 1), cB + hstepB, voffB); PG8_STAGE_A(PG8_SA(0, 1), cA + hstep, 1, false);
        if (wr == 1) PG8_BAR;
        PG8_WAIT_V(4); PG8_BAR;
        PG8_STAGE(PG8_SB(1, 0), cB + kstep, voffB); PG8_STAGE_A(PG8_SA(1, 0), cA + kstep, 0, false); PG8_STAGE(PG8_SB(1, 1), cB + hstepB + kstep, voffB);
        PG8_WAIT_V(6); PG8_BAR;
    }
    for (;;) {
        const bool has_next = S.next(ui + 1, nxt);
        const char* nA = has_next ? (const char*)g.A + (size_t)nxt.pm * tstepA : cA; const char* nB = has_next ? (const char*)g.Bt + (size_t)nxt.pn * tstep : cB;
        for (int t = 0; t < nt; t += 2) {
            if constexpr (Epi::MID_T > 0) { if (t == Epi::MID_T) E.mid(acc, cur, wr, wc, fr, fq); }
            const bool last = (t == nt - 2);
            const char* a1 = cA + (size_t)(t + 1) * kstep;
            const char* a2 = last ? nA : cA + (size_t)(t + 2) * kstep; const char* b2 = last ? nB : cB + (size_t)(t + 2) * kstep;
            const char* a3 = a2 + kstep; const char* b3 = b2 + kstep;
            if (last && has_next) { S.a_ready(nxt); if constexpr (GATHER) PG8_GVOFF(voffGn, ui + 1); }
            if constexpr (SP2) {
            PG8_LDB(B0, 0, 0); PG8_LDB(B1, 0, 1); PG8_SCHED; PG8_LDA(At, 0, 0); PG8_STAGE_A(PG8_SA(1, 1), a1 + hstep, 1, false);
            PG8_WAIT_V(8); PG8_WAIT_L(0); PG8_BAR; PG8_MMA(0, 0, At, B0); PG8_MMA(0, 1, At, B1); PG8_BAR; PG8_SCHED;
            PG8_LDA(At, 0, 1); PG8_STAGE(PG8_SB(0, 0), b2, voffB); PG8_STAGE(PG8_SB(0, 1), b2 + hstepB, voffB); PG8_STAGE_A(PG8_SA(0, 0), a2, 0, last);
            PG8_WAIT_V(8); PG8_WAIT_L(0); PG8_BAR; PG8_MMA(1, 0, At, B0); PG8_MMA(1, 1, At, B1); PG8_BAR; PG8_SCHED;
            PG8_LDB(B0, 1, 0); PG8_LDB(B1, 1, 1); PG8_SCHED; PG8_LDA(At, 1, 0); PG8_STAGE_A(PG8_SA(0, 1), a2 + hstep, 1, last);
            PG8_WAIT_V(8); PG8_WAIT_L(0); PG8_BAR; PG8_MMA(0, 0, At, B0); PG8_MMA(0, 1, At, B1); PG8_BAR; PG8_SCHED;
            PG8_LDA(At, 1, 1); PG8_STAGE(PG8_SB(1, 0), b3, voffB); PG8_STAGE(PG8_SB(1, 1), b3 + hstepB, voffB); PG8_STAGE_A(PG8_SA(1, 0), a3, 0, last);
            PG8_WAIT_V(8); PG8_WAIT_L(0); PG8_BAR; PG8_MMA(1, 0, At, B0); PG8_MMA(1, 1, At, B1); PG8_BAR; PG8_SCHED;
            } else {
            PG8_LDB(B0, 0, 0); PG8_SCHED; PG8_LDA(At, 0, 0); PG8_STAGE_A(PG8_SA(1, 1), a1 + hstep, 1, false);
            PG8_WAIT_L(8); PG8_BAR; PG8_WAIT_L(0); PG8_MMA(0, 0, At, B0); PG8_BAR; PG8_SCHED;
            PG8_LDB(B1, 0, 1); PG8_STAGE(PG8_SB(0, 0), b2, voffB);
            PG8_BAR; PG8_WAIT_L(0); PG8_MMA(0, 1, At, B1); PG8_BAR;
            PG8_LDA(At, 0, 1); PG8_STAGE_A(PG8_SA(0, 0), a2, 0, last);
            PG8_BAR; PG8_WAIT_L(0); PG8_MMA(1, 0, At, B0); PG8_BAR; PG8_SCHED;
            PG8_STAGE(PG8_SB(0, 1), b2 + hstepB, voffB);
            PG8_WAIT_V(6); PG8_BAR; PG8_MMA(1, 1, At, B1); PG8_BAR;
            PG8_LDB(B0, 1, 0); PG8_SCHED; PG8_LDA(At, 1, 0); PG8_STAGE_A(PG8_SA(0, 1), a2 + hstep, 1, last);
            PG8_WAIT_L(8); PG8_BAR; PG8_WAIT_L(0); PG8_MMA(0, 0, At, B0); PG8_BAR; PG8_SCHED;
            PG8_LDB(B1, 1, 1); PG8_STAGE(PG8_SB(1, 0), b3, voffB);
            PG8_BAR; PG8_WAIT_L(0); PG8_MMA(0, 1, At, B1); PG8_BAR;
            PG8_LDA(At, 1, 1); PG8_STAGE_A(PG8_SA(1, 0), a3, 0, last);
            PG8_BAR; PG8_WAIT_L(0); PG8_MMA(1, 0, At, B0); PG8_BAR; PG8_SCHED;
            PG8_STAGE(PG8_SB(1, 1), b3 + hstepB, voffB);
            PG8_WAIT_V(6); PG8_BAR; PG8_MMA(1, 1, At, B1); PG8_BAR;
            }
        }
        if constexpr (ALIGN_EPI) { if (wr == 0) PG8_BAR; }
        if constexpr (!Epi::AFTER_DRAIN) { E(acc, cur, wr, wc, fr, fq); S.done(cur); }
        if (!has_next) break;
#pragma unroll
        for (int a = 0; a < 2; ++a)
#pragma unroll
            for (int b = 0; b < 2; ++b)
#pragma unroll
                for (int m = 0; m < 4; ++m)
#pragma unroll
                    for (int n = 0; n < 2; ++n) acc[a][b][m][n] = (f32x4){0.f, 0.f, 0.f, 0.f};
        cur = nxt; cA = nA; cB = nB; ++ui;
        if constexpr (GATHER) { _Pragma("unroll") for (int _h = 0; _h < 2; ++_h) _Pragma("unroll") for (int _i = 0; _i < 2; ++_i) voffGc[_h][_i] = voffGn[_h][_i]; }
        if constexpr (ALIGN_EPI) { if (wr == 1) PG8_BAR; }
    }
    PG8_WAIT_V(0);
    if constexpr (!ALIGN_EPI) { if (wr == 0) PG8_BAR; }
    PG8_BAR;
    if constexpr (Epi::AFTER_DRAIN) { E.fused(acc, cur, wr, wc, fr, fq, lds, wid, lane); S.done(cur); }
#undef PG8_SA
#undef PG8_SB
#undef PG8_STAGE
#undef PG8_STAGE_A
#undef PG8_GVOFF
#undef PG8_LDA
#undef PG8_LDB
#undef PG8_MMA
#undef PG8_WAIT_V
#undef PG8_WAIT_L
#undef PG8_BAR
#undef PG8_SCHED
}
}

#define LAS __attribute__((address_space(3)))
__host__ __device__ __forceinline__ int rope_pos(int j) { return 2 * (j & 31) + (j >> 5); }
__host__ __device__ __forceinline__ int win_dest_row(int c) {
    if (c < C_K) return (c & ~63) + rope_pos(c & 63);
    if (c < C_V) return 512 + rope_pos(c - C_K);
    if (c < C_IQ) return 512 + 64 + (c - C_V);
    if (c < C_IK) return 768 + ((c - C_IQ) & ~63) + rope_pos((c - C_IQ) & 63);
    if (c < C_IW) return 512 + 128 + rope_pos(c - C_IK);
    if (c < C_Z) return 512 + 192 + (c - C_IW);
    if (c < C_XBC) return 1024 + (c - C_Z);
    if (c < C_DT) return 1536 + (c - C_XBC);
    return 512 + 200 + (c - C_DT);
}
struct EpiInProj {
    static constexpr bool PERM = true, AFTER_DRAIN = false; static constexpr int MID_T = 0;
    bf16 *Q, *K, *V, *IK, *IQ, *Z, *XBC; float *IW, *DT; const float2* rope;
    __device__ __forceinline__ u32x4 pack8(const f32x4 a, const f32x4 b) const { u32x4 w; w.x = pg8::cvt_pk_bf16(a[0], a[1]); w.y = pg8::cvt_pk_bf16(a[2], a[3]); w.z = pg8::cvt_pk_bf16(b[0], b[1]); w.w = pg8::cvt_pk_bf16(b[2], b[3]); return w; }
    __device__ __forceinline__ u32x4 rope8(const f32x4 v0, const f32x4 v1, const f32x4 r0, const f32x4 r1, float sc) const {
        f32x4 a, b;
        a[0] = (v0[0] * r0[0] - v0[1] * r0[1]) * sc; a[1] = (v0[0] * r0[1] + v0[1] * r0[0]) * sc;
        a[2] = (v0[2] * r0[2] - v0[3] * r0[3]) * sc; a[3] = (v0[2] * r0[3] + v0[3] * r0[2]) * sc;
        b[0] = (v1[0] * r1[0] - v1[1] * r1[1]) * sc; b[1] = (v1[0] * r1[1] + v1[1] * r1[0]) * sc;
        b[2] = (v1[2] * r1[2] - v1[3] * r1[3]) * sc; b[3] = (v1[2] * r1[3] + v1[3] * r1[2]) * sc;
        return pack8(a, b);
    }
    __device__ __forceinline__ void operator()(const pg8::f32x4 (&acc)[2][2][4][2], const pg8::Unit& u, int wr, int wc, int fr, int fq) const {
        const int pn = u.pn, row0 = u.pm * 256 + wr * 64 + fr, cw = 32 * wc + 8 * fq;
        if (pn <= 1 || pn == 3) {
            bf16* dst = (pn == 3) ? IQ : Q; const int ld = (pn == 3) ? 256 : 512; const float sc = (pn == 3) ? 1.f : QSCALE; const int hb = (pn == 3) ? 0 : pn * 4;
#pragma unroll
            for (int ai = 0; ai < 2; ++ai)
#pragma unroll
                for (int m = 0; m < 4; ++m) { const int row = row0 + ai * 128 + m * 16, t = row & (SEQ - 1);
                    const f32x4* rp = (const f32x4*)(rope + t * 32 + 16 * (wc & 1) + 4 * fq); const f32x4 r0 = rp[0], r1 = rp[1];
#pragma unroll
                    for (int bj = 0; bj < 2; ++bj) { const int head = hb + 2 * bj + (wc >> 1);
                        *(u32x4*)(dst + (size_t)row * ld + head * 64 + 32 * (wc & 1) + 8 * fq) = rope8(acc[ai][bj][m][0], acc[ai][bj][m][1], r0, r1, sc); } }
        } else if (pn == 2) {
#pragma unroll
            for (int ai = 0; ai < 2; ++ai)
#pragma unroll
                for (int m = 0; m < 4; ++m) { const int row = row0 + ai * 128 + m * 16, t = row & (SEQ - 1);
                    if (wc < 2) { const f32x4* rp = (const f32x4*)(rope + t * 32 + 16 * wc + 4 * fq); const f32x4 r0 = rp[0], r1 = rp[1];
                        *(u32x4*)(K + (size_t)row * 64 + cw) = rope8(acc[ai][0][m][0], acc[ai][0][m][1], r0, r1, 1.f);
                        *(u32x4*)(IK + (size_t)row * 64 + cw) = rope8(acc[ai][1][m][0], acc[ai][1][m][1], r0, r1, 1.f);
                    } else {
                        *(u32x4*)(V + (size_t)row * 64 + (cw - 64)) = pack8(acc[ai][0][m][0], acc[ai][0][m][1]);
                        if (wc == 2 && fq == 0) *(f32x4*)(IW + (size_t)row * 4) = acc[ai][1][m][0] * INDEXER_SCALE;
                        if (wc == 2 && fq == 1) { *(f32x4*)(DT + (size_t)row * 8) = acc[ai][1][m][0]; *(f32x4*)(DT + (size_t)row * 8 + 4) = acc[ai][1][m][1]; }
                    } }
        } else {
            bf16* dst = (pn < 6) ? Z : XBC; const int ld = (pn < 6) ? 512 : 768; const int cb = (pn < 6) ? (pn - 4) * 256 : (pn - 6) * 256;
#pragma unroll
            for (int ai = 0; ai < 2; ++ai)
#pragma unroll
                for (int m = 0; m < 4; ++m) { const int row = row0 + ai * 128 + m * 16;
#pragma unroll
                    for (int bj = 0; bj < 2; ++bj) *(u32x4*)(dst + (size_t)row * ld + cb + 128 * bj + cw) = pack8(acc[ai][bj][m][0], acc[ai][bj][m][1]); }
        }
    }
};
struct EpiH1 {
    static constexpr bool PERM = true, AFTER_DRAIN = false; static constexpr int MID_T = 8;
    const float* x; bf16* out; const float* ssqp;
    __device__ __forceinline__ void mid(pg8::f32x4 (&acc)[2][2][4][2], const pg8::Unit& u, int wr, int wc, int fr, int fq) const {
        asm volatile("" : "+v"(fr));
        const int row0 = u.pm * 256 + wr * 64 + fr;
#pragma unroll
        for (int ai = 0; ai < 2; ++ai)
#pragma unroll
            for (int m = 0; m < 4; ++m) { const f32x4* sp = (const f32x4*)(ssqp + (size_t)(row0 + ai * 128 + m * 16) * 8); const f32x4 s0 = sp[0], s1 = sp[1];
                const float r = rsqrtf(((s0[0] + s0[1]) + (s0[2] + s0[3]) + (s1[0] + s1[1]) + (s1[2] + s1[3])) * (1.f / 512.f) + LN_EPS);
#pragma unroll
                for (int bj = 0; bj < 2; ++bj)
#pragma unroll
                    for (int n = 0; n < 2; ++n) acc[ai][bj][m][n] = acc[ai][bj][m][n] * r; }
    }
    __device__ __forceinline__ void operator()(const pg8::f32x4 (&acc)[2][2][4][2], const pg8::Unit& u, int wr, int wc, int fr, int fq) const {
        const int row0 = u.pm * 256 + wr * 64 + fr, col0 = u.pn * 256 + wc * 32 + 8 * fq;
#pragma unroll
        for (int ai = 0; ai < 2; ++ai)
#pragma unroll
            for (int m = 0; m < 4; ++m) { const size_t off = (size_t)(row0 + ai * 128 + m * 16) * DM + col0;
#pragma unroll
                for (int bj = 0; bj < 2; ++bj) { const u32x4 xb = *(const u32x4*)(out + off + bj * 128);
                    f32x4 h0, h1v;
                    h0[0] = __uint_as_float(xb.x << 16); h0[1] = __uint_as_float(xb.x & 0xffff0000u); h0[2] = __uint_as_float(xb.y << 16); h0[3] = __uint_as_float(xb.y & 0xffff0000u);
                    h1v[0] = __uint_as_float(xb.z << 16); h1v[1] = __uint_as_float(xb.z & 0xffff0000u); h1v[2] = __uint_as_float(xb.w << 16); h1v[3] = __uint_as_float(xb.w & 0xffff0000u);
                    h0 = h0 * ALPHA + acc[ai][bj][m][0]; h1v = h1v * ALPHA + acc[ai][bj][m][1];
                    u32x4 w; w.x = pg8::cvt_pk_bf16(h0[0], h0[1]); w.y = pg8::cvt_pk_bf16(h0[2], h0[3]); w.z = pg8::cvt_pk_bf16(h1v[0], h1v[1]); w.w = pg8::cvt_pk_bf16(h1v[2], h1v[3]);
                    *(u32x4*)(out + off + bj * 128) = w; } }
    }
};
template <class DR, class KM>
__device__ __forceinline__ void transpose_item(const float* W, int K, int N, bf16* WT, LAS float* scr, int item, int lane, DR drow, KM kmap) {
    const int nblk = (N + 31) / 32, kb = item / nblk, nb = item % nblk, k0 = 64 * kb, n0 = 32 * nb;
    float tv[32];
#pragma unroll
    for (int i = 0; i < 32; ++i) { const int kk = 2 * i + (lane >> 5), col = n0 + (lane & 31); float sc = 1.f; const int ks = kmap(k0 + kk, sc); tv[i] = (col < N) ? W[(size_t)ks * N + col] * sc : 0.f; }
#pragma unroll
    for (int i = 0; i < 32; ++i) scr[(2 * i + (lane >> 5)) * 33 + (lane & 31)] = tv[i];
    asm volatile("s_waitcnt lgkmcnt(0)" ::: "memory");
    const int c = lane & 7;
#pragma unroll
    for (int j = 0; j < 4; ++j) { const int n = (lane >> 3) + 8 * j, col = n0 + n; const LAS float* s = scr + (8 * c) * 33 + n;
        u32x4 o; o.x = pg8::cvt_pk_bf16(s[0 * 33], s[1 * 33]); o.y = pg8::cvt_pk_bf16(s[2 * 33], s[3 * 33]); o.z = pg8::cvt_pk_bf16(s[4 * 33], s[5 * 33]); o.w = pg8::cvt_pk_bf16(s[6 * 33], s[7 * 33]);
        if (col < N) *(u32x4*)(WT + (size_t)drow(col) * K + k0 + 8 * c) = o; }
    asm volatile("s_waitcnt lgkmcnt(0)" ::: "memory");
}
namespace attn_body {
using bf16=unsigned short;
using bf16x8=__attribute__((ext_vector_type(8)))short;
using s16x4=__attribute__((ext_vector_type(4)))short;
using f32x16=__attribute__((ext_vector_type(16)))float;
using u32x4=__attribute__((ext_vector_type(4)))unsigned;
constexpr int SEQ=2048,D=64,QP=512,KP=64,OP=1024;
constexpr int NW=8,QBLK=32,KVBLK=64;
__device__ __forceinline__ int crow(int r,int hi){return (r&3)+8*(r>>2)+4*hi;}
#define SBAR() __builtin_amdgcn_sched_barrier(0)
#define ATT_ANDB(X,I,M,K) do{ float t_=X[I]; asm volatile("v_and_b32_sdwa %0, sext(%1), %0 dst_sel:DWORD dst_unused:UNUSED_PAD src0_sel:BYTE_" #K " src1_sel:DWORD":"+v"(t_):"v"(M)); X[I]=t_; }while(0)
#define ATT_AND4(X,B,M) do{ ATT_ANDB(X,(B),M,0); ATT_ANDB(X,(B)+1,M,1); ATT_ANDB(X,(B)+2,M,2); ATT_ANDB(X,(B)+3,M,3); }while(0)

constexpr int NSLOT=3, SLOTB=8192;
constexpr int LDS_K=0, LDS_V=NSLOT*SLOTB, LDS_WS=2*NSLOT*SLOTB, LDS_OST=LDS_WS+NW*64*4, LDS_BYTES=LDS_OST+NW*4096;
constexpr float C2=0.125f*1.4426950408889634f;
__device__ __forceinline__ void glds16(const void*gsrc,unsigned lds_dst){unsigned keep;
  asm volatile("s_mov_b32 %0, m0\n\ts_mov_b32 m0, %2\n\ts_nop 0\n\tglobal_load_lds_dwordx4 %1, off\n\ts_mov_b32 m0, %0":"=&s"(keep):"v"(gsrc),"s"(lds_dst):"memory");}
__device__ __forceinline__ float max3f(float a,float b,float c){float r;asm("v_max3_f32 %0, %1, %2, %3":"=v"(r):"v"(a),"v"(b),"v"(c));return r;}
__device__ __forceinline__ float max2f(float a,float b){float r;asm("v_max_f32_e32 %0, %1, %2":"=v"(r):"v"(a),"v"(b));return r;}
__device__ __forceinline__ float fadd_s(float a,float b){float r;asm("v_add_f32_e32 %0, %1, %2":"=v"(r):"v"(a),"v"(b));return r;}
__device__ __forceinline__ float fsub_s(float a,float b){float r;asm("v_sub_f32_e32 %0, %1, %2":"=v"(r):"v"(a),"v"(b));return r;}
typedef float f32x2_t __attribute__((ext_vector_type(2))); typedef __bf16 bf16x2_t __attribute__((ext_vector_type(2)));
__device__ __forceinline__ unsigned cvtpk_s(float lo,float hi){f32x2_t v={lo,hi};bf16x2_t b=__builtin_convertvector(v,bf16x2_t);return __builtin_bit_cast(unsigned,b);}
#define WAIT_BAR(N) asm volatile("s_waitcnt vmcnt(" #N ") lgkmcnt(0)\n\ts_barrier":::"memory")

__device__ __forceinline__ void qkt(f32x16&p0,f32x16&p1,const char*Kslot,const bf16x8*qr,const f32x16&negm,int r32,int hi){
  const char*kb=Kslot+hi*1024+r32*16;
  #pragma unroll
  for(int d0=0;d0<4;++d0){
    const bf16x8 b0=*reinterpret_cast<const bf16x8*>(kb+d0*2048);
    const bf16x8 b1=*reinterpret_cast<const bf16x8*>(kb+d0*2048+512);
    if(d0==0){p0=__builtin_amdgcn_mfma_f32_32x32x16_bf16(b0,qr[0],negm,0,0,0);p1=__builtin_amdgcn_mfma_f32_32x32x16_bf16(b1,qr[0],negm,0,0,0);}
    else{p0=__builtin_amdgcn_mfma_f32_32x32x16_bf16(b0,qr[d0],p0,0,0,0);p1=__builtin_amdgcn_mfma_f32_32x32x16_bf16(b1,qr[d0],p1,0,0,0);}}
}
typedef __attribute__((address_space(3))) const char* lds_cptr;
typedef short v4i16_t __attribute__((ext_vector_type(4)));
__device__ __forceinline__ void kload8(bf16x8*kf,lds_cptr kp){
  kf[0]=*(const __attribute__((address_space(3))) bf16x8*)(kp);      kf[1]=*(const __attribute__((address_space(3))) bf16x8*)(kp+512);
  kf[2]=*(const __attribute__((address_space(3))) bf16x8*)(kp+2048); kf[3]=*(const __attribute__((address_space(3))) bf16x8*)(kp+2560);
  kf[4]=*(const __attribute__((address_space(3))) bf16x8*)(kp+4096); kf[5]=*(const __attribute__((address_space(3))) bf16x8*)(kp+4608);
  kf[6]=*(const __attribute__((address_space(3))) bf16x8*)(kp+6144); kf[7]=*(const __attribute__((address_space(3))) bf16x8*)(kp+6656);
}
__device__ __forceinline__ void kload2(bf16x8*kf,lds_cptr kp,int j){ kf[2*j]=*(const __attribute__((address_space(3))) bf16x8*)(kp+j*2048); kf[2*j+1]=*(const __attribute__((address_space(3))) bf16x8*)(kp+j*2048+512); }
__device__ __forceinline__ s16x4 vtr(lds_cptr p){ return __builtin_bit_cast(s16x4,__builtin_amdgcn_ds_read_tr16_b64_v4i16((__attribute__((address_space(3))) v4i16_t*)p)); }
__device__ __forceinline__ float rowmax(const f32x16&p0,const f32x16&p1){
  float a=max3f(p0[0],p0[1],p1[0]),b=max3f(p0[2],p0[3],p1[1]);a=max3f(a,p1[2],p1[3]);
  #pragma unroll
  for(int r=4;r<16;r+=4){a=max3f(a,p0[r],p0[r+1]);b=max3f(b,p0[r+2],p0[r+3]);a=max3f(a,p1[r],p1[r+1]);b=max3f(b,p1[r+2],p1[r+3]);}
  const float m=max2f(a,b);
  auto rr=__builtin_amdgcn_permlane32_swap(__float_as_uint(m),__float_as_uint(m),false,false);
  return max2f(__uint_as_float(rr[0]),__uint_as_float(rr[1]));
}
__device__ __forceinline__ void pv(f32x16*o,int vb,bf16x8 pa0,bf16x8 pa1,bf16x8 pa2,bf16x8 pa3){
  #pragma unroll
  for(int d0=0;d0<2;++d0){s16x4 lo[4],hi[4];
    #pragma unroll
    for(int ks=0;ks<4;++ks){
      asm volatile("ds_read_b64_tr_b16 %0,%1 offset:%c2":"=&v"(lo[ks]):"v"(vb),"i"(d0*4096+ks*1024):"memory");
      asm volatile("ds_read_b64_tr_b16 %0,%1 offset:%c2":"=&v"(hi[ks]):"v"(vb),"i"(d0*4096+ks*1024+512):"memory");}
    asm volatile("s_waitcnt lgkmcnt(0)":::"memory");SBAR();
    #define PK(k) (bf16x8){lo[k][0],lo[k][1],lo[k][2],lo[k][3],hi[k][0],hi[k][1],hi[k][2],hi[k][3]}
    o[d0]=__builtin_amdgcn_mfma_f32_32x32x16_bf16(pa0,PK(0),o[d0],0,0,0);
    o[d0]=__builtin_amdgcn_mfma_f32_32x32x16_bf16(pa1,PK(1),o[d0],0,0,0);
    o[d0]=__builtin_amdgcn_mfma_f32_32x32x16_bf16(pa2,PK(2),o[d0],0,0,0);
    o[d0]=__builtin_amdgcn_mfma_f32_32x32x16_bf16(pa3,PK(3),o[d0],0,0,0);
    #undef PK
  }
}

#ifndef ATTN_STORE16
#define ATTN_STORE16(p,v) (*(u32x4*)(p)=(v))
#endif
template<int THRL> __device__ __forceinline__ void attn_unit(int b,int qb,const bf16*Q,const bf16*__restrict__ K,const bf16*__restrict__ V,bf16*O,char*shm,const char*maskb,const int wave_s){
  int lane_l=lane_id(); asm volatile("":"+v"(lane_l)); const int lane=lane_l,tid=wave_s*64+lane,r32=lane&31,hi=lane>>5; const int wid=wave_s;
  const long rowbase=(long)b*SEQ; const int q0=qb*QBLK;
  const bf16*Qw=Q+(rowbase+q0)*QP+wid*D;
  const bf16*Kh=K+rowbase*KP,*Vh=V+rowbase*KP;
  const unsigned lds0=(unsigned)(uintptr_t)shm;
  float*wsf=(float*)(shm+LDS_WS)+wid*64;
  const bf16*ksrc=Kh+(long)lane*KP+wid*8;
  const bf16*vsrc=Vh+(long)(16*(wid&3)+(lane>>2))*KP+(wid>>2)*32+(lane&3)*8;
  const unsigned kdst=lds0+LDS_K+wid*1024, vdst=lds0+LDS_V+wid*1024;
  #define DMA_K(t,slot) glds16(ksrc+(long)(t)*KVBLK*KP,(unsigned)__builtin_amdgcn_readfirstlane(kdst+(slot)))
  #define DMA_V(t,slot) glds16(vsrc+(long)(t)*KVBLK*KP,(unsigned)__builtin_amdgcn_readfirstlane(vdst+(slot)))
  const int vb0=(int)(lds0+LDS_V)+((lane>>4)&1)*32+(lane&3)*8+(4*hi+((lane&15)>>2))*64;
  const char*Kbase=shm+LDS_K; bf16x8 kf[8];
  const lds_cptr shm3=(lds_cptr)shm; const lds_cptr kp0=shm3+LDS_K+hi*1024+r32*16; const lds_cptr vp0=shm3+LDS_V+((lane>>4)&1)*32+(lane&3)*8+(4*hi+((lane&15)>>2))*64;
  const int NTr=(q0+QBLK+KVBLK-1)/KVBLK; const int NT=(NTr<4)?4:((NTr+1)&~1);
  const __attribute__((address_space(3))) char*bm0=(const __attribute__((address_space(3))) char*)((__attribute__((address_space(3))) const char*)maskb)+r32*64;
  const int offA_=(((2*hi)+(r32>>2))&3)*16, offB_=(((2*hi+1)+(r32>>2))&3)*16; u32x4 mbA,mbB;
  #define LDMASK(t) do{ mbA=*(const __attribute__((address_space(3))) u32x4*)(bm0+(t)*2048+offA_); mbB=*(const __attribute__((address_space(3))) u32x4*)(bm0+(t)*2048+offB_); }while(0)
  DMA_K(0,0);DMA_V(0,0);DMA_K(1,SLOTB);
  bf16x8 qr[4];
  #pragma unroll
  for(int d0=0;d0<4;++d0)qr[d0]=*reinterpret_cast<const bf16x8*>(&Qw[(long)r32*QP+d0*16+hi*8]);
  float zz_=0.f; asm volatile("":"+v"(zz_)); float mhat=zz_,l_reg=zz_;f32x16 o[2];
  #pragma unroll
  for(int r=0;r<16;++r){o[0][r]=zz_;o[1][r]=zz_;}
  f32x16 negm;
  #pragma unroll
  for(int r=0;r<16;++r)negm[r]=zz_;
  asm volatile("":"+v"(negm));
  bool resc=false;
  #define START(P0,P1) do{ const float rm=rowmax(P0,P1); resc=false; \
    { const float dl=(rm>-INFINITY)?rm:0.f; mhat=fadd_s(mhat,dl); \
      _Pragma("unroll") for(int r=0;r<16;++r){P0[r]=fsub_s(P0[r],dl);P1[r]=fsub_s(P1[r],dl);} \
      _Pragma("unroll") for(int r=0;r<16;++r)negm[r]=-mhat; asm volatile("":"+v"(negm)); } \
    _Pragma("unroll") for(int r=0;r<16;++r)P0[r]=__builtin_amdgcn_exp2f(P0[r]); \
    ATT_AND4(P0,0,mbA[0]); ATT_AND4(P0,4,mbA[1]); ATT_AND4(P0,8,mbA[2]); ATT_AND4(P0,12,mbA[3]); }while(0)
  #define RESC() do{ if(resc){ asm volatile("s_waitcnt lgkmcnt(0)":::"memory"); \
      _Pragma("unroll") for(int d_=0;d_<2;++d_) _Pragma("unroll") for(int r=0;r<16;++r)o[d_][r]*=wsf[crow(r,hi)]; } }while(0)
  f32x16 pA0,pA1,pB0,pB1;
  int sl_prev=0,sl_cur=0,sl_next=SLOTB;
  #define ROT() do{sl_prev=sl_cur;sl_cur=sl_next;sl_next=(sl_next==(NSLOT-1)*SLOTB)?0:sl_next+SLOTB;}while(0)
  DMA_K(2,2*SLOTB);
  WAIT_BAR(3);
  LDMASK(0);
  qkt(pA0,pA1,Kbase,qr,negm,r32,hi);asm volatile("s_nop 15\n\ts_nop 7":"+v"(pA0),"+v"(pA1));
  START(pA0,pA1);
  _Pragma("unroll") for(int r=0;r<16;++r)pA1[r]=__builtin_amdgcn_exp2f(pA1[r]);
  ATT_AND4(pA1,0,mbB[0]); ATT_AND4(pA1,4,mbB[1]); ATT_AND4(pA1,8,mbB[2]); ATT_AND4(pA1,12,mbB[3]);
  WAIT_BAR(0);
  DMA_K(3,0);DMA_V(1,SLOTB);
  ROT();
  kload8(kf,kp0+sl_cur);
  WAIT_BAR(2);
  s16x4 vlo[8],vhi[8]; u32x4 pw0,pw1,pw2,pw3;
  #define PKW(P,B) cvtpk_s(P[B],P[B+1])
  #define PAF(k) __builtin_bit_cast(bf16x8,pw##k)
  #define VFR(i) (bf16x8){vlo[i][0],vlo[i][1],vlo[i][2],vlo[i][3],vhi[i][0],vhi[i][1],vhi[i][2],vhi[i][3]}
  #define PIN(x) asm volatile("":"+v"(x))
  #define MX3(a,b,c) __builtin_fmaxf(__builtin_fmaxf((a),(b)),(c))
  #define GAPA(MF,A0,A1,A2,A3,W0,W1,PW) do{ MF; sacc+=A0; sacc+=A1; sacc+=A2; sacc+=A3; PIN(sacc); W0; W1; PIN(PW); SBAR(); }while(0)
  #define EX(v) __builtin_amdgcn_exp2f(v)
  #define GAPB(MF,X,B,MR) do{ MF; X[B]=EX(X[B]); X[B+1]=EX(X[B+1]); X[B+2]=EX(X[B+2]); X[B+3]=EX(X[B+3]); ATT_AND4(X,B,MR); PIN(X); SBAR(); }while(0)
  #define VRD(i) do{ vlo[i]=vtr(vp_+(((i)>>2)*4096+((i)&3)*1024)); vhi[i]=vtr(vp_+(((i)>>2)*4096+((i)&3)*1024+512)); }while(0)
  #define KRD(G,j) do{ if(G){ kload2(kf,kp0+sl_next,j); SBAR(); } }while(0)
  #define STEP(C0,C1,P0,P1,t,GK,GV,GL) do{ SBAR(); \
    const lds_cptr vp_=vp0+sl_prev; \
    VRD(0); SBAR(); float sacc=(P0[0]+P0[1]); \
    GAPA(C0=__builtin_amdgcn_mfma_f32_32x32x16_bf16(kf[0],qr[0],negm,0,0,0), P0[2],P0[3],P0[4],P0[5],     pw0[0]=PKW(P0,0), pw0[1]=PKW(P0,2), pw0); \
    VRD(4); SBAR(); GAPA(C1=__builtin_amdgcn_mfma_f32_32x32x16_bf16(kf[1],qr[0],negm,0,0,0), P0[6],P0[7],P0[8],P0[9],     pw0[2]=PKW(P0,4), pw0[3]=PKW(P0,6), pw0); \
    VRD(1); SBAR(); GAPA(C0=__builtin_amdgcn_mfma_f32_32x32x16_bf16(kf[2],qr[1],C0,0,0,0),   P0[10],P0[11],P0[12],P0[13], pw1[0]=PKW(P0,8), pw1[1]=PKW(P0,10), pw1); \
    VRD(5); SBAR(); GAPA(C1=__builtin_amdgcn_mfma_f32_32x32x16_bf16(kf[3],qr[1],C1,0,0,0),   P0[14],P0[15],P1[0],P1[1],   pw1[2]=PKW(P0,12),pw1[3]=PKW(P0,14), pw1); \
    VRD(2); SBAR(); GAPA(C0=__builtin_amdgcn_mfma_f32_32x32x16_bf16(kf[4],qr[2],C0,0,0,0),   P1[2],P1[3],P1[4],P1[5],     pw2[0]=PKW(P1,0), pw2[1]=PKW(P1,2), pw2); \
    VRD(6); SBAR(); GAPA(C1=__builtin_amdgcn_mfma_f32_32x32x16_bf16(kf[5],qr[2],C1,0,0,0),   P1[6],P1[7],P1[8],P1[9],     pw2[2]=PKW(P1,4), pw2[3]=PKW(P1,6), pw2); \
    VRD(3); SBAR(); GAPA(C0=__builtin_amdgcn_mfma_f32_32x32x16_bf16(kf[6],qr[3],C0,0,0,0),   P1[10],P1[11],P1[12],P1[13], pw3[0]=PKW(P1,8), pw3[1]=PKW(P1,10), pw3); \
    VRD(7); SBAR(); GAPA(C1=__builtin_amdgcn_mfma_f32_32x32x16_bf16(kf[7],qr[3],C1,0,0,0),   P1[14],P1[15],0.f,0.f,       pw3[2]=PKW(P1,12),pw3[3]=PKW(P1,14), pw3); \
    l_reg+=sacc; \
    if(GK){DMA_K((t)+3,sl_cur);} if(GV){DMA_V((t)+1,sl_next);} \
    LDMASK(t); \
    { float a=MX3(C0[0],C0[1],C1[0]),b=MX3(C0[2],C0[3],C1[1]); a=MX3(a,C1[2],C1[3]); \
      _Pragma("unroll") for(int r=4;r<16;r+=4){a=MX3(a,C0[r],C0[r+1]);b=MX3(b,C0[r+2],C0[r+3]);a=MX3(a,C1[r],C1[r+1]);b=MX3(b,C1[r+2],C1[r+3]);} \
      float rm=__builtin_fmaxf(a,b); { auto rr=__builtin_amdgcn_permlane32_swap(__float_as_uint(rm),__float_as_uint(rm),false,false); rm=__builtin_fmaxf(__uint_as_float(rr[0]),__uint_as_float(rr[1])); } \
      resc=false; \
      if(__builtin_expect(__any(rm>(float)THRL),0)){ const float dl=__builtin_fmaxf(rm,0.f); mhat+=dl; \
        _Pragma("unroll") for(int r=0;r<16;++r){C0[r]-=dl;C1[r]-=dl;} \
        _Pragma("unroll") for(int r=0;r<16;++r)negm[r]=-mhat; asm volatile("":"+v"(negm)); \
        const float f=__builtin_amdgcn_exp2f(-dl); l_reg*=f; if(hi==0)wsf[r32]=f; resc=true; } } \
    SBAR(); \
    GAPB(o[0]=__builtin_amdgcn_mfma_f32_32x32x16_bf16(PAF(0),VFR(0),o[0],0,0,0), C0,0,mbA[0]); \
    GAPB(o[1]=__builtin_amdgcn_mfma_f32_32x32x16_bf16(PAF(0),VFR(4),o[1],0,0,0), C0,4,mbA[1]); \
    KRD(GL,0); GAPB(o[0]=__builtin_amdgcn_mfma_f32_32x32x16_bf16(PAF(1),VFR(1),o[0],0,0,0), C0,8,mbA[2]); \
    KRD(GL,1); GAPB(o[1]=__builtin_amdgcn_mfma_f32_32x32x16_bf16(PAF(1),VFR(5),o[1],0,0,0), C0,12,mbA[3]); \
    KRD(GL,2); GAPB(o[0]=__builtin_amdgcn_mfma_f32_32x32x16_bf16(PAF(2),VFR(2),o[0],0,0,0), C1,0,mbB[0]); \
    KRD(GL,3); GAPB(o[1]=__builtin_amdgcn_mfma_f32_32x32x16_bf16(PAF(2),VFR(6),o[1],0,0,0), C1,4,mbB[1]); \
    GAPB(o[0]=__builtin_amdgcn_mfma_f32_32x32x16_bf16(PAF(3),VFR(3),o[0],0,0,0), C1,8,mbB[2]); \
    GAPB(o[1]=__builtin_amdgcn_mfma_f32_32x32x16_bf16(PAF(3),VFR(7),o[1],0,0,0), C1,12,mbB[3]); \
    }while(0)
  int t=1;
  for(;t+5<NT;t+=2){
    STEP(pB0,pB1,pA0,pA1,t,true,true,true);     WAIT_BAR(2); RESC(); ROT();
    STEP(pA0,pA1,pB0,pB1,t+1,true,true,true);   WAIT_BAR(2); RESC(); ROT();
  }
  #define ENDW(tt) do{ if((tt)+3<NT){WAIT_BAR(2);} else if((tt)+2<NT){WAIT_BAR(1);} else {WAIT_BAR(0);} }while(0)
  for(;t+1<NT;t+=2){
    STEP(pB0,pB1,pA0,pA1,t,(t+3<NT),(t+1<NT),(t+1<NT));       ENDW(t);   RESC(); ROT();
    STEP(pA0,pA1,pB0,pB1,t+1,(t+4<NT),(t+2<NT),(t+2<NT));     ENDW(t+1); RESC(); ROT();
  }
  STEP(pB0,pB1,pA0,pA1,NT-1,false,false,false); RESC();
  { float sacc=pB0[0]+pB0[1]; _Pragma("unroll") for(int r=2;r<16;++r)sacc+=pB0[r]; _Pragma("unroll") for(int r=0;r<16;++r)sacc+=pB1[r]; l_reg+=sacc;
    pw0=(u32x4){PKW(pB0,0),PKW(pB0,2),PKW(pB0,4),PKW(pB0,6)};pw1=(u32x4){PKW(pB0,8),PKW(pB0,10),PKW(pB0,12),PKW(pB0,14)};pw2=(u32x4){PKW(pB1,0),PKW(pB1,2),PKW(pB1,4),PKW(pB1,6)};pw3=(u32x4){PKW(pB1,8),PKW(pB1,10),PKW(pB1,12),PKW(pB1,14)};
    SBAR(); pv(o,vb0+sl_cur,PAF(0),PAF(1),PAF(2),PAF(3)); }
  #undef PKW
  #undef PAF
  #undef VFR
  #undef PIN
  #undef MX3
  #undef GAPA
  #undef GAPB
  #undef EX
  #undef VRD
  #undef KRD
  #undef STEP
  #undef ENDW
  {auto rr=__builtin_amdgcn_permlane32_swap(__float_as_uint(l_reg),__float_as_uint(l_reg),false,false);l_reg=__uint_as_float(rr[0])+__uint_as_float(rr[1]);}
  if(hi==0)wsf[32+r32]=l_reg;asm volatile("s_waitcnt lgkmcnt(0)":::"memory");
  float rli[16];
  #pragma unroll
  for(int r=0;r<16;++r)rli[r]=__builtin_amdgcn_rcpf(wsf[32+crow(r,hi)]);
  bf16*Ow=O+(rowbase+q0)*OP+512+wid*D;
  { bf16*stg=(bf16*)(shm+LDS_OST)+wid*2048;
    #pragma unroll
    for(int r=0;r<16;++r){const int orow=crow(r,hi);
      #pragma unroll
      for(int d0=0;d0<2;++d0)stg[orow*64+d0*32+r32]=(bf16)(cvtpk_s(o[d0][r]*rli[r],0.f)&0xffffu);}
    asm volatile("s_waitcnt lgkmcnt(0)":::"memory");
    #pragma unroll
    for(int i=0;i<4;++i){const int row=i*8+(lane>>3),ch=lane&7; const u32x4 v=*(const u32x4*)(stg+row*64+ch*8); ATTN_STORE16(Ow+(long)row*OP+ch*8,v);} }
  asm volatile("s_waitcnt lgkmcnt(0)\n\ts_barrier":::"memory");
  #undef DMA_K
  #undef DMA_V
  #undef LDMASK
  #undef START
  #undef RESC
  #undef ROT
}
constexpr int ATTN_LDS_BYTES=LDS_BYTES;
#undef SBAR
#undef WAIT_BAR
}

constexpr int DSA_MASK_OFF = 149504, DSA_MASK_STRIDE = 66;
constexpr int DSA_BMASK_OFF = 83968;
typedef short bf16x8_t __attribute__((ext_vector_type(8)));
__device__ __forceinline__ int wave_sum_dpp_i(int x) {
    x += __builtin_amdgcn_update_dpp(0, x, 0xB1, 0xf, 0xf, true);
    x += __builtin_amdgcn_update_dpp(0, x, 0x4E, 0xf, 0xf, true);
    x += __builtin_amdgcn_update_dpp(0, x, 0x114, 0xf, 0xf, true);
    x += __builtin_amdgcn_update_dpp(0, x, 0x118, 0xf, 0xf, true);
    x += __builtin_amdgcn_update_dpp(0, x, 0x142, 0xa, 0xf, false);
    x += __builtin_amdgcn_update_dpp(0, x, 0x143, 0xc, 0xf, false);
    return __builtin_amdgcn_readlane(x, 63);
}
__device__ __forceinline__ int wave_incl_scan_dpp_i(int x) {
    int v = x;
    v += __builtin_amdgcn_update_dpp(0, x, 0x111, 0xf, 0xf, true);
    v += __builtin_amdgcn_update_dpp(0, x, 0x112, 0xf, 0xf, true);
    v += __builtin_amdgcn_update_dpp(0, x, 0x113, 0xf, 0xf, true);
    v += __builtin_amdgcn_update_dpp(0, v, 0x114, 0xf, 0xe, true);
    v += __builtin_amdgcn_update_dpp(0, v, 0x118, 0xf, 0xc, true);
    v += __builtin_amdgcn_update_dpp(0, v, 0x142, 0xa, 0xf, false);
    v += __builtin_amdgcn_update_dpp(0, v, 0x143, 0xc, 0xf, false);
    return v;
}
__device__ __forceinline__ int count_ge(const unsigned (&k)[32], unsigned cand, int nreg) {
    int cl = 0;
#pragma unroll
    for (int g4 = 0; g4 < 8; ++g4) if (4 * g4 < nreg) {
#pragma unroll
        for (int j = 0; j < 4; ++j) cl += (k[4 * g4 + j] >= cand) ? 1 : 0; }
    return wave_sum_dpp_i(cl);
}
template <int OPK> __device__ __forceinline__ float dpp_opf(float a, float b) { return OPK == 0 ? fmaxf(a, b) : fminf(a, b); }
template <int OPK> __device__ __forceinline__ float wave_reduce_f(float x) {
    const int id = OPK == 0 ? (int)0xff800000 : (int)0x7f800000;
    x = dpp_opf<OPK>(x, __int_as_float(__builtin_amdgcn_update_dpp(id, __float_as_int(x), 0xB1, 0xf, 0xf, false)));
    x = dpp_opf<OPK>(x, __int_as_float(__builtin_amdgcn_update_dpp(id, __float_as_int(x), 0x4E, 0xf, 0xf, false)));
    x = dpp_opf<OPK>(x, __int_as_float(__builtin_amdgcn_update_dpp(id, __float_as_int(x), 0x114, 0xf, 0xf, false)));
    x = dpp_opf<OPK>(x, __int_as_float(__builtin_amdgcn_update_dpp(id, __float_as_int(x), 0x118, 0xf, 0xf, false)));
    x = dpp_opf<OPK>(x, __int_as_float(__builtin_amdgcn_update_dpp(id, __float_as_int(x), 0x142, 0xa, 0xf, false)));
    x = dpp_opf<OPK>(x, __int_as_float(__builtin_amdgcn_update_dpp(id, __float_as_int(x), 0x143, 0xc, 0xf, false)));
    return __int_as_float(__builtin_amdgcn_readlane(__float_as_int(x), 63));
}
__device__ __forceinline__ unsigned binof(float v, float scale, float off) { return (unsigned)__builtin_amdgcn_fmed3f(__builtin_fmaf(v, scale, off), 0.f, 2047.f); }
__device__ __forceinline__ unsigned long long select_topk(const float (&k)[32], int kk, int nvalid, int nreg, int lane, LAS unsigned* hist, unsigned* errw) {
    const float NINF = -INFINITY;
    int mlo = 0, mhi = 0;
#define SEL_PUT(i, m) do { if (lane == (i)) { mlo = (int)(unsigned)(m); mhi = (int)(unsigned)((m) >> 32); } } while (0)
#define SEL_MINE (((unsigned long long)(unsigned)mhi << 32) | (unsigned long long)(unsigned)mlo)
    if (nvalid <= kk) {
#pragma unroll
        for (int g4 = 0; g4 < 8; ++g4) if (4 * g4 < nreg) {
#pragma unroll
            for (int j = 0; j < 4; ++j) { const int i = 4 * g4 + j; const unsigned long long m = __ballot(k[i] > NINF); SEL_PUT(i, m); } }
        return SEL_MINE;
    }
    float T = 0.f; bool exact = false;
    float mx = NINF, mn = INFINITY;
#pragma unroll
    for (int g4 = 0; g4 < 8; ++g4) if (4 * g4 < nreg) {
#pragma unroll
        for (int j = 0; j < 4; ++j) { const float v = k[4 * g4 + j]; mx = fmaxf(mx, v); mn = fminf(mn, v > NINF ? v : INFINITY); } }
    const float vmax = wave_reduce_f<0>(mx), vmin = wave_reduce_f<1>(mn);
    if (vmax == vmin) { T = vmax; }
    else {
        const float scale = 2045.0f / (vmax - vmin), boff = __fsub_rn(1.5f, __fmul_rn(vmin, scale));
        LAS u32x4* h4 = (LAS u32x4*)hist;
#pragma unroll
        for (int j = 0; j < 8; ++j) h4[lane + 64 * j] = (u32x4){0u, 0u, 0u, 0u};
#pragma unroll
        for (int g4 = 0; g4 < 8; ++g4) if (4 * g4 < nreg) {
#pragma unroll
            for (int j = 0; j < 4; ++j) __hip_atomic_fetch_add(hist + binof(k[4 * g4 + j], scale, boff), 1u, __ATOMIC_RELAXED, __HIP_MEMORY_SCOPE_WORKGROUP); }
        u32x4 w[8];
#pragma unroll
        for (int j = 0; j < 8; ++j) w[j] = ((LAS u32x4*)(hist + 2016 - 32 * lane))[j];
        if (lane == 63) w[0][0] = 0u;
        int s = 0;
#pragma unroll
        for (int j = 0; j < 8; ++j) s += (int)((w[j][0] + w[j][1]) + (w[j][2] + w[j][3]));
        const int Pinc = wave_incl_scan_dpp_i(s);
        const unsigned long long geb = __ballot(Pinc >= kk);
        const int Lstar = __builtin_ctzll(geb);
        const int above_l = __builtin_amdgcn_readlane(Pinc - s, Lstar);
        const int binj = 2047 - 32 * Lstar - (lane & 31);
        const int cntj = (binj == 0) ? 0 : (int)hist[binj];
        int P2 = wave_incl_scan_dpp_i(lane < 32 ? cntj : 0) + above_l;
        const int jst = __builtin_ctzll(__ballot(P2 >= kk));
        const int Bstar = 2047 - 32 * Lstar - jst, cnt_above = __builtin_amdgcn_readlane(P2 - cntj, jst), cB = __builtin_amdgcn_readlane(cntj, jst);
        const int r = kk - cnt_above;
        if (cB <= 64) {
            LAS unsigned* cand = hist; int base = 0;
#pragma unroll
            for (int g4 = 0; g4 < 8; ++g4) if (4 * g4 < nreg) {
#pragma unroll
                for (int j = 0; j < 4; ++j) { const float v = k[4 * g4 + j]; const bool c = binof(v, scale, boff) == (unsigned)Bstar; const unsigned long long bal = __ballot(c);
                    if (bal) { if (c) cand[base + __builtin_amdgcn_mbcnt_hi((unsigned)(bal >> 32), __builtin_amdgcn_mbcnt_lo((unsigned)bal, 0u))] = __float_as_uint(v); base += __popcll(bal); } } }
            const float myc = (lane < cB) ? __uint_as_float(cand[lane]) : NINF;
            float prev = INFINITY; int cum = 0;
            for (int it = 0; it < 64; ++it) {
                const float m = wave_reduce_f<0>(myc < prev ? myc : NINF);
                cum += __popcll(__ballot(myc == m));
                if (cum >= r) { T = m; exact = (cum == r); break; }
                prev = m;
            }
        } else {
            float prev = INFINITY; int cum = 0;
            for (int it = 0; it < 2048; ++it) {
                float lm = NINF;
#pragma unroll
                for (int i = 0; i < 32; ++i) { const float v = k[i]; if (v < prev && binof(v, scale, boff) == (unsigned)Bstar) lm = fmaxf(lm, v); }
                const float m = wave_reduce_f<0>(lm);
                int mult = 0;
#pragma unroll
                for (int i = 0; i < 32; ++i) mult += __popcll(__ballot(k[i] == m));
                cum += mult;
                if (cum >= r) { T = m; exact = (cum == r); break; }
                prev = m;
            }
        }
    }
    if (exact) {
#pragma unroll
        for (int g4 = 0; g4 < 8; ++g4) if (4 * g4 < nreg) {
#pragma unroll
            for (int j = 0; j < 4; ++j) { const int i = 4 * g4 + j; const unsigned long long m = __ballot(k[i] >= T); SEL_PUT(i, m); } }
    } else {
        int ngt = 0;
#pragma unroll
        for (int i = 0; i < 32; ++i) ngt += __popcll(__ballot(k[i] > T));
        int need = kk - ngt;
#pragma unroll
        for (int i = 0; i < 32; ++i) {
            const unsigned long long eqb = __ballot(k[i] == T);
            const int rank = __builtin_amdgcn_mbcnt_hi((unsigned)(eqb >> 32), __builtin_amdgcn_mbcnt_lo((unsigned)eqb, 0u));
            const bool sel = (k[i] > T) || ((k[i] == T) && (rank < need));
            const unsigned long long m = __ballot(sel);
            need -= __popcll(eqb); if (need < 0) need = 0;
            SEL_PUT(i, m);
        }
    }
    const unsigned long long mine = SEL_MINE;
    if (wave_sum_dpp_i(lane < 32 ? __popcll(mine) : 0) != kk && lane == 0) atomicOr(errw, 1u);
    return mine;
#undef SEL_PUT
#undef SEL_MINE
}
__device__ __forceinline__ void dsa_select(int b, int qb, const bf16* IQb, const bf16* IKb, const float* IW, unsigned char* lds, int lane, int wave, unsigned* errw) {
    lane = launder_i(lane_id());
    unsigned* keys = (unsigned*)lds; unsigned* maskw = (unsigned*)(lds + DSA_MASK_OFF);
    if (qb < TOPK / 32) {
#pragma unroll 1
        for (int j = 0; j < 4; ++j) { const int q = 4 * wave + j, t = qb * 32 + q;
            if (lane < 32) { const int lo = 64 * lane; unsigned long long m = 0ull; if (t >= lo + 63) m = ~0ull; else if (t >= lo) m = (2ull << (t - lo)) - 1ull;
                *(unsigned long long*)(maskw + q * DSA_MASK_STRIDE + 2 * lane) = m; } }
        __syncthreads();
        return;
    }
    const size_t rb = (size_t)b * SEQ; const int q0 = qb * 32; const int ntk16 = 4 * ((qb >> 1) + 1);
    const int l15 = lane & 15, l4 = lane >> 4;
    bf16x8_t a2[2][4][2]; f32x4 wq2[2][4];
#pragma unroll
    for (int rr = 0; rr < 2; ++rr)
#pragma unroll
        for (int mt = 0; mt < 4; ++mt) {
            const bf16* ar = IQb + (rb + q0 + 16 * rr + 4 * mt + (l15 >> 2)) * 256 + (l15 & 3) * 64 + 8 * l4;
            a2[rr][mt][0] = *(const bf16x8_t*)ar; a2[rr][mt][1] = *(const bf16x8_t*)(ar + 32);
            wq2[rr][mt] = *(const f32x4*)(IW + (rb + q0 + 16 * rr + 4 * mt + l4) * 4);
        }
    bf16x8_t bn[4][2];
#pragma unroll
    for (int rnd = 0; rnd < 2; ++rnd) {
        const int qb0 = q0 + 16 * rnd;
        bf16x8_t a[4][2]; f32x4 wq[4];
#pragma unroll
        for (int mt = 0; mt < 4; ++mt) { a[mt][0] = a2[rnd][mt][0]; a[mt][1] = a2[rnd][mt][1]; wq[mt] = wq2[rnd][mt]; }
        bf16x8_t bc[4][2];
#define DSA_LOADG(dst, ntb) do { _Pragma("unroll") for (int u = 0; u < 4; ++u) { const int nt_ = (ntb) + 8 * u; \
            if (nt_ < ntk16) { const bf16* br = IKb + (rb + 16 * nt_ + l15) * 64 + 8 * l4; dst[u][0] = *(const bf16x8_t*)br; dst[u][1] = *(const bf16x8_t*)(br + 32); } \
            else { dst[u][0] = (bf16x8_t){0, 0, 0, 0, 0, 0, 0, 0}; dst[u][1] = dst[u][0]; } } } while (0)
        if (rnd == 0) DSA_LOADG(bn, wave);
        for (int ntb = wave; ntb < ntk16; ntb += 32) {
#pragma unroll
            for (int u = 0; u < 4; ++u) { bc[u][0] = bn[u][0]; bc[u][1] = bn[u][1]; }
            if (ntb + 32 < ntk16) DSA_LOADG(bn, ntb + 32);
#pragma unroll
            for (int u = 0; u < 4; ++u) {
                const int nt = ntb + 8 * u;
                if (nt < ntk16) {
                    const int s = 16 * nt + l15;
                    f32x4 cc[4];
#pragma unroll
                    for (int mt = 0; mt < 4; ++mt) cc[mt] = __builtin_amdgcn_mfma_f32_16x16x32_bf16(a[mt][0], bc[u][0], (f32x4){0.f, 0.f, 0.f, 0.f}, 0, 0, 0);
#pragma unroll
                    for (int mt = 0; mt < 4; ++mt) cc[mt] = __builtin_amdgcn_mfma_f32_16x16x32_bf16(a[mt][1], bc[u][1], cc[mt], 0, 0, 0);
                    __builtin_amdgcn_sched_barrier(0);
#pragma unroll
                    for (int mt = 0; mt < 4; ++mt) {
                        const f32x4 c = cc[mt];
                        const float r0 = __int_as_float(max(__float_as_int(c[0]), 0)), r1 = __int_as_float(max(__float_as_int(c[1]), 0)), r2 = __int_as_float(max(__float_as_int(c[2]), 0)), r3 = __int_as_float(max(__float_as_int(c[3]), 0));
                        float sc = wq[mt][0] * r0; sc = fmaf(wq[mt][1], r1, sc); sc = fmaf(wq[mt][2], r2, sc); sc = fmaf(wq[mt][3], r3, sc);
                        const int ql = 4 * mt + l4, t = qb0 + ql;
                        keys[ql * 2048 + s] = (s <= t) ? __float_as_uint(sc) : 0xff800000u;
                    }
                }
            }
        }
        if (rnd == 0) DSA_LOADG(bn, wave);
#undef DSA_LOADG
        __syncthreads();
#pragma unroll 1
        for (int j = 0; j < 2; ++j) {
            const int ql = 2 * wave + j, t = qb0 + ql, kk = (t + 1 < TOPK) ? (t + 1) : TOPK, nreg = (t >> 6) + 1;
            float k[32];
#pragma unroll
            for (int i = 0; i < 32; ++i) k[i] = (i < nreg) ? __uint_as_float(keys[ql * 2048 + 64 * i + lane]) : -INFINITY;
            const unsigned long long mine = select_topk(k, kk, t + 1, nreg, lane, (LAS unsigned*)((LAS unsigned char*)lds) + ql * 2048, errw);
            if (lane < 32) *(unsigned long long*)(maskw + (16 * rnd + ql) * DSA_MASK_STRIDE + 2 * lane) = mine;
        }
        __syncthreads();
    }
}

constexpr int LD64 = 72, LD128 = 136;
constexpr int SSD_CM = 0, SSD_BM = 18432, SSD_XS = 36864, SSD_XDT = 55296, SSD_BDT = 72704, SSD_MT = 90112, SSD_HB = 124928, SSD_DTS = 134144, SSD_ACUM = 134656, SSD_CW = 135168;
__device__ __forceinline__ bf16x8_t ldfrag(const bf16* base, int row, int ld, int k0) { return *(const bf16x8_t*)(base + row * ld + k0); }
__device__ __forceinline__ void ssd_item(int b, int h, KPtr P, const bf16* XBC, const bf16* BCc, const float* DT, const bf16* Zb, bf16* ASb, float* SSQP, unsigned char* lds, int tid) {
    tid = launder_i(tid);
    const int lane = tid & 63, w = __builtin_amdgcn_readfirstlane(tid >> 6), l15 = lane & 15, l4 = lane >> 4, g = h >> 2;
    bf16* Cm = (bf16*)(lds + SSD_CM); bf16* Bm = (bf16*)(lds + SSD_BM); bf16* xs = (bf16*)(lds + SSD_XS); bf16* XdtT = (bf16*)(lds + SSD_XDT);
    bf16* BdT = (bf16*)(lds + SSD_BDT); bf16* Mt = (bf16*)(lds + SSD_MT); bf16* Hb = (bf16*)(lds + SSD_HB);
    float* dts = (float*)(lds + SSD_DTS); float* acum = (float*)(lds + SSD_ACUM);
    const float A = -__expf(P->a_log[h]), dtb = P->dt_bias[h], Dh = P->d_skip[h];
    f32x4 Hacc[2]; Hacc[0] = (f32x4){0.f, 0.f, 0.f, 0.f}; Hacc[1] = Hacc[0];
    for (int e = tid; e < 64 * LD64 / 2; e += NT) ((unsigned*)Hb)[e] = 0u;
    float* cwl = (float*)(lds + SSD_CW);
    for (int e = tid; e < 960; e += NT) { const int T = (e < 768) ? (e >> 8) : ((e - 768) >> 6), ch = e & 63, cb = (T == 0) ? h * 64 : (T == 1 ? 512 + g * 64 : 640 + g * 64);
        cwl[e] = (e < 768) ? P->conv_w[((e >> 6) & 3) * 768 + cb + ch] : P->conv_b[cb + ch]; }
    const int pt = w >> 1, ntb = 2 * (w & 1);
    const int sl = tid >> 2, sc0 = (tid & 3) * 16;
    u32x4 raw[4][2], bcv[2][2]; float dtraw = 0.f; u32x2 zc[4], zn[4];
#define SSD_LOADRAW(cc) do { const size_t rb_ = (size_t)b * SEQ + (cc) * 128; const bf16* xr_ = XBC + (rb_ + sl) * 768 + h * 64 + sc0; \
        _Pragma("unroll") for (int j_ = 0; j_ < 4; ++j_) { raw[j_][0] = *(const u32x4*)(xr_ + (j_ - 3) * 768); raw[j_][1] = *(const u32x4*)(xr_ + (j_ - 3) * 768 + 8); } \
        const bf16* bc_ = BCc + (rb_ + sl) * 256 + g * 64 + sc0; \
        bcv[0][0] = *(const u32x4*)bc_; bcv[0][1] = *(const u32x4*)(bc_ + 8); bcv[1][0] = *(const u32x4*)(bc_ + 128); bcv[1][1] = *(const u32x4*)(bc_ + 136); } while (0)
#define SSD_PREFETCH(cc, ZD) do { const size_t rb_ = (size_t)b * SEQ + (cc) * 128; \
        if (tid < 128) dtraw = DT[(rb_ + tid) * 8 + h]; \
        _Pragma("unroll") for (int jt_ = 0; jt_ < 4; ++jt_) ZD[jt_] = *(const u32x2*)(Zb + (rb_ + 16 * w + l15) * 512 + h * 64 + 16 * jt_ + 4 * l4); } while (0)
    SSD_PREFETCH(0, zc);
    for (int c = 0; c < SEQ / 128; ++c) {
        const size_t rbase = (size_t)b * SEQ + c * 128;
        SSD_LOADRAW(c);
        if (tid < 128) { const float v = dtraw + dtb; dts[tid] = (v > 20.f) ? v : log1pf(__expf(v)); }
        __syncthreads();
        if (w == 0) {
            const float a0 = dts[2 * lane] * A, a1 = dts[2 * lane + 1] * A; const float s = a0 + a1; float inc = s;
#pragma unroll
            for (int o = 1; o < 64; o <<= 1) { const float v = __shfl_up(inc, o); if (lane >= o) inc += v; }
            const float ex = inc - s; acum[2 * lane] = ex + a0; acum[2 * lane + 1] = ex + s;
        }
        __syncthreads();
        const float alast = acum[127];
        {
            const int l = sl, c0 = sc0;
            const float dtl = dts[l], dec = __expf(alast - acum[l]);
            const int tmin = 3 - (c * 128 + l);
#pragma unroll
            for (int T = 0; T < 3; ++T) {
                float v[16];
                if (T == 0) {
                    u32x4 u[4][2];
#pragma unroll
                    for (int j = 0; j < 4; ++j) { u[j][0] = raw[j][0]; u[j][1] = raw[j][1]; }
                    if (c == 0) {
#pragma unroll
                        for (int j = 0; j < 3; ++j) if (j < tmin) { u[j][0] = (u32x4){0u, 0u, 0u, 0u}; u[j][1] = u[j][0]; } }
#pragma unroll
                    for (int i = 0; i < 16; ++i) v[i] = cwl[768 + c0 + i];
#pragma unroll
                    for (int j = 0; j < 4; ++j)
#pragma unroll
                        for (int i = 0; i < 16; ++i) { const unsigned wd = u[j][i >> 3][(i >> 1) & 3]; const float xv = (i & 1) ? __uint_as_float(wd & 0xffff0000u) : __uint_as_float(wd << 16);
                            v[i] = fmaf(cwl[j * 64 + c0 + i], xv, v[i]); }
#pragma unroll
                    for (int i = 0; i < 16; ++i) v[i] = silu(v[i]);
                } else {
#pragma unroll
                    for (int i = 0; i < 16; ++i) { const unsigned wd = bcv[T - 1][i >> 3][(i >> 1) & 3]; v[i] = (i & 1) ? __uint_as_float(wd & 0xffff0000u) : __uint_as_float(wd << 16); }
                }
                bf16* dstm = (T == 0) ? xs : (T == 1 ? Bm : Cm);
                if (T == 0) {
                    u32x4 o0, o1; o0.x = pg8::cvt_pk_bf16(v[0], v[1]); o0.y = pg8::cvt_pk_bf16(v[2], v[3]); o0.z = pg8::cvt_pk_bf16(v[4], v[5]); o0.w = pg8::cvt_pk_bf16(v[6], v[7]);
                    o1.x = pg8::cvt_pk_bf16(v[8], v[9]); o1.y = pg8::cvt_pk_bf16(v[10], v[11]); o1.z = pg8::cvt_pk_bf16(v[12], v[13]); o1.w = pg8::cvt_pk_bf16(v[14], v[15]);
                    *(u32x4*)(dstm + l * LD64 + c0) = o0; *(u32x4*)(dstm + l * LD64 + c0 + 8) = o1;
                } else { *(u32x4*)(dstm + l * LD64 + c0) = bcv[T - 1][0]; *(u32x4*)(dstm + l * LD64 + c0 + 8) = bcv[T - 1][1]; }
                if (T == 0) {
#pragma unroll
                    for (int i = 0; i < 16; ++i) XdtT[(c0 + i) * LD128 + l] = f2bf(v[i] * dtl); }
                if (T == 1) {
#pragma unroll
                    for (int i = 0; i < 16; ++i) BdT[(c0 + i) * LD128 + l] = f2bf(v[i] * dec); }
            }
        }
        if (c + 1 < SEQ / 128) SSD_PREFETCH(c + 1, zn);
        __syncthreads();
        const int lrow = 16 * w + l15; const float al = acum[lrow];
        {
            const bf16x8_t c0f = ldfrag(Cm, lrow, LD64, 8 * l4), c1f = ldfrag(Cm, lrow, LD64, 32 + 8 * l4);
            for (int j = 0; j <= w; ++j) {
                const bf16x8_t bf0 = ldfrag(Bm, 16 * j + l15, LD64, 8 * l4), bf1 = ldfrag(Bm, 16 * j + l15, LD64, 32 + 8 * l4);
                f32x4 acc = (f32x4){0.f, 0.f, 0.f, 0.f};
                acc = __builtin_amdgcn_mfma_f32_16x16x32_bf16(bf0, c0f, acc, 0, 0, 0);
                acc = __builtin_amdgcn_mfma_f32_16x16x32_bf16(bf1, c1f, acc, 0, 0, 0);
                const int s0 = 16 * j + 4 * l4; float m[4];
#pragma unroll
                for (int r = 0; r < 4; ++r) { const int s = s0 + r; m[r] = (s <= lrow) ? acc[r] * __expf(al - acum[s]) : 0.f; }
                u32x2 o; o.x = pg8::cvt_pk_bf16(m[0], m[1]); o.y = pg8::cvt_pk_bf16(m[2], m[3]);
                *(u32x2*)(Mt + lrow * LD128 + s0) = o;
            }
            if ((w & 1) == 0) *(u32x2*)(Mt + lrow * LD128 + 16 * (w + 1) + 4 * l4) = (u32x2){0u, 0u};
        }
        {
            const bf16x8_t c0f = ldfrag(Cm, lrow, LD64, 8 * l4), c1f = ldfrag(Cm, lrow, LD64, 32 + 8 * l4);
            const float ea = __expf(al); const int nks = (w >> 1) + 1;
            float ssq = 0.f;
            bf16x8_t mf[4];
#pragma unroll
            for (int ks = 0; ks < 4; ++ks) mf[ks] = (ks < nks) ? ldfrag(Mt, lrow, LD128, 32 * ks + 8 * l4) : (bf16x8_t){0, 0, 0, 0, 0, 0, 0, 0};
#pragma unroll
            for (int jt = 0; jt < 4; ++jt) {
                bf16x8_t hb0 = ldfrag(Hb, 16 * jt + l15, LD64, 8 * l4), hb1 = ldfrag(Hb, 16 * jt + l15, LD64, 32 + 8 * l4), xd[4];
#pragma unroll
                for (int ks = 0; ks < 4; ++ks) if (ks < nks) xd[ks] = ldfrag(XdtT, 16 * jt + l15, LD128, 32 * ks + 8 * l4);
                f32x4 acc = (f32x4){0.f, 0.f, 0.f, 0.f};
                acc = __builtin_amdgcn_mfma_f32_16x16x32_bf16(hb0, c0f, acc, 0, 0, 0);
                acc = __builtin_amdgcn_mfma_f32_16x16x32_bf16(hb1, c1f, acc, 0, 0, 0);
                acc = acc * ea;
#pragma unroll
                for (int ks = 0; ks < 4; ++ks) if (ks < nks) acc = __builtin_amdgcn_mfma_f32_16x16x32_bf16(xd[ks], mf[ks], acc, 0, 0, 0);
                const int p0 = 16 * jt + 4 * l4;
                const u32x2 xb = *(const u32x2*)(xs + lrow * LD64 + p0);
                const u32x2 zb = zc[jt];
                const float x0 = __uint_as_float(xb.x << 16), x1 = __uint_as_float(xb.x & 0xffff0000u), x2 = __uint_as_float(xb.y << 16), x3 = __uint_as_float(xb.y & 0xffff0000u);
                const float z0 = __uint_as_float(zb.x << 16), z1 = __uint_as_float(zb.x & 0xffff0000u), z2 = __uint_as_float(zb.y << 16), z3 = __uint_as_float(zb.y & 0xffff0000u);
                f32x4 y; y[0] = (acc[0] + Dh * x0) * silu(z0); y[1] = (acc[1] + Dh * x1) * silu(z1); y[2] = (acc[2] + Dh * x2) * silu(z2); y[3] = (acc[3] + Dh * x3) * silu(z3);
                u32x2 yo; yo.x = pg8::cvt_pk_bf16(y[0], y[1]); yo.y = pg8::cvt_pk_bf16(y[2], y[3]);
                *(u32x2*)(ASb + (rbase + lrow) * 1024 + h * 64 + p0) = yo;
                ssq += (y[0] * y[0] + y[1] * y[1]) + (y[2] * y[2] + y[3] * y[3]);
            }
            ssq += __shfl_xor(ssq, 16); ssq += __shfl_xor(ssq, 32);
            if (l4 == 0) SSQP[(rbase + lrow) * 8 + h] = ssq;
        }
        __syncthreads();
        {
            const float el = __expf(alast);
            bf16x8_t xf[4];
#pragma unroll
            for (int ks = 0; ks < 4; ++ks) xf[ks] = ldfrag(XdtT, 16 * pt + l15, LD128, 32 * ks + 8 * l4);
#pragma unroll
            for (int i = 0; i < 2; ++i) {
                bf16x8_t bd[4];
#pragma unroll
                for (int ks = 0; ks < 4; ++ks) bd[ks] = ldfrag(BdT, 16 * (ntb + i) + l15, LD128, 32 * ks + 8 * l4);
                f32x4 acc = Hacc[i] * el;
#pragma unroll
                for (int ks = 0; ks < 4; ++ks) acc = __builtin_amdgcn_mfma_f32_16x16x32_bf16(xf[ks], bd[ks], acc, 0, 0, 0);
                Hacc[i] = acc;
#pragma unroll
                for (int r = 0; r < 4; ++r) Hb[(16 * pt + 4 * l4 + r) * LD64 + 16 * (ntb + i) + l15] = f2bf(acc[r]);
            }
        }
#pragma unroll
        for (int jt = 0; jt < 4; ++jt) zc[jt] = zn[jt];
    }
    __syncthreads();
#undef SSD_PREFETCH
#undef SSD_LOADRAW
}

__device__ __forceinline__ void dsa_expand_masks(int qb, unsigned char* lds, int tid) {
    const int NTr = (qb * 32 + 32 + 63) / 64, NTt = (NTr < 4) ? 4 : ((NTr + 1) & ~1);
    const unsigned* maskw = (const unsigned*)(lds + DSA_MASK_OFF);
    for (int it = tid; it < NTt * 128; it += NT) {
        const int t = it >> 7, q = (it >> 2) & 31, c = it & 3, hi = c >> 1, half = c & 1;
        const unsigned w = maskw[q * DSA_MASK_STRIDE + 2 * t + half] >> (4 * hi);
        u32x4 o;
#pragma unroll
        for (int g2 = 0; g2 < 4; ++g2) { const unsigned n = (w >> (8 * g2)) & 0xfu; o[g2] = ((n * 0x00204081u) & 0x01010101u) * 0xffu; }
        *(u32x4*)(lds + DSA_BMASK_OFF + (t * 32 + q) * 64 + ((c + (q >> 2)) & 3) * 16) = o;
    }
    __syncthreads();
}

struct MoeOrder {
    int n; const LAS int* ul;
    __device__ __forceinline__ bool next(int i, pg8::Unit& u) const { if (i >= n) return false; u.pm = ul[2 * i]; u.pn = ul[2 * i + 1]; return true; }
    __device__ __forceinline__ void a_ready(const pg8::Unit&) const {}
    __device__ __forceinline__ void done(const pg8::Unit&) const {}
};
struct EpiSwiGLU {
    static constexpr bool PERM = true, AFTER_DRAIN = false; static constexpr int MID_T = 0;
    bf16* Hid;
    __device__ __forceinline__ void operator()(const pg8::f32x4 (&acc)[2][2][4][2], const pg8::Unit& u, int wr, int wc, int fr, int fq) const {
        const int row0 = u.pm * 256 + wr * 64 + fr, pl = u.pn & 1, hc = 128 * pl + 16 * wc + 4 * fq;
#pragma unroll
        for (int ai = 0; ai < 2; ++ai)
#pragma unroll
            for (int m = 0; m < 4; ++m) { const int row = row0 + ai * 128 + m * 16;
#pragma unroll
                for (int bj = 0; bj < 2; ++bj) { const f32x4 g = acc[ai][bj][m][0], uu = acc[ai][bj][m][1]; f32x4 h;
#pragma unroll
                    for (int e = 0; e < 4; ++e) h[e] = silu(g[e]) * uu[e];
                    u32x2 w; w.x = pg8::cvt_pk_bf16(h[0], h[1]); w.y = pg8::cvt_pk_bf16(h[2], h[3]);
                    *(u32x2*)(Hid + (size_t)row * EFF + hc + 64 * bj) = w; } }
    }
};
struct EpiDown {
    static constexpr bool PERM = true, AFTER_DRAIN = false; static constexpr int MID_T = 0;
    const int* DSTI; const float* WGT; bf16* Y;
    __device__ __forceinline__ void operator()(const pg8::f32x4 (&acc)[2][2][4][2], const pg8::Unit& u, int wr, int wc, int fr, int fq) const {
        const int row0 = u.pm * 256 + wr * 64 + fr, col0 = (u.pn & 3) * 256 + 32 * wc + 8 * fq;
#pragma unroll
        for (int ai = 0; ai < 2; ++ai)
#pragma unroll
            for (int m = 0; m < 4; ++m) { const int row = row0 + ai * 128 + m * 16; const unsigned di = (unsigned)DSTI[row]; const float w = WGT[row];
                bf16* Yr = Y + (size_t)di * DM + col0;
#pragma unroll
                for (int bj = 0; bj < 2; ++bj) { const f32x4 a = acc[ai][bj][m][0] * w, b = acc[ai][bj][m][1] * w;
                    u32x4 o; o.x = pg8::cvt_pk_bf16(a[0], a[1]); o.y = pg8::cvt_pk_bf16(a[2], a[3]); o.z = pg8::cvt_pk_bf16(b[0], b[1]); o.w = pg8::cvt_pk_bf16(b[2], b[3]);
                    *(u32x4*)(Yr + 128 * bj) = o; }
                asm volatile("" ::: "memory"); }
    }
};


__device__ __forceinline__ unsigned wave_select(const unsigned (&keys)[32], int kk, int lane) {
    unsigned T = 0u;
    for (int bit = 31; bit >= 0; --bit) {
        const unsigned cand = T | (1u << bit);
        int c = 0;
#pragma unroll
        for (int i = 0; i < 32; ++i) c += (keys[i] >= cand) ? 1 : 0;
#pragma unroll
        for (int o = 1; o < 64; o <<= 1) c += __shfl_xor(c, o);
        if (c >= kk) T = cand;
    }
    unsigned mgt = 0u, meq = 0u;
#pragma unroll
    for (int i = 0; i < 32; ++i) { mgt |= (keys[i] > T) ? (1u << i) : 0u; meq |= (keys[i] == T) ? (1u << i) : 0u; }
    int ngt = __popc(mgt), neq = __popc(meq);
    int tgt = ngt, teq = neq;
#pragma unroll
    for (int o = 1; o < 64; o <<= 1) { tgt += __shfl_xor(tgt, o); teq += __shfl_xor(teq, o); }
    const int need = kk - tgt;
    if (teq == need) return mgt | meq;
    int pre = neq;
#pragma unroll
    for (int o = 1; o < 64; o <<= 1) { const int v = __shfl_up(pre, o); if (lane >= o) pre += v; }
    pre -= neq;
    unsigned sel = mgt; int taken = pre;
#pragma unroll
    for (int i = 0; i < 32; ++i) { if ((meq >> i) & 1u) { if (taken < need) sel |= (1u << i); ++taken; } }
    return sel;
}

#define XB_TMO      128
#define XB_XCNT(j)  (256  + 64 * (j))
#define XB_XSUB(j)  (1280 + 64 * (j))
#define XB_XGEN(j)  (2304 + 64 * (j))
#define XB_TOP      3328
#define XB_TOPGEN   3392
#define XCD_BAR_WORDS 3456
#define XB_SPIN_CAP (1u << 18)

__device__ __forceinline__ unsigned xb_ld(unsigned* p)              { return __hip_atomic_load(p, __ATOMIC_RELAXED, __HIP_MEMORY_SCOPE_AGENT); }
__device__ __forceinline__ unsigned xb_add(unsigned* p, unsigned v) { return __hip_atomic_fetch_add(p, v, __ATOMIC_RELAXED, __HIP_MEMORY_SCOPE_AGENT); }
__device__ __forceinline__ unsigned xb_xcc_id() { return (unsigned)__builtin_amdgcn_s_getreg((3 << 11) | 20) & 0xFu; }
#define XB_SPIN(cond, bar) do { unsigned _sp = 0; while (cond) { __builtin_amdgcn_s_sleep(1); \
    if ((++_sp & 255u) == 0u) { if (xb_ld(&(bar)[XB_TMO])) break; if (_sp > XB_SPIN_CAP) { atomicAdd(&(bar)[XB_TMO], 1u); break; } } } } while (0)

struct XcdBarrier {
    unsigned* bar; unsigned x;
    volatile LAS unsigned* st;
};

__device__ __forceinline__ XcdBarrier xcd_barrier_post(unsigned* bar, volatile LAS unsigned* st, const int wave_s) {
    XcdBarrier b; b.bar = bar; b.x = xb_xcc_id(); b.st = st;
    if (wave_s == 0 && lane_id() == 0) (void)xb_add(&bar[XB_XCNT(b.x)], 1u);
    return b;
}
__device__ __forceinline__ void xcd_barrier_complete(unsigned* bar, unsigned x, unsigned& nloc, unsigned& nx) {
    const unsigned G = gridDim.x * gridDim.y * gridDim.z;
    unsigned sum, cnt, mine, sp = 0u;
    for (;;) {
        sum = 0u; cnt = 0u; mine = 0u;
#pragma unroll
        for (unsigned j = 0; j < 16; ++j) { const unsigned c = xb_ld(&bar[XB_XCNT(j)]); sum += c; cnt += (c > 0u) ? 1u : 0u; mine = (j == x) ? c : mine; }
        if (sum == G) break;
        __builtin_amdgcn_s_sleep(1);
        if ((++sp & 255u) == 0u) { if (xb_ld(&bar[XB_TMO])) break; if (sp > XB_SPIN_CAP) { atomicAdd(&bar[XB_TMO], 1u); break; } }
    }
    nloc = mine > 0u ? mine : 1u; nx = cnt > 0u ? cnt : 1u;
}

__device__ __forceinline__ void xcd_barrier(const XcdBarrier& b, const int wave_s) {
    asm volatile("s_waitcnt vmcnt(0)" ::: "memory");
    __syncthreads();
    if (wave_s == 0 && lane_id() == 0) {
        unsigned* bar = b.bar;
        __builtin_amdgcn_s_waitcnt(0);
        unsigned nloc = b.st[0], nx = b.st[1];
        if (nloc == 0u) { xcd_barrier_complete(bar, b.x, nloc, nx); b.st[0] = nloc; b.st[1] = nx; }
        const unsigned old = xb_add(&bar[XB_XSUB(b.x)], 1u);
        const unsigned gen = old / nloc;
        if (old + 1u == (gen + 1u) * nloc) {
            __builtin_amdgcn_fence(__ATOMIC_RELEASE, "agent");
            asm volatile("s_waitcnt vmcnt(0)" ::: "memory");
            const unsigned og = xb_add(&bar[XB_TOP], 1u);
            const unsigned tg = og / nx;
            if (og + 1u == (tg + 1u) * nx) xb_add(&bar[XB_TOPGEN], 1u);
            else XB_SPIN(xb_ld(&bar[XB_TOPGEN]) == tg, bar);
            __builtin_amdgcn_fence(__ATOMIC_ACQUIRE, "agent");
            xb_add(&bar[XB_XGEN(b.x)], 1u);
            asm volatile("s_waitcnt vmcnt(0)" ::: "memory");
        } else {
            XB_SPIN(xb_ld(&bar[XB_XGEN(b.x)]) == gen, bar);
            __builtin_amdgcn_fence(__ATOMIC_ACQUIRE, "agent");
            asm volatile("s_waitcnt vmcnt(0)" ::: "memory");
        }
    }
    __syncthreads();
}


#define PHASE_VARS const KPtr P = launder_k(KP0); const int wave = wave_s, lane = launder_i(lane_id()), tid = wave * 64 + lane, gw = bid * 8 + wave; unsigned char* ws = P->ws; unsigned* ctl = (unsigned*)(ws + WS_CTL); float2* rope = (float2*)(ws + WS_ROPE); float* tokw = (float*)(ws + WS_TOKW); int* lists = (int*)(ws + WS_LISTS); bf16* Qb = (bf16*)(ws + WS_Q); bf16* Kb = (bf16*)(ws + WS_K); bf16* Vb = (bf16*)(ws + WS_V); bf16* IKb = (bf16*)(ws + WS_IK); float* IW = (float*)(ws + WS_IW); float* DT = (float*)(ws + WS_DT); bf16* IQb = (bf16*)(ws + WS_IQ); bf16* Zb = (bf16*)(ws + WS_Z); bf16* XBC = (bf16*)(ws + WS_XBC); bf16* ASb = (bf16*)(ws + WS_AS); float* X1 = (float*)(ws + WS_X1); bf16* X1b = (bf16*)(ws + WS_X1B); bf16* Y0 = (bf16*)(ws + WS_Y0); bf16* Y1 = (bf16*)(ws + WS_Y1); float* SSQP = (float*)(ws + WS_SSQP); bf16* BCc = (bf16*)(ws + WS_BCC); bf16* H1b = (bf16*)(ws + WS_X1); float* WGG = (float*)(ws + WS_RCONST + 4096); bf16* WguT = (bf16*)(ws + WS_WGU_T); bf16* WdT = (bf16*)(ws + WS_WD_T); int* ENT = (int*)(ws + WS_ENT); float* WGT = (float*)(ws + WS_ENT + 512 * 1024); int* ROWT = (int*)(ws + WS_ENT + 1024 * 1024); bf16* Xs = (bf16*)(ws + WS_XS); bf16* Hid = (bf16*)(ws + WS_HID); bf16* XB = (bf16*)(ws + WS_XB); bf16* WinT = (bf16*)(ws + WS_WIN_T); bf16* WoutT = (bf16*)(ws + WS_WOUT_T);
#ifndef PROBE_MASK
#define PROBE_MASK 0
#endif
#define STAMP(k) do { if (PROBE_MASK && bid == 0 && wave_s == 0 && lane_id() == 0) { const unsigned long long now_ = __builtin_amdgcn_s_memrealtime(); if ((PROBE_MASK >> (k)) & 1) pst[1] += now_ - pst[0]; pst[0] = now_; } } while (0)
__global__ void __launch_bounds__(NT, 2) hybrid_fwd(Params p) {
    extern __shared__ __attribute__((aligned(16))) unsigned char lds[];
    cg::grid_group grid = cg::this_grid();
    const int wave_s = __builtin_amdgcn_readfirstlane((int)threadIdx.x >> 6);
    const int G = gridDim.x, bid = blockIdx.x, NGW = G * 8;
    const KPtr KP0 = (KPtr)__builtin_amdgcn_kernarg_segment_ptr();
    volatile LAS unsigned* xst = (volatile LAS unsigned*)((LAS unsigned char*)lds + LDS_BYTES - 32);
    if (wave_s == 0 && lane_id() < 4) xst[lane_id()] = 0u;
    __syncthreads();
    const XcdBarrier xbar = xcd_barrier_post((unsigned*)(KP0->ws + WS_CTL) + CW_BAR, xst, wave_s);
    if (KP0->ws == nullptr) grid.sync();
#define GRID_SYNC() xcd_barrier(xbar, wave_s)
    volatile LAS unsigned long long* pst = (volatile LAS unsigned long long*)((LAS unsigned char*)lds + LDS_BYTES - 96);
    if (PROBE_MASK && bid == 0 && wave_s == 0 && lane_id() == 0) { pst[0] = __builtin_amdgcn_s_memrealtime(); pst[1] = 0ull; }
    {   PHASE_VARS
    for (int e = bid * NT + tid; e < SEQ * 32; e += G * NT) {
        const int t = e >> 5, i = e & 31;
        const float inv = powf(10000.0f, -(float)(2 * i) / 64.0f);
        const float ang = (float)t * inv;
        float s, c; sincosf(ang, &s, &c);
        rope[e] = make_float2(c, s);
    }
    for (int e = bid * NT + tid; e < 52 * 128; e += G * NT) {
        const int r = e >> 7, c = e & 127; const int row = (r < 4) ? (512 + 196 + r) : (512 + 208 + (r - 4));
        *(u32x4*)(WinT + (size_t)row * DM + c * 8) = (u32x4){0u, 0u, 0u, 0u};
    }
    {
        LAS float* scr = (LAS float*)((LAS unsigned char*)lds + wave * 16384);
        constexpr int I_IN = (DM / 64) * ((INW + 31) / 32), I_OUT = (DM / 64) * (DM / 32), I_GU = NEXP * 2 * 128, I_D = NEXP * 128;
        for (int it = launder_i(gw); it < I_IN; it += NGW) {
            int r = it;
            if (r < I_IN) { transpose_item(P->w_in, DM, INW, WinT, scr, r, lane, [](int c) { return win_dest_row(c); }, [](int k, float&) { return k; }); continue; } r -= I_IN;
        }
    }
    for (int e = bid * NT + tid; e < DM * 20; e += G * NT) { const int k = e / 20, j = e - k * 20; WGG[e] = P->ln1_g[k] * ((j < 4) ? P->w_rg[k * 4 + j] : P->w_re[k * 16 + (j - 4)]); }
    if (wave == 0 && bid >= G - 20) {
        float* rc = (float*)(ws + WS_RCONST); const int j = G - 1 - bid;
        float wv[16], gv[16], bv[16];
#pragma unroll
        for (int i = 0; i < 16; ++i) { const int k = lane + 64 * i; wv[i] = (j < 4) ? P->w_rg[k * 4 + j] : P->w_re[k * 16 + (j - 4)]; gv[i] = P->ln1_g[k]; bv[i] = P->ln1_b[k]; }
        float gs = 0.f, bs = 0.f;
#pragma unroll
        for (int i = 0; i < 16; ++i) { gs = fmaf(gv[i], wv[i], gs); bs = fmaf(bv[i], wv[i], bs); }
        gs = wave_sum(gs); bs = wave_sum(bs);
        if (lane == 0) { rc[j] = gs; rc[20 + j] = bs + ((j < 4) ? P->b_rg[j] : P->b_re[j - 4]); }
    }
    {
        const size_t NP = (size_t)M * DM / 8, stride = (size_t)G * NT;
        for (size_t e0 = (size_t)bid * NT + tid; e0 < NP; e0 += 8 * stride) {
            f32x4 a[8], b[8];
#pragma unroll
            for (int u = 0; u < 8; ++u) { const size_t e = e0 + u * stride; if (e < NP) { a[u] = __builtin_nontemporal_load((const f32x4*)(P->x + e * 8)); b[u] = __builtin_nontemporal_load((const f32x4*)(P->x + e * 8 + 4)); } }
#pragma unroll
            for (int u = 0; u < 8; ++u) { const size_t e = e0 + u * stride; if (e < NP) {
                u32x4 w; w.x = pg8::cvt_pk_bf16(a[u][0], a[u][1]); w.y = pg8::cvt_pk_bf16(a[u][2], a[u][3]); w.z = pg8::cvt_pk_bf16(b[u][0], b[u][1]); w.w = pg8::cvt_pk_bf16(b[u][2], b[u][3]);
                *(u32x4*)(XB + e * 8) = w; } }
        }
    }
    }
    GRID_SYNC(); STAMP(0);
    {   PHASE_VARS
    {
        pg8::Gemm g{XB, WinT, M, NPAD, DM}; pg8::StaticOrder S; S.init(M, NPAD, G, bid);
        EpiInProj E{Qb, Kb, Vb, IKb, IQb, Zb, XBC, IW, DT, rope};
        pg8::gemm_phase<EpiInProj, pg8::StaticOrder, true, true>((PG8_LAS unsigned char*)lds, g, S, E, wave_s);
    }
    }
    GRID_SYNC(); STAMP(1);
    {   PHASE_VARS
    {
        const int cgp = tid & 15;
        float cwr[4][16], cbr[16];
#pragma unroll
        for (int i = 0; i < 16; ++i) { cbr[i] = P->conv_b[512 + 16 * cgp + i];
#pragma unroll
            for (int j = 0; j < 4; ++j) cwr[j][i] = P->conv_w[j * 768 + 512 + 16 * cgp + i]; }
        const int NI = M * 16, stride = G * NT;
        for (int it0 = bid * NT + tid; it0 < NI; it0 += 4 * stride) {
            u32x4 u[4][4][2];
#pragma unroll
            for (int q = 0; q < 4; ++q) { const int it = it0 + q * stride; if (it < NI) { const int row = it >> 4; const bf16* xr = XBC + (size_t)row * 768 + 512 + 16 * cgp;
#pragma unroll
                for (int j = 0; j < 4; ++j) { u[q][j][0] = *(const u32x4*)(xr + (j - 3) * 768); u[q][j][1] = *(const u32x4*)(xr + (j - 3) * 768 + 8); } } }
#pragma unroll
            for (int q = 0; q < 4; ++q) { const int it = it0 + q * stride; if (it < NI) { const int row = it >> 4, t = row & (SEQ - 1);
                float v[16];
#pragma unroll
                for (int i = 0; i < 16; ++i) v[i] = cbr[i];
#pragma unroll
                for (int j = 0; j < 4; ++j) if (t - 3 + j >= 0) {
#pragma unroll
                    for (int i = 0; i < 16; ++i) { const unsigned wd = u[q][j][i >> 3][(i >> 1) & 3]; const float xv = (i & 1) ? __uint_as_float(wd & 0xffff0000u) : __uint_as_float(wd << 16); v[i] = fmaf(cwr[j][i], xv, v[i]); } }
#pragma unroll
                for (int i = 0; i < 16; ++i) v[i] = silu(v[i]);
                u32x4 o0, o1; o0.x = pg8::cvt_pk_bf16(v[0], v[1]); o0.y = pg8::cvt_pk_bf16(v[2], v[3]); o0.z = pg8::cvt_pk_bf16(v[4], v[5]); o0.w = pg8::cvt_pk_bf16(v[6], v[7]);
                o1.x = pg8::cvt_pk_bf16(v[8], v[9]); o1.y = pg8::cvt_pk_bf16(v[10], v[11]); o1.z = pg8::cvt_pk_bf16(v[12], v[13]); o1.w = pg8::cvt_pk_bf16(v[14], v[15]);
                *(u32x4*)(BCc + (size_t)row * 256 + 16 * cgp) = o0; *(u32x4*)(BCc + (size_t)row * 256 + 16 * cgp + 8) = o1; } }
        }
    }
    }
    GRID_SYNC(); STAMP(22);
    {   PHASE_VARS
    for (int item = bid; item < BATCH * 8; item += G) ssd_item(__builtin_amdgcn_readfirstlane(item >> 3), __builtin_amdgcn_readfirstlane(item & 7), P, XBC, BCc, DT, Zb, ASb, SSQP, lds, tid);
    {
        volatile int* qslot = (volatile int*)(lds + LDS_BYTES - 64);
        const unsigned xcc = (unsigned)__builtin_amdgcn_s_getreg((3 << 11) | 20) & 7u;
        for (;;) {
            __syncthreads();
            if (tid == 0) { int pi = -1;
                for (unsigned a = 0; a < 8 && pi < 0; ++a) { const unsigned q = (xcc + a) & 7u; const unsigned idx = atomicAdd(&ctl[CW_DSAQ + 16 * q], 1u); if (idx < 128u) pi = (int)(q * 128u + idx); }
                *qslot = pi; }
            __syncthreads();
            const int pi = __builtin_amdgcn_readfirstlane(*qslot); if (pi < 0) break;
            const int q = pi >> 7, idx = pi & 127, b = q + 8 * (idx & 1), qb = 63 - (idx >> 1);
            dsa_select(b, qb, IQb, IKb, IW, lds, lane, wave_s, &ctl[CW_ERR]);
            dsa_expand_masks(qb, lds, wave_s * 64 + launder_i(lane_id()));
            attn_body::attn_unit<8>(b, qb, Qb, Kb, Vb, ASb, (char*)lds, (const char*)lds + DSA_BMASK_OFF, wave_s);
        }
    }
    __syncthreads();
    {
        LAS float* scr = (LAS float*)((LAS unsigned char*)lds + wave * 16384);
        constexpr int I_OUT = (DM / 64) * (DM / 32), I_GU = NEXP * 2 * 128, I_D = NEXP * 128, I_ALL = I_OUT + I_GU + I_D;
        for (;;) {
            int base = 0; if (lane == 0) base = (int)atomicAdd(&ctl[CW_WQ], 8u);
            base = __builtin_amdgcn_readfirstlane(base); if (base >= I_ALL) break;
            for (int it = base; it < base + 8 && it < I_ALL; ++it) {
                int r = it;
                if (r < I_OUT) { { const float* nw = P->ssd_norm_w; transpose_item(P->w_out, DM, DM, WoutT, scr, r, lane, [](int c) { return c; }, [nw](int k, float& sc) { if (k < 512) { sc = nw[k]; return k + 512; } return k - 512; }); } continue; } r -= I_OUT;
                if (r < I_GU) { const int e = r >> 8, up = (r >> 7) & 1, sub = r & 127; const float* W = (up ? P->w_up : P->w_gate) + (size_t)e * DM * EFF;
                transpose_item(W, DM, EFF, WguT + (size_t)e * 512 * DM, scr, sub, lane, [up](int c) { return 8 * (c >> 2) + 4 * up + (c & 3); }, [](int k, float&) { return k; }); continue; } r -= I_GU;
                { const int e = r >> 7, sub = r & 127; transpose_item(P->w_down + (size_t)e * EFF * DM, EFF, DM, WdT + (size_t)e * DM * EFF, scr, sub, lane, [](int c) { return c; }, [](int k, float&) { return k; }); }
            }
        }
    }
    }
    GRID_SYNC(); STAMP(2);
    {   PHASE_VARS
    {
        pg8::Gemm g{ASb, WoutT, M, DM, DM}; pg8::StaticOrder S; S.init(M, DM, G, bid);
        EpiH1 E{P->x, H1b, SSQP};
        pg8::gemm_phase<EpiH1, pg8::StaticOrder, true, true>((PG8_LAS unsigned char*)lds, g, S, E, wave_s);
    }
    }
    GRID_SYNC(); STAMP(4);
    {   PHASE_VARS
    {
        float* Wg = (float*)lds;
        int* lcnt = (int*)(lds + 81920); int* lbase = lcnt + 16; int* rec = lbase + 16;
        float* recw = (float*)(rec + 4 * 128);
        float* rlg = recw + 2 * 128;
        float* rstat = rlg + 20 * 128;
        { f32x4 t4[10];
#pragma unroll
          for (int i = 0; i < 10; ++i) t4[i] = ((const f32x4*)WGG)[tid + NT * i];
#pragma unroll
          for (int i = 0; i < 10; ++i) ((f32x4*)Wg)[tid + NT * i] = t4[i]; }
        if (tid < 16) lcnt[tid] = 0;
        __syncthreads();
        const int rows_per_wave = M / NGW;
        const int l15 = lane & 15, ph = lane >> 4;
        {
            const bf16* hr = H1b + (size_t)(gw + NGW * l15) * DM + 4 * ph;
            const float* wb0 = Wg + (4 * ph) * 20 + l15; const float* wb1 = Wg + (4 * ph) * 20 + 16 + (l15 < 4 ? l15 : 3);
            f32x4 c0 = (f32x4){0.f, 0.f, 0.f, 0.f}, c1 = c0; float s = 0.f, ss = 0.f;
            u32x2 an[8];
#pragma unroll
            for (int u = 0; u < 8; ++u) an[u] = *(const u32x2*)(hr + 16 * u);
#pragma unroll 1
            for (int i0 = 0; i0 < 64; i0 += 8) {
                f32x4 a[8];
#pragma unroll
                for (int u = 0; u < 8; ++u) { a[u][0] = __uint_as_float(an[u].x << 16); a[u][1] = __uint_as_float(an[u].x & 0xffff0000u); a[u][2] = __uint_as_float(an[u].y << 16); a[u][3] = __uint_as_float(an[u].y & 0xffff0000u); }
                if (i0 + 8 < 64) {
#pragma unroll
                    for (int u = 0; u < 8; ++u) an[u] = *(const u32x2*)(hr + 16 * (i0 + 8 + u)); }
#pragma unroll
                for (int u = 0; u < 8; ++u) {
                    s += (a[u][0] + a[u][1]) + (a[u][2] + a[u][3]); ss += (a[u][0] * a[u][0] + a[u][1] * a[u][1]) + (a[u][2] * a[u][2] + a[u][3] * a[u][3]);
#pragma unroll
                    for (int e = 0; e < 4; ++e) { const int ko = (16 * (i0 + u) + e) * 20;
                        c0 = __builtin_amdgcn_mfma_f32_16x16x4f32(a[u][e], wb0[ko], c0, 0, 0, 0);
                        c1 = __builtin_amdgcn_mfma_f32_16x16x4f32(a[u][e], wb1[ko], c1, 0, 0, 0); }
                }
            }
            { const int ln2 = launder_i(lane); const int i16 = (ln2 ^ 16) << 2, i32 = (ln2 ^ 32) << 2;
              s += __builtin_bit_cast(float, __builtin_amdgcn_ds_bpermute(i16, __builtin_bit_cast(int, s))); s += __builtin_bit_cast(float, __builtin_amdgcn_ds_bpermute(i32, __builtin_bit_cast(int, s)));
              ss += __builtin_bit_cast(float, __builtin_amdgcn_ds_bpermute(i16, __builtin_bit_cast(int, ss))); ss += __builtin_bit_cast(float, __builtin_amdgcn_ds_bpermute(i32, __builtin_bit_cast(int, ss))); }
            const float mean = s * (1.f / DM), var = ss * (1.f / DM) - mean * mean;
            if (ph == 0) { rstat[(wave * 16 + l15) * 2] = mean; rstat[(wave * 16 + l15) * 2 + 1] = rsqrtf(var + LN_EPS); }
#pragma unroll
            for (int r = 0; r < 4; ++r) { const int rl = wave * 16 + 4 * ph + r; rlg[rl * 20 + l15] = c0[r]; if (l15 < 4) rlg[rl * 20 + 16 + l15] = c1[r]; }
        }
        __syncthreads();
        {
            f32x4 gg[4], bb[4];
#pragma unroll
            for (int j = 0; j < 4; ++j) { gg[j] = *(const f32x4*)(P->ln1_g + lane * 4 + 256 * j); bb[j] = *(const f32x4*)(P->ln1_b + lane * 4 + 256 * j); }
            for (int it = 0; it < rows_per_wave; it += 4) {
                f32x4 v[4][4];
#pragma unroll
                for (int r = 0; r < 4; ++r)
#pragma unroll
                    for (int j = 0; j < 4; ++j) { const u32x2 hb = *(const u32x2*)(H1b + (size_t)(gw + NGW * (it + r)) * DM + lane * 4 + 256 * j);
                        v[r][j][0] = __uint_as_float(hb.x << 16); v[r][j][1] = __uint_as_float(hb.x & 0xffff0000u); v[r][j][2] = __uint_as_float(hb.y << 16); v[r][j][3] = __uint_as_float(hb.y & 0xffff0000u); }
#pragma unroll
                for (int r = 0; r < 4; ++r) { const float mean = rstat[(wave * 16 + it + r) * 2], rstd = rstat[(wave * 16 + it + r) * 2 + 1];
#pragma unroll
                    for (int j = 0; j < 4; ++j) { const f32x4 o = (v[r][j] - mean) * rstd * gg[j] + bb[j]; u32x2 w; w.x = pg8::cvt_pk_bf16(o[0], o[1]); w.y = pg8::cvt_pk_bf16(o[2], o[3]);
                        *(u32x2*)(X1b + (size_t)(gw + NGW * (it + r)) * DM + lane * 4 + 256 * j) = w; } }
            }
        }
        const float* rc = (const float*)(ws + WS_RCONST);
        for (int rl = tid; rl < 8 * rows_per_wave; rl += NT) {
            const float mean = rstat[rl * 2], rstd = rstat[rl * 2 + 1];
            float lg[20];
#pragma unroll
            for (int j = 0; j < 20; ++j) lg[j] = rstd * (rlg[rl * 20 + j] - mean * rc[j]) + rc[20 + j];
            int gi = 0; float gm = lg[0];
#pragma unroll
            for (int i = 1; i < 4; ++i) if (lg[i] > gm) { gm = lg[i]; gi = i; }
            float gs = 0.f;
#pragma unroll
            for (int i = 0; i < 4; ++i) gs += __expf(lg[i] - gm);
            const float gprob = 1.f / gs;
            float el[4];
#pragma unroll
            for (int i = 0; i < 4; ++i) { float v0 = 0.f;
#pragma unroll
                for (int g2 = 0; g2 < 4; ++g2) if (g2 == gi) v0 = lg[4 + g2 * 4 + i];
                el[i] = v0; }
            int i0 = 0; float m0 = el[0];
#pragma unroll
            for (int i = 1; i < 4; ++i) if (el[i] > m0) { m0 = el[i]; i0 = i; }
            int i1 = -1; float m1 = -INFINITY;
#pragma unroll
            for (int i = 0; i < 4; ++i) if (i != i0 && el[i] > m1) { m1 = el[i]; i1 = i; }
            const float e1 = __expf(m1 - m0), inv = 1.f / (1.f + e1);
            const int ex0 = gi * 4 + i0, ex1 = gi * 4 + i1;
            rec[rl * 4 + 0] = ex0; rec[rl * 4 + 1] = atomicAdd(&lcnt[ex0], 1); rec[rl * 4 + 2] = ex1; rec[rl * 4 + 3] = atomicAdd(&lcnt[ex1], 1);
            recw[rl * 2] = inv * gprob; recw[rl * 2 + 1] = e1 * inv * gprob;
        }
        __syncthreads();
        if (tid < 16) lbase[tid] = (int)atomicAdd(&ctl[CW_CNT + 64 * tid], (unsigned)lcnt[tid]);
        __syncthreads();
        for (int rl = tid; rl < 8 * rows_per_wave; rl += NT) {
            const int row = (bid * 8 + rl / rows_per_wave) + NGW * (rl % rows_per_wave);
            const int e0 = rec[rl * 4], e1x = rec[rl * 4 + 2];
            lists[(size_t)e0 * M + lbase[e0] + rec[rl * 4 + 1]] = row * 2; lists[(size_t)e1x * M + lbase[e1x] + rec[rl * 4 + 3]] = row * 2 + 1;
            tokw[row * 2] = recw[rl * 2]; tokw[row * 2 + 1] = recw[rl * 2 + 1];
        }
    }
    }
    GRID_SYNC(); STAMP(5);
    {   PHASE_VARS
    int* tb = (int*)(lds + 135168);
    if (tid < NEXP) tb[32 + tid] = (int)((__hip_atomic_load(&ctl[CW_CNT + 64 * tid], __ATOMIC_RELAXED, __HIP_MEMORY_SCOPE_AGENT) + 255u) >> 8);
    __syncthreads();
    if (tid == 0) { int a = 0; for (int e = 0; e < NEXP; ++e) { tb[e] = a; a += tb[32 + e]; } tb[NEXP] = a; }
    __syncthreads();
    const int ntiles = tb[NEXP];
    for (int sr = bid * NT + tid; sr < ntiles * 256; sr += G * NT) {
        const int rt = sr >> 8; int e = 0;
#pragma unroll
        for (int j = 1; j < NEXP; ++j) if (rt >= tb[j]) e = j;
        const int slot = sr - tb[e] * 256; const int cnt_e = (int)__hip_atomic_load(&ctl[CW_CNT + 64 * e], __ATOMIC_RELAXED, __HIP_MEMORY_SCOPE_AGENT);
        const int en = (slot < cnt_e) ? lists[(size_t)e * M + slot] : -1;
        ENT[sr] = (en >= 0) ? ((en & 1) * M + (en >> 1)) : 2 * M; WGT[sr] = (en >= 0) ? tokw[en] : 0.f;
    }
    {
        LAS int* ul = (LAS int*)((LAS unsigned char*)lds + 135168 + 128); int n = 0;
        if (tid == 0) { for (int L = bid; L < ntiles * 2; L += G) { const int rt = L >> 1; int e = 0; for (int j = 1; j < NEXP; ++j) if (rt >= tb[j]) e = j; ul[2 * n] = rt; ul[2 * n + 1] = e * 2 + (L & 1); ++n; } ul[62] = n; }
        __syncthreads(); n = ul[62];
        LAS int* rtl = (LAS int*)((LAS unsigned char*)lds + 135168 + 512);
        for (int e = tid; e < n * 256; e += NT) { const int rt = ul[2 * (e >> 8)], ex = ul[2 * (e >> 8) + 1] >> 1, slot = (rt - tb[ex]) * 256 + (e & 255);
            const int cnt_e = (int)__hip_atomic_load(&ctl[CW_CNT + 64 * ex], __ATOMIC_RELAXED, __HIP_MEMORY_SCOPE_AGENT); rtl[e] = (slot < cnt_e) ? (lists[(size_t)ex * M + slot] >> 1) : 0; }
        __syncthreads();
        pg8::Gemm g{X1b, WguT, MAXROWS, 512, DM}; MoeOrder S{n, ul};
        EpiSwiGLU E{Hid};
        pg8::gemm_phase<EpiSwiGLU, MoeOrder, true, true, true>((PG8_LAS unsigned char*)lds, g, S, E, wave_s, rtl);
    }
    }
    GRID_SYNC(); STAMP(7);
    {   PHASE_VARS
    const LAS int* tb = (const LAS int*)((LAS unsigned char*)lds + 135168); const int ntiles = tb[NEXP];
    {
        LAS int* ul = (LAS int*)((LAS unsigned char*)lds + 135168 + 128); int n = 0;
        __syncthreads();
        if (tid == 0) { for (int L = bid; L < ntiles * 4; L += G) { const int rt = L >> 2; int e = 0; for (int j = 1; j < NEXP; ++j) if (rt >= tb[j]) e = j; ul[2 * n] = rt; ul[2 * n + 1] = e * 4 + (L & 3); ++n; } ul[62] = n; }
        __syncthreads(); n = ul[62];
        pg8::Gemm g{Hid, WdT, MAXROWS, DM, EFF}; MoeOrder S{n, ul};
        EpiDown E{ENT, WGT, Y0};
        pg8::gemm_phase<EpiDown, MoeOrder, true, true>((PG8_LAS unsigned char*)lds, g, S, E, wave_s);
    }
    }
    GRID_SYNC(); STAMP(8);
    {   PHASE_VARS
    const bool poison = __hip_atomic_load(&ctl[CW_ERR], __ATOMIC_RELAXED, __HIP_MEMORY_SCOPE_AGENT) != 0u; const float qnan = __builtin_nanf("");
    for (int row = launder_i(gw); row < M; row += NGW) {
        f32x4 v[4]; float s = 0.f;
#pragma unroll
        for (int j = 0; j < 4; ++j) { const int c0 = lane * 4 + 256 * j; const u32x2 xb = *(const u32x2*)(X1b + (size_t)row * DM + c0);
            v[j][0] = __uint_as_float(xb.x << 16) * ALPHA; v[j][1] = __uint_as_float(xb.x & 0xffff0000u) * ALPHA; v[j][2] = __uint_as_float(xb.y << 16) * ALPHA; v[j][3] = __uint_as_float(xb.y & 0xffff0000u) * ALPHA;
            const u32x2 a = *(const u32x2*)(Y0 + (size_t)row * DM + c0), b = *(const u32x2*)(Y1 + (size_t)row * DM + c0);
            v[j][0] += __uint_as_float(a.x << 16) + __uint_as_float(b.x << 16); v[j][1] += __uint_as_float(a.x & 0xffff0000u) + __uint_as_float(b.x & 0xffff0000u);
            v[j][2] += __uint_as_float(a.y << 16) + __uint_as_float(b.y << 16); v[j][3] += __uint_as_float(a.y & 0xffff0000u) + __uint_as_float(b.y & 0xffff0000u);
            s += (v[j][0] + v[j][1]) + (v[j][2] + v[j][3]); }
        const float mean = wave_sum(s) * (1.f / DM); float s2 = 0.f;
#pragma unroll
        for (int j = 0; j < 4; ++j) { v[j] = v[j] - mean; s2 += (v[j][0] * v[j][0] + v[j][1] * v[j][1]) + (v[j][2] * v[j][2] + v[j][3] * v[j][3]); }
        const float rstd = rsqrtf(wave_sum(s2) * (1.f / DM) + LN_EPS);
#pragma unroll
        for (int j = 0; j < 4; ++j) { const int c0 = lane * 4 + 256 * j;
            const f32x4 gg = *(const f32x4*)(P->ln2_g + c0), bb = *(const f32x4*)(P->ln2_b + c0);
            f32x4 o = v[j] * rstd * gg + bb; if (poison) o = (f32x4){qnan, qnan, qnan, qnan};
            *(f32x4*)(P->out + (size_t)row * DM + c0) = o; }
    }
    }
    STAMP(9);
    if (PROBE_MASK && bid == 0 && wave_s == 0 && lane_id() == 0) { const unsigned long long t0 = __builtin_amdgcn_s_memrealtime(), d = 8ull * pst[1]; while (__builtin_amdgcn_s_memrealtime() - t0 < d) __builtin_amdgcn_s_sleep(8); }
}

extern "C" void kernel_launch(void* const* d_in, const int* in_sizes, int n_in, void* d_out, int out_size, void* d_ws, size_t ws_size, hipStream_t stream) {
    static int grid = 0;
    if (grid == 0) {
        if (n_in != 20 || in_sizes[0] != M * DM || out_size != M * DM || ws_size < WS_END) { fprintf(stderr, "kernel_launch: unexpected shapes (n_in %d, in0 %d, out %d, ws %zu)\n", n_in, n_in > 0 ? in_sizes[0] : -1, out_size, ws_size); grid = -1; return; }
        int dev = 0, cus = 0, per_cu = 0;
        (void)hipGetDevice(&dev);
        (void)hipDeviceGetAttribute(&cus, hipDeviceAttributeMultiprocessorCount, dev);
        (void)hipFuncSetAttribute((const void*)hybrid_fwd, hipFuncAttributeMaxDynamicSharedMemorySize, LDS_BYTES);
        (void)hipOccupancyMaxActiveBlocksPerMultiprocessor(&per_cu, (const void*)hybrid_fwd, NT, LDS_BYTES);
        if (per_cu < 1) { fprintf(stderr, "kernel_launch: occupancy query says %d blocks/CU\n", per_cu); grid = -1; return; }
        grid = cus;
    }
    if (grid < 0) return;
    (void)hipMemsetAsync((char*)d_ws + WS_CTL, 0, CTL_BYTES, stream);
    Params p{};
    const float** f = (const float**)&p;
    for (int i = 0; i < 20; ++i) f[i] = (const float*)d_in[i];
    p.out = (float*)d_out; p.ws = (unsigned char*)d_ws;
    void* args[] = {&p};
    hipError_t e = hipLaunchCooperativeKernel((const void*)hybrid_fwd, dim3(grid), dim3(NT), args, LDS_BYTES, stream);
    if (e != hipSuccess) fprintf(stderr, "cooperative launch failed: %s (grid %d)\n", hipGetErrorString(e), grid);
}
```
